# Optimizing an MI355X kernel written in HIP

```python
import math
import jax, jax.numpy as jnp
from jax import lax
import numpy as np

D_MODEL = 1024
BATCH = 8
SEQ = 4096
DEPTH = 2

GRID_W = 64
CTX_LEN = 256
HEAD_DIM = 64
GROUP_WIDTH = D_MODEL // 4
D_MIX = 4 * GROUP_WIDTH
BLOCK = 128
WINDOW = 128
A_HEADS = GROUP_WIDTH // HEAD_DIM
A_KV = A_HEADS // 2
B_HEADS = GROUP_WIDTH // HEAD_DIM
B_KV = B_HEADS // 2
C_HEADS = GROUP_WIDTH // HEAD_DIM
C_DK = HEAD_DIM
C_DV = HEAD_DIM
C_CHUNK = 128
M_HEADS = GROUP_WIDTH // HEAD_DIM
M_HEADDIM = HEAD_DIM
M_GROUPS = 2
M_DSTATE = 128
M_CONV = 3
M_CHUNK = 128
M_WIDTH = M_HEADS * M_HEADDIM
CONV_CH = M_WIDTH + 2 * M_GROUPS * M_DSTATE
D_FF = 4 * D_MODEL
ROPE_BASE = 10000.0
EPS = 1e-6
SPLIT_SIZES = (
    A_HEADS * HEAD_DIM, A_KV * HEAD_DIM, A_KV * HEAD_DIM,
    B_HEADS * HEAD_DIM, B_KV * HEAD_DIM, B_KV * HEAD_DIM,
    C_HEADS * C_DK, C_HEADS * C_DK, C_HEADS * C_DV, C_HEADS * C_DV,
    4 * C_HEADS,
    M_WIDTH, M_WIDTH, M_GROUPS * M_DSTATE, M_GROUPS * M_DSTATE,
    2 * M_HEADS,
)
SPLIT_POINTS = tuple(int(s) for s in np.cumsum(SPLIT_SIZES)[:-1])
N_IN = int(sum(SPLIT_SIZES))

kernel_name = 'hybrid_parallel_head_groups_dit'


def rmsnorm(x, g):
    xf = x.astype(jnp.float32)
    y = xf * lax.rsqrt(jnp.mean(xf * xf, axis=-1, keepdims=True) + EPS)
    return (y * g.astype(jnp.float32)).astype(x.dtype)


def axial_rope_tables(rows, dtype):
    row = jnp.repeat(jnp.arange(rows, dtype=jnp.float32), GRID_W)
    col = jnp.tile(jnp.arange(GRID_W, dtype=jnp.float32), rows)
    half = HEAD_DIM // 2
    inv_freq = ROPE_BASE ** (-jnp.arange(0, half, 2, dtype=jnp.float32) / half)
    ang = jnp.concatenate([row[:, None] * inv_freq, col[:, None] * inv_freq], axis=-1)
    return jnp.cos(ang).astype(dtype), jnp.sin(ang).astype(dtype)


def apply_axial_rope(x, cos, sin):
    half = HEAD_DIM // 2
    quarter = half // 2
    parts = []
    for axis in range(2):
        xa = x[..., axis * half:(axis + 1) * half]
        ca = cos[:, None, axis * quarter:(axis + 1) * quarter]
        sa = sin[:, None, axis * quarter:(axis + 1) * quarter]
        x1, x2 = xa[..., :quarter], xa[..., quarter:]
        parts += [x1 * ca - x2 * sa, x2 * ca + x1 * sa]
    return jnp.concatenate(parts, axis=-1)


def attend(qblk, keys, vals, mask=None, sink=None):
    s = jnp.einsum('bqgrd,bkgd->bgrqk', qblk, keys).astype(jnp.float32)
    if mask is not None:
        s = jnp.where(mask, s, -jnp.inf)
    if sink is not None:
        s_sink = jnp.broadcast_to(sink.astype(jnp.float32)[None, :, :, None, None], s.shape[:-1] + (1,))
        p = jax.nn.softmax(jnp.concatenate([s, s_sink], axis=-1), axis=-1)[..., :-1]
    else:
        p = jax.nn.softmax(s, axis=-1)
    return jnp.einsum('bgrqk,bkgd->bqgrd', p.astype(vals.dtype), vals)


def window_attention(lat, ctxp, sink, cos, sin, need_ctx):
    q, k, v = lat
    qc, kc, vc = ctxp
    bsz, n_tok = q.shape[:2]
    n_ctx = qc.shape[1]
    nb = n_tok // BLOCK
    rep = A_HEADS // A_KV
    scale = HEAD_DIM ** -0.5
    q = apply_axial_rope(q.reshape(bsz, n_tok, A_HEADS, HEAD_DIM), cos, sin) * scale
    k = apply_axial_rope(k.reshape(bsz, n_tok, A_KV, HEAD_DIM), cos, sin)
    v = v.reshape(bsz, n_tok, A_KV, HEAD_DIM)
    kc = kc.reshape(bsz, n_ctx, A_KV, HEAD_DIM)
    vc = vc.reshape(bsz, n_ctx, A_KV, HEAD_DIM)
    sink = sink.reshape(A_KV, rep)

    def band(t):
        tb = t.reshape(bsz, nb, BLOCK, A_KV, HEAD_DIM)
        pad = jnp.zeros_like(tb[:, :1])
        prev = jnp.concatenate([pad, tb[:, :-1]], axis=1)
        nxt = jnp.concatenate([tb[:, 1:], pad], axis=1)
        return jnp.moveaxis(jnp.concatenate([prev, tb, nxt], axis=2), 1, 0)

    qb = jnp.moveaxis(q.reshape(bsz, nb, BLOCK, A_KV, rep, HEAD_DIM), 1, 0)
    blk = jnp.arange(nb)[:, None, None]
    q_pos = blk * BLOCK + jnp.arange(BLOCK)[None, :, None]
    k_pos = (blk - 1) * BLOCK + jnp.arange(3 * BLOCK)[None, None, :]
    band_mask = (jnp.abs(q_pos - k_pos) <= WINDOW) & (k_pos >= 0) & (k_pos < n_tok)
    ctx_mask = jnp.ones((BLOCK, n_ctx), dtype=bool)

    def latent_block(args):
        qblk, kb, vb, m = args
        return attend(qblk, jnp.concatenate([kb, kc], axis=1), jnp.concatenate([vb, vc], axis=1),
                      jnp.concatenate([m, ctx_mask], axis=-1), sink)

    y = lax.map(latent_block, (qb, band(k), band(v), band_mask))
    y = jnp.moveaxis(y, 0, 1).reshape(bsz, n_tok, A_HEADS * HEAD_DIM)
    y_ctx = None
    if need_ctx:
        qch = qc.reshape(bsz, n_ctx, A_KV, rep, HEAD_DIM) * scale
        y_ctx = attend(qch, kc, vc, sink=sink).reshape(bsz, n_ctx, A_HEADS * HEAD_DIM)
    return y, y_ctx


def dense_attention(lat, ctxp, g_q, g_k, cos, sin, need_ctx):
    q, k, v = lat
    qc, kc, vc = ctxp
    bsz, n_tok = q.shape[:2]
    n_ctx = qc.shape[1]
    nb = n_tok // BLOCK
    rep = B_HEADS // B_KV
    scale = HEAD_DIM ** -0.5
    q = apply_axial_rope(rmsnorm(q.reshape(bsz, n_tok, B_HEADS, HEAD_DIM), g_q), cos, sin) * scale
    k = apply_axial_rope(rmsnorm(k.reshape(bsz, n_tok, B_KV, HEAD_DIM), g_k), cos, sin)
    v = v.reshape(bsz, n_tok, B_KV, HEAD_DIM)
    kc = rmsnorm(kc.reshape(bsz, n_ctx, B_KV, HEAD_DIM), g_k)
    vc = vc.reshape(bsz, n_ctx, B_KV, HEAD_DIM)
    keys = jnp.concatenate([kc, k], axis=1)
    vals = jnp.concatenate([vc, v], axis=1)
    qb = jnp.moveaxis(q.reshape(bsz, nb, BLOCK, B_KV, rep, HEAD_DIM), 1, 0)
    y = lax.map(lambda qblk: attend(qblk, keys, vals), qb)
    y = jnp.moveaxis(y, 0, 1).reshape(bsz, n_tok, B_HEADS * HEAD_DIM)
    y_ctx = None
    if need_ctx:
        qch = rmsnorm(qc.reshape(bsz, n_ctx, B_KV, rep, HEAD_DIM), g_q) * scale
        y_ctx = attend(qch, kc, vc).reshape(bsz, n_ctx, B_HEADS * HEAD_DIM)
    return y, y_ctx


def flip_time(t, direction):
    return t[:, ::-1] if direction == 1 else t


def mlstm_chunk_scan(q, k, v, ig, fg, state):
    bsz, n_tok, nh, _ = q.shape
    nc = n_tok // C_CHUNK

    def chunks(t):
        return jnp.moveaxis(t.reshape(bsz, nc, C_CHUNK, *t.shape[2:]), 1, 0)

    logf = jax.nn.log_sigmoid(fg)
    tril = jnp.tril(jnp.ones((C_CHUNK, C_CHUNK), dtype=bool))[None, :, :, None]

    def body(carry, inp):
        c_mat, n_vec, m_prev = carry
        qc, kc, vc, ic, lfc = inp
        b = jnp.cumsum(lfc, axis=1)
        dmat = jnp.where(tril, b[:, :, None, :] - b[:, None, :, :] + ic[:, None, :, :], -jnp.inf)
        m_prior = b + m_prev[:, None, :]
        m_t = jnp.maximum(m_prior, dmat.max(axis=2))
        w = jnp.exp(dmat - m_t[:, :, None, :])
        s = jnp.einsum('bthd,bshd->btsh', qc, kc) * w
        decay_prior = jnp.exp(m_prior - m_t)
        num = jnp.einsum('btsh,bshv->bthv', s, vc) + decay_prior[..., None] * jnp.einsum('bthd,bhvd->bthv', qc, c_mat)
        den = s.sum(axis=2) + decay_prior * jnp.einsum('bthd,bhd->bth', qc, n_vec)
        h = num / jnp.maximum(jnp.abs(den), jnp.exp(-m_t))[..., None]
        b_end = b[:, -1]
        g = b_end[:, None, :] - b + ic
        m_new = jnp.maximum(b_end + m_prev, g.max(axis=1))
        wk = jnp.exp(g - m_new[:, None, :])
        carry_decay = jnp.exp(b_end + m_prev - m_new)
        c_new = carry_decay[..., None, None] * c_mat + jnp.einsum('bsh,bshv,bshd->bhvd', wk, vc, kc)
        n_new = carry_decay[..., None] * n_vec + jnp.einsum('bsh,bshd->bhd', wk, kc)
        return (c_new, n_new, m_new), h

    state, hs = lax.scan(body, state, (chunks(q), chunks(k), chunks(v), chunks(ig), chunks(logf)))
    return jnp.moveaxis(hs, 0, 1).reshape(bsz, n_tok, nh, v.shape[-1]), state


def mlstm_mixer(lat, ctxp, b_i, b_f, g_head, need_ctx):
    f32 = jnp.float32

    def heads(q, k, v, gates):
        bsz, n = q.shape[:2]
        qh = q.reshape(bsz, n, C_HEADS, C_DK).astype(f32) * C_DK ** -0.5
        kh = k.reshape(bsz, n, C_HEADS, C_DK).astype(f32)
        vh = v.reshape(bsz, n, C_HEADS, C_DV).astype(f32)
        g = gates.reshape(bsz, n, 4, C_HEADS).astype(f32)
        ig = g[:, :, 0::2] + b_i.astype(f32)
        fg = g[:, :, 1::2] + b_f.astype(f32)
        return qh, kh, vh, ig, fg

    q, k, v, o, gates = lat
    qc, kc, vc, oc, gatesc = ctxp
    lat_h = heads(q, k, v, gates)
    ctx_h = heads(qc, kc, vc, gatesc)
    bsz = q.shape[0]
    outs_lat, outs_ctx = [], []
    for d in range(2):
        state0 = (jnp.zeros((bsz, C_HEADS, C_DV, C_DK), f32), jnp.zeros((bsz, C_HEADS, C_DK), f32),
                  jnp.zeros((bsz, C_HEADS), f32))
        cq, ck, cv, ci, cf = ctx_h
        hc, st = mlstm_chunk_scan(flip_time(cq, d), flip_time(ck, d), flip_time(cv, d),
                                  flip_time(ci[:, :, d], d), flip_time(cf[:, :, d], d), state0)
        lq, lk, lv, li, lf = lat_h
        hl, _ = mlstm_chunk_scan(flip_time(lq, d), flip_time(lk, d), flip_time(lv, d),
                                 flip_time(li[:, :, d], d), flip_time(lf[:, :, d], d), st)
        outs_lat.append(flip_time(hl, d))
        outs_ctx.append(flip_time(hc, d))

    def finish(h, og):
        b, n = h.shape[:2]
        hn = rmsnorm(h, g_head.reshape(C_HEADS, C_DV)).reshape(b, n, C_HEADS * C_DV)
        return (hn * jax.nn.sigmoid(og.astype(f32))).astype(og.dtype)

    y = finish(outs_lat[0] + outs_lat[1], o)
    y_ctx = finish(outs_ctx[0] + outs_ctx[1], oc) if need_ctx else None
    return y, y_ctx


def depthwise_conv(u, w, b):
    ch = u.shape[-1]
    y = lax.conv_general_dilated(u, w[:, None, :].astype(u.dtype), window_strides=(1,),
                                 padding=[(M_CONV // 2, M_CONV // 2)],
                                 dimension_numbers=('NWC', 'WIO', 'NWC'), feature_group_count=ch)
    return y + b.astype(u.dtype)


def ssd_chunk_scan(x, dt, a, bmat, cmat, h0):
    bsz, n_tok, nh, hp = x.shape
    nc = n_tok // M_CHUNK

    def chunks(t):
        return jnp.moveaxis(t.reshape(bsz, nc, M_CHUNK, *t.shape[2:]), 1, 0)

    tril = jnp.tril(jnp.ones((M_CHUNK, M_CHUNK), dtype=bool))[None, :, :, None]

    def body(h, inp):
        xc, dtc, bc, cc = inp
        cum = jnp.cumsum(dtc * a, axis=1)
        decay = jnp.exp(jnp.where(tril, cum[:, :, None, :] - cum[:, None, :, :], -jnp.inf))
        s = jnp.einsum('bthn,bshn->btsh', cc, bc) * decay * dtc[:, None, :, :]
        y = jnp.einsum('btsh,bshp->bthp', s, xc) + jnp.exp(cum)[..., None] * jnp.einsum('bthn,bhpn->bthp', cc, h)
        w_end = jnp.exp(cum[:, -1:, :] - cum) * dtc
        h_new = jnp.exp(cum[:, -1, :])[:, :, None, None] * h + jnp.einsum('bsh,bshp,bshn->bhpn', w_end, xc, bc)
        return h_new, y

    h_fin, ys = lax.scan(body, h0, (chunks(x), chunks(dt), chunks(bmat), chunks(cmat)))
    return jnp.moveaxis(ys, 0, 1).reshape(bsz, n_tok, nh, hp), h_fin


def mamba_mixer(lat, ctxp, conv_w, conv_b, a_log, dt_bias, d_skip, g_ssm, need_ctx):
    f32 = jnp.float32

    def prep(xm, bm, cm, dt):
        bsz, n = xm.shape[:2]
        u = jax.nn.silu(depthwise_conv(jnp.concatenate([xm, bm, cm], axis=-1), conv_w, conv_b)).astype(f32)
        xs, bs, cs = jnp.split(u, [M_WIDTH, M_WIDTH + M_GROUPS * M_DSTATE], axis=-1)
        rep = M_HEADS // M_GROUPS
        xs = xs.reshape(bsz, n, M_HEADS, M_HEADDIM)
        bs = jnp.repeat(bs.reshape(bsz, n, M_GROUPS, M_DSTATE), rep, axis=2)
        cs = jnp.repeat(cs.reshape(bsz, n, M_GROUPS, M_DSTATE), rep, axis=2)
        dts = jax.nn.softplus(dt.reshape(bsz, n, 2, M_HEADS).astype(f32) + dt_bias.astype(f32))
        return xs, bs, cs, dts

    xm, z, bm, cm, dt = lat
    xmc, zc, bmc, cmc, dtc = ctxp
    lat_p = prep(xm, bm, cm, dt)
    ctx_p = prep(xmc, bmc, cmc, dtc)
    a = -jnp.exp(a_log.astype(f32))
    bsz = xm.shape[0]
    outs_lat, outs_ctx = [], []
    for d in range(2):
        h0 = jnp.zeros((bsz, M_HEADS, M_HEADDIM, M_DSTATE), f32)
        cx, cb, cc, cdt = ctx_p
        yc, st = ssd_chunk_scan(flip_time(cx, d), flip_time(cdt[:, :, d], d), a[d],
                                flip_time(cb, d), flip_time(cc, d), h0)
        lx, lb, lc, ldt = lat_p
        yl, _ = ssd_chunk_scan(flip_time(lx, d), flip_time(ldt[:, :, d], d), a[d],
                               flip_time(lb, d), flip_time(lc, d), st)
        outs_lat.append(flip_time(yl, d))
        outs_ctx.append(flip_time(yc, d))

    def finish(y, xs, zz):
        b, n = zz.shape[:2]
        y = (y + d_skip.astype(f32)[:, None] * xs).reshape(b, n, M_WIDTH)
        return rmsnorm(y * jax.nn.silu(zz.astype(f32)), g_ssm).astype(zz.dtype)

    y = finish(outs_lat[0] + outs_lat[1], lat_p[0], z)
    y_ctx = finish(outs_ctx[0] + outs_ctx[1], ctx_p[0], zc) if need_ctx else None
    return y, y_ctx


def sq_relu_ffn(h, w1, w2):
    return jnp.square(jax.nn.relu(h @ w1)) @ w2


def setup_inputs(seed: int = 0) -> dict:
    key = jax.random.key(seed)
    ks = jax.random.split(key, 26)
    f32 = jnp.float32

    def nrm(k, shape, s):
        return jax.random.normal(k, shape, f32) * s

    dt0 = jnp.exp(jax.random.uniform(ks[18], (DEPTH, 2, M_HEADS), f32, math.log(1e-3), math.log(1e-1)))
    return {
        'x': nrm(ks[0], (BATCH, SEQ, D_MODEL), 1.0),
        'c': nrm(ks[1], (BATCH, D_MODEL), 1.0),
        'ctx': nrm(ks[2], (BATCH, CTX_LEN, D_MODEL), 1.0),
        'c_ctx': nrm(ks[3], (D_MODEL,), 1.0),
        'w_ada': nrm(ks[4], (DEPTH, D_MODEL, 6 * D_MODEL), 0.5 * D_MODEL ** -0.5),
        'b_ada': nrm(ks[5], (DEPTH, 6 * D_MODEL), 0.02),
        'g_norm1': 1.0 + nrm(ks[6], (DEPTH, D_MODEL), 0.02),
        'g_norm2': 1.0 + nrm(ks[7], (DEPTH, D_MODEL), 0.02),
        'w_in': nrm(ks[8], (DEPTH, D_MODEL, N_IN), D_MODEL ** -0.5),
        'sink_a': nrm(ks[9], (DEPTH, A_HEADS), 1.0),
        'g_q_b': 1.0 + nrm(ks[10], (DEPTH, HEAD_DIM), 0.02),
        'g_k_b': 1.0 + nrm(ks[11], (DEPTH, HEAD_DIM), 0.02),
        'b_igate': nrm(ks[12], (DEPTH, 2, C_HEADS), 0.1),
        'b_fgate': jnp.linspace(3.0, 6.0, C_HEADS, dtype=f32)[None, None, :] + nrm(ks[13], (DEPTH, 2, C_HEADS), 0.1),
        'g_mlstm': 1.0 + nrm(ks[14], (DEPTH, C_HEADS * C_DV), 0.02),
        'conv_w': nrm(ks[15], (DEPTH, M_CONV, CONV_CH), M_CONV ** -0.5),
        'conv_b': nrm(ks[16], (DEPTH, CONV_CH), 0.02),
        'a_log': jnp.log(jax.random.uniform(ks[17], (DEPTH, 2, M_HEADS), f32, 1.0, 16.0)),
        'dt_bias': dt0 + jnp.log(-jnp.expm1(-dt0)),
        'd_skip': 1.0 + nrm(ks[19], (DEPTH, M_HEADS), 0.1),
        'g_ssm': 1.0 + nrm(ks[20], (DEPTH, M_WIDTH), 0.02),
        'w_out': nrm(ks[21], (DEPTH, D_MIX, D_MODEL), D_MIX ** -0.5),
        'w_ff1': nrm(ks[22], (DEPTH, D_MODEL, D_FF), D_MODEL ** -0.5),
        'w_ff2': nrm(ks[23], (DEPTH, D_FF, D_MODEL), D_FF ** -0.5),
        'g_final': 1.0 + nrm(ks[24], (D_MODEL,), 0.02),
    }


def reference(x, c, ctx, c_ctx, w_ada, b_ada, g_norm1, g_norm2, w_in, sink_a, g_q_b, g_k_b,
              b_igate, b_fgate, g_mlstm, conv_w, conv_b, a_log, dt_bias, d_skip, g_ssm,
              w_out, w_ff1, w_ff2, g_final):
    n_tok = x.shape[1]
    rows = n_tok // GRID_W
    cos, sin = axial_rope_tables(rows, x.dtype)
    xc = ctx
    for layer in range(DEPTH):
        need_ctx = layer < DEPTH - 1
        mod = jax.nn.silu(c) @ w_ada[layer] + b_ada[layer]
        mod_c = jax.nn.silu(c_ctx) @ w_ada[layer] + b_ada[layer]
        sh1, sc1, gt1, sh2, sc2, gt2 = jnp.split(mod[:, None, :], 6, axis=-1)
        sh1c, sc1c, gt1c, sh2c, sc2c, gt2c = jnp.split(mod_c[None, None, :], 6, axis=-1)

        h = rmsnorm(x, g_norm1[layer]) * (1 + sc1) + sh1
        hc = rmsnorm(xc, g_norm1[layer]) * (1 + sc1c) + sh1c
        p = jnp.split(h @ w_in[layer], SPLIT_POINTS, axis=-1)
        pc = jnp.split(hc @ w_in[layer], SPLIT_POINTS, axis=-1)
        ya, ya_c = window_attention(p[0:3], pc[0:3], sink_a[layer], cos, sin, need_ctx)
        yb, yb_c = dense_attention(p[3:6], pc[3:6], g_q_b[layer], g_k_b[layer], cos, sin, need_ctx)
        ym, ym_c = mlstm_mixer(p[6:11], pc[6:11], b_igate[layer], b_fgate[layer], g_mlstm[layer], need_ctx)
        yd, yd_c = mamba_mixer(p[11:16], pc[11:16], conv_w[layer], conv_b[layer], a_log[layer],
                               dt_bias[layer], d_skip[layer], g_ssm[layer], need_ctx)
        x = x + gt1 * (jnp.concatenate([ya, yb, ym, yd], axis=-1) @ w_out[layer])
        h2 = rmsnorm(x, g_norm2[layer]) * (1 + sc2) + sh2
        x = x + gt2 * sq_relu_ffn(h2, w_ff1[layer], w_ff2[layer])

        if need_ctx:
            xc = xc + gt1c * (jnp.concatenate([ya_c, yb_c, ym_c, yd_c], axis=-1) @ w_out[layer])
            h2c = rmsnorm(xc, g_norm2[layer]) * (1 + sc2c) + sh2c
            xc = xc + gt2c * sq_relu_ffn(h2c, w_ff1[layer], w_ff2[layer])
    return rmsnorm(x, g_final)
```

```cpp
#define MK_LAUNCH_MODE 0
#include <hip/hip_runtime.h>
#include <hip/hip_bf16.h>
#include <hip/hip_cooperative_groups.h>
#include <cstdint>
#include <cstdio>
#include <cmath>
#define GAS __attribute__((address_space(1)))
#define LAS __attribute__((address_space(3)))
namespace mk {
constexpr int NB = 8, T = 4096, NC = 256, RB = T + NC, M = NB * RB, DM = 1024, NP = 3328, DFF = 4096, TPB = RB / 256, NINO = 3096;
constexpr float EPS = 1e-6f, L2E = 1.4426950408889634f;
constexpr float QC2 = 0.125f * 1.4426950408889634f;
typedef unsigned short bf16;
typedef unsigned u32x4 __attribute__((ext_vector_type(4)));
typedef unsigned u32x2 __attribute__((ext_vector_type(2)));
typedef float f32x4 __attribute__((ext_vector_type(4)));
typedef float f32x16 __attribute__((ext_vector_type(16)));
typedef short bf16x8 __attribute__((ext_vector_type(8)));
typedef short s16x4 __attribute__((ext_vector_type(4)));
typedef float f32x2v __attribute__((ext_vector_type(2)));
typedef __bf16 bf16x2v __attribute__((ext_vector_type(2)));

constexpr size_t MiB = 1u << 20;
constexpr size_t WS_CTL = 0, CTL_ZERO_BYTES = 1 * MiB;
constexpr size_t WS_MOD = 1 * MiB;
constexpr size_t WS_CS = 2 * MiB;
constexpr size_t WS_G = 4 * MiB;
constexpr size_t WS_XC = 9 * MiB;
constexpr size_t WS_W = 17 * MiB;
constexpr size_t W_LAYER = (size_t)(NP + DM + DFF + DFF) * 1024 * 2;
constexpr size_t WO_IN = 0, WO_OUT = (size_t)NP * DM * 2, WO_1 = WO_OUT + (size_t)DM * DM * 2, WO_2 = WO_1 + (size_t)DFF * DM * 2;
constexpr size_t WS_H = 66 * MiB;
constexpr size_t WS_P = 134 * MiB;
constexpr size_t WS_Y = 355 * MiB;
constexpr size_t WS_U = WS_P;
constexpr size_t WS_END = 423 * MiB;
static_assert(WS_W + 2 * W_LAYER <= WS_H && WS_H + (size_t)M * DM * 2 <= WS_P && WS_P + (size_t)M * NP * 2 <= WS_Y && WS_U + (size_t)M * DFF * 2 <= WS_END, "ws map");
constexpr size_t WS_HC = WS_H, WS_YD = WS_H + (size_t)2 * M * 256 * 2;
constexpr int CW_BAR = 4096;
constexpr int CW_QUEUE = 16384;

__device__ __forceinline__ unsigned cvtpk(float lo, float hi) { f32x2v v = {lo, hi}; bf16x2v b = __builtin_convertvector(v, bf16x2v); return __builtin_bit_cast(unsigned, b); }
__device__ __forceinline__ float bf_lo(unsigned w) { return __uint_as_float(w << 16); }
__device__ __forceinline__ float bf_hi(unsigned w) { return __uint_as_float(w & 0xffff0000u); }
__device__ __forceinline__ float bf2f(bf16 v) { return __uint_as_float(((unsigned)v) << 16); }
__device__ __forceinline__ bf16 f2bf(float f) { return (bf16)(cvtpk(f, 0.f) & 0xffffu); }
__device__ __forceinline__ float wave_sum(float v) {
#pragma unroll
  for (int o = 1; o < 64; o <<= 1) v += __shfl_xor(v, o);
  return v;
}
__device__ __forceinline__ int crow(int r, int hi) { return (r & 3) + 8 * (r >> 2) + 4 * hi; }
__device__ __forceinline__ size_t lat_off(int b, int t) { return ((size_t)b * T + t) * DM; }
__device__ __forceinline__ size_t ctx_off(int b, int j) { return ((size_t)b * NC + j) * DM; }
}
typedef GAS unsigned gu32;
typedef GAS unsigned long long gu64;

#define XB_TMO      128
#define XB_XCNT(j)  (256  + 64 * (j))
#define XB_XSUB(j)  (1280 + 64 * (j))
#define XB_XGEN(j)  (2304 + 64 * (j))
#define XB_TOP      3328
#define XB_TOPGEN   3392
#define XCD_BAR_WORDS 3456
#define XB_SPIN_CAP (1u << 18)

__device__ __forceinline__ unsigned xb_ld(unsigned* p)              { return __hip_atomic_load(p, __ATOMIC_RELAXED, __HIP_MEMORY_SCOPE_AGENT); }
__device__ __forceinline__ unsigned xb_add(unsigned* p, unsigned v) { return __hip_atomic_fetch_add(p, v, __ATOMIC_RELAXED, __HIP_MEMORY_SCOPE_AGENT); }
__device__ __forceinline__ unsigned xb_xcc_id() { return (unsigned)__builtin_amdgcn_s_getreg((3 << 11) | 20) & 0xFu; }
#define XB_SPIN(cond, bar) do { unsigned _sp = 0; while (cond) { __builtin_amdgcn_s_sleep(1); \
    if ((++_sp & 255u) == 0u) { if (xb_ld(&(bar)[XB_TMO])) break; if (_sp > XB_SPIN_CAP) { atomicAdd(&(bar)[XB_TMO], 1u); break; } } } } while (0)

struct XcdBarrier {
    unsigned* bar; unsigned x;
    volatile LAS unsigned* st;
};

__device__ __forceinline__ XcdBarrier xcd_barrier_post(unsigned* bar, volatile LAS unsigned* st) {
    XcdBarrier b; b.bar = bar; b.x = xb_xcc_id(); b.st = st;
    if (threadIdx.x == 0) (void)xb_add(&bar[XB_XCNT(b.x)], 1u);
    return b;
}
__device__ __forceinline__ void xcd_barrier_complete(unsigned* bar, unsigned x, unsigned& nloc, unsigned& nx) {
    const unsigned G = gridDim.x * gridDim.y * gridDim.z;
    unsigned sum, cnt, mine, sp = 0u;
    for (;;) {
        sum = 0u; cnt = 0u; mine = 0u;
#pragma unroll
        for (unsigned j = 0; j < 16; ++j) { const unsigned c = xb_ld(&bar[XB_XCNT(j)]); sum += c; cnt += (c > 0u) ? 1u : 0u; mine = (j == x) ? c : mine; }
        if (sum == G) break;
        __builtin_amdgcn_s_sleep(1);
        if ((++sp & 255u) == 0u) { if (xb_ld(&bar[XB_TMO])) break; if (sp > XB_SPIN_CAP) { atomicAdd(&bar[XB_TMO], 1u); break; } }
    }
    nloc = mine > 0u ? mine : 1u; nx = cnt > 0u ? cnt : 1u;
}

__device__ __forceinline__ void xcd_barrier(const XcdBarrier& b) {
    asm volatile("s_waitcnt vmcnt(0)" ::: "memory");
    __syncthreads();
    if (threadIdx.x == 0) {
        unsigned* bar = b.bar;
        __builtin_amdgcn_s_waitcnt(0);
        unsigned nloc = b.st[0], nx = b.st[1];
        if (nloc == 0u) { xcd_barrier_complete(bar, b.x, nloc, nx); b.st[0] = nloc; b.st[1] = nx; }
        const unsigned old = xb_add(&bar[XB_XSUB(b.x)], 1u);
        const unsigned gen = old / nloc;
        if (old + 1u == (gen + 1u) * nloc) {
            __builtin_amdgcn_fence(__ATOMIC_RELEASE, "agent");
            asm volatile("s_waitcnt vmcnt(0)" ::: "memory");
            const unsigned og = xb_add(&bar[XB_TOP], 1u);
            const unsigned tg = og / nx;
            if (og + 1u == (tg + 1u) * nx) xb_add(&bar[XB_TOPGEN], 1u);
            else XB_SPIN(xb_ld(&bar[XB_TOPGEN]) == tg, bar);
            __builtin_amdgcn_fence(__ATOMIC_ACQUIRE, "agent");
            xb_add(&bar[XB_XGEN(b.x)], 1u);
            asm volatile("s_waitcnt vmcnt(0)" ::: "memory");
        } else {
            XB_SPIN(xb_ld(&bar[XB_XGEN(b.x)]) == gen, bar);
            __builtin_amdgcn_fence(__ATOMIC_ACQUIRE, "agent");
            asm volatile("s_waitcnt vmcnt(0)" ::: "memory");
        }
    }
    __syncthreads();
}
namespace pg8 {
#define PG8_LAS __attribute__((address_space(3)))
typedef unsigned short bf16_t;
typedef short bf16x8 __attribute__((ext_vector_type(8)));
typedef float f32x4 __attribute__((ext_vector_type(4)));
typedef unsigned u32x4 __attribute__((ext_vector_type(4)));
constexpr int BM = 256, BK = 64, HALF = 128, HTB = HALF * BK * 2  , STAGE_BYTES = 8 * HTB, NXCD = 8, WGM = 8;

__host__ __device__ __forceinline__ int lds_byte(int r, int c) { const int st = (r >> 4) * 2 + (c >> 5), rr = r & 15, cc = c & 31, ob = rr * 64 + cc * 2; return st * 1024 + (ob ^ (((ob >> 9) & 1) << 5)); }
__host__ __device__ __forceinline__ void stage_rc(int b, int& R, int& C) { const int st = b / 1024, sb = b % 1024, swz = sb ^ (((sb >> 9) & 1) << 5); R = (st >> 1) * 16 + swz / 64; C = (st & 1) * 32 + (swz % 64) / 2; }
__host__ __device__ __forceinline__ int perm32(int rho) { const int n = rho >> 4, i = rho & 15; return 8 * (i >> 2) + 4 * n + (i & 3); }

struct Unit { int pm, pn; };
struct Gemm { const bf16_t* A; const bf16_t* Bt; int M, N, K; };

struct StaticOrder {
    int nM, nN, nwg, G, c;
    __host__ __device__ void init(int M, int N, int G_, int c_) { nM = M / BM; nN = N / BM; nwg = nM * nN; G = G_; c = c_; }
    __host__ __device__ bool next(int i, Unit& u) const {
        const long L = (long)i * G + c; if (L >= nwg) return false;
        int wgid = (int)L; { const int q = nwg / NXCD, r = nwg % NXCD, xcd = wgid % NXCD, off = wgid / NXCD; wgid = (xcd < r ? xcd * (q + 1) : r * (q + 1) + (xcd - r) * q) + off; }
        const int nig = WGM * nN, gid = wgid / nig, fm = gid * WGM, gsz = (nM - fm) < WGM ? (nM - fm) : WGM;
        u.pm = fm + ((wgid % nig) % gsz); u.pn = (wgid % nig) / gsz; return true;
    }
    __device__ __forceinline__ void a_ready(const Unit&) const {}
    __device__ __forceinline__ void done(const Unit&) const {}
};

__device__ __forceinline__ unsigned cvt_pk_bf16(float lo, float hi) { unsigned r; asm volatile("v_cvt_pk_bf16_f32 %0, %1, %2" : "=v"(r) : "v"(lo), "v"(hi)); return r; }
typedef float f32x2 __attribute__((ext_vector_type(2)));
__device__ __forceinline__ f32x2 gelu_pk(f32x2 v) {
    const f32x2 av = __builtin_elementwise_abs(v), d = av * 0.2316418882f + 1.0f;
    f32x2 t; t.x = __builtin_amdgcn_rcpf(d.x); t.y = __builtin_amdgcn_rcpf(d.y);
    f32x2 q = t * 0.5307027145f + (-0.7265760135f); q = q * t + 0.7107068705f; q = q * t + (-0.142248368f); q = q * t + 0.127414796f; q = q * t;
    const f32x2 s = (v * v) * (-0.72134752044f);
    f32x2 e; e.x = __builtin_amdgcn_exp2f(s.x); e.y = __builtin_amdgcn_exp2f(s.y);
    const f32x2 m = v * (q * e), r = v - m;
    f32x2 o; o.x = v.x < 0.f ? m.x : r.x; o.y = v.y < 0.f ? m.y : r.y; return o;
}

template <int ACT  > struct EpiBf16 {
    static constexpr bool PERM = true, AFTER_DRAIN = false; static_assert(ACT == 0 || ACT == 1, "EpiBf16: ACT is 0 (none) or 1 (gelu_pk)");
    bf16_t* O; int ldc; const float* bias; int split_cols; size_t split_stride; float scale0;
    __device__ __forceinline__ void operator()(const f32x4 (&acc)[2][2][4][2], const Unit& u, int wr, int wc, int fr, int fq) const {
        const int row0 = u.pm * BM + wr * 64 + fr; int colt = u.pn * BM; bf16_t* base = O;
        float sc = 1.f; if (split_cols) { const int t = colt / split_cols; base += (size_t)t * split_stride; colt -= t * split_cols; if (t == 0) sc = scale0; }
        const int col0 = colt + wc * 32 + 8 * fq, bcol0 = u.pn * BM + wc * 32 + 8 * fq;
        f32x4 bv[2][2];
#pragma unroll
        for (int bj = 0; bj < 2; ++bj)
#pragma unroll
            for (int n = 0; n < 2; ++n) bv[bj][n] = bias ? *(const f32x4*)(bias + bcol0 + bj * HALF + 4 * n) : (f32x4){0.f, 0.f, 0.f, 0.f};
#pragma unroll
        for (int ai = 0; ai < 2; ++ai)
#pragma unroll
            for (int m = 0; m < 4; ++m) { bf16_t* rowp = base + (size_t)(row0 + ai * HALF + m * 16) * ldc + col0;
#pragma unroll
                for (int bj = 0; bj < 2; ++bj) { f32x4 v0 = acc[ai][bj][m][0] + bv[bj][0], v1 = acc[ai][bj][m][1] + bv[bj][1];
                    if (ACT == 1) { f32x2 a = gelu_pk((f32x2){v0[0], v0[1]}), b = gelu_pk((f32x2){v0[2], v0[3]}), c = gelu_pk((f32x2){v1[0], v1[1]}), d = gelu_pk((f32x2){v1[2], v1[3]});
                        v0 = (f32x4){a.x, a.y, b.x, b.y}; v1 = (f32x4){c.x, c.y, d.x, d.y}; }
                    v0 = v0 * sc; v1 = v1 * sc; u32x4 w; w.x = cvt_pk_bf16(v0[0], v0[1]); w.y = cvt_pk_bf16(v0[2], v0[3]); w.z = cvt_pk_bf16(v1[0], v1[1]); w.w = cvt_pk_bf16(v1[2], v1[3]);
                    *(u32x4*)(rowp + bj * HALF) = w; } }
    }
};
template <class Epi, class Sched, bool ALIGN_EPI = false, bool SP2 = false>
__device__ __forceinline__ void gemm_phase(PG8_LAS unsigned char* lds, const Gemm g, const Sched& S, const Epi& E) {
    int tid_ = threadIdx.x; asm volatile("" : "+v"(tid_));
    const int tid = tid_, wid = __builtin_amdgcn_readfirstlane(tid >> 6), lane = tid & 63, wr = wid >> 2, wc = wid & 3, fr = lane & 15, fq = lane >> 4;
    const int K = g.K, nt = K / BK;
    unsigned voffA[2], voffB[2];
#pragma unroll
    for (int i = 0; i < 2; ++i) { int R, C; stage_rc(tid * 16 + i * 8192, R, C); const int Rb = Epi::PERM ? ((R & ~31) + perm32(R & 31)) : R;
        voffA[i] = (unsigned)(R * K + C) * 2u; voffB[i] = (unsigned)(Rb * K + C) * 2u; }
    const size_t kstep = (size_t)(BK * 2);
    const size_t hstep = (size_t)HALF * K * 2;
    const size_t tstep = 2 * hstep;
    const unsigned ldsw = (unsigned)wid * 1024u;
    const int aoff = lds_byte(wr * 64 + fr, fq * 8), boff = lds_byte(wc * 32 + fr, fq * 8);
#define PG8_SA(b, h) (((b) * 2 + (h)) * HTB)
#define PG8_SB(b, h) ((4 + (b) * 2 + (h)) * HTB)
#define PG8_STAGE(bufoff, gbase, voff) do { _Pragma("unroll") for (int _i = 0; _i < 2; ++_i) \
        __builtin_amdgcn_global_load_lds((const unsigned*)((const char*)(gbase) + (voff)[_i]), (PG8_LAS unsigned*)(lds + (bufoff) + ldsw + _i * 8192), 16, 0, 0); } while (0)
#define PG8_LDA(dst, b, h) do { _Pragma("unroll") for (int m = 0; m < 4; ++m) _Pragma("unroll") for (int k = 0; k < 2; ++k) dst[m][k] = *(const PG8_LAS bf16x8*)(lds + PG8_SA(b, h) + aoff + m * 2048 + k * 1024); } while (0)
#define PG8_LDB(dst, b, h) do { _Pragma("unroll") for (int n = 0; n < 2; ++n) _Pragma("unroll") for (int k = 0; k < 2; ++k) dst[n][k] = *(const PG8_LAS bf16x8*)(lds + PG8_SB(b, h) + boff + n * 2048 + k * 1024); } while (0)
#define PG8_MMA(ai, bj, At, Bt) do { __builtin_amdgcn_s_setprio(1); _Pragma("unroll") for (int m = 0; m < 4; ++m) _Pragma("unroll") for (int n = 0; n < 2; ++n) _Pragma("unroll") for (int k = 0; k < 2; ++k) \
        acc[ai][bj][m][n] = __builtin_amdgcn_mfma_f32_16x16x32_bf16(Bt[n][k], At[m][k], acc[ai][bj][m][n], 0, 0, 0); __builtin_amdgcn_s_setprio(0); } while (0)
#define PG8_WAIT_V(n) asm volatile("s_waitcnt vmcnt(" #n ")" ::: "memory")
#define PG8_WAIT_L(n) asm volatile("s_waitcnt lgkmcnt(" #n ")" ::: "memory")
#define PG8_BAR __builtin_amdgcn_s_barrier()
#define PG8_SCHED __builtin_amdgcn_sched_barrier(0)
    Unit cur, nxt; int ui = 0;
    if (!S.next(0, cur)) return;
    f32x4 acc[2][2][4][2];
#pragma unroll
    for (int a = 0; a < 2; ++a)
#pragma unroll
        for (int b = 0; b < 2; ++b)
#pragma unroll
            for (int m = 0; m < 4; ++m)
#pragma unroll
                for (int n = 0; n < 2; ++n) acc[a][b][m][n] = (f32x4){0.f, 0.f, 0.f, 0.f};
    bf16x8 At[4][2], B0[2][2], B1[2][2];
    const char* cA = (const char*)g.A + (size_t)cur.pm * tstep; const char* cB = (const char*)g.Bt + (size_t)cur.pn * tstep;
    S.a_ready(cur);
    if constexpr (SP2) {
        PG8_STAGE(PG8_SB(0, 0), cB, voffB); PG8_STAGE(PG8_SB(0, 1), cB + hstep, voffB); PG8_STAGE(PG8_SA(0, 0), cA, voffA); PG8_STAGE(PG8_SA(0, 1), cA + hstep, voffA);
        if (wr == 1) PG8_BAR;
        PG8_WAIT_V(2); PG8_BAR;
        PG8_STAGE(PG8_SB(1, 0), cB + kstep, voffB); PG8_STAGE(PG8_SA(1, 0), cA + kstep, voffA); PG8_STAGE(PG8_SB(1, 1), cB + hstep + kstep, voffB);
        PG8_WAIT_V(6); PG8_BAR;
    } else {
        PG8_STAGE(PG8_SB(0, 0), cB, voffB); PG8_STAGE(PG8_SA(0, 0), cA, voffA); PG8_STAGE(PG8_SB(0, 1), cB + hstep, voffB); PG8_STAGE(PG8_SA(0, 1), cA + hstep, voffA);
        if (wr == 1) PG8_BAR;
        PG8_WAIT_V(4); PG8_BAR;
        PG8_STAGE(PG8_SB(1, 0), cB + kstep, voffB); PG8_STAGE(PG8_SA(1, 0), cA + kstep, voffA); PG8_STAGE(PG8_SB(1, 1), cB + hstep + kstep, voffB);
        PG8_WAIT_V(6); PG8_BAR;
    }
    for (;;) {
        const bool has_next = S.next(ui + 1, nxt);
        const char* nA = has_next ? (const char*)g.A + (size_t)nxt.pm * tstep : cA; const char* nB = has_next ? (const char*)g.Bt + (size_t)nxt.pn * tstep : cB;
        for (int t = 0; t < nt; t += 2) {
            const bool last = (t == nt - 2);
            const char* a1 = cA + (size_t)(t + 1) * kstep;
            const char* a2 = last ? nA : cA + (size_t)(t + 2) * kstep; const char* b2 = last ? nB : cB + (size_t)(t + 2) * kstep;
            const char* a3 = a2 + kstep; const char* b3 = b2 + kstep;
            if (last && has_next) S.a_ready(nxt);
            if constexpr (SP2) {
            PG8_LDB(B0, 0, 0); PG8_LDB(B1, 0, 1); PG8_SCHED; PG8_LDA(At, 0, 0); PG8_STAGE(PG8_SA(1, 1), a1 + hstep, voffA);
            PG8_WAIT_V(8); PG8_WAIT_L(0); PG8_BAR; PG8_MMA(0, 0, At, B0); PG8_MMA(0, 1, At, B1); PG8_BAR; PG8_SCHED;
            PG8_LDA(At, 0, 1); PG8_STAGE(PG8_SB(0, 0), b2, voffB); PG8_STAGE(PG8_SB(0, 1), b2 + hstep, voffB); PG8_STAGE(PG8_SA(0, 0), a2, voffA);
            PG8_WAIT_V(8); PG8_WAIT_L(0); PG8_BAR; PG8_MMA(1, 0, At, B0); PG8_MMA(1, 1, At, B1); PG8_BAR; PG8_SCHED;
            PG8_LDB(B0, 1, 0); PG8_LDB(B1, 1, 1); PG8_SCHED; PG8_LDA(At, 1, 0); PG8_STAGE(PG8_SA(0, 1), a2 + hstep, voffA);
            PG8_WAIT_V(8); PG8_WAIT_L(0); PG8_BAR; PG8_MMA(0, 0, At, B0); PG8_MMA(0, 1, At, B1); PG8_BAR; PG8_SCHED;
            PG8_LDA(At, 1, 1); PG8_STAGE(PG8_SB(1, 0), b3, voffB); PG8_STAGE(PG8_SB(1, 1), b3 + hstep, voffB); PG8_STAGE(PG8_SA(1, 0), a3, voffA);
            PG8_WAIT_V(8); PG8_WAIT_L(0); PG8_BAR; PG8_MMA(1, 0, At, B0); PG8_MMA(1, 1, At, B1); PG8_BAR; PG8_SCHED;
            } else {
            PG8_LDB(B0, 0, 0); PG8_SCHED; PG8_LDA(At, 0, 0); PG8_STAGE(PG8_SA(1, 1), a1 + hstep, voffA);
            PG8_WAIT_L(8); PG8_BAR; PG8_WAIT_L(0); PG8_MMA(0, 0, At, B0); PG8_BAR; PG8_SCHED;
            PG8_LDB(B1, 0, 1); PG8_STAGE(PG8_SB(0, 0), b2, voffB);
            PG8_BAR; PG8_WAIT_L(0); PG8_MMA(0, 1, At, B1); PG8_BAR;
            PG8_LDA(At, 0, 1); PG8_STAGE(PG8_SA(0, 0), a2, voffA);
            PG8_BAR; PG8_WAIT_L(0); PG8_MMA(1, 0, At, B0); PG8_BAR; PG8_SCHED;
            PG8_STAGE(PG8_SB(0, 1), b2 + hstep, voffB);
            PG8_WAIT_V(6); PG8_BAR; PG8_MMA(1, 1, At, B1); PG8_BAR;
            PG8_LDB(B0, 1, 0); PG8_SCHED; PG8_LDA(At, 1, 0); PG8_STAGE(PG8_SA(0, 1), a2 + hstep, voffA);
            PG8_WAIT_L(8); PG8_BAR; PG8_WAIT_L(0); PG8_MMA(0, 0, At, B0); PG8_BAR; PG8_SCHED;
            PG8_LDB(B1, 1, 1); PG8_STAGE(PG8_SB(1, 0), b3, voffB);
            PG8_BAR; PG8_WAIT_L(0); PG8_MMA(0, 1, At, B1); PG8_BAR;
            PG8_LDA(At, 1, 1); PG8_STAGE(PG8_SA(1, 0), a3, voffA);
            PG8_BAR; PG8_WAIT_L(0); PG8_MMA(1, 0, At, B0); PG8_BAR; PG8_SCHED;
            PG8_STAGE(PG8_SB(1, 1), b3 + hstep, voffB);
            PG8_WAIT_V(6); PG8_BAR; PG8_MMA(1, 1, At, B1); PG8_BAR;
            }
        }
        if constexpr (ALIGN_EPI) { if (wr == 0) PG8_BAR; }
        if constexpr (!Epi::AFTER_DRAIN) { E(acc, cur, wr, wc, fr, fq); S.done(cur); }
        if (!has_next) break;
#pragma unroll
        for (int a = 0; a < 2; ++a)
#pragma unroll
            for (int b = 0; b < 2; ++b)
#pragma unroll
                for (int m = 0; m < 4; ++m)
#pragma unroll
                    for (int n = 0; n < 2; ++n) acc[a][b][m][n] = (f32x4){0.f, 0.f, 0.f, 0.f};
        cur = nxt; cA = nA; cB = nB; ++ui;
        if constexpr (ALIGN_EPI) { if (wr == 1) PG8_BAR; }
    }
    PG8_WAIT_V(0);
    if constexpr (!ALIGN_EPI) { if (wr == 0) PG8_BAR; }
    PG8_BAR;
    if constexpr (Epi::AFTER_DRAIN) { E.fused(acc, cur, wr, wc, fr, fq, lds, wid, lane); S.done(cur); }
#undef PG8_SA
#undef PG8_SB
#undef PG8_STAGE
#undef PG8_LDA
#undef PG8_LDB
#undef PG8_MMA
#undef PG8_WAIT_V
#undef PG8_WAIT_L
#undef PG8_BAR
#undef PG8_SCHED
}
}
namespace attn_body {
using bf16=__hip_bfloat16;
using bf16x8=__attribute__((ext_vector_type(8)))short;
using s16x4=__attribute__((ext_vector_type(4)))short;
using f32x16=__attribute__((ext_vector_type(16)))float;
using u32x4=__attribute__((ext_vector_type(4)))unsigned;
constexpr int D=64,PQ=3328,PO=1024;
constexpr int NW=8,QBLK=32,QB=QBLK*NW,KVBLK=64;
__device__ __forceinline__ int crow(int r,int hi){return (r&3)+8*(r>>2)+4*hi;}
#define SBAR() __builtin_amdgcn_sched_barrier(0)
__device__ __forceinline__ void wmask(f32x16&p0,f32x16&p1,int dq,int hi){
  const float NEG=-INFINITY; int kb=4*hi;
  #pragma unroll
  for(int r=0;r<16;++r){int kv=kb+(r&3)+8*(r>>2); int d0=dq-kv; if(d0>128||d0<-128)p0[r]=NEG; int d1=d0-32; if(d1>128||d1<-128)p1[r]=NEG;}
}

constexpr int NSLOT=3, SLOTB=8192;
constexpr int LDS_K=0, LDS_V=NSLOT*SLOTB, LDS_WS=2*NSLOT*SLOTB, LDS_OST=LDS_WS+NW*64*4, LDS_BYTES=LDS_OST+NW*4096;
constexpr float C2=0.125f*1.4426950408889634f;
__device__ __forceinline__ void glds16(const void*gsrc,unsigned lds_dst){unsigned keep;
  asm volatile("s_mov_b32 %0, m0\n\ts_mov_b32 m0, %2\n\ts_nop 0\n\tglobal_load_lds_dwordx4 %1, off\n\ts_mov_b32 m0, %0":"=&s"(keep):"v"(gsrc),"s"(lds_dst):"memory");}
__device__ __forceinline__ float max3f(float a,float b,float c){float r;asm("v_max3_f32 %0, %1, %2, %3":"=v"(r):"v"(a),"v"(b),"v"(c));return r;}
__device__ __forceinline__ float max2f(float a,float b){float r;asm("v_max_f32_e32 %0, %1, %2":"=v"(r):"v"(a),"v"(b));return r;}
__device__ __forceinline__ float fadd_s(float a,float b){float r;asm("v_add_f32_e32 %0, %1, %2":"=v"(r):"v"(a),"v"(b));return r;}
__device__ __forceinline__ float fsub_s(float a,float b){float r;asm("v_sub_f32_e32 %0, %1, %2":"=v"(r):"v"(a),"v"(b));return r;}
typedef float f32x2_t __attribute__((ext_vector_type(2))); typedef __bf16 bf16x2_t __attribute__((ext_vector_type(2)));
__device__ __forceinline__ unsigned cvtpk_s(float lo,float hi){f32x2_t v={lo,hi};bf16x2_t b=__builtin_convertvector(v,bf16x2_t);return __builtin_bit_cast(unsigned,b);}
#define WAIT_BAR(N) asm volatile("s_waitcnt vmcnt(" #N ") lgkmcnt(0)\n\ts_barrier":::"memory")

__device__ __forceinline__ void qkt(f32x16&p0,f32x16&p1,const char*Kslot,const bf16x8*qr,const f32x16&negm,int r32,int hi){
  const char*kb=Kslot+hi*1024+r32*16;
  #pragma unroll
  for(int d0=0;d0<4;++d0){
    const bf16x8 b0=*reinterpret_cast<const bf16x8*>(kb+d0*2048);
    const bf16x8 b1=*reinterpret_cast<const bf16x8*>(kb+d0*2048+512);
    if(d0==0){p0=__builtin_amdgcn_mfma_f32_32x32x16_bf16(b0,qr[0],negm,0,0,0);p1=__builtin_amdgcn_mfma_f32_32x32x16_bf16(b1,qr[0],negm,0,0,0);}
    else{p0=__builtin_amdgcn_mfma_f32_32x32x16_bf16(b0,qr[d0],p0,0,0,0);p1=__builtin_amdgcn_mfma_f32_32x32x16_bf16(b1,qr[d0],p1,0,0,0);}}
}
typedef __attribute__((address_space(3))) const char* lds_cptr;
typedef short v4i16_t __attribute__((ext_vector_type(4)));
__device__ __forceinline__ void kload8(bf16x8*kf,lds_cptr kp){
  kf[0]=*(const __attribute__((address_space(3))) bf16x8*)(kp);      kf[1]=*(const __attribute__((address_space(3))) bf16x8*)(kp+512);
  kf[2]=*(const __attribute__((address_space(3))) bf16x8*)(kp+2048); kf[3]=*(const __attribute__((address_space(3))) bf16x8*)(kp+2560);
  kf[4]=*(const __attribute__((address_space(3))) bf16x8*)(kp+4096); kf[5]=*(const __attribute__((address_space(3))) bf16x8*)(kp+4608);
  kf[6]=*(const __attribute__((address_space(3))) bf16x8*)(kp+6144); kf[7]=*(const __attribute__((address_space(3))) bf16x8*)(kp+6656);
}
__device__ __forceinline__ void kload2(bf16x8*kf,lds_cptr kp,int j){ kf[2*j]=*(const __attribute__((address_space(3))) bf16x8*)(kp+j*2048); kf[2*j+1]=*(const __attribute__((address_space(3))) bf16x8*)(kp+j*2048+512); }
__device__ __forceinline__ s16x4 vtr(lds_cptr p){ return __builtin_bit_cast(s16x4,__builtin_amdgcn_ds_read_tr16_b64_v4i16((__attribute__((address_space(3))) v4i16_t*)p)); }
__device__ __forceinline__ float rowmax(const f32x16&p0,const f32x16&p1){
  float a=max3f(p0[0],p0[1],p1[0]),b=max3f(p0[2],p0[3],p1[1]);a=max3f(a,p1[2],p1[3]);
  #pragma unroll
  for(int r=4;r<16;r+=4){a=max3f(a,p0[r],p0[r+1]);b=max3f(b,p0[r+2],p0[r+3]);a=max3f(a,p1[r],p1[r+1]);b=max3f(b,p1[r+2],p1[r+3]);}
  const float m=max2f(a,b);
  auto rr=__builtin_amdgcn_permlane32_swap(__float_as_uint(m),__float_as_uint(m),false,false);
  return max2f(__uint_as_float(rr[0]),__uint_as_float(rr[1]));
}
__device__ __forceinline__ void pv(f32x16*o,int vb,bf16x8 pa0,bf16x8 pa1,bf16x8 pa2,bf16x8 pa3){
  #pragma unroll
  for(int d0=0;d0<2;++d0){s16x4 lo[4],hi[4];
    #pragma unroll
    for(int ks=0;ks<4;++ks){
      asm volatile("ds_read_b64_tr_b16 %0,%1 offset:%c2":"=&v"(lo[ks]):"v"(vb),"i"(d0*4096+ks*1024):"memory");
      asm volatile("ds_read_b64_tr_b16 %0,%1 offset:%c2":"=&v"(hi[ks]):"v"(vb),"i"(d0*4096+ks*1024+512):"memory");}
    asm volatile("s_waitcnt lgkmcnt(0)":::"memory");SBAR();
    #define PK(k) (bf16x8){lo[k][0],lo[k][1],lo[k][2],lo[k][3],hi[k][0],hi[k][1],hi[k][2],hi[k][3]}
    o[d0]=__builtin_amdgcn_mfma_f32_32x32x16_bf16(pa0,PK(0),o[d0],0,0,0);
    o[d0]=__builtin_amdgcn_mfma_f32_32x32x16_bf16(pa1,PK(1),o[d0],0,0,0);
    o[d0]=__builtin_amdgcn_mfma_f32_32x32x16_bf16(pa2,PK(2),o[d0],0,0,0);
    o[d0]=__builtin_amdgcn_mfma_f32_32x32x16_bf16(pa3,PK(3),o[d0],0,0,0);
    #undef PK
  }
}

#ifndef ATTN_STORE16
#define ATTN_STORE16(p,v) (*(u32x4*)(p)=(v))
#endif
template<int THRL,int MODE> __device__ __forceinline__ void attn_unit(const bf16*Q0,const bf16*__restrict__ Kh,const bf16*__restrict__ Vh,bf16*O0,const int NT,const int band_row0,const int qpos0,const int band_s0,const float sink_l2,char*shm){
  int tid_=threadIdx.x; asm volatile("":"+v"(tid_));
  const int tid=tid_,lane=tid&63,r32=lane&31,hi=lane>>5; const int wid=__builtin_amdgcn_readfirstlane(tid>>6);
  const bf16*Qw=Q0+(long)(wid*QBLK)*PQ;
  #define TROW(t) ((MODE==1&&(t)>=4)?(band_row0+((t)-4)*KVBLK):((t)*KVBLK))
  const unsigned lds0=(unsigned)(uintptr_t)shm;
  float*wsf=(float*)(shm+LDS_WS)+wid*64;
  const bf16*ksrc=Kh+(long)lane*PQ+wid*8;
  const bf16*vsrc=Vh+(long)(16*(wid&3)+(lane>>2))*PQ+(wid>>2)*32+(lane&3)*8;
  const unsigned kdst=lds0+LDS_K+wid*1024, vdst=lds0+LDS_V+wid*1024;
  #define DMA_K(t,slot) glds16(ksrc+(long)TROW(t)*PQ,(unsigned)__builtin_amdgcn_readfirstlane(kdst+(slot)))
  #define DMA_V(t,slot) glds16(vsrc+(long)TROW(t)*PQ,(unsigned)__builtin_amdgcn_readfirstlane(vdst+(slot)))
  const int vb0=(int)(lds0+LDS_V)+((lane>>4)&1)*32+(lane&3)*8+(4*hi+((lane&15)>>2))*64;
  const char*Kbase=shm+LDS_K; bf16x8 kf[8];
  const lds_cptr shm3=(lds_cptr)shm; const lds_cptr kp0=shm3+LDS_K+hi*1024+r32*16; const lds_cptr vp0=shm3+LDS_V+((lane>>4)&1)*32+(lane&3)*8+(4*hi+((lane&15)>>2))*64;
  DMA_K(0,0);DMA_V(0,0);DMA_K(1,SLOTB);
  bf16x8 qr[4];
  #pragma unroll
  for(int d0=0;d0<4;++d0)qr[d0]=*reinterpret_cast<const bf16x8*>(&Qw[(long)r32*PQ+d0*16+hi*8]);
  float mhat=0.f,l_reg=0.f;f32x16 o[2];o[0]=f32x16{};o[1]=f32x16{};f32x16 negm=f32x16{};asm volatile("":"+v"(negm));
  const int qrel=wid*QBLK+r32;
  #define CMASK(P0,P1,t) do{ if(MODE==1&&(t)>=4){ wmask(P0,P1,qpos0+qrel-(band_s0+((t)-4)*KVBLK),hi); } }while(0)
  bool resc=false;
  #define START(P0,P1) do{ const float rm=rowmax(P0,P1); resc=false; \
    { const float dl=rm; mhat=fadd_s(mhat,dl); \
      _Pragma("unroll") for(int r=0;r<16;++r){P0[r]=fsub_s(P0[r],dl);P1[r]=fsub_s(P1[r],dl);} \
      _Pragma("unroll") for(int r=0;r<16;++r)negm[r]=-mhat; asm volatile("":"+v"(negm)); } \
    _Pragma("unroll") for(int r=0;r<16;++r)P0[r]=__builtin_amdgcn_exp2f(P0[r]); }while(0)
  #define RESC() do{ if(resc){ asm volatile("s_waitcnt lgkmcnt(0)":::"memory"); \
      _Pragma("unroll") for(int d_=0;d_<2;++d_) _Pragma("unroll") for(int r=0;r<16;++r)o[d_][r]*=wsf[crow(r,hi)]; } }while(0)
  f32x16 pA0,pA1,pB0,pB1;
  int sl_prev=0,sl_cur=0,sl_next=SLOTB;
  #define ROT() do{sl_prev=sl_cur;sl_cur=sl_next;sl_next=(sl_next==(NSLOT-1)*SLOTB)?0:sl_next+SLOTB;}while(0)
  DMA_K(2,2*SLOTB);
  WAIT_BAR(3);
  qkt(pA0,pA1,Kbase,qr,negm,r32,hi);asm volatile("s_nop 15\n\ts_nop 7":"+v"(pA0),"+v"(pA1));CMASK(pA0,pA1,0);
  START(pA0,pA1);
  _Pragma("unroll") for(int r=0;r<16;++r)pA1[r]=__builtin_amdgcn_exp2f(pA1[r]);
  WAIT_BAR(0);
  DMA_K(3,0);DMA_V(1,SLOTB);
  ROT();
  kload8(kf,kp0+sl_cur);
  WAIT_BAR(2);
  s16x4 vlo[8],vhi[8]; u32x4 pw0,pw1,pw2,pw3;
  #define PKW(P,B) cvtpk_s(P[B],P[B+1])
  #define PAF(k) __builtin_bit_cast(bf16x8,pw##k)
  #define VFR(i) (bf16x8){vlo[i][0],vlo[i][1],vlo[i][2],vlo[i][3],vhi[i][0],vhi[i][1],vhi[i][2],vhi[i][3]}
  #define PIN(x) asm volatile("":"+v"(x))
  #define MX3(a,b,c) __builtin_fmaxf(__builtin_fmaxf((a),(b)),(c))
  #define GAPA(MF,A0,A1,A2,A3,W0,W1,PW) do{ MF; sacc+=A0; sacc+=A1; sacc+=A2; sacc+=A3; PIN(sacc); W0; W1; PIN(PW); SBAR(); }while(0)
  #define EX(v) __builtin_amdgcn_exp2f(v)
  #define GAPB(MF,X,B) do{ MF; X[B]=EX(X[B]); X[B+1]=EX(X[B+1]); X[B+2]=EX(X[B+2]); X[B+3]=EX(X[B+3]); PIN(X); SBAR(); }while(0)
  #define VRD(i) do{ vlo[i]=vtr(vp_+(((i)>>2)*4096+((i)&3)*1024)); vhi[i]=vtr(vp_+(((i)>>2)*4096+((i)&3)*1024+512)); }while(0)
  #define KRD(G,j) do{ if(G){ kload2(kf,kp0+sl_next,j); SBAR(); } }while(0)
  #define STEP(C0,C1,P0,P1,t,GK,GV,GL) do{ SBAR(); \
    const lds_cptr vp_=vp0+sl_prev; \
    VRD(0); SBAR(); float sacc=(P0[0]+P0[1]); \
    GAPA(C0=__builtin_amdgcn_mfma_f32_32x32x16_bf16(kf[0],qr[0],negm,0,0,0), P0[2],P0[3],P0[4],P0[5],     pw0[0]=PKW(P0,0), pw0[1]=PKW(P0,2), pw0); \
    VRD(4); SBAR(); GAPA(C1=__builtin_amdgcn_mfma_f32_32x32x16_bf16(kf[1],qr[0],negm,0,0,0), P0[6],P0[7],P0[8],P0[9],     pw0[2]=PKW(P0,4), pw0[3]=PKW(P0,6), pw0); \
    VRD(1); SBAR(); GAPA(C0=__builtin_amdgcn_mfma_f32_32x32x16_bf16(kf[2],qr[1],C0,0,0,0),   P0[10],P0[11],P0[12],P0[13], pw1[0]=PKW(P0,8), pw1[1]=PKW(P0,10), pw1); \
    VRD(5); SBAR(); GAPA(C1=__builtin_amdgcn_mfma_f32_32x32x16_bf16(kf[3],qr[1],C1,0,0,0),   P0[14],P0[15],P1[0],P1[1],   pw1[2]=PKW(P0,12),pw1[3]=PKW(P0,14), pw1); \
    VRD(2); SBAR(); GAPA(C0=__builtin_amdgcn_mfma_f32_32x32x16_bf16(kf[4],qr[2],C0,0,0,0),   P1[2],P1[3],P1[4],P1[5],     pw2[0]=PKW(P1,0), pw2[1]=PKW(P1,2), pw2); \
    VRD(6); SBAR(); GAPA(C1=__builtin_amdgcn_mfma_f32_32x32x16_bf16(kf[5],qr[2],C1,0,0,0),   P1[6],P1[7],P1[8],P1[9],     pw2[2]=PKW(P1,4), pw2[3]=PKW(P1,6), pw2); \
    VRD(3); SBAR(); GAPA(C0=__builtin_amdgcn_mfma_f32_32x32x16_bf16(kf[6],qr[3],C0,0,0,0),   P1[10],P1[11],P1[12],P1[13], pw3[0]=PKW(P1,8), pw3[1]=PKW(P1,10), pw3); \
    VRD(7); SBAR(); GAPA(C1=__builtin_amdgcn_mfma_f32_32x32x16_bf16(kf[7],qr[3],C1,0,0,0),   P1[14],P1[15],0.f,0.f,       pw3[2]=PKW(P1,12),pw3[3]=PKW(P1,14), pw3); \
    l_reg+=sacc; \
    if(GK){DMA_K((t)+3,sl_cur);} if(GV){DMA_V((t)+1,sl_next);} \
    CMASK(C0,C1,t); \
    { float a=MX3(C0[0],C0[1],C1[0]),b=MX3(C0[2],C0[3],C1[1]); a=MX3(a,C1[2],C1[3]); \
      _Pragma("unroll") for(int r=4;r<16;r+=4){a=MX3(a,C0[r],C0[r+1]);b=MX3(b,C0[r+2],C0[r+3]);a=MX3(a,C1[r],C1[r+1]);b=MX3(b,C1[r+2],C1[r+3]);} \
      float rm=__builtin_fmaxf(a,b); { auto rr=__builtin_amdgcn_permlane32_swap(__float_as_uint(rm),__float_as_uint(rm),false,false); rm=__builtin_fmaxf(__uint_as_float(rr[0]),__uint_as_float(rr[1])); } \
      resc=false; \
      if(__builtin_expect(__any(rm>(float)THRL),0)){ const float dl=__builtin_fmaxf(rm,0.f); mhat+=dl; \
        _Pragma("unroll") for(int r=0;r<16;++r){C0[r]-=dl;C1[r]-=dl;} \
        _Pragma("unroll") for(int r=0;r<16;++r)negm[r]=-mhat; asm volatile("":"+v"(negm)); \
        const float f=__builtin_amdgcn_exp2f(-dl); l_reg*=f; if(hi==0)wsf[r32]=f; resc=true; } } \
    SBAR(); \
    GAPB(o[0]=__builtin_amdgcn_mfma_f32_32x32x16_bf16(PAF(0),VFR(0),o[0],0,0,0), C0,0); \
    GAPB(o[1]=__builtin_amdgcn_mfma_f32_32x32x16_bf16(PAF(0),VFR(4),o[1],0,0,0), C0,4); \
    KRD(GL,0); GAPB(o[0]=__builtin_amdgcn_mfma_f32_32x32x16_bf16(PAF(1),VFR(1),o[0],0,0,0), C0,8); \
    KRD(GL,1); GAPB(o[1]=__builtin_amdgcn_mfma_f32_32x32x16_bf16(PAF(1),VFR(5),o[1],0,0,0), C0,12); \
    KRD(GL,2); GAPB(o[0]=__builtin_amdgcn_mfma_f32_32x32x16_bf16(PAF(2),VFR(2),o[0],0,0,0), C1,0); \
    KRD(GL,3); GAPB(o[1]=__builtin_amdgcn_mfma_f32_32x32x16_bf16(PAF(2),VFR(6),o[1],0,0,0), C1,4); \
    GAPB(o[0]=__builtin_amdgcn_mfma_f32_32x32x16_bf16(PAF(3),VFR(3),o[0],0,0,0), C1,8); \
    GAPB(o[1]=__builtin_amdgcn_mfma_f32_32x32x16_bf16(PAF(3),VFR(7),o[1],0,0,0), C1,12); \
    }while(0)
  int t=1;
  for(;t+5<NT;t+=2){
    STEP(pB0,pB1,pA0,pA1,t,true,true,true);     WAIT_BAR(2); RESC(); ROT();
    STEP(pA0,pA1,pB0,pB1,t+1,true,true,true);   WAIT_BAR(2); RESC(); ROT();
  }
  #define ENDW(tt) do{ if((tt)+3<NT){WAIT_BAR(2);} else if((tt)+2<NT){WAIT_BAR(1);} else {WAIT_BAR(0);} }while(0)
  for(;t+1<NT;t+=2){
    STEP(pB0,pB1,pA0,pA1,t,(t+3<NT),(t+1<NT),(t+1<NT));       ENDW(t);   RESC(); ROT();
    STEP(pA0,pA1,pB0,pB1,t+1,(t+4<NT),(t+2<NT),(t+2<NT));     ENDW(t+1); RESC(); ROT();
  }
  STEP(pB0,pB1,pA0,pA1,NT-1,false,false,false); RESC();
  { float sacc=pB0[0]+pB0[1]; _Pragma("unroll") for(int r=2;r<16;++r)sacc+=pB0[r]; _Pragma("unroll") for(int r=0;r<16;++r)sacc+=pB1[r]; l_reg+=sacc;
    pw0=(u32x4){PKW(pB0,0),PKW(pB0,2),PKW(pB0,4),PKW(pB0,6)};pw1=(u32x4){PKW(pB0,8),PKW(pB0,10),PKW(pB0,12),PKW(pB0,14)};pw2=(u32x4){PKW(pB1,0),PKW(pB1,2),PKW(pB1,4),PKW(pB1,6)};pw3=(u32x4){PKW(pB1,8),PKW(pB1,10),PKW(pB1,12),PKW(pB1,14)};
    SBAR(); pv(o,vb0+sl_cur,PAF(0),PAF(1),PAF(2),PAF(3)); }
  #undef PKW
  #undef PAF
  #undef VFR
  #undef PIN
  #undef MX3
  #undef GAPA
  #undef GAPB
  #undef EX
  #undef VRD
  #undef KRD
  #undef STEP
  #undef ENDW
  {auto rr=__builtin_amdgcn_permlane32_swap(__float_as_uint(l_reg),__float_as_uint(l_reg),false,false);l_reg=__uint_as_float(rr[0])+__uint_as_float(rr[1]);}
  if(MODE==1)l_reg+=__builtin_amdgcn_exp2f(sink_l2-mhat);
  if(hi==0)wsf[32+r32]=l_reg;asm volatile("s_waitcnt lgkmcnt(0)":::"memory");
  float rli[16];
  #pragma unroll
  for(int r=0;r<16;++r)rli[r]=__builtin_amdgcn_rcpf(wsf[32+crow(r,hi)]);
  bf16*Ow=O0+(long)(wid*QBLK)*PO;
  { bf16*stg=(bf16*)(shm+LDS_OST)+wid*2048;
    #pragma unroll
    for(int r=0;r<16;++r){const int orow=crow(r,hi);
      #pragma unroll
      for(int d0=0;d0<2;++d0)stg[orow*64+d0*32+r32]=__float2bfloat16(o[d0][r]*rli[r]);}
    asm volatile("s_waitcnt lgkmcnt(0)":::"memory");
    #pragma unroll
    for(int i=0;i<4;++i){const int row=i*8+(lane>>3),ch=lane&7; const u32x4 v=*(const u32x4*)(stg+row*64+ch*8); ATTN_STORE16(Ow+(long)row*PO+ch*8,v);} }
  asm volatile("s_waitcnt lgkmcnt(0)\n\ts_barrier":::"memory");
  #undef DMA_K
  #undef DMA_V
  #undef TROW
  #undef CMASK
  #undef START
  #undef RESC
  #undef ROT
}
constexpr int ATTN_LDS_BYTES=LDS_BYTES;
#undef SBAR
#undef WAIT_BAR
}
namespace scan {
using namespace mk;
template <int NROWS> __device__ __forceinline__ int img_off(int row, int c) { return (((c >> 5) * (NROWS / 16) + (row >> 4)) << 10) + ((row & 15) << 6) + ((c & 31) << 1); }
__device__ __forceinline__ int tlane(int lane) { return ((lane >> 4) & 1) * 32 + (lane & 3) * 8 + (4 * (lane >> 5) + ((lane & 15) >> 2)) * 64; }
__device__ __forceinline__ bf16x8 rfrag(LAS const char* p) { return *(LAS const bf16x8*)p; }
__device__ __forceinline__ s16x4 tr4(LAS const char* p) { return __builtin_bit_cast(s16x4, __builtin_amdgcn_ds_read_tr16_b64_v4i16((LAS s16x4*)p)); }
__device__ __forceinline__ bf16x8 tfrag(LAS const char* p) { const s16x4 lo = tr4(p), hi = tr4(p + 512); return (bf16x8){lo[0], lo[1], lo[2], lo[3], hi[0], hi[1], hi[2], hi[3]}; }
__device__ __forceinline__ bf16x8 pack8(const f32x16& s, int b) {
  u32x4 w; w.x = cvtpk(s[b], s[b + 1]); w.y = cvtpk(s[b + 2], s[b + 3]); w.z = cvtpk(s[b + 4], s[b + 5]); w.w = cvtpk(s[b + 6], s[b + 7]); return __builtin_bit_cast(bf16x8, w);
}
#define MFMA32(a, b, c) __builtin_amdgcn_mfma_f32_32x32x16_bf16(a, b, c, 0, 0, 0)

template <int DK, int DV>
__device__ __forceinline__ void chunk_core(LAS const char* Qm, LAS const char* Km, LAS const char* Vm, LAS const char* Ss, LAS const float* rowexp, LAS const float* colexp, LAS const float* isc,
                                           f32x16& res0, f32x16& res1, int wid, int lane) {
  constexpr int KS = DK / 16, NVT = DV / 32;
  const int tb = wid & 3, vp = wid >> 2, r32 = lane & 31, hh = lane >> 5, tl = tlane(lane);
  bf16x8 qf[KS];
#pragma unroll
  for (int ks = 0; ks < KS; ++ks) qf[ks] = rfrag(Qm + img_off<128>(32 * tb + r32, 16 * ks + 8 * hh));
  f32x16 o0 = {}, o1 = {};
  const float re = rowexp[32 * tb + r32];
#pragma unroll 1
  for (int st = 0; st <= tb; ++st) {
    f32x16 s = {};
#pragma unroll
    for (int ks = 0; ks < KS; ++ks) { const bf16x8 kf = rfrag(Km + img_off<128>(32 * st + r32, 16 * ks + 8 * hh)); s = MFMA32(kf, qf[ks], s); }
#pragma unroll
    for (int r = 0; r < 16; ++r) { const int sl = crow(r, hh); float w = __builtin_amdgcn_exp2f(re + colexp[32 * st + sl]); if (st == tb && sl > r32) w = 0.f; s[r] *= w; }
    const bf16x8 pa0 = pack8(s, 0), pa1 = pack8(s, 8);
    { const bf16x8 v0 = tfrag(Vm + ((vp * 8 + 2 * st) << 10) + tl), v1 = tfrag(Vm + ((vp * 8 + 2 * st + 1) << 10) + tl); o0 = MFMA32(pa0, v0, o0); o0 = MFMA32(pa1, v1, o0); }
    if (NVT > 2 && vp == 0) { const bf16x8 v0 = tfrag(Vm + ((2 * 8 + 2 * st) << 10) + tl), v1 = tfrag(Vm + ((2 * 8 + 2 * st + 1) << 10) + tl); o1 = MFMA32(pa0, v0, o1); o1 = MFMA32(pa1, v1, o1); }
  }
  f32x16 i0 = {}, i1 = {};
#pragma unroll
  for (int ks = 0; ks < KS; ++ks) { const bf16x8 sf = rfrag(Ss + img_off<DV>(32 * vp + r32, 16 * ks + 8 * hh)); i0 = MFMA32(qf[ks], sf, i0); }
  if (NVT > 2 && vp == 0) {
#pragma unroll
    for (int ks = 0; ks < KS; ++ks) { const bf16x8 sf = rfrag(Ss + img_off<DV>(64 + r32, 16 * ks + 8 * hh)); i1 = MFMA32(qf[ks], sf, i1); }
  }
#pragma unroll
  for (int r = 0; r < 16; ++r) { const float sc = isc[32 * tb + crow(r, hh)]; res0[r] = o0[r] + sc * i0[r]; res1[r] = o1[r] + sc * i1[r]; }
}
template <int DK, int DV>
__device__ __forceinline__ void state_update(LAS const char* Km, LAS const char* Vw, LAS char* Ss, f32x16& st_acc, float sd, int wid, int lane) {
  constexpr int NVT = DV / 32, NDT = DK / 32;
  if (wid < NVT * NDT) {
    const int vt = wid / NDT, dt_ = wid % NDT, r32 = lane & 31, hh = lane >> 5, tl = tlane(lane);
#pragma unroll
    for (int r = 0; r < 16; ++r) st_acc[r] *= sd;
#pragma unroll
    for (int ks = 0; ks < 8; ++ks) { const bf16x8 af = tfrag(Vw + ((vt * 8 + ks) << 10) + tl), bfr = tfrag(Km + ((dt_ * 8 + ks) << 10) + tl); st_acc = MFMA32(af, bfr, st_acc); }
#pragma unroll
    for (int r = 0; r < 16; ++r) *(LAS bf16*)(Ss + img_off<DV>(32 * vt + crow(r, hh), 32 * dt_ + r32)) = f2bf(st_acc[r]);
  }
}
__device__ __forceinline__ float wscan_add(float x, int lane) {
#pragma unroll
  for (int o = 1; o < 64; o <<= 1) { const float y = __shfl_up(x, o); if (lane >= o) x += y; }
  return x;
}
__device__ __forceinline__ float wscan_max(float x, int lane) {
#pragma unroll
  for (int o = 1; o < 64; o <<= 1) { const float y = __shfl_up(x, o); if (lane >= o) x = fmaxf(x, y); }
  return x;
}
__device__ __forceinline__ void chunk_rows(int cc, int dir, int& row0, int& seg0, int& seglen) {
  if (cc < 2) { const int ci = dir ? 1 - cc : cc; row0 = 128 * ci; seg0 = 0; seglen = NC; }
  else { const int ci = dir ? 31 - (cc - 2) : (cc - 2); row0 = NC + 128 * ci; seg0 = NC; seglen = T; }
}
#define SCAN_BAR() do { asm volatile("s_waitcnt vmcnt(0) lgkmcnt(0)" ::: "memory"); __builtin_amdgcn_s_barrier(); asm volatile("" ::: "memory"); } while (0)

__device__ __forceinline__ void mamba_chain(LAS char* lds, const bf16* __restrict__ P, const float* __restrict__ G, const float* __restrict__ conv_w, const float* __restrict__ conv_b,
                                            const float* __restrict__ a_log, const float* __restrict__ dt_bias, bf16* __restrict__ YD, int b, int h, int dir) {
  int tid_ = threadIdx.x; asm volatile("" : "+v"(tid_));
  const int tid = tid_, lane = tid & 63, wid = __builtin_amdgcn_readfirstlane(tid >> 6), g = h >> 1;
  LAS char* Qm = lds; LAS char* Km = lds + 32768; LAS char* Vm = lds + 65536; LAS char* Vw = lds + 81920; LAS char* Ss = lds + 98304;
  LAS float* rowexp = (LAS float*)(lds + 114688); LAS float* colexp = rowexp + 128; LAS float* isc = rowexp + 256; LAS float* vw = rowexp + 384; LAS float* misc = rowexp + 512;
  LAS float* cwl = (LAS float*)(lds + 118784);
  for (int lc = tid; lc < 320; lc += 512) { const int ch = lc < 64 ? h * 64 + lc : (lc < 192 ? 256 + g * 128 + (lc - 64) : 512 + g * 128 + (lc - 192));
    *(LAS f32x4*)(cwl + 4 * lc) = (f32x4){conv_w[ch], conv_w[768 + ch], conv_w[1536 + ch], conv_b[ch]}; }
  for (int i = tid; i < 16384 / 4; i += 512) ((LAS unsigned*)Ss)[i] = 0u;
  f32x16 st_acc = {};
  const float a = -expf(a_log[dir * 4 + h]), dtb = dt_bias[dir * 4 + h];
  const size_t rowb = (size_t)b * RB;
  SCAN_BAR();
#pragma unroll 1
  for (int cc = 0; cc < 34; ++cc) {
    int row0, seg0, seglen; chunk_rows(cc, dir, row0, seg0, seglen);
    if (wid == 0) {
      float dt2[2], cum2[2];
#pragma unroll
      for (int e = 0; e < 2; ++e) { const int i = 2 * lane + e, io = dir ? 127 - i : i; const float dr = G[(rowb + row0 + io) * 32 + 16 + dir * 4 + h] + dtb; dt2[e] = dr > 20.f ? dr : log1pf(expf(dr)); }
      const float p0 = dt2[0] * a, p1 = p0 + dt2[1] * a; const float inc = wscan_add(p1, lane); const float exc = inc - p1;
      cum2[0] = exc + p0; cum2[1] = exc + p1; const float cend = __shfl(inc, 63);
#pragma unroll
      for (int e = 0; e < 2; ++e) { const int i = 2 * lane + e; rowexp[i] = cum2[e] * L2E; colexp[i] = -cum2[e] * L2E + log2f(dt2[e]); isc[i] = expf(cum2[e]); vw[i] = expf(cend - cum2[e]) * dt2[e]; }
      if (lane == 0) misc[0] = expf(cend);
    }
    SCAN_BAR();
#pragma unroll 1
    for (int k = 0; k < 10; ++k) {
      const int task = tid + 512 * k, io = task / 40, cg = task % 40, i = dir ? 127 - io : io;
      const int pcol = cg < 8 ? 2048 + h * 64 + cg * 8 : (cg < 24 ? 2560 + g * 128 + (cg - 8) * 8 : 2816 + g * 128 + (cg - 24) * 8);
      const int lc = cg * 8;
      const int sl = row0 - seg0 + io;
      const bf16* pr = P + (rowb + row0 + io) * NP + pcol;
      const u32x4 zero4 = {0u, 0u, 0u, 0u};
      const u32x4 xm = sl > 0 ? *(const u32x4*)(pr - NP) : zero4, x0 = *(const u32x4*)pr, xp = sl + 1 < seglen ? *(const u32x4*)(pr + NP) : zero4;
      float u[8];
#pragma unroll
      for (int e = 0; e < 4; ++e) {
        const f32x4 w0 = *(LAS const f32x4*)(cwl + 4 * (lc + 2 * e)), w1 = *(LAS const f32x4*)(cwl + 4 * (lc + 2 * e + 1));
        const float y0 = w0[3] + w0[0] * bf_lo(xm[e]) + w0[1] * bf_lo(x0[e]) + w0[2] * bf_lo(xp[e]);
        const float y1 = w1[3] + w1[0] * bf_hi(xm[e]) + w1[1] * bf_hi(x0[e]) + w1[2] * bf_hi(xp[e]);
        u[2 * e] = y0 / (1.f + __expf(-y0)); u[2 * e + 1] = y1 / (1.f + __expf(-y1));
      }
      const u32x4 pk = {cvtpk(u[0], u[1]), cvtpk(u[2], u[3]), cvtpk(u[4], u[5]), cvtpk(u[6], u[7])};
      if (cg < 8) { const float s = vw[i]; const u32x4 pw = {cvtpk(u[0] * s, u[1] * s), cvtpk(u[2] * s, u[3] * s), cvtpk(u[4] * s, u[5] * s), cvtpk(u[6] * s, u[7] * s)};
        *(LAS u32x4*)(Vm + img_off<128>(i, cg * 8)) = pk; *(LAS u32x4*)(Vw + img_off<128>(i, cg * 8)) = pw; }
      else if (cg < 24) *(LAS u32x4*)(Km + img_off<128>(i, (cg - 8) * 8)) = pk;
      else *(LAS u32x4*)(Qm + img_off<128>(i, (cg - 24) * 8)) = pk;
    }
    SCAN_BAR();
    f32x16 res0, res1; chunk_core<128, 64>(Qm, Km, Vm, Ss, rowexp, colexp, isc, res0, res1, wid, lane);
    { const int tb = wid & 3, vp = wid >> 2, r32 = lane & 31, hh = lane >> 5;
#pragma unroll
      for (int r = 0; r < 16; ++r) { const int t = 32 * tb + crow(r, hh), io = dir ? 127 - t : t; YD[((size_t)dir * M + rowb + row0 + io) * 256 + h * 64 + 32 * vp + r32] = f2bf(res0[r]); } }
    const float sd = misc[0];
    SCAN_BAR();
    state_update<128, 64>(Km, Vw, Ss, st_acc, sd, wid, lane);
  }
  SCAN_BAR();
}

__device__ __forceinline__ void mlstm_chain(LAS char* lds, const bf16* __restrict__ P, const float* __restrict__ G, const float* __restrict__ b_i, const float* __restrict__ b_f,
                                            bf16* __restrict__ HC, int b, int h, int dir) {
  int tid_ = threadIdx.x; asm volatile("" : "+v"(tid_));
  const int tid = tid_, lane = tid & 63, wid = __builtin_amdgcn_readfirstlane(tid >> 6);
  LAS char* Qm = lds; LAS char* Km = lds + 16384; LAS char* Vm = lds + 32768; LAS char* Vw = lds + 57344; LAS char* Ss = lds + 81920;
  LAS float* rowexp = (LAS float*)(lds + 94208); LAS float* colexp = rowexp + 128; LAS float* isc = rowexp + 256; LAS float* vw = rowexp + 384; LAS float* emn = rowexp + 512; LAS float* den = rowexp + 640; LAS float* misc = rowexp + 768;
  for (int i = tid; i < 12288 / 4; i += 512) ((LAS unsigned*)Ss)[i] = 0u;
  f32x16 st_acc = {};
  const float bi = b_i[dir * 4 + h], bfg = b_f[dir * 4 + h];
  float m_prev = 0.f;
  const size_t rowb = (size_t)b * RB;
  SCAN_BAR();
#pragma unroll 1
  for (int cc = 0; cc < 34; ++cc) {
    int row0, seg0, seglen; chunk_rows(cc, dir, row0, seg0, seglen);
    const int io = tid >> 2, part = tid & 3, i = dir ? 127 - io : io;
    const bf16* pr = P + (rowb + row0 + io) * NP + h * 64 + part * 16;
    const u32x4 q0 = *(const u32x4*)(pr + 1024), q1 = *(const u32x4*)(pr + 1024 + 8), k0 = *(const u32x4*)(pr + 1280), k1 = *(const u32x4*)(pr + 1280 + 8), v0 = *(const u32x4*)(pr + 1536), v1 = *(const u32x4*)(pr + 1536 + 8);
    if (wid == 0) {
      float ig[2], lf[2], bb[2], aa[2], mm[2];
#pragma unroll
      for (int e = 0; e < 2; ++e) { const int ii = 2 * lane + e, ioo = dir ? 127 - ii : ii; const float* gr = G + (rowb + row0 + ioo) * 32;
        ig[e] = gr[(2 * dir) * 4 + h] + bi; const float fg = gr[(2 * dir + 1) * 4 + h] + bfg; lf[e] = fminf(fg, 0.f) - log1pf(expf(-fabsf(fg))); }
      const float p1 = lf[0] + lf[1]; const float inc = wscan_add(p1, lane); const float exc = inc - p1;
      bb[0] = exc + lf[0]; bb[1] = exc + p1; aa[0] = ig[0] - bb[0]; aa[1] = ig[1] - bb[1];
      const float q1m = fmaxf(aa[0], aa[1]); const float incm = wscan_max(q1m, lane); float excm = __shfl_up(incm, 1); if (lane == 0) excm = -INFINITY;
      mm[0] = fmaxf(m_prev, fmaxf(excm, aa[0])); mm[1] = fmaxf(m_prev, fmaxf(excm, q1m));
      const float b_end = __shfl(bb[1], 63), mm_end = __shfl(mm[1], 63);
#pragma unroll
      for (int e = 0; e < 2; ++e) { const int ii = 2 * lane + e; rowexp[ii] = -mm[e] * L2E; colexp[ii] = aa[e] * L2E; isc[ii] = expf(m_prev - mm[e]); emn[ii] = expf(-(bb[e] + mm[e])); vw[ii] = expf(aa[e] - mm_end); }
      if (lane == 0) misc[0] = expf(m_prev - mm_end);
      m_prev = b_end + mm_end;
    }
    SCAN_BAR();
    {
      const float s = vw[i];
      u32x4 qa, qb, va, vb;
#pragma unroll
      for (int e = 0; e < 4; ++e) { qa[e] = cvtpk(bf_lo(q0[e]) * 0.125f, bf_hi(q0[e]) * 0.125f); qb[e] = cvtpk(bf_lo(q1[e]) * 0.125f, bf_hi(q1[e]) * 0.125f);
        va[e] = cvtpk(bf_lo(v0[e]) * s, bf_hi(v0[e]) * s); vb[e] = cvtpk(bf_lo(v1[e]) * s, bf_hi(v1[e]) * s); }
      const int o0 = img_off<128>(i, part * 16), o1 = img_off<128>(i, part * 16 + 8);
      *(LAS u32x4*)(Qm + o0) = qa; *(LAS u32x4*)(Qm + o1) = qb; *(LAS u32x4*)(Km + o0) = k0; *(LAS u32x4*)(Km + o1) = k1;
      *(LAS u32x4*)(Vm + o0) = v0; *(LAS u32x4*)(Vm + o1) = v1; *(LAS u32x4*)(Vw + o0) = va; *(LAS u32x4*)(Vw + o1) = vb;
      const int o2 = img_off<128>(i, 64 + part * 8);
      const unsigned one = part == 0 ? 0x3f80u : 0u, wkb = part == 0 ? (cvtpk(s, 0.f) & 0xffffu) : 0u;
      *(LAS u32x4*)(Vm + o2) = (u32x4){one, 0u, 0u, 0u}; *(LAS u32x4*)(Vw + o2) = (u32x4){wkb, 0u, 0u, 0u};
    }
    SCAN_BAR();
    f32x16 res0, res1; chunk_core<64, 96>(Qm, Km, Vm, Ss, rowexp, colexp, isc, res0, res1, wid, lane);
    const int tb = wid & 3, vp = wid >> 2, r32 = lane & 31, hh = lane >> 5;
    if (vp == 0 && r32 == 0) {
#pragma unroll
      for (int r = 0; r < 16; ++r) den[32 * tb + crow(r, hh)] = res1[r];
    }
    const float sd = misc[0];
    float em[16];
#pragma unroll
    for (int r = 0; r < 16; ++r) em[r] = emn[32 * tb + crow(r, hh)];
    SCAN_BAR();
#pragma unroll
    for (int r = 0; r < 16; ++r) { const int t = 32 * tb + crow(r, hh), ioo = dir ? 127 - t : t; const float dn = fmaxf(fabsf(den[t]), em[r]);
      HC[((size_t)dir * M + rowb + row0 + ioo) * 256 + h * 64 + 32 * vp + r32] = f2bf(res0[r] / dn); }
    state_update<64, 96>(Km, Vw, Ss, st_acc, sd, wid, lane);
  }
  SCAN_BAR();
}
#undef MFMA32
}
namespace pg8 {
typedef float f32x4e __attribute__((ext_vector_type(4)));
struct EpiInProj {
    static constexpr bool PERM = true, AFTER_DRAIN = false;
    bf16_t* O; float* G;
    __device__ __forceinline__ void operator()(const f32x4 (&acc)[2][2][4][2], const Unit& u, int wr, int wc, int fr, int fq) const {
        const int row0 = u.pm * BM + wr * 64 + fr, col0 = u.pn * BM + wc * 32 + 8 * fq;
#pragma unroll
        for (int ai = 0; ai < 2; ++ai)
#pragma unroll
            for (int m = 0; m < 4; ++m) { bf16_t* rowp = O + (size_t)(row0 + ai * HALF + m * 16) * 3328 + col0;
#pragma unroll
                for (int bj = 0; bj < 2; ++bj) { const f32x4 v0 = acc[ai][bj][m][0], v1 = acc[ai][bj][m][1];
                    u32x4 w; w.x = cvt_pk_bf16(v0[0], v0[1]); w.y = cvt_pk_bf16(v0[2], v0[3]); w.z = cvt_pk_bf16(v1[0], v1[1]); w.w = cvt_pk_bf16(v1[2], v1[3]);
                    *(u32x4*)(rowp + bj * HALF) = w; } }
        if (u.pn == 12 && wc == 0) {
#pragma unroll
            for (int ai = 0; ai < 2; ++ai)
#pragma unroll
                for (int m = 0; m < 4; ++m) { float* gp = G + (size_t)(row0 + ai * HALF + m * 16) * 32 + 8 * fq; *(f32x4*)gp = acc[ai][0][m][0]; *(f32x4*)(gp + 4) = acc[ai][0][m][1]; }
        }
    }
};
struct EpiRelu2 {
    static constexpr bool PERM = true, AFTER_DRAIN = false;
    bf16_t* O;
    __device__ __forceinline__ void operator()(const f32x4 (&acc)[2][2][4][2], const Unit& u, int wr, int wc, int fr, int fq) const {
        const int row0 = u.pm * BM + wr * 64 + fr, col0 = u.pn * BM + wc * 32 + 8 * fq;
#pragma unroll
        for (int ai = 0; ai < 2; ++ai)
#pragma unroll
            for (int m = 0; m < 4; ++m) { bf16_t* rowp = O + (size_t)(row0 + ai * HALF + m * 16) * 4096 + col0;
#pragma unroll
                for (int bj = 0; bj < 2; ++bj) { f32x4 v0 = acc[ai][bj][m][0], v1 = acc[ai][bj][m][1];
#pragma unroll
                    for (int e = 0; e < 4; ++e) { const float a = v0[e] > 0.f ? v0[e] : 0.f, b = v1[e] > 0.f ? v1[e] : 0.f; v0[e] = a * a; v1[e] = b * b; }
                    u32x4 w; w.x = cvt_pk_bf16(v0[0], v0[1]); w.y = cvt_pk_bf16(v0[2], v0[3]); w.z = cvt_pk_bf16(v1[0], v1[1]); w.w = cvt_pk_bf16(v1[2], v1[3]);
                    *(u32x4*)(rowp + bj * HALF) = w; } }
    }
};
struct EpiResid {
    static constexpr bool PERM = false, AFTER_DRAIN = false;
    const float* xin_lat; const float* xin_ctx; float* xout_lat; float* xout_ctx; const float* mod; int gate_off;
    __device__ __forceinline__ void operator()(const f32x4 (&acc)[2][2][4][2], const Unit& u, int wr, int wc, int fr, int fq) const {
        const int b = u.pm / 17, tp = u.pm % 17;
        const float* xin; float* xout; const float* gate;
        if (tp == 0) { xin = xin_ctx + (size_t)b * 256 * 1024; xout = xout_ctx + (size_t)b * 256 * 1024; gate = mod + 8 * 6144 + gate_off; }
        else { const size_t o = ((size_t)b * 4096 + (size_t)(tp - 1) * 256) * 1024; xin = xin_lat + o; xout = xout_lat + o; gate = mod + b * 6144 + gate_off; }
        const int col0 = u.pn * BM + wc * 32 + 4 * fq;
#pragma unroll
        for (int bj = 0; bj < 2; ++bj)
#pragma unroll
            for (int n = 0; n < 2; ++n) { const int cc = col0 + bj * HALF + n * 16; const f32x4 gv = *(const f32x4*)(gate + cc);
#pragma unroll
                for (int ai = 0; ai < 2; ++ai)
#pragma unroll
                    for (int m = 0; m < 4; ++m) { const size_t off = (size_t)(ai * HALF + wr * 64 + m * 16 + fr) * 1024 + cc; const f32x4 bs = *(const f32x4*)(xin + off); *(f32x4*)(xout + off) = bs + gv * acc[ai][bj][m][n]; }
                asm volatile("" ::: "memory"); }
    }
};
struct LatentOrder {
    StaticOrder base;
    __host__ __device__ void init(int N, int G_, int c_) { base.init(128 * 256, N, G_, c_); }
    __device__ __forceinline__ bool next(int i, Unit& u) const { if (!base.next(i, u)) return false; u.pm = (u.pm >> 4) * 17 + 1 + (u.pm & 15); return true; }
    __device__ __forceinline__ void a_ready(const Unit&) const {}
    __device__ __forceinline__ void done(const Unit&) const {}
};
}

namespace mk {
constexpr int NWAVES = 8;
constexpr int RING_OFF = 0, RING_BYTES = 131072, LDSCTL_OFF = RING_BYTES, MISC_OFF = LDSCTL_OFF + 320, LDS_BYTES = 147456;
#define RLX_AGENT __ATOMIC_RELAXED, __HIP_MEMORY_SCOPE_AGENT

struct Args {
  const float* in[25]; float* out; unsigned char* ws; int ph_lo, ph_hi, n_layers, use_cg;
};
enum { I_X = 0, I_C, I_CTX, I_CCTX, I_WADA, I_BADA, I_GN1, I_GN2, I_WIN, I_SINK, I_GQ, I_GK, I_BI, I_BF, I_GML, I_CW, I_CB, I_ALOG, I_DTB, I_DSK, I_GSSM, I_WOUT, I_W1, I_W2, I_GFIN };

template <class F> __device__ __forceinline__ void transpose_item(const float* W, int K, int N, bf16* WT, LAS float* scr, int item, int nblk, int lane, F srccol) {
  const int kb = item / nblk, nb = item % nblk, k0 = 64 * kb, n0 = 32 * nb;
  const int sc = srccol(n0 + (lane & 31));
#pragma unroll 8
  for (int i = 0; i < 32; ++i) { const int kk = 2 * i + (lane >> 5); scr[kk * 33 + (lane & 31)] = sc >= 0 ? W[(size_t)(k0 + kk) * N + sc] : 0.f; }
  asm volatile("s_waitcnt lgkmcnt(0)" ::: "memory");
  const int c = lane & 7;
#pragma unroll
  for (int j = 0; j < 4; ++j) { const int n = (lane >> 3) + 8 * j; const LAS float* s = scr + (8 * c) * 33 + n;
    u32x4 o; o.x = cvtpk(s[0 * 33], s[1 * 33]); o.y = cvtpk(s[2 * 33], s[3 * 33]); o.z = cvtpk(s[4 * 33], s[5 * 33]); o.w = cvtpk(s[6 * 33], s[7 * 33]);
    *(u32x4*)(WT + (size_t)(n0 + n) * K + k0 + 8 * c) = o; }
  asm volatile("s_waitcnt lgkmcnt(0)" ::: "memory");
}
__device__ __forceinline__ int win_srccol(int n) { return n < 2048 ? n : (n < 3072 ? n + 16 : (n < 3088 ? n - 1024 : (n < 3096 ? n : -1))); }

__device__ __forceinline__ void norm_row(const float* xrow, const float* g, const float* shv, const float* scv, bf16* orow, int lane) {
  const f32x4* xr = (const f32x4*)xrow + lane; f32x4 v[4]; float s = 0.f;
#pragma unroll
  for (int j = 0; j < 4; ++j) { v[j] = xr[64 * j]; s += (v[j].x * v[j].x + v[j].y * v[j].y) + (v[j].z * v[j].z + v[j].w * v[j].w); }
  const float rs = rsqrtf(wave_sum(s) * (1.f / DM) + EPS);
  unsigned long long* o8 = (unsigned long long*)orow + lane;
#pragma unroll
  for (int j = 0; j < 4; ++j) { const f32x4 gg = ((const f32x4*)g)[64 * j + lane], sh = ((const f32x4*)shv)[64 * j + lane], sc = ((const f32x4*)scv)[64 * j + lane];
    const f32x4 y = v[j] * rs * gg * (sc + 1.f) + sh;
    o8[64 * j] = (unsigned long long)cvtpk(y.x, y.y) | ((unsigned long long)cvtpk(y.z, y.w) << 32); }
}

__device__ __forceinline__ void attn_item(int idx, const bf16* P, bf16* Y, const float* sink, char* shm) {
  using attn_body::attn_unit; typedef attn_body::bf16 abf;
  bool isA; int b, hq, qrow, NT, band_row0 = 0, qpos0 = 0, band_s0 = 0;
  if (idx < 1024) { isA = idx >= 512; const int id = idx & 511; b = id >> 6; hq = (id >> 4) & 3; const int q0 = (id & 15) * 256; qrow = NC + q0; NT = 68;
    if (isA) { const int s_lo = q0 - 128 > 0 ? q0 - 128 : 0, s_hi = q0 + 384 < T ? q0 + 384 : T; NT = 4 + (s_hi - s_lo) / 64; band_row0 = NC + s_lo; qpos0 = q0; band_s0 = s_lo; } }
  else { const int id = idx - 1024; isA = id >= 32; b = (id & 31) >> 2; hq = id & 3; qrow = 0; NT = 4; }
  const int g = hq >> 1; const size_t rowb = (size_t)b * RB; const int cq = isA ? 0 : 512, ck = isA ? 256 : 768, cv = isA ? 384 : 896, cy = isA ? 0 : 256;
  const abf* Q0 = (const abf*)(P + (rowb + qrow) * NP + cq + hq * 64); const abf* Kh = (const abf*)(P + rowb * NP + ck + g * 64); const abf* Vh = (const abf*)(P + rowb * NP + cv + g * 64);
  abf* O0 = (abf*)(Y + (rowb + qrow) * DM + cy + hq * 64);
#ifndef MK_NO_B
  if (!isA) attn_unit<8, 0>(Q0, Kh, Vh, O0, NT, 0, 0, 0, 0.f, shm);
#endif
#ifndef MK_NO_A
  if (isA) attn_unit<8, 1>(Q0, Kh, Vh, O0, NT, band_row0, qpos0, band_s0, sink[hq] * L2E, shm);
#endif
}

__global__ void __launch_bounds__(NWAVES * 64, 2) mk_fwd(Args args) {
  extern __shared__ __attribute__((aligned(16))) unsigned char lds_raw[];
  LAS unsigned char* lds = (LAS unsigned char*)lds_raw;
  volatile LAS unsigned* MISC = (volatile LAS unsigned*)(lds + MISC_OFF);
  const int tid0 = threadIdx.x, wave = __builtin_amdgcn_readfirstlane(tid0 >> 6);
  const int G = gridDim.x; const int bx = blockIdx.x; const int vcu = (G % 8 == 0) ? (bx % 8) * (G / 8) + bx / 8 : bx;
  for (int u = tid0; u < (LDS_BYTES - LDSCTL_OFF) / 4; u += NWAVES * 64) ((LAS unsigned*)(lds + LDSCTL_OFF))[u] = 0u;
  __syncthreads();
  XcdBarrier bar = xcd_barrier_post(((unsigned*)(args.ws + WS_CTL)) + CW_BAR, MISC + 8);
#ifndef MK_PHSEL
#define MK_PHSEL 0xFFFF
#endif
#define PH_PROLOG int tid = threadIdx.x; asm volatile("" : "+v"(tid)); const int lane = tid & 63; (void)lane; unsigned char* wsp = args.ws; asm volatile("" : "+s"(wsp));
  const int gw = vcu * NWAVES + wave, NGW = G * NWAVES;

  const int nph = 1 + 9 * args.n_layers + 1;
#pragma unroll 1
  for (int ph = args.ph_lo; ph < args.ph_hi; ++ph) {
  int kind, l = 0;
  if (ph == 0) kind = 0; else if (ph == nph - 1) kind = 10; else { l = (ph - 1) / 9; kind = 1 + (ph - 1) % 9; }
  if (kind == 0) { PH_PROLOG if ((MK_PHSEL >> 0) & 1) {
    {
      if (vcu >= G - 24) {
        LAS float* sc = (LAS float*)(lds + RING_OFF);
        for (int i = tid; i < 9 * DM; i += NWAVES * 64) { const int j = i / DM, k = i % DM; const float v = j < 8 ? args.in[I_C][j * DM + k] : args.in[I_CCTX][k]; sc[i] = v / (1.f + expf(-v)); }
        __syncthreads();
        const int o = (vcu - (G - 24)) * 512 + tid;
        const int l = o / 6144, n = o % 6144; const float* w = args.in[I_WADA] + (size_t)l * DM * 6144 + n;
        float acc[9];
#pragma unroll
        for (int j = 0; j < 9; ++j) acc[j] = 0.f;
        for (int k = 0; k < DM; ++k) { const float wv = w[(size_t)k * 6144];
#pragma unroll
          for (int j = 0; j < 9; ++j) acc[j] += sc[j * DM + k] * wv; }
        const float bb = args.in[I_BADA][l * 6144 + n];
#pragma unroll
        for (int j = 0; j < 9; ++j) ((float*)(wsp + WS_MOD))[(size_t)(l * 9 + j) * 6144 + n] = acc[j] + bb;
        __syncthreads();
      }
      for (int i = gw * 64 + lane; i < T * 32; i += NGW * 64) { const int t = i >> 5, e = i & 31, fi = e & 15; const float invf = exp2f(-(float)fi * (13.287712379549449f / 16.f));
        const float ang = (float)(e < 16 ? (t >> 6) : (t & 63)) * invf; ((float*)(wsp + WS_CS))[i] = cosf(ang); ((float*)(wsp + WS_CS))[T * 32 + i] = sinf(ang); }
      LAS float* scr = (LAS float*)(lds + RING_OFF + 40960 + wave * 8704);
      constexpr int I_IN = 16 * 104, I_OUT = 16 * 32, I_1 = 16 * 128, I_2 = 64 * 32, I_L = I_IN + I_OUT + I_1 + I_2;
      for (int it = gw; it < 2 * I_L; it += NGW) {
        const int l = it / I_L; int r = it % I_L; unsigned char* wl = (wsp) + WS_W + (size_t)l * W_LAYER;
        if (r < I_IN) { transpose_item(args.in[I_WIN] + (size_t)l * DM * NINO, DM, NINO, (bf16*)(wl + WO_IN), scr, r, 104, lane, [](int n) { return win_srccol(n); }); continue; } r -= I_IN;
        if (r < I_OUT) { transpose_item(args.in[I_WOUT] + (size_t)l * DM * DM, DM, DM, (bf16*)(wl + WO_OUT), scr, r, 32, lane, [](int n) { return n; }); continue; } r -= I_OUT;
        if (r < I_1) { transpose_item(args.in[I_W1] + (size_t)l * DM * DFF, DM, DFF, (bf16*)(wl + WO_1), scr, r, 128, lane, [](int n) { return n; }); continue; } r -= I_1;
        transpose_item(args.in[I_W2] + (size_t)l * DFF * DM, DFF, DM, (bf16*)(wl + WO_2), scr, r, 32, lane, [](int n) { return n; });
      }
    }
  } }

  {
    if (kind == 1) { PH_PROLOG if ((MK_PHSEL >> 1) & 1) {
      for (int m = gw; m < M; m += NGW) { const int b = m / RB, r = m % RB; const bool isc = r < NC;
        const float* xr = isc ? (l == 0 ? args.in[I_CTX] : (const float*)(wsp + WS_XC)) + ctx_off(b, r) : (l == 0 ? args.in[I_X] : (const float*)args.out) + lat_off(b, r - NC); const float* mr = (((float*)(wsp + WS_MOD)) + (size_t)l * 9 * 6144) + (isc ? 8 : b) * 6144;
        norm_row(xr, args.in[I_GN1] + l * DM, mr, mr + 1024, ((bf16*)(wsp + WS_H)) + (size_t)m * DM, lane); }
    } }
    if (kind == 2) { PH_PROLOG if ((MK_PHSEL >> 2) & 1) {
      { pg8::Gemm g{((bf16*)(wsp + WS_H)), (const bf16*)((wsp + WS_W + (size_t)l * W_LAYER) + WO_IN), M, NP, DM}; pg8::StaticOrder S; S.init(M, NP, G, bx);
        pg8::EpiInProj E{((bf16*)(wsp + WS_P)), ((float*)(wsp + WS_G))}; pg8::gemm_phase<pg8::EpiInProj, pg8::StaticOrder, true, true>(lds + RING_OFF, g, S, E); }
    } }
    if (kind == 3) { PH_PROLOG if ((MK_PHSEL >> 3) & 1) {
      { const float* gq = args.in[I_GQ] + l * 64; const float* gk = args.in[I_GK] + l * 64;
        for (int it = gw; it < M * 12; it += NGW) { const int m = it / 12, slot = it % 12, r = m % RB;
          const int col = slot < 4 ? slot * 64 : (slot < 6 ? 256 + (slot - 4) * 64 : (slot < 10 ? 512 + (slot - 6) * 64 : 768 + (slot - 10) * 64));
          const bool isq = slot < 4 || (slot >= 6 && slot < 10), isB = slot >= 6;
          bf16* p = ((bf16*)(wsp + WS_P)) + (size_t)m * NP + col + lane; float x = bf2f(*p);
          if (isB) { const float ss = wave_sum(x * x); x = x * rsqrtf(ss * (1.f / 64.f) + EPS) * (isq ? gq[lane] : gk[lane]); }
          if (r >= NC) { const int t = r - NC; const float other = __shfl_xor(x, 16); const int e = ((lane >> 5) << 4) + (lane & 15); const float c = ((float*)(wsp + WS_CS))[t * 32 + e], s = ((float*)(wsp + WS_CS))[T * 32 + t * 32 + e];
            x = (lane & 16) ? x * c + other * s : x * c - other * s; }
          if (isq) x *= QC2;
          *p = f2bf(x); } }
    } }
    if (kind == 4) { PH_PROLOG if ((MK_PHSEL >> 4) & 1) {
      {
#ifndef MK_NO_MAMBA
        if (bx < 64) scan::mamba_chain((LAS char*)lds, ((bf16*)(wsp + WS_P)), ((float*)(wsp + WS_G)), args.in[I_CW] + l * 3 * 768, args.in[I_CB] + l * 768, args.in[I_ALOG] + l * 8, args.in[I_DTB] + l * 8, ((bf16*)(wsp + WS_YD)), bx >> 3, (bx >> 1) & 3, bx & 1);
#endif
#ifndef MK_NO_MLSTM
        if (bx >= 64 && bx < 128) { const int c = bx - 64; scan::mlstm_chain((LAS char*)lds, ((bf16*)(wsp + WS_P)), ((float*)(wsp + WS_G)), args.in[I_BI] + l * 8, args.in[I_BF] + l * 8, ((bf16*)(wsp + WS_HC)), c >> 3, (c >> 1) & 3, c & 1); }
#endif
        const int nunits = (l == 1) ? 1024 : 1088;
        for (;;) {
          if (tid == 0) MISC[16] = __hip_atomic_fetch_add(((unsigned*)(wsp + WS_CTL)) + CW_QUEUE + 64 * l, 1u, RLX_AGENT);
          __syncthreads(); const int idx = __builtin_amdgcn_readfirstlane((int)MISC[16]); __syncthreads();
          if (idx >= nunits) break;
          attn_item(idx, ((bf16*)(wsp + WS_P)), ((bf16*)(wsp + WS_Y)), args.in[I_SINK] + l * 4, (char*)lds_raw + RING_OFF);
        } }
    } }
    if (kind == 5) { PH_PROLOG if ((MK_PHSEL >> 5) & 1) {
      { const float* gml = args.in[I_GML] + l * 256; const float* gss = args.in[I_GSSM] + l * 256; const float* dsk = args.in[I_DSK] + l * 4; const float* cw = args.in[I_CW] + l * 3 * 768; const float* cb = args.in[I_CB] + l * 768;
        for (int m = gw; m < M; m += NGW) { const int r = m % RB; if ((l == 1) && r < NC) continue;
          const int c0 = 4 * lane;
          { const u32x2 a = *(const u32x2*)(((bf16*)(wsp + WS_HC)) + (size_t)m * 256 + c0), bq = *(const u32x2*)(((bf16*)(wsp + WS_HC)) + ((size_t)M + m) * 256 + c0);
            float hs[4] = {bf_lo(a.x) + bf_lo(bq.x), bf_hi(a.x) + bf_hi(bq.x), bf_lo(a.y) + bf_lo(bq.y), bf_hi(a.y) + bf_hi(bq.y)};
            float ss = hs[0] * hs[0] + hs[1] * hs[1] + hs[2] * hs[2] + hs[3] * hs[3];
            ss += __shfl_xor(ss, 1); ss += __shfl_xor(ss, 2); ss += __shfl_xor(ss, 4); ss += __shfl_xor(ss, 8);
            const float rs = rsqrtf(ss * (1.f / 64.f) + EPS); const u32x2 ow = *(const u32x2*)(((bf16*)(wsp + WS_P)) + (size_t)m * NP + 1792 + c0); const f32x4 gg = *(const f32x4*)(gml + c0);
            const float o4[4] = {bf_lo(ow.x), bf_hi(ow.x), bf_lo(ow.y), bf_hi(ow.y)}; float y[4];
#pragma unroll
            for (int e = 0; e < 4; ++e) y[e] = hs[e] * rs * gg[e] / (1.f + __expf(-o4[e]));
            *(u32x2*)(((bf16*)(wsp + WS_Y)) + (size_t)m * DM + 512 + c0) = (u32x2){cvtpk(y[0], y[1]), cvtpk(y[2], y[3])}; }
          { const u32x2 a = *(const u32x2*)(((bf16*)(wsp + WS_YD)) + (size_t)m * 256 + c0), bq = *(const u32x2*)(((bf16*)(wsp + WS_YD)) + ((size_t)M + m) * 256 + c0);
            const int seg0 = r < NC ? 0 : NC, seglen = r < NC ? NC : T, sl = r - seg0; const bf16* px = ((bf16*)(wsp + WS_P)) + (size_t)m * NP + 2048 + c0; const u32x2 z2 = {0u, 0u};
            const u32x2 xm = sl > 0 ? *(const u32x2*)(px - NP) : z2, x0 = *(const u32x2*)px, xp = sl + 1 < seglen ? *(const u32x2*)(px + NP) : z2;
            const float im[4] = {bf_lo(xm.x), bf_hi(xm.x), bf_lo(xm.y), bf_hi(xm.y)}, i0[4] = {bf_lo(x0.x), bf_hi(x0.x), bf_lo(x0.y), bf_hi(x0.y)}, ip[4] = {bf_lo(xp.x), bf_hi(xp.x), bf_lo(xp.y), bf_hi(xp.y)};
            const f32x4 w0 = *(const f32x4*)(cw + c0), w1 = *(const f32x4*)(cw + 768 + c0), w2 = *(const f32x4*)(cw + 1536 + c0), bb = *(const f32x4*)(cb + c0);
            const u32x2 zw = *(const u32x2*)(((bf16*)(wsp + WS_P)) + (size_t)m * NP + 2304 + c0); const float z4[4] = {bf_lo(zw.x), bf_hi(zw.x), bf_lo(zw.y), bf_hi(zw.y)};
            const float ys[4] = {bf_lo(a.x) + bf_lo(bq.x), bf_hi(a.x) + bf_hi(bq.x), bf_lo(a.y) + bf_lo(bq.y), bf_hi(a.y) + bf_hi(bq.y)};
            const float dk = dsk[lane >> 4]; float v[4]; float ss = 0.f;
#pragma unroll
            for (int e = 0; e < 4; ++e) { const float cv = bb[e] + w0[e] * im[e] + w1[e] * i0[e] + w2[e] * ip[e]; const float xs = cv / (1.f + __expf(-cv));
              v[e] = (ys[e] + dk * xs) * (z4[e] / (1.f + __expf(-z4[e]))); ss += v[e] * v[e]; }
            const float rs = rsqrtf(wave_sum(ss) * (1.f / 256.f) + EPS); const f32x4 gg = *(const f32x4*)(gss + c0);
            *(u32x2*)(((bf16*)(wsp + WS_Y)) + (size_t)m * DM + 768 + c0) = (u32x2){cvtpk(v[0] * rs * gg[0], v[1] * rs * gg[1]), cvtpk(v[2] * rs * gg[2], v[3] * rs * gg[3])}; }
        } }
    } }
    if (kind == 6) { PH_PROLOG if ((MK_PHSEL >> 6) & 1) {
      { pg8::Gemm g{((bf16*)(wsp + WS_Y)), (const bf16*)((wsp + WS_W + (size_t)l * W_LAYER) + WO_OUT), M, DM, DM}; pg8::EpiResid E{(l == 0 ? args.in[I_X] : (const float*)args.out), (l == 0 ? args.in[I_CTX] : (const float*)(wsp + WS_XC)), (args.out), ((float*)(wsp + WS_XC)), (((float*)(wsp + WS_MOD)) + (size_t)l * 9 * 6144), 2048};
        if (!(l == 1)) { pg8::StaticOrder S; S.init(M, DM, G, bx); pg8::gemm_phase<pg8::EpiResid, pg8::StaticOrder, true, true>(lds + RING_OFF, g, S, E); }
        else { pg8::LatentOrder S; S.init(DM, G, bx); pg8::gemm_phase<pg8::EpiResid, pg8::LatentOrder, true, true>(lds + RING_OFF, g, S, E); } }
    } }
    if (kind == 7) { PH_PROLOG if ((MK_PHSEL >> 7) & 1) {
      for (int m = gw; m < M; m += NGW) { const int b = m / RB, r = m % RB; const bool isc = r < NC; if ((l == 1) && isc) continue;
        const float* xr = isc ? ((float*)(wsp + WS_XC)) + ctx_off(b, r) : (args.out) + lat_off(b, r - NC); const float* mr = (((float*)(wsp + WS_MOD)) + (size_t)l * 9 * 6144) + (isc ? 8 : b) * 6144;
        norm_row(xr, args.in[I_GN2] + l * DM, mr + 3072, mr + 4096, ((bf16*)(wsp + WS_H)) + (size_t)m * DM, lane); }
    } }
    if (kind == 8) { PH_PROLOG if ((MK_PHSEL >> 8) & 1) {
      { pg8::Gemm g{((bf16*)(wsp + WS_H)), (const bf16*)((wsp + WS_W + (size_t)l * W_LAYER) + WO_1), M, DFF, DM}; pg8::EpiRelu2 E{((bf16*)(wsp + WS_U))};
        if (!(l == 1)) { pg8::StaticOrder S; S.init(M, DFF, G, bx); pg8::gemm_phase<pg8::EpiRelu2, pg8::StaticOrder, true, true>(lds + RING_OFF, g, S, E); }
        else { pg8::LatentOrder S; S.init(DFF, G, bx); pg8::gemm_phase<pg8::EpiRelu2, pg8::LatentOrder, true, true>(lds + RING_OFF, g, S, E); } }
    } }
    if (kind == 9) { PH_PROLOG if ((MK_PHSEL >> 9) & 1) {
      { pg8::Gemm g{((bf16*)(wsp + WS_U)), (const bf16*)((wsp + WS_W + (size_t)l * W_LAYER) + WO_2), M, DM, DFF}; pg8::EpiResid E{(args.out), ((float*)(wsp + WS_XC)), (args.out), ((float*)(wsp + WS_XC)), (((float*)(wsp + WS_MOD)) + (size_t)l * 9 * 6144), 5120};
        if (!(l == 1)) { pg8::StaticOrder S; S.init(M, DM, G, bx); pg8::gemm_phase<pg8::EpiResid, pg8::StaticOrder, true, true>(lds + RING_OFF, g, S, E); }
        else { pg8::LatentOrder S; S.init(DM, G, bx); pg8::gemm_phase<pg8::EpiResid, pg8::LatentOrder, true, true>(lds + RING_OFF, g, S, E); } }
    } }
  }
  if (kind == 10) { PH_PROLOG if ((MK_PHSEL >> 10) & 1) {
    { const float* gf = args.in[I_GFIN];
      for (int m = gw; m < NB * T; m += NGW) { f32x4* xr = (f32x4*)((args.out) + (size_t)m * DM) + lane; f32x4 v[4]; float s = 0.f;
#pragma unroll
        for (int j = 0; j < 4; ++j) { v[j] = xr[64 * j]; s += (v[j].x * v[j].x + v[j].y * v[j].y) + (v[j].z * v[j].z + v[j].w * v[j].w); }
        const float rs = rsqrtf(wave_sum(s) * (1.f / DM) + EPS);
#pragma unroll
        for (int j = 0; j < 4; ++j) xr[64 * j] = v[j] * rs * ((const f32x4*)gf)[64 * j + lane]; } }
  } }
  if (ph + 1 < args.ph_hi) { if (args.use_cg && ph == args.ph_lo) cooperative_groups::this_grid().sync(); else xcd_barrier(bar); }
  }
#undef PH_PROLOG
}
constexpr int N_PHASES = 1 + 2 * 9 + 1;

static void launch(void* const* d_in, float* out, void* d_ws, hipStream_t stream, int n_launch_mode  , int n_layers) {
  static int grid = 0;
  if (grid == 0) {
    int dev = 0, cus = 0, per_cu = 0;
    (void)hipGetDevice(&dev); (void)hipDeviceGetAttribute(&cus, hipDeviceAttributeMultiprocessorCount, dev);
    (void)hipFuncSetAttribute((const void*)mk_fwd, hipFuncAttributeMaxDynamicSharedMemorySize, LDS_BYTES);
    (void)hipOccupancyMaxActiveBlocksPerMultiprocessor(&per_cu, (const void*)mk_fwd, NWAVES * 64, LDS_BYTES);
    (void)hipGetLastError();
    if (per_cu < 1) fprintf(stderr, "mk: occupancy query says %d blocks per CU\n", per_cu);
    grid = cus;
  }
  (void)hipMemsetAsync((char*)d_ws + WS_CTL, 0, CTL_ZERO_BYTES, stream);
  Args a{}; for (int i = 0; i < 25; ++i) a.in[i] = (const float*)d_in[i];
  a.out = out; a.ws = (unsigned char*)d_ws; a.n_layers = n_layers;
  const int nph = 1 + n_layers * 9 + 1;
  if (n_launch_mode == 0) {
    a.ph_lo = 0; a.ph_hi = nph; a.use_cg = 1;
    void* kargs[] = {&a};
    hipError_t e = hipLaunchCooperativeKernel((const void*)mk_fwd, dim3(grid), dim3(NWAVES * 64), kargs, LDS_BYTES, stream);
    if (e != hipSuccess) { fprintf(stderr, "mk: cooperative launch failed (%s), plain launch instead\n", hipGetErrorName(e)); (void)hipGetLastError(); a.use_cg = 0; hipLaunchKernelGGL(mk_fwd, dim3(grid), dim3(NWAVES * 64), LDS_BYTES, stream, a); }
  }
  else for (int p = 0; p < nph; ++p) { a.ph_lo = p; a.ph_hi = p + 1; hipLaunchKernelGGL(mk_fwd, dim3(grid), dim3(NWAVES * 64), LDS_BYTES, stream, a); }
  const hipError_t le = hipPeekAtLastError(); if (le != hipSuccess) fprintf(stderr, "mk: launch failed: %s\n", hipGetErrorName(le));
}
}
extern "C" void kernel_launch(void* const* d_in, const int* in_sizes, int n_in, void* d_out, int out_size, void* d_ws, size_t ws_size, hipStream_t stream) {
  mk::launch(d_in, (float*)d_out, d_ws, stream, MK_LAUNCH_MODE, 2);
}
```

```cpp
#define MK_LAUNCH_MODE 0
#include <hip/hip_runtime.h>
#include <hip/hip_bf16.h>
#include <hip/hip_cooperative_groups.h>
#include <cstdint>
#include <cstdio>
#include <cmath>
#define GAS __attribute__((address_space(1)))
#define LAS __attribute__((address_space(3)))
namespace mk {
constexpr int NB = 8, T = 4096, NC = 256, RB = T + NC, M = NB * RB, DM = 1024, NP = 3328, DFF = 4096, TPB = RB / 256, NINO = 3096;
constexpr float EPS = 1e-6f, L2E = 1.4426950408889634f;
constexpr float QC2 = 0.125f * 1.4426950408889634f;
typedef unsigned short bf16;
typedef unsigned u32x4 __attribute__((ext_vector_type(4)));
typedef unsigned u32x2 __attribute__((ext_vector_type(2)));
typedef float f32x4 __attribute__((ext_vector_type(4)));
typedef float f32x16 __attribute__((ext_vector_type(16)));
typedef short bf16x8 __attribute__((ext_vector_type(8)));
typedef short s16x4 __attribute__((ext_vector_type(4)));
typedef float f32x2v __attribute__((ext_vector_type(2)));
typedef __bf16 bf16x2v __attribute__((ext_vector_type(2)));

constexpr size_t MiB = 1u << 20;
constexpr size_t WS_CTL = 0, CTL_ZERO_BYTES = 1 * MiB;
constexpr size_t WS_MOD = 1 * MiB;
constexpr size_t WS_CS = 2 * MiB;
constexpr size_t WS_G = 4 * MiB;
constexpr size_t WS_XC = 9 * MiB;
constexpr size_t WS_W = 17 * MiB;
constexpr size_t W_LAYER = (size_t)(NP + DM + DFF + DFF) * 1024 * 2;
constexpr size_t WO_IN = 0, WO_OUT = (size_t)NP * DM * 2, WO_1 = WO_OUT + (size_t)DM * DM * 2, WO_2 = WO_1 + (size_t)DFF * DM * 2;
constexpr size_t WS_H = 66 * MiB;
constexpr size_t WS_P = 134 * MiB;
constexpr size_t WS_Y = 355 * MiB;
constexpr size_t WS_U = WS_P;
constexpr size_t WS_UC = 423 * MiB;
constexpr size_t WS_END = 474 * MiB;
static_assert(WS_W + 2 * W_LAYER <= WS_H && WS_H + (size_t)M * DM * 2 <= WS_P && WS_P + (size_t)M * NP * 2 <= WS_Y && WS_U + (size_t)M * DFF * 2 <= WS_UC && WS_UC + (size_t)M * 768 * 2 <= WS_END, "ws map");
constexpr size_t WS_HC = WS_H, WS_YD = WS_H + (size_t)2 * M * 256 * 2;
constexpr int CW_BAR = 4096;
constexpr int CW_QUEUE = 16384;

__device__ __forceinline__ unsigned cvtpk(float lo, float hi) { f32x2v v = {lo, hi}; bf16x2v b = __builtin_convertvector(v, bf16x2v); return __builtin_bit_cast(unsigned, b); }
__device__ __forceinline__ float bf_lo(unsigned w) { return __uint_as_float(w << 16); }
__device__ __forceinline__ float bf_hi(unsigned w) { return __uint_as_float(w & 0xffff0000u); }
__device__ __forceinline__ float bf2f(bf16 v) { return __uint_as_float(((unsigned)v) << 16); }
__device__ __forceinline__ bf16 f2bf(float f) { return (bf16)(cvtpk(f, 0.f) & 0xffffu); }
__device__ __forceinline__ float wave_sum(float v) {
#pragma unroll
  for (int o = 1; o < 64; o <<= 1) v += __shfl_xor(v, o);
  return v;
}
__device__ __forceinline__ int crow(int r, int hi) { return (r & 3) + 8 * (r >> 2) + 4 * hi; }
__device__ __forceinline__ size_t lat_off(int b, int t) { return ((size_t)b * T + t) * DM; }
__device__ __forceinline__ size_t ctx_off(int b, int j) { return ((size_t)b * NC + j) * DM; }
}
typedef GAS unsigned gu32;
typedef GAS unsigned long long gu64;

#define XB_TMO      128
#define XB_XCNT(j)  (256  + 64 * (j))
#define XB_XSUB(j)  (1280 + 64 * (j))
#define XB_XGEN(j)  (2304 + 64 * (j))
#define XB_TOP      3328
#define XB_TOPGEN   3392
#define XCD_BAR_WORDS 3456
#define XB_SPIN_CAP (1u << 18)

__device__ __forceinline__ unsigned xb_ld(unsigned* p)              { return __hip_atomic_load(p, __ATOMIC_RELAXED, __HIP_MEMORY_SCOPE_AGENT); }
__device__ __forceinline__ unsigned xb_add(unsigned* p, unsigned v) { return __hip_atomic_fetch_add(p, v, __ATOMIC_RELAXED, __HIP_MEMORY_SCOPE_AGENT); }
__device__ __forceinline__ unsigned xb_xcc_id() { return (unsigned)__builtin_amdgcn_s_getreg((3 << 11) | 20) & 0xFu; }
#define XB_SPIN(cond, bar) do { unsigned _sp = 0; while (cond) { __builtin_amdgcn_s_sleep(1); \
    if ((++_sp & 255u) == 0u) { if (xb_ld(&(bar)[XB_TMO])) break; if (_sp > XB_SPIN_CAP) { atomicAdd(&(bar)[XB_TMO], 1u); break; } } } } while (0)

struct XcdBarrier {
    unsigned* bar; unsigned x;
    volatile LAS unsigned* st;
};

__device__ __forceinline__ XcdBarrier xcd_barrier_post(unsigned* bar, volatile LAS unsigned* st) {
    XcdBarrier b; b.bar = bar; b.x = xb_xcc_id(); b.st = st;
    if (threadIdx.x == 0) (void)xb_add(&bar[XB_XCNT(b.x)], 1u);
    return b;
}
__device__ __forceinline__ void xcd_barrier_complete(unsigned* bar, unsigned x, unsigned& nloc, unsigned& nx) {
    const unsigned G = gridDim.x * gridDim.y * gridDim.z;
    unsigned sum, cnt, mine, sp = 0u;
    for (;;) {
        sum = 0u; cnt = 0u; mine = 0u;
#pragma unroll 1
        for (unsigned j = 0; j < 16; ++j) { const unsigned c = xb_ld(&bar[XB_XCNT(j)]); sum += c; cnt += (c > 0u) ? 1u : 0u; mine = (j == x) ? c : mine; }
        if (sum == G) break;
        __builtin_amdgcn_s_sleep(1);
        if ((++sp & 255u) == 0u) { if (xb_ld(&bar[XB_TMO])) break; if (sp > XB_SPIN_CAP) { atomicAdd(&bar[XB_TMO], 1u); break; } }
    }
    nloc = mine > 0u ? mine : 1u; nx = cnt > 0u ? cnt : 1u;
}

__device__ __forceinline__ void xcd_barrier(const XcdBarrier& b) {
    asm volatile("s_waitcnt vmcnt(0)" ::: "memory");
    __syncthreads();
    if (threadIdx.x == 0) {
        unsigned* bar = b.bar;
        __builtin_amdgcn_s_waitcnt(0);
        unsigned nloc = b.st[0], nx = b.st[1];
        if (nloc == 0u) { xcd_barrier_complete(bar, b.x, nloc, nx); b.st[0] = nloc; b.st[1] = nx; }
        const unsigned old = xb_add(&bar[XB_XSUB(b.x)], 1u);
        const unsigned gen = old / nloc;
        if (old + 1u == (gen + 1u) * nloc) {
            __builtin_amdgcn_fence(__ATOMIC_RELEASE, "agent");
            asm volatile("s_waitcnt vmcnt(0)" ::: "memory");
            const unsigned og = xb_add(&bar[XB_TOP], 1u);
            const unsigned tg = og / nx;
            if (og + 1u == (tg + 1u) * nx) xb_add(&bar[XB_TOPGEN], 1u);
            else XB_SPIN(xb_ld(&bar[XB_TOPGEN]) == tg, bar);
            __builtin_amdgcn_fence(__ATOMIC_ACQUIRE, "agent");
            xb_add(&bar[XB_XGEN(b.x)], 1u);
            asm volatile("s_waitcnt vmcnt(0)" ::: "memory");
        } else {
            XB_SPIN(xb_ld(&bar[XB_XGEN(b.x)]) == gen, bar);
            __builtin_amdgcn_fence(__ATOMIC_ACQUIRE, "agent");
            asm volatile("s_waitcnt vmcnt(0)" ::: "memory");
        }
    }
    __syncthreads();
}
namespace pg8 {
#define PG8_LAS __attribute__((address_space(3)))
typedef unsigned short bf16_t;
typedef short bf16x8 __attribute__((ext_vector_type(8)));
typedef float f32x4 __attribute__((ext_vector_type(4)));
typedef unsigned u32x4 __attribute__((ext_vector_type(4)));
constexpr int BM = 256, BK = 64, HALF = 128, HTB = HALF * BK * 2  , STAGE_BYTES = 8 * HTB, NXCD = 8, WGM = 8;

__host__ __device__ __forceinline__ int lds_byte(int r, int c) { const int st = (r >> 4) * 2 + (c >> 5), rr = r & 15, cc = c & 31, ob = rr * 64 + cc * 2; return st * 1024 + (ob ^ (((ob >> 9) & 1) << 5)); }
__host__ __device__ __forceinline__ void stage_rc(int b, int& R, int& C) { const int st = b / 1024, sb = b % 1024, swz = sb ^ (((sb >> 9) & 1) << 5); R = (st >> 1) * 16 + swz / 64; C = (st & 1) * 32 + (swz % 64) / 2; }
__host__ __device__ __forceinline__ int perm32(int rho) { const int n = rho >> 4, i = rho & 15; return 8 * (i >> 2) + 4 * n + (i & 3); }

struct Unit { int pm, pn; };
struct Gemm { const bf16_t* A; const bf16_t* Bt; int M, N, K; };

struct StaticOrder {
    int nM, nN, nwg, G, c;
    __host__ __device__ void init(int M, int N, int G_, int c_) { nM = M / BM; nN = N / BM; nwg = nM * nN; G = G_; c = c_; }
    __host__ __device__ bool next(int i, Unit& u) const {
        const long L = (long)i * G + c; if (L >= nwg) return false;
        int wgid = (int)L; { const int q = nwg / NXCD, r = nwg % NXCD, xcd = wgid % NXCD, off = wgid / NXCD; wgid = (xcd < r ? xcd * (q + 1) : r * (q + 1) + (xcd - r) * q) + off; }
        const int nig = WGM * nN, gid = wgid / nig, fm = gid * WGM, gsz = (nM - fm) < WGM ? (nM - fm) : WGM;
        u.pm = fm + ((wgid % nig) % gsz); u.pn = (wgid % nig) / gsz; return true;
    }
    __device__ __forceinline__ void a_ready(const Unit&) const {}
    __device__ __forceinline__ void done(const Unit&) const {}
};

__device__ __forceinline__ unsigned cvt_pk_bf16(float lo, float hi) { unsigned r; asm volatile("v_cvt_pk_bf16_f32 %0, %1, %2" : "=v"(r) : "v"(lo), "v"(hi)); return r; }
typedef float f32x2 __attribute__((ext_vector_type(2)));
__device__ __forceinline__ f32x2 gelu_pk(f32x2 v) {
    const f32x2 av = __builtin_elementwise_abs(v), d = av * 0.2316418882f + 1.0f;
    f32x2 t; t.x = __builtin_amdgcn_rcpf(d.x); t.y = __builtin_amdgcn_rcpf(d.y);
    f32x2 q = t * 0.5307027145f + (-0.7265760135f); q = q * t + 0.7107068705f; q = q * t + (-0.142248368f); q = q * t + 0.127414796f; q = q * t;
    const f32x2 s = (v * v) * (-0.72134752044f);
    f32x2 e; e.x = __builtin_amdgcn_exp2f(s.x); e.y = __builtin_amdgcn_exp2f(s.y);
    const f32x2 m = v * (q * e), r = v - m;
    f32x2 o; o.x = v.x < 0.f ? m.x : r.x; o.y = v.y < 0.f ? m.y : r.y; return o;
}

template <int ACT  > struct EpiBf16 {
    static constexpr bool PERM = true, AFTER_DRAIN = false; static_assert(ACT == 0 || ACT == 1, "EpiBf16: ACT is 0 (none) or 1 (gelu_pk)");
    bf16_t* O; int ldc; const float* bias; int split_cols; size_t split_stride; float scale0;
    __device__ __forceinline__ void operator()(const f32x4 (&acc)[2][2][4][2], const Unit& u, int wr, int wc, int fr, int fq) const {
        const int row0 = u.pm * BM + wr * 64 + fr; int colt = u.pn * BM; bf16_t* base = O;
        float sc = 1.f; if (split_cols) { const int t = colt / split_cols; base += (size_t)t * split_stride; colt -= t * split_cols; if (t == 0) sc = scale0; }
        const int col0 = colt + wc * 32 + 8 * fq, bcol0 = u.pn * BM + wc * 32 + 8 * fq;
        f32x4 bv[2][2];
#pragma unroll
        for (int bj = 0; bj < 2; ++bj)
#pragma unroll
            for (int n = 0; n < 2; ++n) bv[bj][n] = bias ? *(const f32x4*)(bias + bcol0 + bj * HALF + 4 * n) : (f32x4){0.f, 0.f, 0.f, 0.f};
#pragma unroll
        for (int ai = 0; ai < 2; ++ai)
#pragma unroll
            for (int m = 0; m < 4; ++m) { bf16_t* rowp = base + (size_t)(row0 + ai * HALF + m * 16) * ldc + col0;
#pragma unroll
                for (int bj = 0; bj < 2; ++bj) { f32x4 v0 = acc[ai][bj][m][0] + bv[bj][0], v1 = acc[ai][bj][m][1] + bv[bj][1];
                    if (ACT == 1) { f32x2 a = gelu_pk((f32x2){v0[0], v0[1]}), b = gelu_pk((f32x2){v0[2], v0[3]}), c = gelu_pk((f32x2){v1[0], v1[1]}), d = gelu_pk((f32x2){v1[2], v1[3]});
                        v0 = (f32x4){a.x, a.y, b.x, b.y}; v1 = (f32x4){c.x, c.y, d.x, d.y}; }
                    v0 = v0 * sc; v1 = v1 * sc; u32x4 w; w.x = cvt_pk_bf16(v0[0], v0[1]); w.y = cvt_pk_bf16(v0[2], v0[3]); w.z = cvt_pk_bf16(v1[0], v1[1]); w.w = cvt_pk_bf16(v1[2], v1[3]);
                    *(u32x4*)(rowp + bj * HALF) = w; } }
    }
};
template <class Epi, class Sched, bool ALIGN_EPI = false, bool SP2 = false>
__device__ __forceinline__ void gemm_phase(PG8_LAS unsigned char* lds, const Gemm g, const Sched& S, const Epi& E) {
    int tid_ = threadIdx.x; asm volatile("" : "+v"(tid_));
    const int tid = tid_, wid = __builtin_amdgcn_readfirstlane(tid >> 6), lane = tid & 63, wr = wid >> 2, wc = wid & 3, fr = lane & 15, fq = lane >> 4;
    const int K = g.K, nt = K / BK;
    unsigned voffA[2], voffB[2];
#pragma unroll
    for (int i = 0; i < 2; ++i) { int R, C; stage_rc(tid * 16 + i * 8192, R, C); const int Rb = Epi::PERM ? ((R & ~31) + perm32(R & 31)) : R;
        voffA[i] = (unsigned)(R * K + C) * 2u; voffB[i] = (unsigned)(Rb * K + C) * 2u; }
    const size_t kstep = (size_t)(BK * 2);
    const size_t hstep = (size_t)HALF * K * 2;
    const size_t tstep = 2 * hstep;
    const unsigned ldsw = (unsigned)wid * 1024u;
    const int aoff = lds_byte(wr * 64 + fr, fq * 8), boff = lds_byte(wc * 32 + fr, fq * 8);
#define PG8_SA(b, h) (((b) * 2 + (h)) * HTB)
#define PG8_SB(b, h) ((4 + (b) * 2 + (h)) * HTB)
#define PG8_STAGE(bufoff, gbase, voff) do { _Pragma("unroll") for (int _i = 0; _i < 2; ++_i) \
        __builtin_amdgcn_global_load_lds((const unsigned*)((const char*)(gbase) + (voff)[_i]), (PG8_LAS unsigned*)(lds + (bufoff) + ldsw + _i * 8192), 16, 0, 0); } while (0)
#define PG8_LDA(dst, b, h) do { _Pragma("unroll") for (int m = 0; m < 4; ++m) _Pragma("unroll") for (int k = 0; k < 2; ++k) dst[m][k] = *(const PG8_LAS bf16x8*)(lds + PG8_SA(b, h) + aoff + m * 2048 + k * 1024); } while (0)
#define PG8_LDB(dst, b, h) do { _Pragma("unroll") for (int n = 0; n < 2; ++n) _Pragma("unroll") for (int k = 0; k < 2; ++k) dst[n][k] = *(const PG8_LAS bf16x8*)(lds + PG8_SB(b, h) + boff + n * 2048 + k * 1024); } while (0)
#define PG8_MMA(ai, bj, At, Bt) do { __builtin_amdgcn_s_setprio(1); _Pragma("unroll") for (int m = 0; m < 4; ++m) _Pragma("unroll") for (int n = 0; n < 2; ++n) _Pragma("unroll") for (int k = 0; k < 2; ++k) \
        acc[ai][bj][m][n] = __builtin_amdgcn_mfma_f32_16x16x32_bf16(Bt[n][k], At[m][k], acc[ai][bj][m][n], 0, 0, 0); __builtin_amdgcn_s_setprio(0); } while (0)
#define PG8_WAIT_V(n) asm volatile("s_waitcnt vmcnt(" #n ")" ::: "memory")
#define PG8_WAIT_L(n) asm volatile("s_waitcnt lgkmcnt(" #n ")" ::: "memory")
#define PG8_BAR __builtin_amdgcn_s_barrier()
#define PG8_SCHED __builtin_amdgcn_sched_barrier(0)
    Unit cur, nxt; int ui = 0;
    if (!S.next(0, cur)) return;
    f32x4 acc[2][2][4][2];
#pragma unroll
    for (int a = 0; a < 2; ++a)
#pragma unroll
        for (int b = 0; b < 2; ++b)
#pragma unroll
            for (int m = 0; m < 4; ++m)
#pragma unroll
                for (int n = 0; n < 2; ++n) acc[a][b][m][n] = (f32x4){0.f, 0.f, 0.f, 0.f};
    bf16x8 At[4][2], B0[2][2], B1[2][2];
    const char* cA = (const char*)g.A + (size_t)cur.pm * tstep; const char* cB = (const char*)g.Bt + (size_t)cur.pn * tstep;
    S.a_ready(cur);
    if constexpr (SP2) {
        PG8_STAGE(PG8_SB(0, 0), cB, voffB); PG8_STAGE(PG8_SB(0, 1), cB + hstep, voffB); PG8_STAGE(PG8_SA(0, 0), cA, voffA); PG8_STAGE(PG8_SA(0, 1), cA + hstep, voffA);
        if (wr == 1) PG8_BAR;
        PG8_WAIT_V(2); PG8_BAR;
        PG8_STAGE(PG8_SB(1, 0), cB + kstep, voffB); PG8_STAGE(PG8_SA(1, 0), cA + kstep, voffA); PG8_STAGE(PG8_SB(1, 1), cB + hstep + kstep, voffB);
        PG8_WAIT_V(6); PG8_BAR;
    } else {
        PG8_STAGE(PG8_SB(0, 0), cB, voffB); PG8_STAGE(PG8_SA(0, 0), cA, voffA); PG8_STAGE(PG8_SB(0, 1), cB + hstep, voffB); PG8_STAGE(PG8_SA(0, 1), cA + hstep, voffA);
        if (wr == 1) PG8_BAR;
        PG8_WAIT_V(4); PG8_BAR;
        PG8_STAGE(PG8_SB(1, 0), cB + kstep, voffB); PG8_STAGE(PG8_SA(1, 0), cA + kstep, voffA); PG8_STAGE(PG8_SB(1, 1), cB + hstep + kstep, voffB);
        PG8_WAIT_V(6); PG8_BAR;
    }
    for (;;) {
        const bool has_next = S.next(ui + 1, nxt);
        const char* nA = has_next ? (const char*)g.A + (size_t)nxt.pm * tstep : cA; const char* nB = has_next ? (const char*)g.Bt + (size_t)nxt.pn * tstep : cB;
        for (int t = 0; t < nt; t += 2) {
            const bool last = (t == nt - 2);
            const char* a1 = cA + (size_t)(t + 1) * kstep;
            const char* a2 = last ? nA : cA + (size_t)(t + 2) * kstep; const char* b2 = last ? nB : cB + (size_t)(t + 2) * kstep;
            const char* a3 = a2 + kstep; const char* b3 = b2 + kstep;
            if (last && has_next) S.a_ready(nxt);
            if constexpr (SP2) {
            PG8_LDB(B0, 0, 0); PG8_LDB(B1, 0, 1); PG8_SCHED; PG8_LDA(At, 0, 0); PG8_STAGE(PG8_SA(1, 1), a1 + hstep, voffA);
            PG8_WAIT_V(8); PG8_WAIT_L(0); PG8_BAR; PG8_MMA(0, 0, At, B0); PG8_MMA(0, 1, At, B1); PG8_BAR; PG8_SCHED;
            PG8_LDA(At, 0, 1); PG8_STAGE(PG8_SB(0, 0), b2, voffB); PG8_STAGE(PG8_SB(0, 1), b2 + hstep, voffB); PG8_STAGE(PG8_SA(0, 0), a2, voffA);
            PG8_WAIT_V(8); PG8_WAIT_L(0); PG8_BAR; PG8_MMA(1, 0, At, B0); PG8_MMA(1, 1, At, B1); PG8_BAR; PG8_SCHED;
            PG8_LDB(B0, 1, 0); PG8_LDB(B1, 1, 1); PG8_SCHED; PG8_LDA(At, 1, 0); PG8_STAGE(PG8_SA(0, 1), a2 + hstep, voffA);
            PG8_WAIT_V(8); PG8_WAIT_L(0); PG8_BAR; PG8_MMA(0, 0, At, B0); PG8_MMA(0, 1, At, B1); PG8_BAR; PG8_SCHED;
            PG8_LDA(At, 1, 1); PG8_STAGE(PG8_SB(1, 0), b3, voffB); PG8_STAGE(PG8_SB(1, 1), b3 + hstep, voffB); PG8_STAGE(PG8_SA(1, 0), a3, voffA);
            PG8_WAIT_V(8); PG8_WAIT_L(0); PG8_BAR; PG8_MMA(1, 0, At, B0); PG8_MMA(1, 1, At, B1); PG8_BAR; PG8_SCHED;
            } else {
            PG8_LDB(B0, 0, 0); PG8_SCHED; PG8_LDA(At, 0, 0); PG8_STAGE(PG8_SA(1, 1), a1 + hstep, voffA);
            PG8_WAIT_L(8); PG8_BAR; PG8_WAIT_L(0); PG8_MMA(0, 0, At, B0); PG8_BAR; PG8_SCHED;
            PG8_LDB(B1, 0, 1); PG8_STAGE(PG8_SB(0, 0), b2, voffB);
            PG8_BAR; PG8_WAIT_L(0); PG8_MMA(0, 1, At, B1); PG8_BAR;
            PG8_LDA(At, 0, 1); PG8_STAGE(PG8_SA(0, 0), a2, voffA);
            PG8_BAR; PG8_WAIT_L(0); PG8_MMA(1, 0, At, B0); PG8_BAR; PG8_SCHED;
            PG8_STAGE(PG8_SB(0, 1), b2 + hstep, voffB);
            PG8_WAIT_V(6); PG8_BAR; PG8_MMA(1, 1, At, B1); PG8_BAR;
            PG8_LDB(B0, 1, 0); PG8_SCHED; PG8_LDA(At, 1, 0); PG8_STAGE(PG8_SA(0, 1), a2 + hstep, voffA);
            PG8_WAIT_L(8); PG8_BAR; PG8_WAIT_L(0); PG8_MMA(0, 0, At, B0); PG8_BAR; PG8_SCHED;
            PG8_LDB(B1, 1, 1); PG8_STAGE(PG8_SB(1, 0), b3, voffB);
            PG8_BAR; PG8_WAIT_L(0); PG8_MMA(0, 1, At, B1); PG8_BAR;
            PG8_LDA(At, 1, 1); PG8_STAGE(PG8_SA(1, 0), a3, voffA);
            PG8_BAR; PG8_WAIT_L(0); PG8_MMA(1, 0, At, B0); PG8_BAR; PG8_SCHED;
            PG8_STAGE(PG8_SB(1, 1), b3 + hstep, voffB);
            PG8_WAIT_V(6); PG8_BAR; PG8_MMA(1, 1, At, B1); PG8_BAR;
            }
        }
        if constexpr (ALIGN_EPI) { if (wr == 0) PG8_BAR; }
        if constexpr (!Epi::AFTER_DRAIN) { E(acc, cur, wr, wc, fr, fq); S.done(cur); }
        if (!has_next) break;
#pragma unroll
        for (int a = 0; a < 2; ++a)
#pragma unroll
            for (int b = 0; b < 2; ++b)
#pragma unroll
                for (int m = 0; m < 4; ++m)
#pragma unroll
                    for (int n = 0; n < 2; ++n) acc[a][b][m][n] = (f32x4){0.f, 0.f, 0.f, 0.f};
        cur = nxt; cA = nA; cB = nB; ++ui;
        if constexpr (ALIGN_EPI) { if (wr == 1) PG8_BAR; }
    }
    PG8_WAIT_V(0);
    if constexpr (!ALIGN_EPI) { if (wr == 0) PG8_BAR; }
    PG8_BAR;
    if constexpr (Epi::AFTER_DRAIN) { E.fused(acc, cur, wr, wc, fr, fq, lds, wid, lane); S.done(cur); }
#undef PG8_SA
#undef PG8_SB
#undef PG8_STAGE
#undef PG8_LDA
#undef PG8_LDB
#undef PG8_MMA
#undef PG8_WAIT_V
#undef PG8_WAIT_L
#undef PG8_BAR
#undef PG8_SCHED
}
}
namespace attn_body {
using bf16=__hip_bfloat16;
using bf16x8=__attribute__((ext_vector_type(8)))short;
using s16x4=__attribute__((ext_vector_type(4)))short;
using f32x16=__attribute__((ext_vector_type(16)))float;
using u32x4=__attribute__((ext_vector_type(4)))unsigned;
constexpr int D=64,PQ=3328,PO=1024;
constexpr int NW=8,QBLK=32,QB=QBLK*NW,KVBLK=64;
__device__ __forceinline__ int crow(int r,int hi){return (r&3)+8*(r>>2)+4*hi;}
#define SBAR() __builtin_amdgcn_sched_barrier(0)
__device__ __forceinline__ void wmask(f32x16&p0,f32x16&p1,int dq,int hi){
  const float NEG=-INFINITY; int kb=4*hi;
  #pragma unroll
  for(int r=0;r<16;++r){int kv=kb+(r&3)+8*(r>>2); int d0=dq-kv; if(d0>128||d0<-128)p0[r]=NEG; int d1=d0-32; if(d1>128||d1<-128)p1[r]=NEG;}
}

constexpr int NSLOT=3, SLOTB=8192;
constexpr int LDS_K=0, LDS_V=NSLOT*SLOTB, LDS_WS=2*NSLOT*SLOTB, LDS_OST=LDS_WS+NW*64*4, LDS_BYTES=LDS_OST+NW*4096;
constexpr float C2=0.125f*1.4426950408889634f;
__device__ __forceinline__ void glds16(const void*gsrc,unsigned lds_dst){unsigned keep;
  asm volatile("s_mov_b32 %0, m0\n\ts_mov_b32 m0, %2\n\ts_nop 0\n\tglobal_load_lds_dwordx4 %1, off\n\ts_mov_b32 m0, %0":"=&s"(keep):"v"(gsrc),"s"(lds_dst):"memory");}
__device__ __forceinline__ float max3f(float a,float b,float c){float r;asm("v_max3_f32 %0, %1, %2, %3":"=v"(r):"v"(a),"v"(b),"v"(c));return r;}
__device__ __forceinline__ float max2f(float a,float b){float r;asm("v_max_f32_e32 %0, %1, %2":"=v"(r):"v"(a),"v"(b));return r;}
__device__ __forceinline__ float fadd_s(float a,float b){float r;asm("v_add_f32_e32 %0, %1, %2":"=v"(r):"v"(a),"v"(b));return r;}
__device__ __forceinline__ float fsub_s(float a,float b){float r;asm("v_sub_f32_e32 %0, %1, %2":"=v"(r):"v"(a),"v"(b));return r;}
typedef float f32x2_t __attribute__((ext_vector_type(2))); typedef __bf16 bf16x2_t __attribute__((ext_vector_type(2)));
__device__ __forceinline__ unsigned cvtpk_s(float lo,float hi){f32x2_t v={lo,hi};bf16x2_t b=__builtin_convertvector(v,bf16x2_t);return __builtin_bit_cast(unsigned,b);}
#define WAIT_BAR(N) asm volatile("s_waitcnt vmcnt(" #N ") lgkmcnt(0)\n\ts_barrier":::"memory")

__device__ __forceinline__ void qkt(f32x16&p0,f32x16&p1,const char*Kslot,const bf16x8*qr,const f32x16&negm,int r32,int hi){
  const char*kb=Kslot+hi*1024+r32*16;
  #pragma unroll
  for(int d0=0;d0<4;++d0){
    const bf16x8 b0=*reinterpret_cast<const bf16x8*>(kb+d0*2048);
    const bf16x8 b1=*reinterpret_cast<const bf16x8*>(kb+d0*2048+512);
    if(d0==0){p0=__builtin_amdgcn_mfma_f32_32x32x16_bf16(b0,qr[0],negm,0,0,0);p1=__builtin_amdgcn_mfma_f32_32x32x16_bf16(b1,qr[0],negm,0,0,0);}
    else{p0=__builtin_amdgcn_mfma_f32_32x32x16_bf16(b0,qr[d0],p0,0,0,0);p1=__builtin_amdgcn_mfma_f32_32x32x16_bf16(b1,qr[d0],p1,0,0,0);}}
}
typedef __attribute__((address_space(3))) const char* lds_cptr;
typedef short v4i16_t __attribute__((ext_vector_type(4)));
__device__ __forceinline__ void kload8(bf16x8*kf,lds_cptr kp){
  kf[0]=*(const __attribute__((address_space(3))) bf16x8*)(kp);      kf[1]=*(const __attribute__((address_space(3))) bf16x8*)(kp+512);
  kf[2]=*(const __attribute__((address_space(3))) bf16x8*)(kp+2048); kf[3]=*(const __attribute__((address_space(3))) bf16x8*)(kp+2560);
  kf[4]=*(const __attribute__((address_space(3))) bf16x8*)(kp+4096); kf[5]=*(const __attribute__((address_space(3))) bf16x8*)(kp+4608);
  kf[6]=*(const __attribute__((address_space(3))) bf16x8*)(kp+6144); kf[7]=*(const __attribute__((address_space(3))) bf16x8*)(kp+6656);
}
__device__ __forceinline__ void kload2(bf16x8*kf,lds_cptr kp,int j){ kf[2*j]=*(const __attribute__((address_space(3))) bf16x8*)(kp+j*2048); kf[2*j+1]=*(const __attribute__((address_space(3))) bf16x8*)(kp+j*2048+512); }
__device__ __forceinline__ s16x4 vtr(lds_cptr p){ return __builtin_bit_cast(s16x4,__builtin_amdgcn_ds_read_tr16_b64_v4i16((__attribute__((address_space(3))) v4i16_t*)p)); }
__device__ __forceinline__ float rowmax(const f32x16&p0,const f32x16&p1){
  float a=max3f(p0[0],p0[1],p1[0]),b=max3f(p0[2],p0[3],p1[1]);a=max3f(a,p1[2],p1[3]);
  #pragma unroll
  for(int r=4;r<16;r+=4){a=max3f(a,p0[r],p0[r+1]);b=max3f(b,p0[r+2],p0[r+3]);a=max3f(a,p1[r],p1[r+1]);b=max3f(b,p1[r+2],p1[r+3]);}
  const float m=max2f(a,b);
  auto rr=__builtin_amdgcn_permlane32_swap(__float_as_uint(m),__float_as_uint(m),false,false);
  return max2f(__uint_as_float(rr[0]),__uint_as_float(rr[1]));
}
__device__ __forceinline__ void pv(f32x16*o,int vb,bf16x8 pa0,bf16x8 pa1,bf16x8 pa2,bf16x8 pa3){
  #pragma unroll
  for(int d0=0;d0<2;++d0){s16x4 lo[4],hi[4];
    #pragma unroll
    for(int ks=0;ks<4;++ks){
      asm volatile("ds_read_b64_tr_b16 %0,%1 offset:%c2":"=&v"(lo[ks]):"v"(vb),"i"(d0*4096+ks*1024):"memory");
      asm volatile("ds_read_b64_tr_b16 %0,%1 offset:%c2":"=&v"(hi[ks]):"v"(vb),"i"(d0*4096+ks*1024+512):"memory");}
    asm volatile("s_waitcnt lgkmcnt(0)":::"memory");SBAR();
    #define PK(k) (bf16x8){lo[k][0],lo[k][1],lo[k][2],lo[k][3],hi[k][0],hi[k][1],hi[k][2],hi[k][3]}
    o[d0]=__builtin_amdgcn_mfma_f32_32x32x16_bf16(pa0,PK(0),o[d0],0,0,0);
    o[d0]=__builtin_amdgcn_mfma_f32_32x32x16_bf16(pa1,PK(1),o[d0],0,0,0);
    o[d0]=__builtin_amdgcn_mfma_f32_32x32x16_bf16(pa2,PK(2),o[d0],0,0,0);
    o[d0]=__builtin_amdgcn_mfma_f32_32x32x16_bf16(pa3,PK(3),o[d0],0,0,0);
    #undef PK
  }
}

#ifndef ATTN_STORE16
#define ATTN_STORE16(p,v) (*(u32x4*)(p)=(v))
#endif
template<int THRL,int MODE> __device__ __forceinline__ void attn_unit(const bf16*Q0,const bf16*__restrict__ Kh,const bf16*__restrict__ Vh,bf16*O0,const int NT,const int band_row0,const int qpos0,const int band_s0,const float sink_l2,char*shm){
  int tid_=threadIdx.x; asm volatile("":"+v"(tid_));
  const int tid=tid_,lane=tid&63,r32=lane&31,hi=lane>>5; const int wid=__builtin_amdgcn_readfirstlane(tid>>6);
  const bf16*Qw=Q0+(long)(wid*QBLK)*PQ;
  #define TROW(t) ((MODE==1&&(t)>=4)?(band_row0+((t)-4)*KVBLK):((t)*KVBLK))
  const unsigned lds0=(unsigned)(uintptr_t)shm;
  float*wsf=(float*)(shm+LDS_WS)+wid*64;
  const bf16*ksrc=Kh+(long)lane*PQ+wid*8;
  const bf16*vsrc=Vh+(long)(16*(wid&3)+(lane>>2))*PQ+(wid>>2)*32+(lane&3)*8;
  const unsigned kdst=lds0+LDS_K+wid*1024, vdst=lds0+LDS_V+wid*1024;
  #define DMA_K(t,slot) glds16(ksrc+(long)TROW(t)*PQ,(unsigned)__builtin_amdgcn_readfirstlane(kdst+(slot)))
  #define DMA_V(t,slot) glds16(vsrc+(long)TROW(t)*PQ,(unsigned)__builtin_amdgcn_readfirstlane(vdst+(slot)))
  const int vb0=(int)(lds0+LDS_V)+((lane>>4)&1)*32+(lane&3)*8+(4*hi+((lane&15)>>2))*64;
  const char*Kbase=shm+LDS_K; bf16x8 kf[8];
  const lds_cptr shm3=(lds_cptr)shm; const lds_cptr kp0=shm3+LDS_K+hi*1024+r32*16; const lds_cptr vp0=shm3+LDS_V+((lane>>4)&1)*32+(lane&3)*8+(4*hi+((lane&15)>>2))*64;
  DMA_K(0,0);DMA_V(0,0);DMA_K(1,SLOTB);
  bf16x8 qr[4];
  #pragma unroll
  for(int d0=0;d0<4;++d0)qr[d0]=*reinterpret_cast<const bf16x8*>(&Qw[(long)r32*PQ+d0*16+hi*8]);
  float mhat=0.f,l_reg=0.f;f32x16 o[2];o[0]=f32x16{};o[1]=f32x16{};f32x16 negm=f32x16{};asm volatile("":"+v"(negm));
  const int qrel=wid*QBLK+r32;
  #define CMASK(P0,P1,t) do{ if(MODE==1&&(t)>=4){ wmask(P0,P1,qpos0+qrel-(band_s0+((t)-4)*KVBLK),hi); } }while(0)
  bool resc=false;
  #define START(P0,P1) do{ const float rm=rowmax(P0,P1); resc=false; \
    { const float dl=rm; mhat=fadd_s(mhat,dl); \
      _Pragma("unroll") for(int r=0;r<16;++r){P0[r]=fsub_s(P0[r],dl);P1[r]=fsub_s(P1[r],dl);} \
      _Pragma("unroll") for(int r=0;r<16;++r)negm[r]=-mhat; asm volatile("":"+v"(negm)); } \
    _Pragma("unroll") for(int r=0;r<16;++r)P0[r]=__builtin_amdgcn_exp2f(P0[r]); }while(0)
  #define RESC() do{ if(resc){ asm volatile("s_waitcnt lgkmcnt(0)":::"memory"); \
      _Pragma("unroll") for(int d_=0;d_<2;++d_) _Pragma("unroll") for(int r=0;r<16;++r)o[d_][r]*=wsf[crow(r,hi)]; } }while(0)
  f32x16 pA0,pA1,pB0,pB1;
  int sl_prev=0,sl_cur=0,sl_next=SLOTB;
  #define ROT() do{sl_prev=sl_cur;sl_cur=sl_next;sl_next=(sl_next==(NSLOT-1)*SLOTB)?0:sl_next+SLOTB;}while(0)
  DMA_K(2,2*SLOTB);
  WAIT_BAR(3);
  qkt(pA0,pA1,Kbase,qr,negm,r32,hi);asm volatile("s_nop 15\n\ts_nop 7":"+v"(pA0),"+v"(pA1));CMASK(pA0,pA1,0);
  START(pA0,pA1);
  _Pragma("unroll") for(int r=0;r<16;++r)pA1[r]=__builtin_amdgcn_exp2f(pA1[r]);
  WAIT_BAR(0);
  DMA_K(3,0);DMA_V(1,SLOTB);
  ROT();
  kload8(kf,kp0+sl_cur);
  WAIT_BAR(2);
  s16x4 vlo[8],vhi[8]; u32x4 pw0,pw1,pw2,pw3;
  #define PKW(P,B) cvtpk_s(P[B],P[B+1])
  #define PAF(k) __builtin_bit_cast(bf16x8,pw##k)
  #define VFR(i) (bf16x8){vlo[i][0],vlo[i][1],vlo[i][2],vlo[i][3],vhi[i][0],vhi[i][1],vhi[i][2],vhi[i][3]}
  #define PIN(x) asm volatile("":"+v"(x))
  #define MX3(a,b,c) __builtin_fmaxf(__builtin_fmaxf((a),(b)),(c))
  #define GAPA(MF,A0,A1,A2,A3,W0,W1,PW) do{ MF; sacc+=A0; sacc+=A1; sacc+=A2; sacc+=A3; PIN(sacc); W0; W1; PIN(PW); SBAR(); }while(0)
  #define EX(v) __builtin_amdgcn_exp2f(v)
  #define GAPB(MF,X,B) do{ MF; X[B]=EX(X[B]); X[B+1]=EX(X[B+1]); X[B+2]=EX(X[B+2]); X[B+3]=EX(X[B+3]); PIN(X); SBAR(); }while(0)
  #define VRD(i) do{ vlo[i]=vtr(vp_+(((i)>>2)*4096+((i)&3)*1024)); vhi[i]=vtr(vp_+(((i)>>2)*4096+((i)&3)*1024+512)); }while(0)
  #define KRD(G,j) do{ if(G){ kload2(kf,kp0+sl_next,j); SBAR(); } }while(0)
  #define STEP(C0,C1,P0,P1,t,GK,GV,GL) do{ SBAR(); \
    const lds_cptr vp_=vp0+sl_prev; \
    VRD(0); SBAR(); float sacc=(P0[0]+P0[1]); \
    GAPA(C0=__builtin_amdgcn_mfma_f32_32x32x16_bf16(kf[0],qr[0],negm,0,0,0), P0[2],P0[3],P0[4],P0[5],     pw0[0]=PKW(P0,0), pw0[1]=PKW(P0,2), pw0); \
    VRD(4); SBAR(); GAPA(C1=__builtin_amdgcn_mfma_f32_32x32x16_bf16(kf[1],qr[0],negm,0,0,0), P0[6],P0[7],P0[8],P0[9],     pw0[2]=PKW(P0,4), pw0[3]=PKW(P0,6), pw0); \
    VRD(1); SBAR(); GAPA(C0=__builtin_amdgcn_mfma_f32_32x32x16_bf16(kf[2],qr[1],C0,0,0,0),   P0[10],P0[11],P0[12],P0[13], pw1[0]=PKW(P0,8), pw1[1]=PKW(P0,10), pw1); \
    VRD(5); SBAR(); GAPA(C1=__builtin_amdgcn_mfma_f32_32x32x16_bf16(kf[3],qr[1],C1,0,0,0),   P0[14],P0[15],P1[0],P1[1],   pw1[2]=PKW(P0,12),pw1[3]=PKW(P0,14), pw1); \
    VRD(2); SBAR(); GAPA(C0=__builtin_amdgcn_mfma_f32_32x32x16_bf16(kf[4],qr[2],C0,0,0,0),   P1[2],P1[3],P1[4],P1[5],     pw2[0]=PKW(P1,0), pw2[1]=PKW(P1,2), pw2); \
    VRD(6); SBAR(); GAPA(C1=__builtin_amdgcn_mfma_f32_32x32x16_bf16(kf[5],qr[2],C1,0,0,0),   P1[6],P1[7],P1[8],P1[9],     pw2[2]=PKW(P1,4), pw2[3]=PKW(P1,6), pw2); \
    VRD(3); SBAR(); GAPA(C0=__builtin_amdgcn_mfma_f32_32x32x16_bf16(kf[6],qr[3],C0,0,0,0),   P1[10],P1[11],P1[12],P1[13], pw3[0]=PKW(P1,8), pw3[1]=PKW(P1,10), pw3); \
    VRD(7); SBAR(); GAPA(C1=__builtin_amdgcn_mfma_f32_32x32x16_bf16(kf[7],qr[3],C1,0,0,0),   P1[14],P1[15],0.f,0.f,       pw3[2]=PKW(P1,12),pw3[3]=PKW(P1,14), pw3); \
    l_reg+=sacc; \
    if(GK){DMA_K((t)+3,sl_cur);} if(GV){DMA_V((t)+1,sl_next);} \
    CMASK(C0,C1,t); \
    { float a=MX3(C0[0],C0[1],C1[0]),b=MX3(C0[2],C0[3],C1[1]); a=MX3(a,C1[2],C1[3]); \
      _Pragma("unroll") for(int r=4;r<16;r+=4){a=MX3(a,C0[r],C0[r+1]);b=MX3(b,C0[r+2],C0[r+3]);a=MX3(a,C1[r],C1[r+1]);b=MX3(b,C1[r+2],C1[r+3]);} \
      float rm=__builtin_fmaxf(a,b); { auto rr=__builtin_amdgcn_permlane32_swap(__float_as_uint(rm),__float_as_uint(rm),false,false); rm=__builtin_fmaxf(__uint_as_float(rr[0]),__uint_as_float(rr[1])); } \
      resc=false; \
      if(__builtin_expect(__any(rm>(float)THRL),0)){ const float dl=__builtin_fmaxf(rm,0.f); mhat+=dl; \
        _Pragma("unroll") for(int r=0;r<16;++r){C0[r]-=dl;C1[r]-=dl;} \
        _Pragma("unroll") for(int r=0;r<16;++r)negm[r]=-mhat; asm volatile("":"+v"(negm)); \
        const float f=__builtin_amdgcn_exp2f(-dl); l_reg*=f; if(hi==0)wsf[r32]=f; resc=true; } } \
    SBAR(); \
    GAPB(o[0]=__builtin_amdgcn_mfma_f32_32x32x16_bf16(PAF(0),VFR(0),o[0],0,0,0), C0,0); \
    GAPB(o[1]=__builtin_amdgcn_mfma_f32_32x32x16_bf16(PAF(0),VFR(4),o[1],0,0,0), C0,4); \
    KRD(GL,0); GAPB(o[0]=__builtin_amdgcn_mfma_f32_32x32x16_bf16(PAF(1),VFR(1),o[0],0,0,0), C0,8); \
    KRD(GL,1); GAPB(o[1]=__builtin_amdgcn_mfma_f32_32x32x16_bf16(PAF(1),VFR(5),o[1],0,0,0), C0,12); \
    KRD(GL,2); GAPB(o[0]=__builtin_amdgcn_mfma_f32_32x32x16_bf16(PAF(2),VFR(2),o[0],0,0,0), C1,0); \
    KRD(GL,3); GAPB(o[1]=__builtin_amdgcn_mfma_f32_32x32x16_bf16(PAF(2),VFR(6),o[1],0,0,0), C1,4); \
    GAPB(o[0]=__builtin_amdgcn_mfma_f32_32x32x16_bf16(PAF(3),VFR(3),o[0],0,0,0), C1,8); \
    GAPB(o[1]=__builtin_amdgcn_mfma_f32_32x32x16_bf16(PAF(3),VFR(7),o[1],0,0,0), C1,12); \
    }while(0)
  int t=1;
  for(;t+5<NT;t+=2){
    STEP(pB0,pB1,pA0,pA1,t,true,true,true);     WAIT_BAR(2); RESC(); ROT();
    STEP(pA0,pA1,pB0,pB1,t+1,true,true,true);   WAIT_BAR(2); RESC(); ROT();
  }
  #define ENDW(tt) do{ if((tt)+3<NT){WAIT_BAR(2);} else if((tt)+2<NT){WAIT_BAR(1);} else {WAIT_BAR(0);} }while(0)
  for(;t+1<NT;t+=2){
    STEP(pB0,pB1,pA0,pA1,t,(t+3<NT),(t+1<NT),(t+1<NT));       ENDW(t);   RESC(); ROT();
    STEP(pA0,pA1,pB0,pB1,t+1,(t+4<NT),(t+2<NT),(t+2<NT));     ENDW(t+1); RESC(); ROT();
  }
  STEP(pB0,pB1,pA0,pA1,NT-1,false,false,false); RESC();
  { float sacc=pB0[0]+pB0[1]; _Pragma("unroll") for(int r=2;r<16;++r)sacc+=pB0[r]; _Pragma("unroll") for(int r=0;r<16;++r)sacc+=pB1[r]; l_reg+=sacc;
    pw0=(u32x4){PKW(pB0,0),PKW(pB0,2),PKW(pB0,4),PKW(pB0,6)};pw1=(u32x4){PKW(pB0,8),PKW(pB0,10),PKW(pB0,12),PKW(pB0,14)};pw2=(u32x4){PKW(pB1,0),PKW(pB1,2),PKW(pB1,4),PKW(pB1,6)};pw3=(u32x4){PKW(pB1,8),PKW(pB1,10),PKW(pB1,12),PKW(pB1,14)};
    SBAR(); pv(o,vb0+sl_cur,PAF(0),PAF(1),PAF(2),PAF(3)); }
  #undef PKW
  #undef PAF
  #undef VFR
  #undef PIN
  #undef MX3
  #undef GAPA
  #undef GAPB
  #undef EX
  #undef VRD
  #undef KRD
  #undef STEP
  #undef ENDW
  {auto rr=__builtin_amdgcn_permlane32_swap(__float_as_uint(l_reg),__float_as_uint(l_reg),false,false);l_reg=__uint_as_float(rr[0])+__uint_as_float(rr[1]);}
  if(MODE==1)l_reg+=__builtin_amdgcn_exp2f(sink_l2-mhat);
  if(hi==0)wsf[32+r32]=l_reg;asm volatile("s_waitcnt lgkmcnt(0)":::"memory");
  float rli[16];
  #pragma unroll
  for(int r=0;r<16;++r)rli[r]=__builtin_amdgcn_rcpf(wsf[32+crow(r,hi)]);
  bf16*Ow=O0+(long)(wid*QBLK)*PO;
  { bf16*stg=(bf16*)(shm+LDS_OST)+wid*2048;
    #pragma unroll
    for(int r=0;r<16;++r){const int orow=crow(r,hi);
      #pragma unroll
      for(int d0=0;d0<2;++d0)stg[orow*64+d0*32+r32]=__float2bfloat16(o[d0][r]*rli[r]);}
    asm volatile("s_waitcnt lgkmcnt(0)":::"memory");
    #pragma unroll
    for(int i=0;i<4;++i){const int row=i*8+(lane>>3),ch=lane&7; const u32x4 v=*(const u32x4*)(stg+row*64+ch*8); ATTN_STORE16(Ow+(long)row*PO+ch*8,v);} }
  asm volatile("s_waitcnt lgkmcnt(0)\n\ts_barrier":::"memory");
  #undef DMA_K
  #undef DMA_V
  #undef TROW
  #undef CMASK
  #undef START
  #undef RESC
  #undef ROT
}
constexpr int ATTN_LDS_BYTES=LDS_BYTES;
#undef SBAR
#undef WAIT_BAR
}
namespace scan {
using namespace mk;
template <int NROWS> __device__ __forceinline__ int img_off(int row, int c) { return (((c >> 5) * (NROWS / 16) + (row >> 4)) << 10) + ((row & 15) << 6) + ((c & 31) << 1); }
__device__ __forceinline__ int tlane(int lane) { return ((lane >> 4) & 1) * 32 + (lane & 3) * 8 + (4 * (lane >> 5) + ((lane & 15) >> 2)) * 64; }
__device__ __forceinline__ bf16x8 rfrag(LAS const char* p) { return *(LAS const bf16x8*)p; }
__device__ __forceinline__ s16x4 tr4(LAS const char* p) { return __builtin_bit_cast(s16x4, __builtin_amdgcn_ds_read_tr16_b64_v4i16((LAS s16x4*)p)); }
__device__ __forceinline__ bf16x8 tfrag(LAS const char* p) { const s16x4 lo = tr4(p), hi = tr4(p + 512); return (bf16x8){lo[0], lo[1], lo[2], lo[3], hi[0], hi[1], hi[2], hi[3]}; }
__device__ __forceinline__ bf16x8 pack8(const f32x16& s, int b) {
  u32x4 w; w.x = cvtpk(s[b], s[b + 1]); w.y = cvtpk(s[b + 2], s[b + 3]); w.z = cvtpk(s[b + 4], s[b + 5]); w.w = cvtpk(s[b + 6], s[b + 7]); return __builtin_bit_cast(bf16x8, w);
}
#define MFMA32(a, b, c) __builtin_amdgcn_mfma_f32_32x32x16_bf16(a, b, c, 0, 0, 0)

template <int DK, int DV>
__device__ __forceinline__ void chunk_core(LAS const char* Qm, LAS const char* Km, LAS const char* Vm, LAS const char* Ss, LAS const float* rowexp, LAS const float* colexp, LAS const float* isc,
                                           f32x16& res0, f32x16& res1, int wid, int lane) {
  constexpr int KS = DK / 16, NVT = DV / 32;
  const int tb = wid & 3, vp = wid >> 2, r32 = lane & 31, hh = lane >> 5, tl = tlane(lane);
  constexpr bool HOLDQ = (KS <= 4);
  bf16x8 qf[HOLDQ ? KS : 1];
  if (HOLDQ) {
#pragma unroll
    for (int ks = 0; ks < KS; ++ks) qf[ks] = rfrag(Qm + img_off<128>(32 * tb + r32, 16 * ks + 8 * hh)); }
#define QF(ks) (HOLDQ ? qf[HOLDQ ? (ks) : 0] : rfrag(Qm + img_off<128>(32 * tb + r32, 16 * (ks) + 8 * hh)))
  f32x16 o0 = {}, o1 = {};
  const float re = rowexp[32 * tb + r32];
#pragma unroll 1
  for (int st = 0; st <= tb; ++st) {
    f32x16 s = {};
#pragma unroll
    for (int ks = 0; ks < KS; ++ks) { const bf16x8 kf = rfrag(Km + img_off<128>(32 * st + r32, 16 * ks + 8 * hh)); s = MFMA32(kf, QF(ks), s); }
#pragma unroll
    for (int r = 0; r < 16; ++r) { const int sl = crow(r, hh); float w = __builtin_amdgcn_exp2f(re + colexp[32 * st + sl]); if (st == tb && sl > r32) w = 0.f; s[r] *= w; }
    const bf16x8 pa0 = pack8(s, 0), pa1 = pack8(s, 8);
    { const bf16x8 v0 = tfrag(Vm + ((vp * 8 + 2 * st) << 10) + tl), v1 = tfrag(Vm + ((vp * 8 + 2 * st + 1) << 10) + tl); o0 = MFMA32(pa0, v0, o0); o0 = MFMA32(pa1, v1, o0); }
    if (NVT > 2 && vp == 0) { const bf16x8 v0 = tfrag(Vm + ((2 * 8 + 2 * st) << 10) + tl), v1 = tfrag(Vm + ((2 * 8 + 2 * st + 1) << 10) + tl); o1 = MFMA32(pa0, v0, o1); o1 = MFMA32(pa1, v1, o1); }
  }
  f32x16 i0 = {}, i1 = {};
#pragma unroll
  for (int ks = 0; ks < KS; ++ks) { const bf16x8 sf = rfrag(Ss + img_off<DV>(32 * vp + r32, 16 * ks + 8 * hh)); i0 = MFMA32(QF(ks), sf, i0); }
  if (NVT > 2 && vp == 0) {
#pragma unroll
    for (int ks = 0; ks < KS; ++ks) { const bf16x8 sf = rfrag(Ss + img_off<DV>(64 + r32, 16 * ks + 8 * hh)); i1 = MFMA32(QF(ks), sf, i1); }
  }
#pragma unroll
  for (int r = 0; r < 16; ++r) { const float sc = isc[32 * tb + crow(r, hh)]; res0[r] = o0[r] + sc * i0[r]; res1[r] = o1[r] + sc * i1[r]; }
#undef QF
}
template <int DK, int DV>
__device__ __forceinline__ void state_update(LAS const char* Km, LAS const char* Vw, LAS char* Ss, f32x16& st_acc, float sd, int wid, int lane) {
  constexpr int NVT = DV / 32, NDT = DK / 32;
  if (wid < NVT * NDT) {
    const int vt = wid / NDT, dt_ = wid % NDT, r32 = lane & 31, hh = lane >> 5, tl = tlane(lane);
#pragma unroll
    for (int r = 0; r < 16; ++r) st_acc[r] *= sd;
#pragma unroll
    for (int ks = 0; ks < 8; ++ks) { const bf16x8 af = tfrag(Vw + ((vt * 8 + ks) << 10) + tl), bfr = tfrag(Km + ((dt_ * 8 + ks) << 10) + tl); st_acc = MFMA32(af, bfr, st_acc); }
#pragma unroll
    for (int r = 0; r < 16; ++r) *(LAS bf16*)(Ss + img_off<DV>(32 * vt + crow(r, hh), 32 * dt_ + r32)) = f2bf(st_acc[r]);
  }
}
__device__ __forceinline__ float wscan_add(float x, int lane) {
#pragma unroll
  for (int o = 1; o < 64; o <<= 1) { const float y = __shfl_up(x, o); if (lane >= o) x += y; }
  return x;
}
__device__ __forceinline__ float wscan_max(float x, int lane) {
#pragma unroll
  for (int o = 1; o < 64; o <<= 1) { const float y = __shfl_up(x, o); if (lane >= o) x = fmaxf(x, y); }
  return x;
}
__device__ __forceinline__ void chunk_rows(int cc, int dir, int& row0, int& seg0, int& seglen) {
  if (cc < 2) { const int ci = dir ? 1 - cc : cc; row0 = 128 * ci; seg0 = 0; seglen = NC; }
  else { const int ci = dir ? 31 - (cc - 2) : (cc - 2); row0 = NC + 128 * ci; seg0 = NC; seglen = T; }
}
#define SCAN_BAR() do { asm volatile("s_waitcnt vmcnt(0) lgkmcnt(0)" ::: "memory"); __builtin_amdgcn_s_barrier(); asm volatile("" ::: "memory"); } while (0)

#define SCAN_BAR_L() do { asm volatile("s_waitcnt lgkmcnt(0)" ::: "memory"); __builtin_amdgcn_s_barrier(); asm volatile("" ::: "memory"); } while (0)

__device__ __forceinline__ void mamba_chain(LAS char* lds, const bf16* __restrict__ UC, const float* __restrict__ G, const float* __restrict__ a_log, bf16* __restrict__ YD, int b, int h, int dir) {
  int tid_ = threadIdx.x; asm volatile("" : "+v"(tid_));
  const int tid = tid_, lane = tid & 63, wid = __builtin_amdgcn_readfirstlane(tid >> 6), g = h >> 1;
  LAS char* Qm = lds; LAS char* Km = lds + 32768; LAS char* Vm = lds + 65536; LAS char* Vw = lds + 81920; LAS char* Ss = lds + 98304;
  LAS float* rowexp = (LAS float*)(lds + 114688); LAS float* colexp = rowexp + 128; LAS float* isc = rowexp + 256; LAS float* vw = rowexp + 384; LAS float* misc = rowexp + 512;
  for (int i = tid; i < 16384 / 4; i += 512) ((LAS unsigned*)Ss)[i] = 0u;
  f32x16 st_acc = {};
  const float a = -__expf(a_log[dir * 4 + h]);
  const size_t rowb = (size_t)b * RB;
  u32x4 pc[10]; float dtn[2] = {0.f, 0.f};
#define MAMBA_LOAD(cc_) do { int row0_, seg0_, seglen_; chunk_rows((cc_), dir, row0_, seg0_, seglen_); int tq_ = tid; asm volatile("" : "+v"(tq_)); \
    _Pragma("unroll") for (int k = 0; k < 10; ++k) { const int task = tq_ + 512 * k, io = task / 40, cg = task % 40; \
      const int ucol = cg < 8 ? h * 64 + cg * 8 : (cg < 24 ? 256 + g * 128 + (cg - 8) * 8 : 512 + g * 128 + (cg - 24) * 8); \
      pc[k] = *(const u32x4*)(UC + (rowb + row0_ + io) * 768 + ucol); } \
    if (wid == 0) { _Pragma("unroll") for (int e = 0; e < 2; ++e) { const int i = 2 * lane + e, io = dir ? 127 - i : i; dtn[e] = G[(rowb + row0_ + io) * 32 + 16 + dir * 4 + h]; } } } while (0)
  MAMBA_LOAD(0);
  SCAN_BAR();
#pragma unroll 1
  for (int cc = 0; cc < 34; ++cc) {
    int row0, seg0, seglen; chunk_rows(cc, dir, row0, seg0, seglen);
    if (wid == 0) {
      float cum2[2];
      const float p0 = dtn[0] * a, p1 = p0 + dtn[1] * a; const float inc = wscan_add(p1, lane); const float exc = inc - p1;
      cum2[0] = exc + p0; cum2[1] = exc + p1; const float cend = __shfl(inc, 63);
#pragma unroll
      for (int e = 0; e < 2; ++e) { const int i = 2 * lane + e; rowexp[i] = cum2[e] * L2E; colexp[i] = -cum2[e] * L2E + __builtin_amdgcn_logf(dtn[e]); isc[i] = __builtin_amdgcn_exp2f(cum2[e] * L2E); vw[i] = __builtin_amdgcn_exp2f((cend - cum2[e]) * L2E) * dtn[e]; }
      if (lane == 0) misc[0] = __builtin_amdgcn_exp2f(cend * L2E);
    }
    SCAN_BAR_L();
    int tw_ = tid; asm volatile("" : "+v"(tw_));
#pragma unroll
    for (int k = 0; k < 10; ++k) {
      const int task = tw_ + 512 * k, io = task / 40, cg = task % 40, i = dir ? 127 - io : io;
      if (cg < 8) { const float s = vw[i]; u32x4 pw;
#pragma unroll
        for (int e = 0; e < 4; ++e) pw[e] = cvtpk(bf_lo(pc[k][e]) * s, bf_hi(pc[k][e]) * s);
        *(LAS u32x4*)(Vm + img_off<128>(i, cg * 8)) = pc[k]; *(LAS u32x4*)(Vw + img_off<128>(i, cg * 8)) = pw; }
      else if (cg < 24) *(LAS u32x4*)(Km + img_off<128>(i, (cg - 8) * 8)) = pc[k];
      else *(LAS u32x4*)(Qm + img_off<128>(i, (cg - 24) * 8)) = pc[k];
    }
    SCAN_BAR_L();
    if (cc + 1 < 34) MAMBA_LOAD(cc + 1);
    f32x16 res0, res1; chunk_core<128, 64>(Qm, Km, Vm, Ss, rowexp, colexp, isc, res0, res1, wid, lane);
    { const int tb = wid & 3, vp = wid >> 2, r32 = lane & 31, hh = lane >> 5;
#pragma unroll
      for (int r = 0; r < 16; ++r) { const int t = 32 * tb + crow(r, hh), io = dir ? 127 - t : t; YD[((size_t)dir * M + rowb + row0 + io) * 256 + h * 64 + 32 * vp + r32] = f2bf(res0[r]); } }
    const float sd = misc[0];
    SCAN_BAR_L();
    state_update<128, 64>(Km, Vw, Ss, st_acc, sd, wid, lane);
  }
#undef MAMBA_LOAD
  SCAN_BAR();
}

__device__ __forceinline__ void mlstm_chain(LAS char* lds, const bf16* __restrict__ P, const float* __restrict__ G, bf16* __restrict__ HC, int b, int h, int dir) {
  int tid_ = threadIdx.x; asm volatile("" : "+v"(tid_));
  const int tid = tid_, lane = tid & 63, wid = __builtin_amdgcn_readfirstlane(tid >> 6);
  LAS char* Qm = lds; LAS char* Km = lds + 16384; LAS char* Vm = lds + 32768; LAS char* Vw = lds + 57344; LAS char* Ss = lds + 81920;
  LAS float* rowexp = (LAS float*)(lds + 94208); LAS float* colexp = rowexp + 128; LAS float* isc = rowexp + 256; LAS float* vw = rowexp + 384; LAS float* emn = rowexp + 512; LAS float* den = rowexp + 640; LAS float* misc = rowexp + 768;
  for (int i = tid; i < 12288 / 4; i += 512) ((LAS unsigned*)Ss)[i] = 0u;
  f32x16 st_acc = {};
  float m_prev = 0.f;
  const size_t rowb = (size_t)b * RB;
  const int io = tid >> 2, part = tid & 3, i = dir ? 127 - io : io;
  u32x4 q0, q1, k0, k1, v0, v1; float ign[2] = {0.f, 0.f}, lfn[2] = {0.f, 0.f};
#define MLSTM_LOAD(cc_) do { int row0_, seg0_, seglen_; chunk_rows((cc_), dir, row0_, seg0_, seglen_); \
    const bf16* pr = P + (rowb + row0_ + io) * NP + h * 64 + part * 16; \
    q0 = *(const u32x4*)(pr + 1024); q1 = *(const u32x4*)(pr + 1024 + 8); k0 = *(const u32x4*)(pr + 1280); k1 = *(const u32x4*)(pr + 1280 + 8); v0 = *(const u32x4*)(pr + 1536); v1 = *(const u32x4*)(pr + 1536 + 8); \
    if (wid == 0) { _Pragma("unroll") for (int e = 0; e < 2; ++e) { const int ii = 2 * lane + e, ioo = dir ? 127 - ii : ii; const float* gr = G + (rowb + row0_ + ioo) * 32; ign[e] = gr[(2 * dir) * 4 + h]; lfn[e] = gr[(2 * dir + 1) * 4 + h]; } } } while (0)
  MLSTM_LOAD(0);
  SCAN_BAR();
#pragma unroll 1
  for (int cc = 0; cc < 34; ++cc) {
    int row0, seg0, seglen; chunk_rows(cc, dir, row0, seg0, seglen);
    if (wid == 0) {
      float bb[2], aa[2], mm[2];
      const float p1 = lfn[0] + lfn[1]; const float inc = wscan_add(p1, lane); const float exc = inc - p1;
      bb[0] = exc + lfn[0]; bb[1] = exc + p1; aa[0] = ign[0] - bb[0]; aa[1] = ign[1] - bb[1];
      const float q1m = fmaxf(aa[0], aa[1]); const float incm = wscan_max(q1m, lane); float excm = __shfl_up(incm, 1); if (lane == 0) excm = -INFINITY;
      mm[0] = fmaxf(m_prev, fmaxf(excm, aa[0])); mm[1] = fmaxf(m_prev, fmaxf(excm, q1m));
      const float b_end = __shfl(bb[1], 63), mm_end = __shfl(mm[1], 63);
#pragma unroll
      for (int e = 0; e < 2; ++e) { const int ii = 2 * lane + e; rowexp[ii] = -mm[e] * L2E; colexp[ii] = aa[e] * L2E; isc[ii] = __builtin_amdgcn_exp2f((m_prev - mm[e]) * L2E); emn[ii] = __builtin_amdgcn_exp2f(-(bb[e] + mm[e]) * L2E); vw[ii] = __builtin_amdgcn_exp2f((aa[e] - mm_end) * L2E); }
      if (lane == 0) misc[0] = __builtin_amdgcn_exp2f((m_prev - mm_end) * L2E);
      m_prev = b_end + mm_end;
    }
    SCAN_BAR_L();
    {
      const float s = vw[i];
      u32x4 qa, qb, va, vb;
#pragma unroll
      for (int e = 0; e < 4; ++e) { qa[e] = cvtpk(bf_lo(q0[e]) * 0.125f, bf_hi(q0[e]) * 0.125f); qb[e] = cvtpk(bf_lo(q1[e]) * 0.125f, bf_hi(q1[e]) * 0.125f);
        va[e] = cvtpk(bf_lo(v0[e]) * s, bf_hi(v0[e]) * s); vb[e] = cvtpk(bf_lo(v1[e]) * s, bf_hi(v1[e]) * s); }
      const int o0 = img_off<128>(i, part * 16), o1 = img_off<128>(i, part * 16 + 8);
      *(LAS u32x4*)(Qm + o0) = qa; *(LAS u32x4*)(Qm + o1) = qb; *(LAS u32x4*)(Km + o0) = k0; *(LAS u32x4*)(Km + o1) = k1;
      *(LAS u32x4*)(Vm + o0) = v0; *(LAS u32x4*)(Vm + o1) = v1; *(LAS u32x4*)(Vw + o0) = va; *(LAS u32x4*)(Vw + o1) = vb;
      const int o2 = img_off<128>(i, 64 + part * 8);
      const unsigned one = part == 0 ? 0x3f80u : 0u, wkb = part == 0 ? (cvtpk(s, 0.f) & 0xffffu) : 0u;
      *(LAS u32x4*)(Vm + o2) = (u32x4){one, 0u, 0u, 0u}; *(LAS u32x4*)(Vw + o2) = (u32x4){wkb, 0u, 0u, 0u};
    }
    SCAN_BAR_L();
    if (cc + 1 < 34) MLSTM_LOAD(cc + 1);
    f32x16 res0, res1; chunk_core<64, 96>(Qm, Km, Vm, Ss, rowexp, colexp, isc, res0, res1, wid, lane);
    const int tb = wid & 3, vp = wid >> 2, r32 = lane & 31, hh = lane >> 5;
    if (vp == 0 && r32 == 0) {
#pragma unroll
      for (int r = 0; r < 16; ++r) den[32 * tb + crow(r, hh)] = res1[r];
    }
    const float sd = misc[0];
    float em[16];
#pragma unroll
    for (int r = 0; r < 16; ++r) em[r] = emn[32 * tb + crow(r, hh)];
    SCAN_BAR_L();
#pragma unroll
    for (int r = 0; r < 16; ++r) { const int t = 32 * tb + crow(r, hh), ioo = dir ? 127 - t : t; const float dn = fmaxf(fabsf(den[t]), em[r]);
      HC[((size_t)dir * M + rowb + row0 + ioo) * 256 + h * 64 + 32 * vp + r32] = f2bf(res0[r] / dn); }
    state_update<64, 96>(Km, Vw, Ss, st_acc, sd, wid, lane);
  }
#undef MLSTM_LOAD
  SCAN_BAR();
}
#undef MFMA32
}
namespace pg8 {
typedef float f32x4e __attribute__((ext_vector_type(4)));
struct EpiInProj {
    static constexpr bool PERM = true, AFTER_DRAIN = false;
    bf16_t* O; float* G;
    __device__ __forceinline__ void operator()(const f32x4 (&acc)[2][2][4][2], const Unit& u, int wr, int wc, int fr, int fq) const {
        const int row0 = u.pm * BM + wr * 64 + fr, col0 = u.pn * BM + wc * 32 + 8 * fq;
#pragma unroll
        for (int ai = 0; ai < 2; ++ai)
#pragma unroll
            for (int m = 0; m < 4; ++m) { bf16_t* rowp = O + (size_t)(row0 + ai * HALF + m * 16) * 3328 + col0;
#pragma unroll
                for (int bj = 0; bj < 2; ++bj) { const f32x4 v0 = acc[ai][bj][m][0], v1 = acc[ai][bj][m][1];
                    u32x4 w; w.x = cvt_pk_bf16(v0[0], v0[1]); w.y = cvt_pk_bf16(v0[2], v0[3]); w.z = cvt_pk_bf16(v1[0], v1[1]); w.w = cvt_pk_bf16(v1[2], v1[3]);
                    *(u32x4*)(rowp + bj * HALF) = w; } }
        if (u.pn == 12 && wc == 0) {
#pragma unroll
            for (int ai = 0; ai < 2; ++ai)
#pragma unroll
                for (int m = 0; m < 4; ++m) { float* gp = G + (size_t)(row0 + ai * HALF + m * 16) * 32 + 8 * fq; *(f32x4*)gp = acc[ai][0][m][0]; *(f32x4*)(gp + 4) = acc[ai][0][m][1]; }
        }
    }
};
struct EpiRelu2 {
    static constexpr bool PERM = true, AFTER_DRAIN = false;
    bf16_t* O;
    __device__ __forceinline__ void operator()(const f32x4 (&acc)[2][2][4][2], const Unit& u, int wr, int wc, int fr, int fq) const {
        const int row0 = u.pm * BM + wr * 64 + fr, col0 = u.pn * BM + wc * 32 + 8 * fq;
#pragma unroll
        for (int ai = 0; ai < 2; ++ai)
#pragma unroll
            for (int m = 0; m < 4; ++m) { bf16_t* rowp = O + (size_t)(row0 + ai * HALF + m * 16) * 4096 + col0;
#pragma unroll
                for (int bj = 0; bj < 2; ++bj) { f32x4 v0 = acc[ai][bj][m][0], v1 = acc[ai][bj][m][1];
#pragma unroll
                    for (int e = 0; e < 4; ++e) { const float a = v0[e] > 0.f ? v0[e] : 0.f, b = v1[e] > 0.f ? v1[e] : 0.f; v0[e] = a * a; v1[e] = b * b; }
                    u32x4 w; w.x = cvt_pk_bf16(v0[0], v0[1]); w.y = cvt_pk_bf16(v0[2], v0[3]); w.z = cvt_pk_bf16(v1[0], v1[1]); w.w = cvt_pk_bf16(v1[2], v1[3]);
                    *(u32x4*)(rowp + bj * HALF) = w; } }
    }
};
struct EpiResid {
    static constexpr bool PERM = false, AFTER_DRAIN = false;
    const float* xin_lat; const float* xin_ctx; float* xout_lat; float* xout_ctx; const float* mod; int gate_off; float gsign;
    __device__ __forceinline__ void operator()(const f32x4 (&acc)[2][2][4][2], const Unit& u, int wr, int wc, int fr, int fq) const {
        const int b = u.pm / 17, tp = u.pm % 17;
        const float* xin; float* xout; const float* gate;
        if (tp == 0) { xin = xin_ctx + (size_t)b * 256 * 1024; xout = xout_ctx + (size_t)b * 256 * 1024; gate = mod + 8 * 6144 + gate_off; }
        else { const size_t o = ((size_t)b * 4096 + (size_t)(tp - 1) * 256) * 1024; xin = xin_lat + o; xout = xout_lat + o; gate = mod + b * 6144 + gate_off; }
        const int col0 = u.pn * BM + wc * 32 + 4 * fq;
#pragma unroll
        for (int bj = 0; bj < 2; ++bj)
#pragma unroll
            for (int n = 0; n < 2; ++n) { const int cc = col0 + bj * HALF + n * 16; const f32x4 gv = *(const f32x4*)(gate + cc) * gsign;
#pragma unroll
                for (int ai = 0; ai < 2; ++ai)
#pragma unroll
                    for (int m = 0; m < 4; ++m) { const size_t off = (size_t)(ai * HALF + wr * 64 + m * 16 + fr) * 1024 + cc; const f32x4 bs = *(const f32x4*)(xin + off); *(f32x4*)(xout + off) = bs + gv * acc[ai][bj][m][n]; }
                asm volatile("" ::: "memory"); }
    }
};
struct LatentOrder {
    StaticOrder base;
    __host__ __device__ void init(int N, int G_, int c_) { base.init(128 * 256, N, G_, c_); }
    __device__ __forceinline__ bool next(int i, Unit& u) const { if (!base.next(i, u)) return false; u.pm = (u.pm >> 4) * 17 + 1 + (u.pm & 15); return true; }
    __device__ __forceinline__ void a_ready(const Unit&) const {}
    __device__ __forceinline__ void done(const Unit&) const {}
};
}

namespace mk {
constexpr int NWAVES = 8;
constexpr int RING_OFF = 0, RING_BYTES = 131072, LDSCTL_OFF = RING_BYTES, MISC_OFF = LDSCTL_OFF + 320, LDS_BYTES = 147456;
#define RLX_AGENT __ATOMIC_RELAXED, __HIP_MEMORY_SCOPE_AGENT

struct Args {
  const float* in[25]; float* out; unsigned char* ws; int ph_lo, ph_hi, n_layers, use_cg; int rep[12];
};
enum { I_X = 0, I_C, I_CTX, I_CCTX, I_WADA, I_BADA, I_GN1, I_GN2, I_WIN, I_SINK, I_GQ, I_GK, I_BI, I_BF, I_GML, I_CW, I_CB, I_ALOG, I_DTB, I_DSK, I_GSSM, I_WOUT, I_W1, I_W2, I_GFIN };

template <class F> __device__ __forceinline__ void transpose_item(const float* W, int K, int N, bf16* WT, LAS float* scr, int item, int nblk, int lane, F srccol) {
  const int kb = item / nblk, nb = item % nblk, k0 = 64 * kb, n0 = 32 * nb;
  const int sc = srccol(n0 + (lane & 31));
#pragma unroll 8
  for (int i = 0; i < 32; ++i) { const int kk = 2 * i + (lane >> 5); scr[kk * 33 + (lane & 31)] = sc >= 0 ? W[(size_t)(k0 + kk) * N + sc] : 0.f; }
  asm volatile("s_waitcnt lgkmcnt(0)" ::: "memory");
  const int c = lane & 7;
#pragma unroll
  for (int j = 0; j < 4; ++j) { const int n = (lane >> 3) + 8 * j; const LAS float* s = scr + (8 * c) * 33 + n;
    u32x4 o; o.x = cvtpk(s[0 * 33], s[1 * 33]); o.y = cvtpk(s[2 * 33], s[3 * 33]); o.z = cvtpk(s[4 * 33], s[5 * 33]); o.w = cvtpk(s[6 * 33], s[7 * 33]);
    *(u32x4*)(WT + (size_t)(n0 + n) * K + k0 + 8 * c) = o; }
  asm volatile("s_waitcnt lgkmcnt(0)" ::: "memory");
}
__device__ __forceinline__ int win_srccol(int n) { return n < 2048 ? n : (n < 3072 ? n + 16 : (n < 3088 ? n - 1024 : (n < 3096 ? n : -1))); }

__device__ __forceinline__ void norm_row(const float* xrow, const float* g, const float* shv, const float* scv, bf16* orow, int lane) {
  const f32x4* xr = (const f32x4*)xrow + lane; f32x4 v[4]; float s = 0.f;
#pragma unroll
  for (int j = 0; j < 4; ++j) { v[j] = xr[64 * j]; s += (v[j].x * v[j].x + v[j].y * v[j].y) + (v[j].z * v[j].z + v[j].w * v[j].w); }
  const float rs = rsqrtf(wave_sum(s) * (1.f / DM) + EPS);
  unsigned long long* o8 = (unsigned long long*)orow + lane;
#pragma unroll
  for (int j = 0; j < 4; ++j) { const f32x4 gg = ((const f32x4*)g)[64 * j + lane], sh = ((const f32x4*)shv)[64 * j + lane], sc = ((const f32x4*)scv)[64 * j + lane];
    const f32x4 y = v[j] * rs * gg * (sc + 1.f) + sh;
    o8[64 * j] = (unsigned long long)cvtpk(y.x, y.y) | ((unsigned long long)cvtpk(y.z, y.w) << 32); }
}

__device__ __forceinline__ void attn_item(int idx, const bf16* P, bf16* Y, const float* sink, char* shm) {
  using attn_body::attn_unit; typedef attn_body::bf16 abf;
  bool isA; int b, hq, qrow, NT, band_row0 = 0, qpos0 = 0, band_s0 = 0;
  if (idx < 1024) { isA = idx >= 512; const int id = idx & 511; b = id >> 6; hq = (id >> 4) & 3; const int q0 = (id & 15) * 256; qrow = NC + q0; NT = 68;
    if (isA) { const int s_lo = q0 - 128 > 0 ? q0 - 128 : 0, s_hi = q0 + 384 < T ? q0 + 384 : T; NT = 4 + (s_hi - s_lo) / 64; band_row0 = NC + s_lo; qpos0 = q0; band_s0 = s_lo; } }
  else { const int id = idx - 1024; isA = id >= 32; b = (id & 31) >> 2; hq = id & 3; qrow = 0; NT = 4; }
  const int g = hq >> 1; const size_t rowb = (size_t)b * RB; const int cq = isA ? 0 : 512, ck = isA ? 256 : 768, cv = isA ? 384 : 896, cy = isA ? 0 : 256;
  const abf* Q0 = (const abf*)(P + (rowb + qrow) * NP + cq + hq * 64); const abf* Kh = (const abf*)(P + rowb * NP + ck + g * 64); const abf* Vh = (const abf*)(P + rowb * NP + cv + g * 64);
  abf* O0 = (abf*)(Y + (rowb + qrow) * DM + cy + hq * 64);
#ifndef MK_NO_B
  if (!isA) attn_unit<8, 0>(Q0, Kh, Vh, O0, NT, 0, 0, 0, 0.f, shm);
#endif
#ifndef MK_NO_A
  if (isA) attn_unit<8, 1>(Q0, Kh, Vh, O0, NT, band_row0, qpos0, band_s0, sink[hq] * L2E, shm);
#endif
}

__global__ void __launch_bounds__(NWAVES * 64, 2) mk_fwd(Args args) {
  extern __shared__ __attribute__((aligned(16))) unsigned char lds_raw[];
  LAS unsigned char* lds = (LAS unsigned char*)lds_raw;
  volatile LAS unsigned* MISC = (volatile LAS unsigned*)(lds + MISC_OFF);
  const int tid0 = threadIdx.x, wave = __builtin_amdgcn_readfirstlane(tid0 >> 6);
  const int G = gridDim.x; const int bx = blockIdx.x; const int vcu = (G % 8 == 0) ? (bx % 8) * (G / 8) + bx / 8 : bx;
  for (int u = tid0; u < (LDS_BYTES - LDSCTL_OFF) / 4; u += NWAVES * 64) ((LAS unsigned*)(lds + LDSCTL_OFF))[u] = 0u;
  __syncthreads();
  if (tid0 < 25) ((volatile LAS unsigned long long*)(lds + MISC_OFF + 256))[tid0] = (unsigned long long)(uintptr_t)args.in[tid0];
  __syncthreads();
  XcdBarrier bar = xcd_barrier_post(((unsigned*)(args.ws + WS_CTL)) + CW_BAR, MISC + 8);
#ifndef MK_PHSEL
#define MK_PHSEL 0xFFFF
#endif
#define AIN(k) ((const float*)(uintptr_t)(((unsigned long long)(unsigned)__builtin_amdgcn_readfirstlane((int)MISC[64 + 2 * (k) + 1]) << 32) | (unsigned long long)(unsigned)__builtin_amdgcn_readfirstlane((int)MISC[64 + 2 * (k)])))
#define PH_PROLOG int tid = threadIdx.x; asm volatile("" : "+v"(tid)); const int lane = tid & 63; (void)lane; unsigned char* wsp = args.ws; asm volatile("" : "+s"(wsp));
  const int gw = vcu * NWAVES + wave, NGW = G * NWAVES;

  const int nph = 1 + 9 * args.n_layers + 1;
#pragma unroll 1
  for (int ph = args.ph_lo; ph < args.ph_hi; ++ph) {
  int kind, l = 0;
  if (ph == 0) kind = 0; else if (ph == nph - 1) kind = 10; else { l = (ph - 1) / 9; kind = 1 + (ph - 1) % 9; }
  if (kind == 0) { PH_PROLOG if ((MK_PHSEL >> 0) & 1) for (int rp = 0; rp < args.rep[0]; ++rp) {
    {
      if (vcu >= G - 24) {
        LAS float* sc = (LAS float*)(lds + RING_OFF);
        for (int i = tid; i < 9 * DM; i += NWAVES * 64) { const int j = i / DM, k = i % DM; const float v = j < 8 ? AIN(I_C)[j * DM + k] : AIN(I_CCTX)[k]; sc[i] = v / (1.f + __expf(-v)); }
        __syncthreads();
        const int o = (vcu - (G - 24)) * 512 + tid;
        const int l = o / 6144, n = o % 6144; const float* w = AIN(I_WADA) + (size_t)l * DM * 6144 + n;
        float acc[9];
#pragma unroll
        for (int j = 0; j < 9; ++j) acc[j] = 0.f;
        for (int k = 0; k < DM; ++k) { const float wv = w[(size_t)k * 6144];
#pragma unroll
          for (int j = 0; j < 9; ++j) acc[j] += sc[j * DM + k] * wv; }
        const float bb = AIN(I_BADA)[l * 6144 + n];
#pragma unroll
        for (int j = 0; j < 9; ++j) ((float*)(wsp + WS_MOD))[(size_t)(l * 9 + j) * 6144 + n] = acc[j] + bb;
        __syncthreads();
      }
      for (int i = gw * 64 + lane; i < T * 32; i += NGW * 64) { const int t = i >> 5, e = i & 31, fi = e & 15; const float invf = __builtin_amdgcn_exp2f(-(float)fi * (13.287712379549449f / 16.f));
        const float ang = (float)(e < 16 ? (t >> 6) : (t & 63)) * invf; ((float*)(wsp + WS_CS))[i] = __cosf(ang); ((float*)(wsp + WS_CS))[T * 32 + i] = __sinf(ang); }
      LAS float* scr = (LAS float*)(lds + RING_OFF + 40960 + wave * 8704);
      constexpr int I_IN = 16 * 104, I_OUT = 16 * 32, I_1 = 16 * 128, I_2 = 64 * 32, I_L = I_IN + I_OUT + I_1 + I_2;
      for (int it = gw; it < 2 * I_L; it += NGW) {
        const int l = it / I_L; int r = it % I_L; unsigned char* wl = (wsp) + WS_W + (size_t)l * W_LAYER;
        if (r < I_IN) { transpose_item(AIN(I_WIN) + (size_t)l * DM * NINO, DM, NINO, (bf16*)(wl + WO_IN), scr, r, 104, lane, [](int n) { return win_srccol(n); }); continue; } r -= I_IN;
        if (r < I_OUT) { transpose_item(AIN(I_WOUT) + (size_t)l * DM * DM, DM, DM, (bf16*)(wl + WO_OUT), scr, r, 32, lane, [](int n) { return n; }); continue; } r -= I_OUT;
        if (r < I_1) { transpose_item(AIN(I_W1) + (size_t)l * DM * DFF, DM, DFF, (bf16*)(wl + WO_1), scr, r, 128, lane, [](int n) { return n; }); continue; } r -= I_1;
        transpose_item(AIN(I_W2) + (size_t)l * DFF * DM, DFF, DM, (bf16*)(wl + WO_2), scr, r, 32, lane, [](int n) { return n; });
      }
    }
  } }

  {
    if (kind == 1) { PH_PROLOG if ((MK_PHSEL >> 1) & 1) for (int rp = 0; rp < args.rep[1]; ++rp) {
      for (int m = gw; m < M; m += NGW) { const int b = m / RB, r = m % RB; const bool isc = r < NC;
        const float* xr = isc ? (l == 0 ? AIN(I_CTX) : (const float*)(wsp + WS_XC)) + ctx_off(b, r) : (l == 0 ? AIN(I_X) : (const float*)args.out) + lat_off(b, r - NC); const float* mr = (((float*)(wsp + WS_MOD)) + (size_t)l * 9 * 6144) + (isc ? 8 : b) * 6144;
        norm_row(xr, AIN(I_GN1) + l * DM, mr, mr + 1024, ((bf16*)(wsp + WS_H)) + (size_t)m * DM, lane); }
    } }
    if (kind == 2) { PH_PROLOG if ((MK_PHSEL >> 2) & 1) for (int rp = 0; rp < args.rep[2]; ++rp) {
      { pg8::Gemm g{((bf16*)(wsp + WS_H)), (const bf16*)((wsp + WS_W + (size_t)l * W_LAYER) + WO_IN), M, NP, DM}; pg8::StaticOrder S; S.init(M, NP, G, bx);
        pg8::EpiInProj E{((bf16*)(wsp + WS_P)), ((float*)(wsp + WS_G))}; pg8::gemm_phase<pg8::EpiInProj, pg8::StaticOrder, true, true>(lds + RING_OFF, g, S, E); }
    } }
    if (kind == 3) { PH_PROLOG if ((MK_PHSEL >> 3) & 1) for (int rp = 0; rp < args.rep[3]; ++rp) {
      { const float* gq = AIN(I_GQ) + l * 64; const float* gk = AIN(I_GK) + l * 64; const float* cw = AIN(I_CW) + l * 3 * 768; const float* cb = AIN(I_CB) + l * 768;
        bf16* Pq = ((bf16*)(wsp + WS_P)); bf16* UCb = ((bf16*)(wsp + WS_UC)); float* Gp = ((float*)(wsp + WS_G)); const float* cst = ((const float*)(wsp + WS_CS));
        const int hw = 2 * gw + (lane >> 5), l32 = lane & 31, which = hw % 3, j = l32 & 7, slot = 4 * which + (l32 >> 3);
        const int blk = slot < 6 ? slot : slot + 2;
        const bool isq = slot < 4 || (slot >= 6 && slot < 10), isB = slot >= 6;
        const float* gv = isq ? gq : gk; float gn[8];
#pragma unroll
        for (int e = 0; e < 8; ++e) gn[e] = gv[8 * j + e];
        const int cch = 256 * which + 8 * l32, pcol = (which == 0 ? 2048 : (which == 1 ? 2560 : 2816)) + 8 * l32;
        f32x4 w0[2], w1[2], w2[2], bb[2];
#pragma unroll
        for (int q = 0; q < 2; ++q) { w0[q] = *(const f32x4*)(cw + cch + 4 * q); w1[q] = *(const f32x4*)(cw + 768 + cch + 4 * q); w2[q] = *(const f32x4*)(cw + 1536 + cch + 4 * q); bb[q] = *(const f32x4*)(cb + cch + 4 * q); }
        const float bgate = l32 < 16 ? (((l32 >> 2) & 1) ? AIN(I_BF)[l * 8 + (l32 >> 3) * 4 + (l32 & 3)] : AIN(I_BI)[l * 8 + (l32 >> 3) * 4 + (l32 & 3)]) : (l32 < 24 ? AIN(I_DTB)[l * 8 + (l32 - 16)] : 0.f);
        if (hw < 4095)
        for (int m = hw / 3; m < M; m += 1365) { const int r = m % RB;
          { bf16* p = Pq + (size_t)m * NP + blk * 64 + 8 * j; const u32x4 w = *(const u32x4*)p; float x[8] = {bf_lo(w.x), bf_hi(w.x), bf_lo(w.y), bf_hi(w.y), bf_lo(w.z), bf_hi(w.z), bf_lo(w.w), bf_hi(w.w)};
            if (isB) { float ss = 0.f;
#pragma unroll
              for (int e = 0; e < 8; ++e) ss += x[e] * x[e];
              ss += __shfl_xor(ss, 1); ss += __shfl_xor(ss, 2); ss += __shfl_xor(ss, 4); const float rs = rsqrtf(ss * (1.f / 64.f) + EPS);
#pragma unroll
              for (int e = 0; e < 8; ++e) x[e] = x[e] * rs * gn[e]; }
            if (r >= NC) { const int t = r - NC; const float* cp = cst + t * 32 + (j >> 2) * 16 + (j & 1) * 8; const f32x4 c0 = *(const f32x4*)cp, c1 = *(const f32x4*)(cp + 4), s0 = *(const f32x4*)(cp + T * 32), s1 = *(const f32x4*)(cp + T * 32 + 4);
              const float cc[8] = {c0[0], c0[1], c0[2], c0[3], c1[0], c1[1], c1[2], c1[3]}, sn[8] = {s0[0], s0[1], s0[2], s0[3], s1[0], s1[1], s1[2], s1[3]};
#pragma unroll
              for (int e = 0; e < 8; ++e) { const float other = __shfl_xor(x[e], 2); x[e] = (j & 2) ? x[e] * cc[e] + other * sn[e] : x[e] * cc[e] - other * sn[e]; } }
            if (isq) {
#pragma unroll
              for (int e = 0; e < 8; ++e) x[e] *= QC2; }
            *(u32x4*)p = (u32x4){cvtpk(x[0], x[1]), cvtpk(x[2], x[3]), cvtpk(x[4], x[5]), cvtpk(x[6], x[7])}; }
          { const int seg0 = r < NC ? 0 : NC, seglen = r < NC ? NC : T, sl = r - seg0; const bf16* px = Pq + (size_t)m * NP + pcol; const u32x4 z4 = {0u, 0u, 0u, 0u};
            const u32x4 xm = sl > 0 ? *(const u32x4*)(px - NP) : z4, x0 = *(const u32x4*)px, xp = sl + 1 < seglen ? *(const u32x4*)(px + NP) : z4; float u[8];
#pragma unroll
            for (int e = 0; e < 4; ++e) { const int q = e >> 1, o = (e & 1) * 2;
              const float y0 = bb[q][o] + w0[q][o] * bf_lo(xm[e]) + w1[q][o] * bf_lo(x0[e]) + w2[q][o] * bf_lo(xp[e]);
              const float y1 = bb[q][o + 1] + w0[q][o + 1] * bf_hi(xm[e]) + w1[q][o + 1] * bf_hi(x0[e]) + w2[q][o + 1] * bf_hi(xp[e]);
              u[2 * e] = y0 / (1.f + __expf(-y0)); u[2 * e + 1] = y1 / (1.f + __expf(-y1)); }
            *(u32x4*)(UCb + (size_t)m * 768 + cch) = (u32x4){cvtpk(u[0], u[1]), cvtpk(u[2], u[3]), cvtpk(u[4], u[5]), cvtpk(u[6], u[7])}; }
          if (which == 0 && l32 < 24) { float* gp = Gp + (size_t)m * 32 + l32; const float v = *gp + bgate; float o;
            if (l32 < 16) o = ((l32 >> 2) & 1) ? fminf(v, 0.f) - __logf(1.f + __expf(-fabsf(v))) : v; else o = v > 20.f ? v : __logf(1.f + __expf(v));
            *gp = o; }
        } }
    } }
    if (kind == 4) { PH_PROLOG if ((MK_PHSEL >> 4) & 1) for (int rp = 0; rp < args.rep[4]; ++rp) {
      {
#ifndef MK_NO_MAMBA
        if (bx < 64) scan::mamba_chain((LAS char*)lds, ((bf16*)(wsp + WS_UC)), ((float*)(wsp + WS_G)), AIN(I_ALOG) + l * 8, ((bf16*)(wsp + WS_YD)), bx >> 3, (bx >> 1) & 3, bx & 1);
#endif
#ifndef MK_NO_MLSTM
        if (bx >= 64 && bx < 128) { const int c = bx - 64; scan::mlstm_chain((LAS char*)lds, ((bf16*)(wsp + WS_P)), ((float*)(wsp + WS_G)), ((bf16*)(wsp + WS_HC)), c >> 3, (c >> 1) & 3, c & 1); }
#endif
        const int nunits = (l == 1) ? 1024 : 1088;
        for (;;) {
          if (tid == 0) MISC[16] = __hip_atomic_fetch_add(((unsigned*)(wsp + WS_CTL)) + CW_QUEUE + 64 * (l * 4 + rp), 1u, RLX_AGENT);
          __syncthreads(); const int idx = __builtin_amdgcn_readfirstlane((int)MISC[16]); __syncthreads();
          if (idx >= nunits) break;
          attn_item(idx, ((bf16*)(wsp + WS_P)), ((bf16*)(wsp + WS_Y)), AIN(I_SINK) + l * 4, (char*)lds_raw + RING_OFF);
        } }
    } }
    if (kind == 5) { PH_PROLOG if ((MK_PHSEL >> 5) & 1) for (int rp = 0; rp < args.rep[5]; ++rp) {
      { const float* gml = AIN(I_GML) + l * 256; const float* gss = AIN(I_GSSM) + l * 256; const float* dsk = AIN(I_DSK) + l * 4;
        for (int m = gw; m < M; m += NGW) { const int r = m % RB; if ((l == 1) && r < NC) continue;
          const int c0 = 4 * lane;
          { const u32x2 a = *(const u32x2*)(((bf16*)(wsp + WS_HC)) + (size_t)m * 256 + c0), bq = *(const u32x2*)(((bf16*)(wsp + WS_HC)) + ((size_t)M + m) * 256 + c0);
            float hs[4] = {bf_lo(a.x) + bf_lo(bq.x), bf_hi(a.x) + bf_hi(bq.x), bf_lo(a.y) + bf_lo(bq.y), bf_hi(a.y) + bf_hi(bq.y)};
            float ss = hs[0] * hs[0] + hs[1] * hs[1] + hs[2] * hs[2] + hs[3] * hs[3];
            ss += __shfl_xor(ss, 1); ss += __shfl_xor(ss, 2); ss += __shfl_xor(ss, 4); ss += __shfl_xor(ss, 8);
            const float rs = rsqrtf(ss * (1.f / 64.f) + EPS); const u32x2 ow = *(const u32x2*)(((bf16*)(wsp + WS_P)) + (size_t)m * NP + 1792 + c0); const f32x4 gg = *(const f32x4*)(gml + c0);
            const float o4[4] = {bf_lo(ow.x), bf_hi(ow.x), bf_lo(ow.y), bf_hi(ow.y)}; float y[4];
#pragma unroll
            for (int e = 0; e < 4; ++e) y[e] = hs[e] * rs * gg[e] / (1.f + __expf(-o4[e]));
            *(u32x2*)(((bf16*)(wsp + WS_Y)) + (size_t)m * DM + 512 + c0) = (u32x2){cvtpk(y[0], y[1]), cvtpk(y[2], y[3])}; }
          { const u32x2 a = *(const u32x2*)(((bf16*)(wsp + WS_YD)) + (size_t)m * 256 + c0), bq = *(const u32x2*)(((bf16*)(wsp + WS_YD)) + ((size_t)M + m) * 256 + c0);
            const u32x2 xw = *(const u32x2*)(((bf16*)(wsp + WS_UC)) + (size_t)m * 768 + c0); const float xs4[4] = {bf_lo(xw.x), bf_hi(xw.x), bf_lo(xw.y), bf_hi(xw.y)};
            const u32x2 zw = *(const u32x2*)(((bf16*)(wsp + WS_P)) + (size_t)m * NP + 2304 + c0); const float z4[4] = {bf_lo(zw.x), bf_hi(zw.x), bf_lo(zw.y), bf_hi(zw.y)};
            const float ys[4] = {bf_lo(a.x) + bf_lo(bq.x), bf_hi(a.x) + bf_hi(bq.x), bf_lo(a.y) + bf_lo(bq.y), bf_hi(a.y) + bf_hi(bq.y)};
            const float dk = dsk[lane >> 4]; float v[4]; float ss = 0.f;
#pragma unroll
            for (int e = 0; e < 4; ++e) { v[e] = (ys[e] + dk * xs4[e]) * (z4[e] / (1.f + __expf(-z4[e]))); ss += v[e] * v[e]; }
            const float rs = rsqrtf(wave_sum(ss) * (1.f / 256.f) + EPS); const f32x4 gg = *(const f32x4*)(gss + c0);
            *(u32x2*)(((bf16*)(wsp + WS_Y)) + (size_t)m * DM + 768 + c0) = (u32x2){cvtpk(v[0] * rs * gg[0], v[1] * rs * gg[1]), cvtpk(v[2] * rs * gg[2], v[3] * rs * gg[3])}; }
        } }
    } }
    if (kind == 6) { PH_PROLOG if ((MK_PHSEL >> 6) & 1) for (int rp = 0; rp < args.rep[6]; ++rp) {
      { pg8::Gemm g{((bf16*)(wsp + WS_Y)), (const bf16*)((wsp + WS_W + (size_t)l * W_LAYER) + WO_OUT), M, DM, DM}; pg8::EpiResid E{(l == 0 ? AIN(I_X) : (const float*)args.out), (l == 0 ? AIN(I_CTX) : (const float*)(wsp + WS_XC)), (args.out), ((float*)(wsp + WS_XC)), (((float*)(wsp + WS_MOD)) + (size_t)l * 9 * 6144), 2048, (rp & 1) ? -1.f : 1.f};
        if (!(l == 1)) { pg8::StaticOrder S; S.init(M, DM, G, bx); pg8::gemm_phase<pg8::EpiResid, pg8::StaticOrder, true, true>(lds + RING_OFF, g, S, E); }
        else { pg8::LatentOrder S; S.init(DM, G, bx); pg8::gemm_phase<pg8::EpiResid, pg8::LatentOrder, true, true>(lds + RING_OFF, g, S, E); } }
    } }
    if (kind == 7) { PH_PROLOG if ((MK_PHSEL >> 7) & 1) for (int rp = 0; rp < args.rep[7]; ++rp) {
      for (int m = gw; m < M; m += NGW) { const int b = m / RB, r = m % RB; const bool isc = r < NC; if ((l == 1) && isc) continue;
        const float* xr = isc ? ((float*)(wsp + WS_XC)) + ctx_off(b, r) : (args.out) + lat_off(b, r - NC); const float* mr = (((float*)(wsp + WS_MOD)) + (size_t)l * 9 * 6144) + (isc ? 8 : b) * 6144;
        norm_row(xr, AIN(I_GN2) + l * DM, mr + 3072, mr + 4096, ((bf16*)(wsp + WS_H)) + (size_t)m * DM, lane); }
    } }
    if (kind == 8) { PH_PROLOG if ((MK_PHSEL >> 8) & 1) for (int rp = 0; rp < args.rep[8]; ++rp) {
      { pg8::Gemm g{((bf16*)(wsp + WS_H)), (const bf16*)((wsp + WS_W + (size_t)l * W_LAYER) + WO_1), M, DFF, DM}; pg8::EpiRelu2 E{((bf16*)(wsp + WS_U))};
        if (!(l == 1)) { pg8::StaticOrder S; S.init(M, DFF, G, bx); pg8::gemm_phase<pg8::EpiRelu2, pg8::StaticOrder, true, true>(lds + RING_OFF, g, S, E); }
        else { pg8::LatentOrder S; S.init(DFF, G, bx); pg8::gemm_phase<pg8::EpiRelu2, pg8::LatentOrder, true, true>(lds + RING_OFF, g, S, E); } }
    } }
    if (kind == 9) { PH_PROLOG if ((MK_PHSEL >> 9) & 1) for (int rp = 0; rp < args.rep[9]; ++rp) {
      { pg8::Gemm g{((bf16*)(wsp + WS_U)), (const bf16*)((wsp + WS_W + (size_t)l * W_LAYER) + WO_2), M, DM, DFF}; pg8::EpiResid E{(args.out), ((float*)(wsp + WS_XC)), (args.out), ((float*)(wsp + WS_XC)), (((float*)(wsp + WS_MOD)) + (size_t)l * 9 * 6144), 5120, (rp & 1) ? -1.f : 1.f};
        if (!(l == 1)) { pg8::StaticOrder S; S.init(M, DM, G, bx); pg8::gemm_phase<pg8::EpiResid, pg8::StaticOrder, true, true>(lds + RING_OFF, g, S, E); }
        else { pg8::LatentOrder S; S.init(DM, G, bx); pg8::gemm_phase<pg8::EpiResid, pg8::LatentOrder, true, true>(lds + RING_OFF, g, S, E); } }
    } }
  }
  if (kind == 10) { PH_PROLOG if ((MK_PHSEL >> 10) & 1) for (int rp = 0; rp < args.rep[10]; ++rp) {
    { const float* gf = AIN(I_GFIN);
      for (int m = gw; m < NB * T; m += NGW) { f32x4* xr = (f32x4*)((args.out) + (size_t)m * DM) + lane; f32x4 v[4]; float s = 0.f;
#pragma unroll
        for (int j = 0; j < 4; ++j) { v[j] = xr[64 * j]; s += (v[j].x * v[j].x + v[j].y * v[j].y) + (v[j].z * v[j].z + v[j].w * v[j].w); }
        const float rs = rsqrtf(wave_sum(s) * (1.f / DM) + EPS);
#pragma unroll
        for (int j = 0; j < 4; ++j) xr[64 * j] = v[j] * rs * ((const f32x4*)gf)[64 * j + lane]; } }
  } }
  if (ph + 1 < args.ph_hi) { if (args.use_cg && ph == args.ph_lo) cooperative_groups::this_grid().sync(); else xcd_barrier(bar); }
  }
#undef PH_PROLOG
#undef AIN
}
constexpr int N_PHASES = 1 + 2 * 9 + 1;

static void launch(void* const* d_in, float* out, void* d_ws, hipStream_t stream, int n_launch_mode  , int n_layers) {
  static int grid = 0;
  if (grid == 0) {
    int dev = 0, cus = 0, per_cu = 0;
    (void)hipGetDevice(&dev); (void)hipDeviceGetAttribute(&cus, hipDeviceAttributeMultiprocessorCount, dev);
    (void)hipFuncSetAttribute((const void*)mk_fwd, hipFuncAttributeMaxDynamicSharedMemorySize, LDS_BYTES);
    (void)hipOccupancyMaxActiveBlocksPerMultiprocessor(&per_cu, (const void*)mk_fwd, NWAVES * 64, LDS_BYTES);
    (void)hipGetLastError();
    if (per_cu < 1) fprintf(stderr, "mk: occupancy query says %d blocks per CU\n", per_cu);
    grid = cus;
  }
  (void)hipMemsetAsync((char*)d_ws + WS_CTL, 0, CTL_ZERO_BYTES, stream);
  Args a{}; for (int i = 0; i < 25; ++i) a.in[i] = (const float*)d_in[i];
  a.out = out; a.ws = (unsigned char*)d_ws; a.n_layers = n_layers;
  for (int k = 0; k < 12; ++k) a.rep[k] = 1;
#ifdef MK_REP_MASK
  for (int k = 0; k < 12; ++k) if ((MK_REP_MASK >> k) & 1) a.rep[k] = MK_REP_N;
#endif
  const int nph = 1 + n_layers * 9 + 1;
  if (n_launch_mode == 0) {
    a.ph_lo = 0; a.ph_hi = nph; a.use_cg = 1;
    void* kargs[] = {&a};
    hipError_t e = hipLaunchCooperativeKernel((const void*)mk_fwd, dim3(grid), dim3(NWAVES * 64), kargs, LDS_BYTES, stream);
    if (e != hipSuccess) { fprintf(stderr, "mk: cooperative launch failed (%s), plain launch instead\n", hipGetErrorName(e)); (void)hipGetLastError(); a.use_cg = 0; hipLaunchKernelGGL(mk_fwd, dim3(grid), dim3(NWAVES * 64), LDS_BYTES, stream, a); }
  }
  else for (int p = 0; p < nph; ++p) { a.ph_lo = p; a.ph_hi = p + 1; hipLaunchKernelGGL(mk_fwd, dim3(grid), dim3(NWAVES * 64), LDS_BYTES, stream, a); }
  const hipError_t le = hipPeekAtLastError(); if (le != hipSuccess) fprintf(stderr, "mk: launch failed: %s\n", hipGetErrorName(le));
}
}
extern "C" void kernel_launch(void* const* d_in, const int* in_sizes, int n_in, void* d_out, int out_size, void* d_ws, size_t ws_size, hipStream_t stream) {
  mk::launch(d_in, (float*)d_out, d_ws, stream, MK_LAUNCH_MODE, 2);
}
```

```cpp
#define MK_LAUNCH_MODE 0
#include <hip/hip_runtime.h>
#include <hip/hip_bf16.h>
#include <hip/hip_cooperative_groups.h>
#include <cstdint>
#include <cstdio>
#include <cmath>
#define GAS __attribute__((address_space(1)))
#define LAS __attribute__((address_space(3)))
namespace mk {
constexpr int NB = 8, T = 4096, NC = 256, RB = T + NC, M = NB * RB, DM = 1024, NP = 3328, DFF = 4096, TPB = RB / 256, NINO = 3096;
constexpr float EPS = 1e-6f, L2E = 1.4426950408889634f;
constexpr float QC2 = 0.125f * 1.4426950408889634f;
typedef unsigned short bf16;
typedef unsigned u32x4 __attribute__((ext_vector_type(4)));
typedef unsigned u32x2 __attribute__((ext_vector_type(2)));
typedef float f32x4 __attribute__((ext_vector_type(4)));
typedef float f32x16 __attribute__((ext_vector_type(16)));
typedef short bf16x8 __attribute__((ext_vector_type(8)));
typedef short s16x4 __attribute__((ext_vector_type(4)));
typedef float f32x2v __attribute__((ext_vector_type(2)));
typedef __bf16 bf16x2v __attribute__((ext_vector_type(2)));

constexpr size_t MiB = 1u << 20;
constexpr size_t WS_CTL = 0, CTL_ZERO_BYTES = 1 * MiB;
constexpr size_t WS_MOD = 1 * MiB;
constexpr size_t WS_CS = 2 * MiB;
constexpr size_t WS_G = 4 * MiB;
constexpr size_t WS_XC = 9 * MiB;
constexpr size_t WS_W = 17 * MiB;
constexpr size_t W_LAYER = (size_t)(NP + DM + DFF + DFF) * 1024 * 2;
constexpr size_t WO_IN = 0, WO_OUT = (size_t)NP * DM * 2, WO_1 = WO_OUT + (size_t)DM * DM * 2, WO_2 = WO_1 + (size_t)DFF * DM * 2;
constexpr size_t WS_H = 66 * MiB;
constexpr size_t WS_P = 134 * MiB;
constexpr size_t WS_Y = 355 * MiB;
constexpr size_t WS_U = WS_P;
constexpr size_t WS_UC = 423 * MiB;
constexpr size_t WS_END = 474 * MiB;
static_assert(WS_W + 2 * W_LAYER <= WS_H && WS_H + (size_t)M * DM * 2 <= WS_P && WS_P + (size_t)M * NP * 2 <= WS_Y && WS_U + (size_t)M * DFF * 2 <= WS_UC && WS_UC + (size_t)M * 768 * 2 <= WS_END, "ws map");
constexpr size_t WS_HC = WS_H, WS_YD = WS_H + (size_t)2 * M * 256 * 2;
constexpr int CW_BAR = 4096;
constexpr int CW_QUEUE = 16384;

__device__ __forceinline__ unsigned cvtpk(float lo, float hi) { f32x2v v = {lo, hi}; bf16x2v b = __builtin_convertvector(v, bf16x2v); return __builtin_bit_cast(unsigned, b); }
__device__ __forceinline__ float bf_lo(unsigned w) { return __uint_as_float(w << 16); }
__device__ __forceinline__ float bf_hi(unsigned w) { return __uint_as_float(w & 0xffff0000u); }
__device__ __forceinline__ float bf2f(bf16 v) { return __uint_as_float(((unsigned)v) << 16); }
__device__ __forceinline__ bf16 f2bf(float f) { return (bf16)(cvtpk(f, 0.f) & 0xffffu); }
__device__ __forceinline__ float wave_sum(float v) {
#pragma unroll
  for (int o = 1; o < 64; o <<= 1) v += __shfl_xor(v, o);
  return v;
}
__device__ __forceinline__ int crow(int r, int hi) { return (r & 3) + 8 * (r >> 2) + 4 * hi; }
__device__ __forceinline__ size_t lat_off(int b, int t) { return ((size_t)b * T + t) * DM; }
__device__ __forceinline__ size_t ctx_off(int b, int j) { return ((size_t)b * NC + j) * DM; }
}
typedef GAS unsigned gu32;
typedef GAS unsigned long long gu64;

#define XB_TMO      128
#define XB_XCNT(j)  (256  + 64 * (j))
#define XB_XSUB(j)  (1280 + 64 * (j))
#define XB_XGEN(j)  (2304 + 64 * (j))
#define XB_TOP      3328
#define XB_TOPGEN   3392
#define XCD_BAR_WORDS 3456
#define XB_SPIN_CAP (1u << 18)

__device__ __forceinline__ unsigned xb_ld(unsigned* p)              { return __hip_atomic_load(p, __ATOMIC_RELAXED, __HIP_MEMORY_SCOPE_AGENT); }
__device__ __forceinline__ unsigned xb_add(unsigned* p, unsigned v) { return __hip_atomic_fetch_add(p, v, __ATOMIC_RELAXED, __HIP_MEMORY_SCOPE_AGENT); }
__device__ __forceinline__ unsigned xb_xcc_id() { return (unsigned)__builtin_amdgcn_s_getreg((3 << 11) | 20) & 0xFu; }
#define XB_SPIN(cond, bar) do { unsigned _sp = 0; while (cond) { __builtin_amdgcn_s_sleep(1); \
    if ((++_sp & 255u) == 0u) { if (xb_ld(&(bar)[XB_TMO])) break; if (_sp > XB_SPIN_CAP) { atomicAdd(&(bar)[XB_TMO], 1u); break; } } } } while (0)

struct XcdBarrier {
    unsigned* bar; unsigned x;
    volatile LAS unsigned* st;
};

__device__ __forceinline__ XcdBarrier xcd_barrier_post(unsigned* bar, volatile LAS unsigned* st) {
    XcdBarrier b; b.bar = bar; b.x = xb_xcc_id(); b.st = st;
    if (threadIdx.x == 0) (void)xb_add(&bar[XB_XCNT(b.x)], 1u);
    return b;
}
__device__ __forceinline__ void xcd_barrier_complete(unsigned* bar, unsigned x, unsigned& nloc, unsigned& nx) {
    const unsigned G = gridDim.x * gridDim.y * gridDim.z;
    unsigned sum, cnt, mine, sp = 0u;
    for (;;) {
        sum = 0u; cnt = 0u; mine = 0u;
#pragma unroll 1
        for (unsigned j = 0; j < 16; ++j) { const unsigned c = xb_ld(&bar[XB_XCNT(j)]); sum += c; cnt += (c > 0u) ? 1u : 0u; mine = (j == x) ? c : mine; }
        if (sum == G) break;
        __builtin_amdgcn_s_sleep(1);
        if ((++sp & 255u) == 0u) { if (xb_ld(&bar[XB_TMO])) break; if (sp > XB_SPIN_CAP) { atomicAdd(&bar[XB_TMO], 1u); break; } }
    }
    nloc = mine > 0u ? mine : 1u; nx = cnt > 0u ? cnt : 1u;
}

__device__ __forceinline__ void xcd_barrier(const XcdBarrier& b) {
    asm volatile("s_waitcnt vmcnt(0)" ::: "memory");
    __syncthreads();
    if (threadIdx.x == 0) {
        unsigned* bar = b.bar;
        __builtin_amdgcn_s_waitcnt(0);
        unsigned nloc = b.st[0], nx = b.st[1];
        if (nloc == 0u) { xcd_barrier_complete(bar, b.x, nloc, nx); b.st[0] = nloc; b.st[1] = nx; }
        const unsigned old = xb_add(&bar[XB_XSUB(b.x)], 1u);
        const unsigned gen = old / nloc;
        if (old + 1u == (gen + 1u) * nloc) {
            __builtin_amdgcn_fence(__ATOMIC_RELEASE, "agent");
            asm volatile("s_waitcnt vmcnt(0)" ::: "memory");
            const unsigned og = xb_add(&bar[XB_TOP], 1u);
            const unsigned tg = og / nx;
            if (og + 1u == (tg + 1u) * nx) xb_add(&bar[XB_TOPGEN], 1u);
            else XB_SPIN(xb_ld(&bar[XB_TOPGEN]) == tg, bar);
            __builtin_amdgcn_fence(__ATOMIC_ACQUIRE, "agent");
            xb_add(&bar[XB_XGEN(b.x)], 1u);
            asm volatile("s_waitcnt vmcnt(0)" ::: "memory");
        } else {
            XB_SPIN(xb_ld(&bar[XB_XGEN(b.x)]) == gen, bar);
            __builtin_amdgcn_fence(__ATOMIC_ACQUIRE, "agent");
            asm volatile("s_waitcnt vmcnt(0)" ::: "memory");
        }
    }
    __syncthreads();
}
namespace pg8 {
#define PG8_LAS __attribute__((address_space(3)))
typedef unsigned short bf16_t;
typedef short bf16x8 __attribute__((ext_vector_type(8)));
typedef float f32x4 __attribute__((ext_vector_type(4)));
typedef unsigned u32x4 __attribute__((ext_vector_type(4)));
constexpr int BM = 256, BK = 64, HALF = 128, HTB = HALF * BK * 2  , STAGE_BYTES = 8 * HTB, NXCD = 8, WGM = 8;

__host__ __device__ __forceinline__ int lds_byte(int r, int c) { const int st = (r >> 4) * 2 + (c >> 5), rr = r & 15, cc = c & 31, ob = rr * 64 + cc * 2; return st * 1024 + (ob ^ (((ob >> 9) & 1) << 5)); }
__host__ __device__ __forceinline__ void stage_rc(int b, int& R, int& C) { const int st = b / 1024, sb = b % 1024, swz = sb ^ (((sb >> 9) & 1) << 5); R = (st >> 1) * 16 + swz / 64; C = (st & 1) * 32 + (swz % 64) / 2; }
__host__ __device__ __forceinline__ int perm32(int rho) { const int n = rho >> 4, i = rho & 15; return 8 * (i >> 2) + 4 * n + (i & 3); }

struct Unit { int pm, pn; };
struct Gemm { const bf16_t* A; const bf16_t* Bt; int M, N, K; };

struct StaticOrder {
    int nM, nN, nwg, G, c;
    __host__ __device__ void init(int M, int N, int G_, int c_) { nM = M / BM; nN = N / BM; nwg = nM * nN; G = G_; c = c_; }
    __host__ __device__ bool next(int i, Unit& u) const {
        const long L = (long)i * G + c; if (L >= nwg) return false;
        int wgid = (int)L; { const int q = nwg / NXCD, r = nwg % NXCD, xcd = wgid % NXCD, off = wgid / NXCD; wgid = (xcd < r ? xcd * (q + 1) : r * (q + 1) + (xcd - r) * q) + off; }
        const int nig = WGM * nN, gid = wgid / nig, fm = gid * WGM, gsz = (nM - fm) < WGM ? (nM - fm) : WGM;
        u.pm = fm + ((wgid % nig) % gsz); u.pn = (wgid % nig) / gsz; return true;
    }
    __device__ __forceinline__ void a_ready(const Unit&) const {}
    __device__ __forceinline__ void done(const Unit&) const {}
};

__device__ __forceinline__ unsigned cvt_pk_bf16(float lo, float hi) { unsigned r; asm volatile("v_cvt_pk_bf16_f32 %0, %1, %2" : "=v"(r) : "v"(lo), "v"(hi)); return r; }
typedef float f32x2 __attribute__((ext_vector_type(2)));
__device__ __forceinline__ f32x2 gelu_pk(f32x2 v) {
    const f32x2 av = __builtin_elementwise_abs(v), d = av * 0.2316418882f + 1.0f;
    f32x2 t; t.x = __builtin_amdgcn_rcpf(d.x); t.y = __builtin_amdgcn_rcpf(d.y);
    f32x2 q = t * 0.5307027145f + (-0.7265760135f); q = q * t + 0.7107068705f; q = q * t + (-0.142248368f); q = q * t + 0.127414796f; q = q * t;
    const f32x2 s = (v * v) * (-0.72134752044f);
    f32x2 e; e.x = __builtin_amdgcn_exp2f(s.x); e.y = __builtin_amdgcn_exp2f(s.y);
    const f32x2 m = v * (q * e), r = v - m;
    f32x2 o; o.x = v.x < 0.f ? m.x : r.x; o.y = v.y < 0.f ? m.y : r.y; return o;
}

template <int ACT  > struct EpiBf16 {
    static constexpr bool PERM = true, AFTER_DRAIN = false; static_assert(ACT == 0 || ACT == 1, "EpiBf16: ACT is 0 (none) or 1 (gelu_pk)");
    bf16_t* O; int ldc; const float* bias; int split_cols; size_t split_stride; float scale0;
    __device__ __forceinline__ void operator()(const f32x4 (&acc)[2][2][4][2], const Unit& u, int wr, int wc, int fr, int fq) const {
        const int row0 = u.pm * BM + wr * 64 + fr; int colt = u.pn * BM; bf16_t* base = O;
        float sc = 1.f; if (split_cols) { const int t = colt / split_cols; base += (size_t)t * split_stride; colt -= t * split_cols; if (t == 0) sc = scale0; }
        const int col0 = colt + wc * 32 + 8 * fq, bcol0 = u.pn * BM + wc * 32 + 8 * fq;
        f32x4 bv[2][2];
#pragma unroll
        for (int bj = 0; bj < 2; ++bj)
#pragma unroll
            for (int n = 0; n < 2; ++n) bv[bj][n] = bias ? *(const f32x4*)(bias + bcol0 + bj * HALF + 4 * n) : (f32x4){0.f, 0.f, 0.f, 0.f};
#pragma unroll
        for (int ai = 0; ai < 2; ++ai)
#pragma unroll
            for (int m = 0; m < 4; ++m) { bf16_t* rowp = base + (size_t)(row0 + ai * HALF + m * 16) * ldc + col0;
#pragma unroll
                for (int bj = 0; bj < 2; ++bj) { f32x4 v0 = acc[ai][bj][m][0] + bv[bj][0], v1 = acc[ai][bj][m][1] + bv[bj][1];
                    if (ACT == 1) { f32x2 a = gelu_pk((f32x2){v0[0], v0[1]}), b = gelu_pk((f32x2){v0[2], v0[3]}), c = gelu_pk((f32x2){v1[0], v1[1]}), d = gelu_pk((f32x2){v1[2], v1[3]});
                        v0 = (f32x4){a.x, a.y, b.x, b.y}; v1 = (f32x4){c.x, c.y, d.x, d.y}; }
                    v0 = v0 * sc; v1 = v1 * sc; u32x4 w; w.x = cvt_pk_bf16(v0[0], v0[1]); w.y = cvt_pk_bf16(v0[2], v0[3]); w.z = cvt_pk_bf16(v1[0], v1[1]); w.w = cvt_pk_bf16(v1[2], v1[3]);
                    *(u32x4*)(rowp + bj * HALF) = w; } }
    }
};
template <class Epi, class Sched, bool ALIGN_EPI = false, bool SP2 = false>
__device__ __forceinline__ void gemm_phase(PG8_LAS unsigned char* lds, const Gemm g, const Sched& S, const Epi& E) {
    int tid_ = threadIdx.x; asm volatile("" : "+v"(tid_));
    const int tid = tid_, wid = __builtin_amdgcn_readfirstlane(tid >> 6), lane = tid & 63, wr = wid >> 2, wc = wid & 3, fr = lane & 15, fq = lane >> 4;
    const int K = g.K, nt = K / BK;
    unsigned voffA[2], voffB[2];
#pragma unroll
    for (int i = 0; i < 2; ++i) { int R, C; stage_rc(tid * 16 + i * 8192, R, C); const int Rb = Epi::PERM ? ((R & ~31) + perm32(R & 31)) : R;
        voffA[i] = (unsigned)(R * K + C) * 2u; voffB[i] = (unsigned)(Rb * K + C) * 2u; }
    const size_t kstep = (size_t)(BK * 2);
    const size_t hstep = (size_t)HALF * K * 2;
    const size_t tstep = 2 * hstep;
    const unsigned ldsw = (unsigned)wid * 1024u;
    const int aoff = lds_byte(wr * 64 + fr, fq * 8), boff = lds_byte(wc * 32 + fr, fq * 8);
#define PG8_SA(b, h) (((b) * 2 + (h)) * HTB)
#define PG8_SB(b, h) ((4 + (b) * 2 + (h)) * HTB)
#define PG8_STAGE(bufoff, gbase, voff) do { _Pragma("unroll") for (int _i = 0; _i < 2; ++_i) \
        __builtin_amdgcn_global_load_lds((const unsigned*)((const char*)(gbase) + (voff)[_i]), (PG8_LAS unsigned*)(lds + (bufoff) + ldsw + _i * 8192), 16, 0, 0); } while (0)
#define PG8_LDA(dst, b, h) do { _Pragma("unroll") for (int m = 0; m < 4; ++m) _Pragma("unroll") for (int k = 0; k < 2; ++k) dst[m][k] = *(const PG8_LAS bf16x8*)(lds + PG8_SA(b, h) + aoff + m * 2048 + k * 1024); } while (0)
#define PG8_LDB(dst, b, h) do { _Pragma("unroll") for (int n = 0; n < 2; ++n) _Pragma("unroll") for (int k = 0; k < 2; ++k) dst[n][k] = *(const PG8_LAS bf16x8*)(lds + PG8_SB(b, h) + boff + n * 2048 + k * 1024); } while (0)
#define PG8_MMA(ai, bj, At, Bt) do { __builtin_amdgcn_s_setprio(1); _Pragma("unroll") for (int m = 0; m < 4; ++m) _Pragma("unroll") for (int n = 0; n < 2; ++n) _Pragma("unroll") for (int k = 0; k < 2; ++k) \
        acc[ai][bj][m][n] = __builtin_amdgcn_mfma_f32_16x16x32_bf16(Bt[n][k], At[m][k], acc[ai][bj][m][n], 0, 0, 0); __builtin_amdgcn_s_setprio(0); } while (0)
#define PG8_WAIT_V(n) asm volatile("s_waitcnt vmcnt(" #n ")" ::: "memory")
#define PG8_WAIT_L(n) asm volatile("s_waitcnt lgkmcnt(" #n ")" ::: "memory")
#define PG8_BAR __builtin_amdgcn_s_barrier()
#define PG8_SCHED __builtin_amdgcn_sched_barrier(0)
    Unit cur, nxt; int ui = 0;
    if (!S.next(0, cur)) return;
    f32x4 acc[2][2][4][2];
#pragma unroll
    for (int a = 0; a < 2; ++a)
#pragma unroll
        for (int b = 0; b < 2; ++b)
#pragma unroll
            for (int m = 0; m < 4; ++m)
#pragma unroll
                for (int n = 0; n < 2; ++n) acc[a][b][m][n] = (f32x4){0.f, 0.f, 0.f, 0.f};
    bf16x8 At[4][2], B0[2][2], B1[2][2];
    const char* cA = (const char*)g.A + (size_t)cur.pm * tstep; const char* cB = (const char*)g.Bt + (size_t)cur.pn * tstep;
    S.a_ready(cur);
    if constexpr (SP2) {
        PG8_STAGE(PG8_SB(0, 0), cB, voffB); PG8_STAGE(PG8_SB(0, 1), cB + hstep, voffB); PG8_STAGE(PG8_SA(0, 0), cA, voffA); PG8_STAGE(PG8_SA(0, 1), cA + hstep, voffA);
        if (wr == 1) PG8_BAR;
        PG8_WAIT_V(2); PG8_BAR;
        PG8_STAGE(PG8_SB(1, 0), cB + kstep, voffB); PG8_STAGE(PG8_SA(1, 0), cA + kstep, voffA); PG8_STAGE(PG8_SB(1, 1), cB + hstep + kstep, voffB);
        PG8_WAIT_V(6); PG8_BAR;
    } else {
        PG8_STAGE(PG8_SB(0, 0), cB, voffB); PG8_STAGE(PG8_SA(0, 0), cA, voffA); PG8_STAGE(PG8_SB(0, 1), cB + hstep, voffB); PG8_STAGE(PG8_SA(0, 1), cA + hstep, voffA);
        if (wr == 1) PG8_BAR;
        PG8_WAIT_V(4); PG8_BAR;
        PG8_STAGE(PG8_SB(1, 0), cB + kstep, voffB); PG8_STAGE(PG8_SA(1, 0), cA + kstep, voffA); PG8_STAGE(PG8_SB(1, 1), cB + hstep + kstep, voffB);
        PG8_WAIT_V(6); PG8_BAR;
    }
    for (;;) {
        const bool has_next = S.next(ui + 1, nxt);
        const char* nA = has_next ? (const char*)g.A + (size_t)nxt.pm * tstep : cA; const char* nB = has_next ? (const char*)g.Bt + (size_t)nxt.pn * tstep : cB;
        for (int t = 0; t < nt; t += 2) {
            const bool last = (t == nt - 2);
            const char* a1 = cA + (size_t)(t + 1) * kstep;
            const char* a2 = last ? nA : cA + (size_t)(t + 2) * kstep; const char* b2 = last ? nB : cB + (size_t)(t + 2) * kstep;
            const char* a3 = a2 + kstep; const char* b3 = b2 + kstep;
            if (last && has_next) S.a_ready(nxt);
            if constexpr (SP2) {
            PG8_LDB(B0, 0, 0); PG8_LDB(B1, 0, 1); PG8_SCHED; PG8_LDA(At, 0, 0); PG8_STAGE(PG8_SA(1, 1), a1 + hstep, voffA);
            PG8_WAIT_V(8); PG8_WAIT_L(0); PG8_BAR; PG8_MMA(0, 0, At, B0); PG8_MMA(0, 1, At, B1); PG8_BAR; PG8_SCHED;
            PG8_LDA(At, 0, 1); PG8_STAGE(PG8_SB(0, 0), b2, voffB); PG8_STAGE(PG8_SB(0, 1), b2 + hstep, voffB); PG8_STAGE(PG8_SA(0, 0), a2, voffA);
            PG8_WAIT_V(8); PG8_WAIT_L(0); PG8_BAR; PG8_MMA(1, 0, At, B0); PG8_MMA(1, 1, At, B1); PG8_BAR; PG8_SCHED;
            PG8_LDB(B0, 1, 0); PG8_LDB(B1, 1, 1); PG8_SCHED; PG8_LDA(At, 1, 0); PG8_STAGE(PG8_SA(0, 1), a2 + hstep, voffA);
            PG8_WAIT_V(8); PG8_WAIT_L(0); PG8_BAR; PG8_MMA(0, 0, At, B0); PG8_MMA(0, 1, At, B1); PG8_BAR; PG8_SCHED;
            PG8_LDA(At, 1, 1); PG8_STAGE(PG8_SB(1, 0), b3, voffB); PG8_STAGE(PG8_SB(1, 1), b3 + hstep, voffB); PG8_STAGE(PG8_SA(1, 0), a3, voffA);
            PG8_WAIT_V(8); PG8_WAIT_L(0); PG8_BAR; PG8_MMA(1, 0, At, B0); PG8_MMA(1, 1, At, B1); PG8_BAR; PG8_SCHED;
            } else {
            PG8_LDB(B0, 0, 0); PG8_SCHED; PG8_LDA(At, 0, 0); PG8_STAGE(PG8_SA(1, 1), a1 + hstep, voffA);
            PG8_WAIT_L(8); PG8_BAR; PG8_WAIT_L(0); PG8_MMA(0, 0, At, B0); PG8_BAR; PG8_SCHED;
            PG8_LDB(B1, 0, 1); PG8_STAGE(PG8_SB(0, 0), b2, voffB);
            PG8_BAR; PG8_WAIT_L(0); PG8_MMA(0, 1, At, B1); PG8_BAR;
            PG8_LDA(At, 0, 1); PG8_STAGE(PG8_SA(0, 0), a2, voffA);
            PG8_BAR; PG8_WAIT_L(0); PG8_MMA(1, 0, At, B0); PG8_BAR; PG8_SCHED;
            PG8_STAGE(PG8_SB(0, 1), b2 + hstep, voffB);
            PG8_WAIT_V(6); PG8_BAR; PG8_MMA(1, 1, At, B1); PG8_BAR;
            PG8_LDB(B0, 1, 0); PG8_SCHED; PG8_LDA(At, 1, 0); PG8_STAGE(PG8_SA(0, 1), a2 + hstep, voffA);
            PG8_WAIT_L(8); PG8_BAR; PG8_WAIT_L(0); PG8_MMA(0, 0, At, B0); PG8_BAR; PG8_SCHED;
            PG8_LDB(B1, 1, 1); PG8_STAGE(PG8_SB(1, 0), b3, voffB);
            PG8_BAR; PG8_WAIT_L(0); PG8_MMA(0, 1, At, B1); PG8_BAR;
            PG8_LDA(At, 1, 1); PG8_STAGE(PG8_SA(1, 0), a3, voffA);
            PG8_BAR; PG8_WAIT_L(0); PG8_MMA(1, 0, At, B0); PG8_BAR; PG8_SCHED;
            PG8_STAGE(PG8_SB(1, 1), b3 + hstep, voffB);
            PG8_WAIT_V(6); PG8_BAR; PG8_MMA(1, 1, At, B1); PG8_BAR;
            }
        }
        if constexpr (ALIGN_EPI) { if (wr == 0) PG8_BAR; }
        if constexpr (!Epi::AFTER_DRAIN) { E(acc, cur, wr, wc, fr, fq); S.done(cur); }
        if (!has_next) break;
#pragma unroll
        for (int a = 0; a < 2; ++a)
#pragma unroll
            for (int b = 0; b < 2; ++b)
#pragma unroll
                for (int m = 0; m < 4; ++m)
#pragma unroll
                    for (int n = 0; n < 2; ++n) acc[a][b][m][n] = (f32x4){0.f, 0.f, 0.f, 0.f};
        cur = nxt; cA = nA; cB = nB; ++ui;
        if constexpr (ALIGN_EPI) { if (wr == 1) PG8_BAR; }
    }
    PG8_WAIT_V(0);
    if constexpr (!ALIGN_EPI) { if (wr == 0) PG8_BAR; }
    PG8_BAR;
    if constexpr (Epi::AFTER_DRAIN) { E.fused(acc, cur, wr, wc, fr, fq, lds, wid, lane); S.done(cur); }
#undef PG8_SA
#undef PG8_SB
#undef PG8_STAGE
#undef PG8_LDA
#undef PG8_LDB
#undef PG8_MMA
#undef PG8_WAIT_V
#undef PG8_WAIT_L
#undef PG8_BAR
#undef PG8_SCHED
}
}
namespace attn_body {
using bf16=__hip_bfloat16;
using bf16x8=__attribute__((ext_vector_type(8)))short;
using s16x4=__attribute__((ext_vector_type(4)))short;
using f32x16=__attribute__((ext_vector_type(16)))float;
using u32x4=__attribute__((ext_vector_type(4)))unsigned;
constexpr int D=64,PQ=3328,PO=1024;
constexpr int NW=8,QBLK=32,QB=QBLK*NW,KVBLK=64;
__device__ __forceinline__ int crow(int r,int hi){return (r&3)+8*(r>>2)+4*hi;}
#define SBAR() __builtin_amdgcn_sched_barrier(0)
__device__ __forceinline__ void wmask(f32x16&p0,f32x16&p1,int dq,int hi){
  const float NEG=-INFINITY; int kb=4*hi;
  #pragma unroll
  for(int r=0;r<16;++r){int kv=kb+(r&3)+8*(r>>2); int d0=dq-kv; if(d0>128||d0<-128)p0[r]=NEG; int d1=d0-32; if(d1>128||d1<-128)p1[r]=NEG;}
}

constexpr int NSLOT=3, SLOTB=8192;
constexpr int LDS_K=0, LDS_V=NSLOT*SLOTB, LDS_WS=2*NSLOT*SLOTB, LDS_OST=LDS_WS+NW*64*4, LDS_BYTES=LDS_OST+NW*4096;
constexpr float C2=0.125f*1.4426950408889634f;
__device__ __forceinline__ void glds16(const void*gsrc,unsigned lds_dst){unsigned keep;
  asm volatile("s_mov_b32 %0, m0\n\ts_mov_b32 m0, %2\n\ts_nop 0\n\tglobal_load_lds_dwordx4 %1, off\n\ts_mov_b32 m0, %0":"=&s"(keep):"v"(gsrc),"s"(lds_dst):"memory");}
__device__ __forceinline__ float max3f(float a,float b,float c){float r;asm("v_max3_f32 %0, %1, %2, %3":"=v"(r):"v"(a),"v"(b),"v"(c));return r;}
__device__ __forceinline__ float max2f(float a,float b){float r;asm("v_max_f32_e32 %0, %1, %2":"=v"(r):"v"(a),"v"(b));return r;}
__device__ __forceinline__ float fadd_s(float a,float b){float r;asm("v_add_f32_e32 %0, %1, %2":"=v"(r):"v"(a),"v"(b));return r;}
__device__ __forceinline__ float fsub_s(float a,float b){float r;asm("v_sub_f32_e32 %0, %1, %2":"=v"(r):"v"(a),"v"(b));return r;}
typedef float f32x2_t __attribute__((ext_vector_type(2))); typedef __bf16 bf16x2_t __attribute__((ext_vector_type(2)));
__device__ __forceinline__ unsigned cvtpk_s(float lo,float hi){f32x2_t v={lo,hi};bf16x2_t b=__builtin_convertvector(v,bf16x2_t);return __builtin_bit_cast(unsigned,b);}
#define WAIT_BAR(N) asm volatile("s_waitcnt vmcnt(" #N ") lgkmcnt(0)\n\ts_barrier":::"memory")

__device__ __forceinline__ void qkt(f32x16&p0,f32x16&p1,const char*Kslot,const bf16x8*qr,const f32x16&negm,int r32,int hi){
  const char*kb=Kslot+hi*1024+r32*16;
  #pragma unroll
  for(int d0=0;d0<4;++d0){
    const bf16x8 b0=*reinterpret_cast<const bf16x8*>(kb+d0*2048);
    const bf16x8 b1=*reinterpret_cast<const bf16x8*>(kb+d0*2048+512);
    if(d0==0){p0=__builtin_amdgcn_mfma_f32_32x32x16_bf16(b0,qr[0],negm,0,0,0);p1=__builtin_amdgcn_mfma_f32_32x32x16_bf16(b1,qr[0],negm,0,0,0);}
    else{p0=__builtin_amdgcn_mfma_f32_32x32x16_bf16(b0,qr[d0],p0,0,0,0);p1=__builtin_amdgcn_mfma_f32_32x32x16_bf16(b1,qr[d0],p1,0,0,0);}}
}
typedef __attribute__((address_space(3))) const char* lds_cptr;
typedef short v4i16_t __attribute__((ext_vector_type(4)));
__device__ __forceinline__ void kload8(bf16x8*kf,lds_cptr kp){
  kf[0]=*(const __attribute__((address_space(3))) bf16x8*)(kp);      kf[1]=*(const __attribute__((address_space(3))) bf16x8*)(kp+512);
  kf[2]=*(const __attribute__((address_space(3))) bf16x8*)(kp+2048); kf[3]=*(const __attribute__((address_space(3))) bf16x8*)(kp+2560);
  kf[4]=*(const __attribute__((address_space(3))) bf16x8*)(kp+4096); kf[5]=*(const __attribute__((address_space(3))) bf16x8*)(kp+4608);
  kf[6]=*(const __attribute__((address_space(3))) bf16x8*)(kp+6144); kf[7]=*(const __attribute__((address_space(3))) bf16x8*)(kp+6656);
}
__device__ __forceinline__ void kload2(bf16x8*kf,lds_cptr kp,int j){ kf[2*j]=*(const __attribute__((address_space(3))) bf16x8*)(kp+j*2048); kf[2*j+1]=*(const __attribute__((address_space(3))) bf16x8*)(kp+j*2048+512); }
__device__ __forceinline__ s16x4 vtr(lds_cptr p){ return __builtin_bit_cast(s16x4,__builtin_amdgcn_ds_read_tr16_b64_v4i16((__attribute__((address_space(3))) v4i16_t*)p)); }
__device__ __forceinline__ float rowmax(const f32x16&p0,const f32x16&p1){
  float a=max3f(p0[0],p0[1],p1[0]),b=max3f(p0[2],p0[3],p1[1]);a=max3f(a,p1[2],p1[3]);
  #pragma unroll
  for(int r=4;r<16;r+=4){a=max3f(a,p0[r],p0[r+1]);b=max3f(b,p0[r+2],p0[r+3]);a=max3f(a,p1[r],p1[r+1]);b=max3f(b,p1[r+2],p1[r+3]);}
  const float m=max2f(a,b);
  auto rr=__builtin_amdgcn_permlane32_swap(__float_as_uint(m),__float_as_uint(m),false,false);
  return max2f(__uint_as_float(rr[0]),__uint_as_float(rr[1]));
}
__device__ __forceinline__ void pv(f32x16*o,int vb,bf16x8 pa0,bf16x8 pa1,bf16x8 pa2,bf16x8 pa3){
  #pragma unroll
  for(int d0=0;d0<2;++d0){s16x4 lo[4],hi[4];
    #pragma unroll
    for(int ks=0;ks<4;++ks){
      asm volatile("ds_read_b64_tr_b16 %0,%1 offset:%c2":"=&v"(lo[ks]):"v"(vb),"i"(d0*4096+ks*1024):"memory");
      asm volatile("ds_read_b64_tr_b16 %0,%1 offset:%c2":"=&v"(hi[ks]):"v"(vb),"i"(d0*4096+ks*1024+512):"memory");}
    asm volatile("s_waitcnt lgkmcnt(0)":::"memory");SBAR();
    #define PK(k) (bf16x8){lo[k][0],lo[k][1],lo[k][2],lo[k][3],hi[k][0],hi[k][1],hi[k][2],hi[k][3]}
    o[d0]=__builtin_amdgcn_mfma_f32_32x32x16_bf16(pa0,PK(0),o[d0],0,0,0);
    o[d0]=__builtin_amdgcn_mfma_f32_32x32x16_bf16(pa1,PK(1),o[d0],0,0,0);
    o[d0]=__builtin_amdgcn_mfma_f32_32x32x16_bf16(pa2,PK(2),o[d0],0,0,0);
    o[d0]=__builtin_amdgcn_mfma_f32_32x32x16_bf16(pa3,PK(3),o[d0],0,0,0);
    #undef PK
  }
}

#ifndef ATTN_STORE16
#define ATTN_STORE16(p,v) (*(u32x4*)(p)=(v))
#endif
template<int THRL,int MODE> __device__ __forceinline__ void attn_unit(const bf16*Q0,const bf16*__restrict__ Kh,const bf16*__restrict__ Vh,bf16*O0,const int NT,const int band_row0,const int qpos0,const int band_s0,const float sink_l2,char*shm){
  int tid_=threadIdx.x; asm volatile("":"+v"(tid_));
  const int tid=tid_,lane=tid&63,r32=lane&31,hi=lane>>5; const int wid=__builtin_amdgcn_readfirstlane(tid>>6);
  const bf16*Qw=Q0+(long)(wid*QBLK)*PQ;
  #define TROW(t) ((MODE==1&&(t)>=4)?(band_row0+((t)-4)*KVBLK):((t)*KVBLK))
  const unsigned lds0=(unsigned)(uintptr_t)shm;
  float*wsf=(float*)(shm+LDS_WS)+wid*64;
  const bf16*ksrc=Kh+(long)lane*PQ+wid*8;
  const bf16*vsrc=Vh+(long)(16*(wid&3)+(lane>>2))*PQ+(wid>>2)*32+(lane&3)*8;
  const unsigned kdst=lds0+LDS_K+wid*1024, vdst=lds0+LDS_V+wid*1024;
  #define DMA_K(t,slot) glds16(ksrc+(long)TROW(t)*PQ,(unsigned)__builtin_amdgcn_readfirstlane(kdst+(slot)))
  #define DMA_V(t,slot) glds16(vsrc+(long)TROW(t)*PQ,(unsigned)__builtin_amdgcn_readfirstlane(vdst+(slot)))
  const int vb0=(int)(lds0+LDS_V)+((lane>>4)&1)*32+(lane&3)*8+(4*hi+((lane&15)>>2))*64;
  const char*Kbase=shm+LDS_K; bf16x8 kf[8];
  const lds_cptr shm3=(lds_cptr)shm; const lds_cptr kp0=shm3+LDS_K+hi*1024+r32*16; const lds_cptr vp0=shm3+LDS_V+((lane>>4)&1)*32+(lane&3)*8+(4*hi+((lane&15)>>2))*64;
  DMA_K(0,0);DMA_V(0,0);DMA_K(1,SLOTB);
  bf16x8 qr[4];
  #pragma unroll
  for(int d0=0;d0<4;++d0)qr[d0]=*reinterpret_cast<const bf16x8*>(&Qw[(long)r32*PQ+d0*16+hi*8]);
  float mhat=0.f,l_reg=0.f;f32x16 o[2];o[0]=f32x16{};o[1]=f32x16{};f32x16 negm=f32x16{};asm volatile("":"+v"(negm));
  const int qrel=wid*QBLK+r32;
  #define CMASK(P0,P1,t) do{ if(MODE==1&&(t)>=4){ wmask(P0,P1,qpos0+qrel-(band_s0+((t)-4)*KVBLK),hi); } }while(0)
  bool resc=false;
  #define START(P0,P1) do{ const float rm=rowmax(P0,P1); resc=false; \
    { const float dl=rm; mhat=fadd_s(mhat,dl); \
      _Pragma("unroll") for(int r=0;r<16;++r){P0[r]=fsub_s(P0[r],dl);P1[r]=fsub_s(P1[r],dl);} \
      _Pragma("unroll") for(int r=0;r<16;++r)negm[r]=-mhat; asm volatile("":"+v"(negm)); } \
    _Pragma("unroll") for(int r=0;r<16;++r)P0[r]=__builtin_amdgcn_exp2f(P0[r]); }while(0)
  #define RESC() do{ if(resc){ asm volatile("s_waitcnt lgkmcnt(0)":::"memory"); \
      _Pragma("unroll") for(int d_=0;d_<2;++d_) _Pragma("unroll") for(int r=0;r<16;++r)o[d_][r]*=wsf[crow(r,hi)]; } }while(0)
  f32x16 pA0,pA1,pB0,pB1;
  int sl_prev=0,sl_cur=0,sl_next=SLOTB;
  #define ROT() do{sl_prev=sl_cur;sl_cur=sl_next;sl_next=(sl_next==(NSLOT-1)*SLOTB)?0:sl_next+SLOTB;}while(0)
  DMA_K(2,2*SLOTB);
  WAIT_BAR(3);
  qkt(pA0,pA1,Kbase,qr,negm,r32,hi);asm volatile("s_nop 15\n\ts_nop 7":"+v"(pA0),"+v"(pA1));CMASK(pA0,pA1,0);
  START(pA0,pA1);
  _Pragma("unroll") for(int r=0;r<16;++r)pA1[r]=__builtin_amdgcn_exp2f(pA1[r]);
  WAIT_BAR(0);
  DMA_K(3,0);DMA_V(1,SLOTB);
  ROT();
  kload8(kf,kp0+sl_cur);
  WAIT_BAR(2);
  s16x4 vlo[8],vhi[8]; u32x4 pw0,pw1,pw2,pw3;
  #define PKW(P,B) cvtpk_s(P[B],P[B+1])
  #define PAF(k) __builtin_bit_cast(bf16x8,pw##k)
  #define VFR(i) (bf16x8){vlo[i][0],vlo[i][1],vlo[i][2],vlo[i][3],vhi[i][0],vhi[i][1],vhi[i][2],vhi[i][3]}
  #define PIN(x) asm volatile("":"+v"(x))
  #define MX3(a,b,c) __builtin_fmaxf(__builtin_fmaxf((a),(b)),(c))
  #define GAPA(MF,A0,A1,A2,A3,W0,W1,PW) do{ MF; sacc+=A0; sacc+=A1; sacc+=A2; sacc+=A3; PIN(sacc); W0; W1; PIN(PW); SBAR(); }while(0)
  #define EX(v) __builtin_amdgcn_exp2f(v)
  #define GAPB(MF,X,B) do{ MF; X[B]=EX(X[B]); X[B+1]=EX(X[B+1]); X[B+2]=EX(X[B+2]); X[B+3]=EX(X[B+3]); PIN(X); SBAR(); }while(0)
  #define VRD(i) do{ vlo[i]=vtr(vp_+(((i)>>2)*4096+((i)&3)*1024)); vhi[i]=vtr(vp_+(((i)>>2)*4096+((i)&3)*1024+512)); }while(0)
  #define KRD(G,j) do{ if(G){ kload2(kf,kp0+sl_next,j); SBAR(); } }while(0)
  #define STEP(C0,C1,P0,P1,t,GK,GV,GL) do{ SBAR(); \
    const lds_cptr vp_=vp0+sl_prev; \
    VRD(0); SBAR(); float sacc=(P0[0]+P0[1]); \
    GAPA(C0=__builtin_amdgcn_mfma_f32_32x32x16_bf16(kf[0],qr[0],negm,0,0,0), P0[2],P0[3],P0[4],P0[5],     pw0[0]=PKW(P0,0), pw0[1]=PKW(P0,2), pw0); \
    VRD(4); SBAR(); GAPA(C1=__builtin_amdgcn_mfma_f32_32x32x16_bf16(kf[1],qr[0],negm,0,0,0), P0[6],P0[7],P0[8],P0[9],     pw0[2]=PKW(P0,4), pw0[3]=PKW(P0,6), pw0); \
    VRD(1); SBAR(); GAPA(C0=__builtin_amdgcn_mfma_f32_32x32x16_bf16(kf[2],qr[1],C0,0,0,0),   P0[10],P0[11],P0[12],P0[13], pw1[0]=PKW(P0,8), pw1[1]=PKW(P0,10), pw1); \
    VRD(5); SBAR(); GAPA(C1=__builtin_amdgcn_mfma_f32_32x32x16_bf16(kf[3],qr[1],C1,0,0,0),   P0[14],P0[15],P1[0],P1[1],   pw1[2]=PKW(P0,12),pw1[3]=PKW(P0,14), pw1); \
    VRD(2); SBAR(); GAPA(C0=__builtin_amdgcn_mfma_f32_32x32x16_bf16(kf[4],qr[2],C0,0,0,0),   P1[2],P1[3],P1[4],P1[5],     pw2[0]=PKW(P1,0), pw2[1]=PKW(P1,2), pw2); \
    VRD(6); SBAR(); GAPA(C1=__builtin_amdgcn_mfma_f32_32x32x16_bf16(kf[5],qr[2],C1,0,0,0),   P1[6],P1[7],P1[8],P1[9],     pw2[2]=PKW(P1,4), pw2[3]=PKW(P1,6), pw2); \
    VRD(3); SBAR(); GAPA(C0=__builtin_amdgcn_mfma_f32_32x32x16_bf16(kf[6],qr[3],C0,0,0,0),   P1[10],P1[11],P1[12],P1[13], pw3[0]=PKW(P1,8), pw3[1]=PKW(P1,10), pw3); \
    VRD(7); SBAR(); GAPA(C1=__builtin_amdgcn_mfma_f32_32x32x16_bf16(kf[7],qr[3],C1,0,0,0),   P1[14],P1[15],0.f,0.f,       pw3[2]=PKW(P1,12),pw3[3]=PKW(P1,14), pw3); \
    l_reg+=sacc; \
    if(GK){DMA_K((t)+3,sl_cur);} if(GV){DMA_V((t)+1,sl_next);} \
    CMASK(C0,C1,t); \
    { float a=MX3(C0[0],C0[1],C1[0]),b=MX3(C0[2],C0[3],C1[1]); a=MX3(a,C1[2],C1[3]); \
      _Pragma("unroll") for(int r=4;r<16;r+=4){a=MX3(a,C0[r],C0[r+1]);b=MX3(b,C0[r+2],C0[r+3]);a=MX3(a,C1[r],C1[r+1]);b=MX3(b,C1[r+2],C1[r+3]);} \
      float rm=__builtin_fmaxf(a,b); { auto rr=__builtin_amdgcn_permlane32_swap(__float_as_uint(rm),__float_as_uint(rm),false,false); rm=__builtin_fmaxf(__uint_as_float(rr[0]),__uint_as_float(rr[1])); } \
      resc=false; \
      if(__builtin_expect(__any(rm>(float)THRL),0)){ const float dl=__builtin_fmaxf(rm,0.f); mhat+=dl; \
        _Pragma("unroll") for(int r=0;r<16;++r){C0[r]-=dl;C1[r]-=dl;} \
        _Pragma("unroll") for(int r=0;r<16;++r)negm[r]=-mhat; asm volatile("":"+v"(negm)); \
        const float f=__builtin_amdgcn_exp2f(-dl); l_reg*=f; if(hi==0)wsf[r32]=f; resc=true; } } \
    SBAR(); \
    GAPB(o[0]=__builtin_amdgcn_mfma_f32_32x32x16_bf16(PAF(0),VFR(0),o[0],0,0,0), C0,0); \
    GAPB(o[1]=__builtin_amdgcn_mfma_f32_32x32x16_bf16(PAF(0),VFR(4),o[1],0,0,0), C0,4); \
    KRD(GL,0); GAPB(o[0]=__builtin_amdgcn_mfma_f32_32x32x16_bf16(PAF(1),VFR(1),o[0],0,0,0), C0,8); \
    KRD(GL,1); GAPB(o[1]=__builtin_amdgcn_mfma_f32_32x32x16_bf16(PAF(1),VFR(5),o[1],0,0,0), C0,12); \
    KRD(GL,2); GAPB(o[0]=__builtin_amdgcn_mfma_f32_32x32x16_bf16(PAF(2),VFR(2),o[0],0,0,0), C1,0); \
    KRD(GL,3); GAPB(o[1]=__builtin_amdgcn_mfma_f32_32x32x16_bf16(PAF(2),VFR(6),o[1],0,0,0), C1,4); \
    GAPB(o[0]=__builtin_amdgcn_mfma_f32_32x32x16_bf16(PAF(3),VFR(3),o[0],0,0,0), C1,8); \
    GAPB(o[1]=__builtin_amdgcn_mfma_f32_32x32x16_bf16(PAF(3),VFR(7),o[1],0,0,0), C1,12); \
    }while(0)
  int t=1;
  for(;t+5<NT;t+=2){
    STEP(pB0,pB1,pA0,pA1,t,true,true,true);     WAIT_BAR(2); RESC(); ROT();
    STEP(pA0,pA1,pB0,pB1,t+1,true,true,true);   WAIT_BAR(2); RESC(); ROT();
  }
  #define ENDW(tt) do{ if((tt)+3<NT){WAIT_BAR(2);} else if((tt)+2<NT){WAIT_BAR(1);} else {WAIT_BAR(0);} }while(0)
  for(;t+1<NT;t+=2){
    STEP(pB0,pB1,pA0,pA1,t,(t+3<NT),(t+1<NT),(t+1<NT));       ENDW(t);   RESC(); ROT();
    STEP(pA0,pA1,pB0,pB1,t+1,(t+4<NT),(t+2<NT),(t+2<NT));     ENDW(t+1); RESC(); ROT();
  }
  STEP(pB0,pB1,pA0,pA1,NT-1,false,false,false); RESC();
  { float sacc=pB0[0]+pB0[1]; _Pragma("unroll") for(int r=2;r<16;++r)sacc+=pB0[r]; _Pragma("unroll") for(int r=0;r<16;++r)sacc+=pB1[r]; l_reg+=sacc;
    pw0=(u32x4){PKW(pB0,0),PKW(pB0,2),PKW(pB0,4),PKW(pB0,6)};pw1=(u32x4){PKW(pB0,8),PKW(pB0,10),PKW(pB0,12),PKW(pB0,14)};pw2=(u32x4){PKW(pB1,0),PKW(pB1,2),PKW(pB1,4),PKW(pB1,6)};pw3=(u32x4){PKW(pB1,8),PKW(pB1,10),PKW(pB1,12),PKW(pB1,14)};
    SBAR(); pv(o,vb0+sl_cur,PAF(0),PAF(1),PAF(2),PAF(3)); }
  #undef PKW
  #undef PAF
  #undef VFR
  #undef PIN
  #undef MX3
  #undef GAPA
  #undef GAPB
  #undef EX
  #undef VRD
  #undef KRD
  #undef STEP
  #undef ENDW
  {auto rr=__builtin_amdgcn_permlane32_swap(__float_as_uint(l_reg),__float_as_uint(l_reg),false,false);l_reg=__uint_as_float(rr[0])+__uint_as_float(rr[1]);}
  if(MODE==1)l_reg+=__builtin_amdgcn_exp2f(sink_l2-mhat);
  if(hi==0)wsf[32+r32]=l_reg;asm volatile("s_waitcnt lgkmcnt(0)":::"memory");
  float rli[16];
  #pragma unroll
  for(int r=0;r<16;++r)rli[r]=__builtin_amdgcn_rcpf(wsf[32+crow(r,hi)]);
  bf16*Ow=O0+(long)(wid*QBLK)*PO;
  { bf16*stg=(bf16*)(shm+LDS_OST)+wid*2048;
    #pragma unroll
    for(int r=0;r<16;++r){const int orow=crow(r,hi);
      #pragma unroll
      for(int d0=0;d0<2;++d0)stg[orow*64+d0*32+r32]=__float2bfloat16(o[d0][r]*rli[r]);}
    asm volatile("s_waitcnt lgkmcnt(0)":::"memory");
    #pragma unroll
    for(int i=0;i<4;++i){const int row=i*8+(lane>>3),ch=lane&7; const u32x4 v=*(const u32x4*)(stg+row*64+ch*8); ATTN_STORE16(Ow+(long)row*PO+ch*8,v);} }
  asm volatile("s_waitcnt lgkmcnt(0)\n\ts_barrier":::"memory");
  #undef DMA_K
  #undef DMA_V
  #undef TROW
  #undef CMASK
  #undef START
  #undef RESC
  #undef ROT
}
constexpr int ATTN_LDS_BYTES=LDS_BYTES;
#undef SBAR
#undef WAIT_BAR
}
namespace scan {
using namespace mk;
template <int NROWS> __device__ __forceinline__ int img_off(int row, int c) { return (((c >> 5) * (NROWS / 16) + (row >> 4)) << 10) + ((row & 15) << 6) + ((c & 31) << 1); }
__device__ __forceinline__ int tlane(int lane) { return ((lane >> 4) & 1) * 32 + (lane & 3) * 8 + (4 * (lane >> 5) + ((lane & 15) >> 2)) * 64; }
__device__ __forceinline__ bf16x8 rfrag(LAS const char* p) { return *(LAS const bf16x8*)p; }
__device__ __forceinline__ s16x4 tr4(LAS const char* p) { return __builtin_bit_cast(s16x4, __builtin_amdgcn_ds_read_tr16_b64_v4i16((LAS s16x4*)p)); }
__device__ __forceinline__ bf16x8 tfrag(LAS const char* p) { const s16x4 lo = tr4(p), hi = tr4(p + 512); return (bf16x8){lo[0], lo[1], lo[2], lo[3], hi[0], hi[1], hi[2], hi[3]}; }
__device__ __forceinline__ bf16x8 pack8(const f32x16& s, int b) {
  u32x4 w; w.x = cvtpk(s[b], s[b + 1]); w.y = cvtpk(s[b + 2], s[b + 3]); w.z = cvtpk(s[b + 4], s[b + 5]); w.w = cvtpk(s[b + 6], s[b + 7]); return __builtin_bit_cast(bf16x8, w);
}
#define MFMA32(a, b, c) __builtin_amdgcn_mfma_f32_32x32x16_bf16(a, b, c, 0, 0, 0)

template <int DK, int DV>
__device__ __forceinline__ void chunk_core(LAS const char* Qm, LAS const char* Km, LAS const char* Vm, LAS const char* Ss, LAS const float* rowexp, LAS const float* colexp, LAS const float* isc,
                                           f32x16& res0, f32x16& res1, int wid, int lane) {
  constexpr int KS = DK / 16, NVT = DV / 32;
  const int tb = wid & 3, vp = wid >> 2, r32 = lane & 31, hh = lane >> 5, tl = tlane(lane);
  constexpr bool HOLDQ = (KS <= 4);
  bf16x8 qf[HOLDQ ? KS : 1];
  if (HOLDQ) {
#pragma unroll
    for (int ks = 0; ks < KS; ++ks) qf[ks] = rfrag(Qm + img_off<128>(32 * tb + r32, 16 * ks + 8 * hh)); }
#define QF(ks) (HOLDQ ? qf[HOLDQ ? (ks) : 0] : rfrag(Qm + img_off<128>(32 * tb + r32, 16 * (ks) + 8 * hh)))
  f32x16 o0 = {}, o1 = {};
  const float re = rowexp[32 * tb + r32];
#pragma unroll 1
  for (int st = 0; st <= tb; ++st) {
    f32x16 s = {};
#pragma unroll
    for (int ks = 0; ks < KS; ++ks) { const bf16x8 kf = rfrag(Km + img_off<128>(32 * st + r32, 16 * ks + 8 * hh)); s = MFMA32(kf, QF(ks), s); }
#pragma unroll
    for (int r = 0; r < 16; ++r) { const int sl = crow(r, hh); float w = __builtin_amdgcn_exp2f(re + colexp[32 * st + sl]); if (st == tb && sl > r32) w = 0.f; s[r] *= w; }
    const bf16x8 pa0 = pack8(s, 0), pa1 = pack8(s, 8);
    { const bf16x8 v0 = tfrag(Vm + ((vp * 8 + 2 * st) << 10) + tl), v1 = tfrag(Vm + ((vp * 8 + 2 * st + 1) << 10) + tl); o0 = MFMA32(pa0, v0, o0); o0 = MFMA32(pa1, v1, o0); }
    if (NVT > 2 && vp == 0) { const bf16x8 v0 = tfrag(Vm + ((2 * 8 + 2 * st) << 10) + tl), v1 = tfrag(Vm + ((2 * 8 + 2 * st + 1) << 10) + tl); o1 = MFMA32(pa0, v0, o1); o1 = MFMA32(pa1, v1, o1); }
  }
  f32x16 i0 = {}, i1 = {};
#pragma unroll
  for (int ks = 0; ks < KS; ++ks) { const bf16x8 sf = rfrag(Ss + img_off<DV>(32 * vp + r32, 16 * ks + 8 * hh)); i0 = MFMA32(QF(ks), sf, i0); }
  if (NVT > 2 && vp == 0) {
#pragma unroll
    for (int ks = 0; ks < KS; ++ks) { const bf16x8 sf = rfrag(Ss + img_off<DV>(64 + r32, 16 * ks + 8 * hh)); i1 = MFMA32(QF(ks), sf, i1); }
  }
#pragma unroll
  for (int r = 0; r < 16; ++r) { const float sc = isc[32 * tb + crow(r, hh)]; res0[r] = o0[r] + sc * i0[r]; res1[r] = o1[r] + sc * i1[r]; }
#undef QF
}
template <int DK, int DV>
__device__ __forceinline__ void state_update(LAS const char* Km, LAS const char* Vw, LAS char* Ss, f32x16& st_acc, float sd, int wid, int lane) {
  constexpr int NVT = DV / 32, NDT = DK / 32;
  if (wid < NVT * NDT) {
    const int vt = wid / NDT, dt_ = wid % NDT, r32 = lane & 31, hh = lane >> 5, tl = tlane(lane);
#pragma unroll
    for (int r = 0; r < 16; ++r) st_acc[r] *= sd;
#pragma unroll
    for (int ks = 0; ks < 8; ++ks) { const bf16x8 af = tfrag(Vw + ((vt * 8 + ks) << 10) + tl), bfr = tfrag(Km + ((dt_ * 8 + ks) << 10) + tl); st_acc = MFMA32(af, bfr, st_acc); }
#pragma unroll
    for (int r = 0; r < 16; ++r) *(LAS bf16*)(Ss + img_off<DV>(32 * vt + crow(r, hh), 32 * dt_ + r32)) = f2bf(st_acc[r]);
  }
}
__device__ __forceinline__ float wscan_add(float x, int lane) {
#pragma unroll
  for (int o = 1; o < 64; o <<= 1) { const float y = __shfl_up(x, o); if (lane >= o) x += y; }
  return x;
}
__device__ __forceinline__ float wscan_max(float x, int lane) {
#pragma unroll
  for (int o = 1; o < 64; o <<= 1) { const float y = __shfl_up(x, o); if (lane >= o) x = fmaxf(x, y); }
  return x;
}
__device__ __forceinline__ void chunk_rows(int cc, int dir, int& row0, int& seg0, int& seglen) {
  if (cc < 2) { const int ci = dir ? 1 - cc : cc; row0 = 128 * ci; seg0 = 0; seglen = NC; }
  else { const int ci = dir ? 31 - (cc - 2) : (cc - 2); row0 = NC + 128 * ci; seg0 = NC; seglen = T; }
}
#define SCAN_BAR() do { asm volatile("s_waitcnt vmcnt(0) lgkmcnt(0)" ::: "memory"); __builtin_amdgcn_s_barrier(); asm volatile("" ::: "memory"); } while (0)

#define SCAN_BAR_L() do { asm volatile("s_waitcnt lgkmcnt(0)" ::: "memory"); __builtin_amdgcn_s_barrier(); asm volatile("" ::: "memory"); } while (0)

__device__ __forceinline__ void mamba_chain(LAS char* lds, const bf16* __restrict__ UC, const float* __restrict__ G, const float* __restrict__ a_log, bf16* __restrict__ YD, int b, int h, int dir) {
  int tid_ = threadIdx.x; asm volatile("" : "+v"(tid_));
  const int tid = tid_, lane = tid & 63, wid = __builtin_amdgcn_readfirstlane(tid >> 6), g = h >> 1;
  LAS char* Qm = lds; LAS char* Km = lds + 32768; LAS char* Vm = lds + 65536; LAS char* Vw = lds + 81920; LAS char* Ss = lds + 98304;
  LAS float* rowexp = (LAS float*)(lds + 114688); LAS float* colexp = rowexp + 128; LAS float* isc = rowexp + 256; LAS float* vw = rowexp + 384; LAS float* misc = rowexp + 512;
  for (int i = tid; i < 16384 / 4; i += 512) ((LAS unsigned*)Ss)[i] = 0u;
  f32x16 st_acc = {};
  const float a = -__expf(a_log[dir * 4 + h]);
  const size_t rowb = (size_t)b * RB;
  u32x4 pc[10]; float dtn[2] = {0.f, 0.f};
#define MAMBA_LOAD(cc_) do { int row0_, seg0_, seglen_; chunk_rows((cc_), dir, row0_, seg0_, seglen_); int tq_ = tid; asm volatile("" : "+v"(tq_)); \
    _Pragma("unroll") for (int k = 0; k < 10; ++k) { const int task = tq_ + 512 * k, io = task / 40, cg = task % 40; \
      const int ucol = cg < 8 ? h * 64 + cg * 8 : (cg < 24 ? 256 + g * 128 + (cg - 8) * 8 : 512 + g * 128 + (cg - 24) * 8); \
      pc[k] = *(const u32x4*)(UC + (rowb + row0_ + io) * 768 + ucol); } \
    if (wid == 0) { _Pragma("unroll") for (int e = 0; e < 2; ++e) { const int i = 2 * lane + e, io = dir ? 127 - i : i; dtn[e] = G[(rowb + row0_ + io) * 32 + 16 + dir * 4 + h]; } } } while (0)
  MAMBA_LOAD(0);
  SCAN_BAR();
#pragma unroll 1
  for (int cc = 0; cc < 34; ++cc) {
    int row0, seg0, seglen; chunk_rows(cc, dir, row0, seg0, seglen);
    if (wid == 0) {
      float cum2[2];
      const float p0 = dtn[0] * a, p1 = p0 + dtn[1] * a; const float inc = wscan_add(p1, lane); const float exc = inc - p1;
      cum2[0] = exc + p0; cum2[1] = exc + p1; const float cend = __shfl(inc, 63);
#pragma unroll
      for (int e = 0; e < 2; ++e) { const int i = 2 * lane + e; rowexp[i] = cum2[e] * L2E; colexp[i] = -cum2[e] * L2E + __builtin_amdgcn_logf(dtn[e]); isc[i] = __builtin_amdgcn_exp2f(cum2[e] * L2E); vw[i] = __builtin_amdgcn_exp2f((cend - cum2[e]) * L2E) * dtn[e]; }
      if (lane == 0) misc[0] = __builtin_amdgcn_exp2f(cend * L2E);
    }
    SCAN_BAR_L();
    int tw_ = tid; asm volatile("" : "+v"(tw_));
#pragma unroll
    for (int k = 0; k < 10; ++k) {
      const int task = tw_ + 512 * k, io = task / 40, cg = task % 40, i = dir ? 127 - io : io;
      if (cg < 8) { const float s = vw[i]; u32x4 pw;
#pragma unroll
        for (int e = 0; e < 4; ++e) pw[e] = cvtpk(bf_lo(pc[k][e]) * s, bf_hi(pc[k][e]) * s);
        *(LAS u32x4*)(Vm + img_off<128>(i, cg * 8)) = pc[k]; *(LAS u32x4*)(Vw + img_off<128>(i, cg * 8)) = pw; }
      else if (cg < 24) *(LAS u32x4*)(Km + img_off<128>(i, (cg - 8) * 8)) = pc[k];
      else *(LAS u32x4*)(Qm + img_off<128>(i, (cg - 24) * 8)) = pc[k];
    }
    SCAN_BAR_L();
    if (cc + 1 < 34) MAMBA_LOAD(cc + 1);
    f32x16 res0, res1; chunk_core<128, 64>(Qm, Km, Vm, Ss, rowexp, colexp, isc, res0, res1, wid, lane);
    { const int tb = wid & 3, vp = wid >> 2, r32 = lane & 31, hh = lane >> 5;
#pragma unroll
      for (int r = 0; r < 16; ++r) { const int t = 32 * tb + crow(r, hh), io = dir ? 127 - t : t; YD[((size_t)dir * M + rowb + row0 + io) * 256 + h * 64 + 32 * vp + r32] = f2bf(res0[r]); } }
    const float sd = misc[0];
    SCAN_BAR_L();
    state_update<128, 64>(Km, Vw, Ss, st_acc, sd, wid, lane);
  }
#undef MAMBA_LOAD
  SCAN_BAR();
}

__device__ __forceinline__ void mlstm_chain(LAS char* lds, const bf16* __restrict__ P, const float* __restrict__ G, bf16* __restrict__ HC, int b, int h, int dir) {
  int tid_ = threadIdx.x; asm volatile("" : "+v"(tid_));
  const int tid = tid_, lane = tid & 63, wid = __builtin_amdgcn_readfirstlane(tid >> 6);
  LAS char* Qm = lds; LAS char* Km = lds + 16384; LAS char* Vm = lds + 32768; LAS char* Vw = lds + 57344; LAS char* Ss = lds + 81920;
  LAS float* rowexp = (LAS float*)(lds + 94208); LAS float* colexp = rowexp + 128; LAS float* isc = rowexp + 256; LAS float* vw = rowexp + 384; LAS float* emn = rowexp + 512; LAS float* den = rowexp + 640; LAS float* misc = rowexp + 768;
  for (int i = tid; i < 12288 / 4; i += 512) ((LAS unsigned*)Ss)[i] = 0u;
  f32x16 st_acc = {};
  float m_prev = 0.f;
  const size_t rowb = (size_t)b * RB;
  const int io = tid >> 2, part = tid & 3, i = dir ? 127 - io : io;
  u32x4 q0, q1, k0, k1, v0, v1; float ign[2] = {0.f, 0.f}, lfn[2] = {0.f, 0.f};
#define MLSTM_LOAD(cc_) do { int row0_, seg0_, seglen_; chunk_rows((cc_), dir, row0_, seg0_, seglen_); \
    const bf16* pr = P + (rowb + row0_ + io) * NP + h * 64 + part * 16; \
    q0 = *(const u32x4*)(pr + 1024); q1 = *(const u32x4*)(pr + 1024 + 8); k0 = *(const u32x4*)(pr + 1280); k1 = *(const u32x4*)(pr + 1280 + 8); v0 = *(const u32x4*)(pr + 1536); v1 = *(const u32x4*)(pr + 1536 + 8); \
    if (wid == 0) { _Pragma("unroll") for (int e = 0; e < 2; ++e) { const int ii = 2 * lane + e, ioo = dir ? 127 - ii : ii; const float* gr = G + (rowb + row0_ + ioo) * 32; ign[e] = gr[(2 * dir) * 4 + h]; lfn[e] = gr[(2 * dir + 1) * 4 + h]; } } } while (0)
  MLSTM_LOAD(0);
  SCAN_BAR();
#pragma unroll 1
  for (int cc = 0; cc < 34; ++cc) {
    int row0, seg0, seglen; chunk_rows(cc, dir, row0, seg0, seglen);
    if (wid == 0) {
      float bb[2], aa[2], mm[2];
      const float p1 = lfn[0] + lfn[1]; const float inc = wscan_add(p1, lane); const float exc = inc - p1;
      bb[0] = exc + lfn[0]; bb[1] = exc + p1; aa[0] = ign[0] - bb[0]; aa[1] = ign[1] - bb[1];
      const float q1m = fmaxf(aa[0], aa[1]); const float incm = wscan_max(q1m, lane); float excm = __shfl_up(incm, 1); if (lane == 0) excm = -INFINITY;
      mm[0] = fmaxf(m_prev, fmaxf(excm, aa[0])); mm[1] = fmaxf(m_prev, fmaxf(excm, q1m));
      const float b_end = __shfl(bb[1], 63), mm_end = __shfl(mm[1], 63);
#pragma unroll
      for (int e = 0; e < 2; ++e) { const int ii = 2 * lane + e; rowexp[ii] = -mm[e] * L2E; colexp[ii] = aa[e] * L2E; isc[ii] = __builtin_amdgcn_exp2f((m_prev - mm[e]) * L2E); emn[ii] = __builtin_amdgcn_exp2f(-(bb[e] + mm[e]) * L2E); vw[ii] = __builtin_amdgcn_exp2f((aa[e] - mm_end) * L2E); }
      if (lane == 0) misc[0] = __builtin_amdgcn_exp2f((m_prev - mm_end) * L2E);
      m_prev = b_end + mm_end;
    }
    SCAN_BAR_L();
    {
      const float s = vw[i];
      u32x4 qa, qb, va, vb;
#pragma unroll
      for (int e = 0; e < 4; ++e) { qa[e] = cvtpk(bf_lo(q0[e]) * 0.125f, bf_hi(q0[e]) * 0.125f); qb[e] = cvtpk(bf_lo(q1[e]) * 0.125f, bf_hi(q1[e]) * 0.125f);
        va[e] = cvtpk(bf_lo(v0[e]) * s, bf_hi(v0[e]) * s); vb[e] = cvtpk(bf_lo(v1[e]) * s, bf_hi(v1[e]) * s); }
      const int o0 = img_off<128>(i, part * 16), o1 = img_off<128>(i, part * 16 + 8);
      *(LAS u32x4*)(Qm + o0) = qa; *(LAS u32x4*)(Qm + o1) = qb; *(LAS u32x4*)(Km + o0) = k0; *(LAS u32x4*)(Km + o1) = k1;
      *(LAS u32x4*)(Vm + o0) = v0; *(LAS u32x4*)(Vm + o1) = v1; *(LAS u32x4*)(Vw + o0) = va; *(LAS u32x4*)(Vw + o1) = vb;
      const int o2 = img_off<128>(i, 64 + part * 8);
      const unsigned one = part == 0 ? 0x3f80u : 0u, wkb = part == 0 ? (cvtpk(s, 0.f) & 0xffffu) : 0u;
      *(LAS u32x4*)(Vm + o2) = (u32x4){one, 0u, 0u, 0u}; *(LAS u32x4*)(Vw + o2) = (u32x4){wkb, 0u, 0u, 0u};
    }
    SCAN_BAR_L();
    if (cc + 1 < 34) MLSTM_LOAD(cc + 1);
    f32x16 res0, res1; chunk_core<64, 96>(Qm, Km, Vm, Ss, rowexp, colexp, isc, res0, res1, wid, lane);
    const int tb = wid & 3, vp = wid >> 2, r32 = lane & 31, hh = lane >> 5;
    if (vp == 0 && r32 == 0) {
#pragma unroll
      for (int r = 0; r < 16; ++r) den[32 * tb + crow(r, hh)] = res1[r];
    }
    const float sd = misc[0];
    float em[16];
#pragma unroll
    for (int r = 0; r < 16; ++r) em[r] = emn[32 * tb + crow(r, hh)];
    SCAN_BAR_L();
#pragma unroll
    for (int r = 0; r < 16; ++r) { const int t = 32 * tb + crow(r, hh), ioo = dir ? 127 - t : t; const float dn = fmaxf(fabsf(den[t]), em[r]);
      HC[((size_t)dir * M + rowb + row0 + ioo) * 256 + h * 64 + 32 * vp + r32] = f2bf(res0[r] / dn); }
    state_update<64, 96>(Km, Vw, Ss, st_acc, sd, wid, lane);
  }
#undef MLSTM_LOAD
  SCAN_BAR();
}
#undef MFMA32
}
namespace pg8 {
typedef float f32x4e __attribute__((ext_vector_type(4)));
struct EpiInProj {
    static constexpr bool PERM = true, AFTER_DRAIN = false;
    bf16_t* O; float* G;
    __device__ __forceinline__ void operator()(const f32x4 (&acc)[2][2][4][2], const Unit& u, int wr, int wc, int fr, int fq) const {
        const int row0 = u.pm * BM + wr * 64 + fr, col0 = u.pn * BM + wc * 32 + 8 * fq;
#pragma unroll
        for (int ai = 0; ai < 2; ++ai)
#pragma unroll
            for (int m = 0; m < 4; ++m) { bf16_t* rowp = O + (size_t)(row0 + ai * HALF + m * 16) * 3328 + col0;
#pragma unroll
                for (int bj = 0; bj < 2; ++bj) { const f32x4 v0 = acc[ai][bj][m][0], v1 = acc[ai][bj][m][1];
                    u32x4 w; w.x = cvt_pk_bf16(v0[0], v0[1]); w.y = cvt_pk_bf16(v0[2], v0[3]); w.z = cvt_pk_bf16(v1[0], v1[1]); w.w = cvt_pk_bf16(v1[2], v1[3]);
                    *(u32x4*)(rowp + bj * HALF) = w; } }
        if (u.pn == 12 && wc == 0) {
#pragma unroll
            for (int ai = 0; ai < 2; ++ai)
#pragma unroll
                for (int m = 0; m < 4; ++m) { float* gp = G + (size_t)(row0 + ai * HALF + m * 16) * 32 + 8 * fq; *(f32x4*)gp = acc[ai][0][m][0]; *(f32x4*)(gp + 4) = acc[ai][0][m][1]; }
        }
    }
};
struct EpiRelu2 {
    static constexpr bool PERM = true, AFTER_DRAIN = false;
    bf16_t* O;
    __device__ __forceinline__ void operator()(const f32x4 (&acc)[2][2][4][2], const Unit& u, int wr, int wc, int fr, int fq) const {
        const int row0 = u.pm * BM + wr * 64 + fr, col0 = u.pn * BM + wc * 32 + 8 * fq;
#pragma unroll
        for (int ai = 0; ai < 2; ++ai)
#pragma unroll
            for (int m = 0; m < 4; ++m) { bf16_t* rowp = O + (size_t)(row0 + ai * HALF + m * 16) * 4096 + col0;
#pragma unroll
                for (int bj = 0; bj < 2; ++bj) { f32x4 v0 = acc[ai][bj][m][0], v1 = acc[ai][bj][m][1];
#pragma unroll
                    for (int e = 0; e < 4; ++e) { const float a = v0[e] > 0.f ? v0[e] : 0.f, b = v1[e] > 0.f ? v1[e] : 0.f; v0[e] = a * a; v1[e] = b * b; }
                    u32x4 w; w.x = cvt_pk_bf16(v0[0], v0[1]); w.y = cvt_pk_bf16(v0[2], v0[3]); w.z = cvt_pk_bf16(v1[0], v1[1]); w.w = cvt_pk_bf16(v1[2], v1[3]);
                    *(u32x4*)(rowp + bj * HALF) = w; } }
    }
};
struct EpiResid {
    static constexpr bool PERM = false, AFTER_DRAIN = false;
    const float* xin_lat; const float* xin_ctx; float* xout_lat; float* xout_ctx; const float* mod; int gate_off; float gsign;
    __device__ __forceinline__ void operator()(const f32x4 (&acc)[2][2][4][2], const Unit& u, int wr, int wc, int fr, int fq) const {
        const int b = u.pm / 17, tp = u.pm % 17;
        const float* xin; float* xout; const float* gate;
        if (tp == 0) { xin = xin_ctx + (size_t)b * 256 * 1024; xout = xout_ctx + (size_t)b * 256 * 1024; gate = mod + 8 * 6144 + gate_off; }
        else { const size_t o = ((size_t)b * 4096 + (size_t)(tp - 1) * 256) * 1024; xin = xin_lat + o; xout = xout_lat + o; gate = mod + b * 6144 + gate_off; }
        const int col0 = u.pn * BM + wc * 32 + 4 * fq;
#pragma unroll
        for (int bj = 0; bj < 2; ++bj)
#pragma unroll
            for (int n = 0; n < 2; ++n) { const int cc = col0 + bj * HALF + n * 16; const f32x4 gv = *(const f32x4*)(gate + cc) * gsign;
#pragma unroll
                for (int ai = 0; ai < 2; ++ai)
#pragma unroll
                    for (int m = 0; m < 4; ++m) { const size_t off = (size_t)(ai * HALF + wr * 64 + m * 16 + fr) * 1024 + cc; const f32x4 bs = *(const f32x4*)(xin + off); *(f32x4*)(xout + off) = bs + gv * acc[ai][bj][m][n]; }
                asm volatile("" ::: "memory"); }
    }
};
struct LatentOrder {
    StaticOrder base;
    __host__ __device__ void init(int N, int G_, int c_) { base.init(128 * 256, N, G_, c_); }
    __device__ __forceinline__ bool next(int i, Unit& u) const { if (!base.next(i, u)) return false; u.pm = (u.pm >> 4) * 17 + 1 + (u.pm & 15); return true; }
    __device__ __forceinline__ void a_ready(const Unit&) const {}
    __device__ __forceinline__ void done(const Unit&) const {}
};
}

namespace mk {
constexpr int NWAVES = 8;
constexpr int RING_OFF = 0, RING_BYTES = 131072, LDSCTL_OFF = RING_BYTES, MISC_OFF = LDSCTL_OFF + 320, LDS_BYTES = 147456;
#define RLX_AGENT __ATOMIC_RELAXED, __HIP_MEMORY_SCOPE_AGENT

struct Args {
  const float* in[25]; float* out; unsigned char* ws; int ph_lo, ph_hi, n_layers, use_cg; int rep[12];
};
enum { I_X = 0, I_C, I_CTX, I_CCTX, I_WADA, I_BADA, I_GN1, I_GN2, I_WIN, I_SINK, I_GQ, I_GK, I_BI, I_BF, I_GML, I_CW, I_CB, I_ALOG, I_DTB, I_DSK, I_GSSM, I_WOUT, I_W1, I_W2, I_GFIN };

template <class F> __device__ __forceinline__ void transpose_item(const float* W, int K, int N, bf16* WT, LAS float* scr, int item, int nblk, int lane, F srccol) {
  const int kb = item / nblk, nb = item % nblk, k0 = 64 * kb, n0 = 32 * nb;
  const int sc = srccol(n0 + (lane & 31));
#pragma unroll 8
  for (int i = 0; i < 32; ++i) { const int kk = 2 * i + (lane >> 5); scr[kk * 33 + (lane & 31)] = sc >= 0 ? W[(size_t)(k0 + kk) * N + sc] : 0.f; }
  asm volatile("s_waitcnt lgkmcnt(0)" ::: "memory");
  const int c = lane & 7;
#pragma unroll
  for (int j = 0; j < 4; ++j) { const int n = (lane >> 3) + 8 * j; const LAS float* s = scr + (8 * c) * 33 + n;
    u32x4 o; o.x = cvtpk(s[0 * 33], s[1 * 33]); o.y = cvtpk(s[2 * 33], s[3 * 33]); o.z = cvtpk(s[4 * 33], s[5 * 33]); o.w = cvtpk(s[6 * 33], s[7 * 33]);
    *(u32x4*)(WT + (size_t)(n0 + n) * K + k0 + 8 * c) = o; }
  asm volatile("s_waitcnt lgkmcnt(0)" ::: "memory");
}
__device__ __forceinline__ int win_srccol(int n) { return n < 2048 ? n : (n < 3072 ? n + 16 : (n < 3088 ? n - 1024 : (n < 3096 ? n : -1))); }

__device__ __forceinline__ void norm_row(const float* xrow, const float* g, const float* shv, const float* scv, bf16* orow, int lane) {
  const f32x4* xr = (const f32x4*)xrow + lane; f32x4 v[4]; float s = 0.f;
#pragma unroll
  for (int j = 0; j < 4; ++j) { v[j] = xr[64 * j]; s += (v[j].x * v[j].x + v[j].y * v[j].y) + (v[j].z * v[j].z + v[j].w * v[j].w); }
  const float rs = rsqrtf(wave_sum(s) * (1.f / DM) + EPS);
  unsigned long long* o8 = (unsigned long long*)orow + lane;
#pragma unroll
  for (int j = 0; j < 4; ++j) { const f32x4 gg = ((const f32x4*)g)[64 * j + lane], sh = ((const f32x4*)shv)[64 * j + lane], sc = ((const f32x4*)scv)[64 * j + lane];
    const f32x4 y = v[j] * rs * gg * (sc + 1.f) + sh;
    o8[64 * j] = (unsigned long long)cvtpk(y.x, y.y) | ((unsigned long long)cvtpk(y.z, y.w) << 32); }
}

__device__ __forceinline__ void attn_item(int idx, const bf16* P, bf16* Y, const float* sink, char* shm) {
  using attn_body::attn_unit; typedef attn_body::bf16 abf;
  bool isA; int b, hq, qrow, NT, band_row0 = 0, qpos0 = 0, band_s0 = 0;
  if (idx < 1024) { isA = idx >= 512; const int id = idx & 511; b = id >> 6; hq = (id >> 4) & 3; const int q0 = (id & 15) * 256; qrow = NC + q0; NT = 68;
    if (isA) { const int s_lo = q0 - 128 > 0 ? q0 - 128 : 0, s_hi = q0 + 384 < T ? q0 + 384 : T; NT = 4 + (s_hi - s_lo) / 64; band_row0 = NC + s_lo; qpos0 = q0; band_s0 = s_lo; } }
  else { const int id = idx - 1024; isA = id >= 32; b = (id & 31) >> 2; hq = id & 3; qrow = 0; NT = 4; }
  const int g = hq >> 1; const size_t rowb = (size_t)b * RB; const int cq = isA ? 0 : 512, ck = isA ? 256 : 768, cv = isA ? 384 : 896, cy = isA ? 0 : 256;
  const abf* Q0 = (const abf*)(P + (rowb + qrow) * NP + cq + hq * 64); const abf* Kh = (const abf*)(P + rowb * NP + ck + g * 64); const abf* Vh = (const abf*)(P + rowb * NP + cv + g * 64);
  abf* O0 = (abf*)(Y + (rowb + qrow) * DM + cy + hq * 64);
#ifndef MK_NO_B
  if (!isA) attn_unit<8, 0>(Q0, Kh, Vh, O0, NT, 0, 0, 0, 0.f, shm);
#endif
#ifndef MK_NO_A
  if (isA) attn_unit<8, 1>(Q0, Kh, Vh, O0, NT, band_row0, qpos0, band_s0, sink[hq] * L2E, shm);
#endif
}

__global__ void __launch_bounds__(NWAVES * 64, 2) mk_fwd(Args args) {
  extern __shared__ __attribute__((aligned(16))) unsigned char lds_raw[];
  LAS unsigned char* lds = (LAS unsigned char*)lds_raw;
  volatile LAS unsigned* MISC = (volatile LAS unsigned*)(lds + MISC_OFF);
  const int tid0 = threadIdx.x, wave = __builtin_amdgcn_readfirstlane(tid0 >> 6);
  const int G = gridDim.x; const int bx = blockIdx.x; const int vcu = (G % 8 == 0) ? (bx % 8) * (G / 8) + bx / 8 : bx;
  for (int u = tid0; u < (LDS_BYTES - LDSCTL_OFF) / 4; u += NWAVES * 64) ((LAS unsigned*)(lds + LDSCTL_OFF))[u] = 0u;
  __syncthreads();
  if (tid0 < 25) ((volatile LAS unsigned long long*)(lds + MISC_OFF + 256))[tid0] = (unsigned long long)(uintptr_t)args.in[tid0];
  __syncthreads();
  XcdBarrier bar = xcd_barrier_post(((unsigned*)(args.ws + WS_CTL)) + CW_BAR, MISC + 8);
#ifndef MK_PHSEL
#define MK_PHSEL 0xFFFF
#endif
#ifndef MK_PROBE_NOCHAIN
#define MK_PROBE_NOCHAIN 0
#endif
#define AIN(k) ((const float*)(GAS const float*)(uintptr_t)(((unsigned long long)(unsigned)__builtin_amdgcn_readfirstlane((int)MISC[64 + 2 * (k) + 1]) << 32) | (unsigned long long)(unsigned)__builtin_amdgcn_readfirstlane((int)MISC[64 + 2 * (k)])))
#define PH_PROLOG int tid = threadIdx.x; asm volatile("" : "+v"(tid)); const int lane = tid & 63; (void)lane; GAS unsigned char* wsg_ = (GAS unsigned char*)args.ws; asm volatile("" : "+s"(wsg_)); unsigned char* wsp = (unsigned char*)wsg_;
  const int gw = vcu * NWAVES + wave, NGW = G * NWAVES;

  const int nph = 1 + 9 * args.n_layers + 1;
#pragma unroll 1
  for (int ph = args.ph_lo; ph < args.ph_hi; ++ph) {
  int kind, l = 0;
  if (ph == 0) kind = 0; else if (ph == nph - 1) kind = 10; else { l = (ph - 1) / 9; kind = 1 + (ph - 1) % 9; }
  if (kind == 0) { PH_PROLOG if ((MK_PHSEL >> 0) & 1) for (int rp = 0; rp < args.rep[0]; ++rp) {
    {
      if (vcu >= G - 24) {
        LAS float* sc = (LAS float*)(lds + RING_OFF);
        for (int i = tid; i < 9 * DM; i += NWAVES * 64) { const int j = i / DM, k = i % DM; const float v = j < 8 ? AIN(I_C)[j * DM + k] : AIN(I_CCTX)[k]; sc[i] = v / (1.f + __expf(-v)); }
        __syncthreads();
        const int o = (vcu - (G - 24)) * 512 + tid;
        const int l = o / 6144, n = o % 6144; const float* w = AIN(I_WADA) + (size_t)l * DM * 6144 + n;
        float acc[9];
#pragma unroll
        for (int j = 0; j < 9; ++j) acc[j] = 0.f;
        for (int k = 0; k < DM; ++k) { const float wv = w[(size_t)k * 6144];
#pragma unroll
          for (int j = 0; j < 9; ++j) acc[j] += sc[j * DM + k] * wv; }
        const float bb = AIN(I_BADA)[l * 6144 + n];
#pragma unroll
        for (int j = 0; j < 9; ++j) ((float*)(wsp + WS_MOD))[(size_t)(l * 9 + j) * 6144 + n] = acc[j] + bb;
        __syncthreads();
      }
      for (int i = gw * 64 + lane; i < T * 32; i += NGW * 64) { const int t = i >> 5, e = i & 31, fi = e & 15; const float invf = __builtin_amdgcn_exp2f(-(float)fi * (13.287712379549449f / 16.f));
        const float ang = (float)(e < 16 ? (t >> 6) : (t & 63)) * invf; ((float*)(wsp + WS_CS))[i] = __cosf(ang); ((float*)(wsp + WS_CS))[T * 32 + i] = __sinf(ang); }
      LAS float* scr = (LAS float*)(lds + RING_OFF + 40960 + wave * 8704);
      constexpr int I_IN = 16 * 104, I_OUT = 16 * 32, I_1 = 16 * 128, I_2 = 64 * 32, I_L = I_IN + I_OUT + I_1 + I_2;
      for (int it = gw; it < 2 * I_L; it += NGW) {
        const int l = it / I_L; int r = it % I_L; unsigned char* wl = (wsp) + WS_W + (size_t)l * W_LAYER;
        if (r < I_IN) { transpose_item(AIN(I_WIN) + (size_t)l * DM * NINO, DM, NINO, (bf16*)(wl + WO_IN), scr, r, 104, lane, [](int n) { return win_srccol(n); }); continue; } r -= I_IN;
        if (r < I_OUT) { transpose_item(AIN(I_WOUT) + (size_t)l * DM * DM, DM, DM, (bf16*)(wl + WO_OUT), scr, r, 32, lane, [](int n) { return n; }); continue; } r -= I_OUT;
        if (r < I_1) { transpose_item(AIN(I_W1) + (size_t)l * DM * DFF, DM, DFF, (bf16*)(wl + WO_1), scr, r, 128, lane, [](int n) { return n; }); continue; } r -= I_1;
        transpose_item(AIN(I_W2) + (size_t)l * DFF * DM, DFF, DM, (bf16*)(wl + WO_2), scr, r, 32, lane, [](int n) { return n; });
      }
    }
  } }

  {
    if (kind == 1) { PH_PROLOG if ((MK_PHSEL >> 1) & 1) for (int rp = 0; rp < args.rep[1]; ++rp) {
      for (int m = gw; m < M; m += NGW) { const int b = m / RB, r = m % RB; const bool isc = r < NC;
        const float* xr = isc ? (l == 0 ? AIN(I_CTX) : (const float*)(wsp + WS_XC)) + ctx_off(b, r) : (l == 0 ? AIN(I_X) : (const float*)args.out) + lat_off(b, r - NC); const float* mr = (((float*)(wsp + WS_MOD)) + (size_t)l * 9 * 6144) + (isc ? 8 : b) * 6144;
        norm_row(xr, AIN(I_GN1) + l * DM, mr, mr + 1024, ((bf16*)(wsp + WS_H)) + (size_t)m * DM, lane); }
    } }
    if (kind == 2) { PH_PROLOG if ((MK_PHSEL >> 2) & 1) for (int rp = 0; rp < args.rep[2]; ++rp) {
      { pg8::Gemm g{((bf16*)(wsp + WS_H)), (const bf16*)((wsp + WS_W + (size_t)l * W_LAYER) + WO_IN), M, NP, DM}; pg8::StaticOrder S; S.init(M, NP, G, bx);
        pg8::EpiInProj E{((bf16*)(wsp + WS_P)), ((float*)(wsp + WS_G))}; pg8::gemm_phase<pg8::EpiInProj, pg8::StaticOrder, true, true>(lds + RING_OFF, g, S, E); }
    } }
    if (kind == 3) { PH_PROLOG if ((MK_PHSEL >> 3) & 1) for (int rp = 0; rp < args.rep[3]; ++rp) {
      { const float* gq = AIN(I_GQ) + l * 64; const float* gk = AIN(I_GK) + l * 64; const float* cw = AIN(I_CW) + l * 3 * 768; const float* cb = AIN(I_CB) + l * 768;
        bf16* Pq = ((bf16*)(wsp + WS_P)); bf16* UCb = ((bf16*)(wsp + WS_UC)); float* Gp = ((float*)(wsp + WS_G)); const float* cst = ((const float*)(wsp + WS_CS));
        const int hw = 2 * gw + (lane >> 5), l32 = lane & 31, which = hw % 3, j = l32 & 7, slot = 4 * which + (l32 >> 3);
        const int blk = slot < 6 ? slot : slot + 2;
        const bool isq = slot < 4 || (slot >= 6 && slot < 10), isB = slot >= 6;
        const float* gv = isq ? gq : gk; float gn[8];
#pragma unroll
        for (int e = 0; e < 8; ++e) gn[e] = gv[8 * j + e];
        const int cch = 256 * which + 8 * l32, pcol = (which == 0 ? 2048 : (which == 1 ? 2560 : 2816)) + 8 * l32;
        f32x4 w0[2], w1[2], w2[2], bb[2];
#pragma unroll
        for (int q = 0; q < 2; ++q) { w0[q] = *(const f32x4*)(cw + cch + 4 * q); w1[q] = *(const f32x4*)(cw + 768 + cch + 4 * q); w2[q] = *(const f32x4*)(cw + 1536 + cch + 4 * q); bb[q] = *(const f32x4*)(cb + cch + 4 * q); }
        const float bgate = l32 < 16 ? (((l32 >> 2) & 1) ? AIN(I_BF)[l * 8 + (l32 >> 3) * 4 + (l32 & 3)] : AIN(I_BI)[l * 8 + (l32 >> 3) * 4 + (l32 & 3)]) : (l32 < 24 ? AIN(I_DTB)[l * 8 + (l32 - 16)] : 0.f);
        if (hw < 4095)
        for (int m = hw / 3; m < M; m += 1365) { const int r = m % RB;
          { bf16* p = Pq + (size_t)m * NP + blk * 64 + 8 * j; const u32x4 w = *(const u32x4*)p; float x[8] = {bf_lo(w.x), bf_hi(w.x), bf_lo(w.y), bf_hi(w.y), bf_lo(w.z), bf_hi(w.z), bf_lo(w.w), bf_hi(w.w)};
            if (isB) { float ss = 0.f;
#pragma unroll
              for (int e = 0; e < 8; ++e) ss += x[e] * x[e];
              ss += __shfl_xor(ss, 1); ss += __shfl_xor(ss, 2); ss += __shfl_xor(ss, 4); const float rs = rsqrtf(ss * (1.f / 64.f) + EPS);
#pragma unroll
              for (int e = 0; e < 8; ++e) x[e] = x[e] * rs * gn[e]; }
            if (r >= NC) { const int t = r - NC; const float* cp = cst + t * 32 + (j >> 2) * 16 + (j & 1) * 8; const f32x4 c0 = *(const f32x4*)cp, c1 = *(const f32x4*)(cp + 4), s0 = *(const f32x4*)(cp + T * 32), s1 = *(const f32x4*)(cp + T * 32 + 4);
              const float cc[8] = {c0[0], c0[1], c0[2], c0[3], c1[0], c1[1], c1[2], c1[3]}, sn[8] = {s0[0], s0[1], s0[2], s0[3], s1[0], s1[1], s1[2], s1[3]};
#pragma unroll
              for (int e = 0; e < 8; ++e) { const float other = __shfl_xor(x[e], 2); x[e] = (j & 2) ? x[e] * cc[e] + other * sn[e] : x[e] * cc[e] - other * sn[e]; } }
            if (isq) {
#pragma unroll
              for (int e = 0; e < 8; ++e) x[e] *= QC2; }
            *(u32x4*)p = (u32x4){cvtpk(x[0], x[1]), cvtpk(x[2], x[3]), cvtpk(x[4], x[5]), cvtpk(x[6], x[7])}; }
          { const int seg0 = r < NC ? 0 : NC, seglen = r < NC ? NC : T, sl = r - seg0; const bf16* px = Pq + (size_t)m * NP + pcol; const u32x4 z4 = {0u, 0u, 0u, 0u};
            const u32x4 xm = sl > 0 ? *(const u32x4*)(px - NP) : z4, x0 = *(const u32x4*)px, xp = sl + 1 < seglen ? *(const u32x4*)(px + NP) : z4; float u[8];
#pragma unroll
            for (int e = 0; e < 4; ++e) { const int q = e >> 1, o = (e & 1) * 2;
              const float y0 = bb[q][o] + w0[q][o] * bf_lo(xm[e]) + w1[q][o] * bf_lo(x0[e]) + w2[q][o] * bf_lo(xp[e]);
              const float y1 = bb[q][o + 1] + w0[q][o + 1] * bf_hi(xm[e]) + w1[q][o + 1] * bf_hi(x0[e]) + w2[q][o + 1] * bf_hi(xp[e]);
              u[2 * e] = y0 / (1.f + __expf(-y0)); u[2 * e + 1] = y1 / (1.f + __expf(-y1)); }
            *(u32x4*)(UCb + (size_t)m * 768 + cch) = (u32x4){cvtpk(u[0], u[1]), cvtpk(u[2], u[3]), cvtpk(u[4], u[5]), cvtpk(u[6], u[7])}; }
          if (which == 0 && l32 < 24) { float* gp = Gp + (size_t)m * 32 + l32; const float v = *gp + bgate; float o;
            if (l32 < 16) o = ((l32 >> 2) & 1) ? fminf(v, 0.f) - __logf(1.f + __expf(-fabsf(v))) : v; else o = v > 20.f ? v : __logf(1.f + __expf(v));
            *gp = o; }
        } }
    } }
    if (kind == 4) { PH_PROLOG if ((MK_PHSEL >> 4) & 1) for (int rp = 0; rp < args.rep[4]; ++rp) {
      {
#ifndef MK_NO_MAMBA
        if (bx < 64 && (rp == 0 || !MK_PROBE_NOCHAIN)) scan::mamba_chain((LAS char*)lds, ((bf16*)(wsp + WS_UC)), ((float*)(wsp + WS_G)), AIN(I_ALOG) + l * 8, ((bf16*)(wsp + WS_YD)), bx >> 3, (bx >> 1) & 3, bx & 1);
#endif
#ifndef MK_NO_MLSTM
        if (bx >= 64 && bx < 128 && (rp == 0 || !MK_PROBE_NOCHAIN)) { const int c = bx - 64; scan::mlstm_chain((LAS char*)lds, ((bf16*)(wsp + WS_P)), ((float*)(wsp + WS_G)), ((bf16*)(wsp + WS_HC)), c >> 3, (c >> 1) & 3, c & 1); }
#endif
        const int nunits = (l == 1) ? 1024 : 1088;
        for (;;) {
          if (tid == 0) MISC[16] = __hip_atomic_fetch_add(((unsigned*)(wsp + WS_CTL)) + CW_QUEUE + 64 * (l * 4 + rp), 1u, RLX_AGENT);
          __syncthreads(); const int idx = __builtin_amdgcn_readfirstlane((int)MISC[16]); __syncthreads();
          if (idx >= nunits) break;
          attn_item(idx, ((bf16*)(wsp + WS_P)), ((bf16*)(wsp + WS_Y)), AIN(I_SINK) + l * 4, (char*)lds_raw + RING_OFF);
        } }
    } }
    if (kind == 5) { PH_PROLOG if ((MK_PHSEL >> 5) & 1) for (int rp = 0; rp < args.rep[5]; ++rp) {
      { const float* gml = AIN(I_GML) + l * 256; const float* gss = AIN(I_GSSM) + l * 256; const float* dsk = AIN(I_DSK) + l * 4;
        for (int m = gw; m < M; m += NGW) { const int r = m % RB; if ((l == 1) && r < NC) continue;
          const int c0 = 4 * lane;
          { const u32x2 a = *(const u32x2*)(((bf16*)(wsp + WS_HC)) + (size_t)m * 256 + c0), bq = *(const u32x2*)(((bf16*)(wsp + WS_HC)) + ((size_t)M + m) * 256 + c0);
            float hs[4] = {bf_lo(a.x) + bf_lo(bq.x), bf_hi(a.x) + bf_hi(bq.x), bf_lo(a.y) + bf_lo(bq.y), bf_hi(a.y) + bf_hi(bq.y)};
            float ss = hs[0] * hs[0] + hs[1] * hs[1] + hs[2] * hs[2] + hs[3] * hs[3];
            ss += __shfl_xor(ss, 1); ss += __shfl_xor(ss, 2); ss += __shfl_xor(ss, 4); ss += __shfl_xor(ss, 8);
            const float rs = rsqrtf(ss * (1.f / 64.f) + EPS); const u32x2 ow = *(const u32x2*)(((bf16*)(wsp + WS_P)) + (size_t)m * NP + 1792 + c0); const f32x4 gg = *(const f32x4*)(gml + c0);
            const float o4[4] = {bf_lo(ow.x), bf_hi(ow.x), bf_lo(ow.y), bf_hi(ow.y)}; float y[4];
#pragma unroll
            for (int e = 0; e < 4; ++e) y[e] = hs[e] * rs * gg[e] / (1.f + __expf(-o4[e]));
            *(u32x2*)(((bf16*)(wsp + WS_Y)) + (size_t)m * DM + 512 + c0) = (u32x2){cvtpk(y[0], y[1]), cvtpk(y[2], y[3])}; }
          { const u32x2 a = *(const u32x2*)(((bf16*)(wsp + WS_YD)) + (size_t)m * 256 + c0), bq = *(const u32x2*)(((bf16*)(wsp + WS_YD)) + ((size_t)M + m) * 256 + c0);
            const u32x2 xw = *(const u32x2*)(((bf16*)(wsp + WS_UC)) + (size_t)m * 768 + c0); const float xs4[4] = {bf_lo(xw.x), bf_hi(xw.x), bf_lo(xw.y), bf_hi(xw.y)};
            const u32x2 zw = *(const u32x2*)(((bf16*)(wsp + WS_P)) + (size_t)m * NP + 2304 + c0); const float z4[4] = {bf_lo(zw.x), bf_hi(zw.x), bf_lo(zw.y), bf_hi(zw.y)};
            const float ys[4] = {bf_lo(a.x) + bf_lo(bq.x), bf_hi(a.x) + bf_hi(bq.x), bf_lo(a.y) + bf_lo(bq.y), bf_hi(a.y) + bf_hi(bq.y)};
            const float dk = dsk[lane >> 4]; float v[4]; float ss = 0.f;
#pragma unroll
            for (int e = 0; e < 4; ++e) { v[e] = (ys[e] + dk * xs4[e]) * (z4[e] / (1.f + __expf(-z4[e]))); ss += v[e] * v[e]; }
            const float rs = rsqrtf(wave_sum(ss) * (1.f / 256.f) + EPS); const f32x4 gg = *(const f32x4*)(gss + c0);
            *(u32x2*)(((bf16*)(wsp + WS_Y)) + (size_t)m * DM + 768 + c0) = (u32x2){cvtpk(v[0] * rs * gg[0], v[1] * rs * gg[1]), cvtpk(v[2] * rs * gg[2], v[3] * rs * gg[3])}; }
        } }
    } }
    if (kind == 6) { PH_PROLOG if ((MK_PHSEL >> 6) & 1) for (int rp = 0; rp < args.rep[6]; ++rp) {
      { pg8::Gemm g{((bf16*)(wsp + WS_Y)), (const bf16*)((wsp + WS_W + (size_t)l * W_LAYER) + WO_OUT), M, DM, DM}; pg8::EpiResid E{(l == 0 ? AIN(I_X) : (const float*)args.out), (l == 0 ? AIN(I_CTX) : (const float*)(wsp + WS_XC)), (args.out), ((float*)(wsp + WS_XC)), (((float*)(wsp + WS_MOD)) + (size_t)l * 9 * 6144), 2048, (rp & 1) ? -1.f : 1.f};
        if (!(l == 1)) { pg8::StaticOrder S; S.init(M, DM, G, bx); pg8::gemm_phase<pg8::EpiResid, pg8::StaticOrder, true, true>(lds + RING_OFF, g, S, E); }
        else { pg8::LatentOrder S; S.init(DM, G, bx); pg8::gemm_phase<pg8::EpiResid, pg8::LatentOrder, true, true>(lds + RING_OFF, g, S, E); } }
    } }
    if (kind == 7) { PH_PROLOG if ((MK_PHSEL >> 7) & 1) for (int rp = 0; rp < args.rep[7]; ++rp) {
      for (int m = gw; m < M; m += NGW) { const int b = m / RB, r = m % RB; const bool isc = r < NC; if ((l == 1) && isc) continue;
        const float* xr = isc ? ((float*)(wsp + WS_XC)) + ctx_off(b, r) : (args.out) + lat_off(b, r - NC); const float* mr = (((float*)(wsp + WS_MOD)) + (size_t)l * 9 * 6144) + (isc ? 8 : b) * 6144;
        norm_row(xr, AIN(I_GN2) + l * DM, mr + 3072, mr + 4096, ((bf16*)(wsp + WS_H)) + (size_t)m * DM, lane); }
    } }
    if (kind == 8) { PH_PROLOG if ((MK_PHSEL >> 8) & 1) for (int rp = 0; rp < args.rep[8]; ++rp) {
      { pg8::Gemm g{((bf16*)(wsp + WS_H)), (const bf16*)((wsp + WS_W + (size_t)l * W_LAYER) + WO_1), M, DFF, DM}; pg8::EpiRelu2 E{((bf16*)(wsp + WS_U))};
        if (!(l == 1)) { pg8::StaticOrder S; S.init(M, DFF, G, bx); pg8::gemm_phase<pg8::EpiRelu2, pg8::StaticOrder, true, true>(lds + RING_OFF, g, S, E); }
        else { pg8::LatentOrder S; S.init(DFF, G, bx); pg8::gemm_phase<pg8::EpiRelu2, pg8::LatentOrder, true, true>(lds + RING_OFF, g, S, E); } }
    } }
    if (kind == 9) { PH_PROLOG if ((MK_PHSEL >> 9) & 1) for (int rp = 0; rp < args.rep[9]; ++rp) {
      { pg8::Gemm g{((bf16*)(wsp + WS_U)), (const bf16*)((wsp + WS_W + (size_t)l * W_LAYER) + WO_2), M, DM, DFF}; pg8::EpiResid E{(args.out), ((float*)(wsp + WS_XC)), (args.out), ((float*)(wsp + WS_XC)), (((float*)(wsp + WS_MOD)) + (size_t)l * 9 * 6144), 5120, (rp & 1) ? -1.f : 1.f};
        if (!(l == 1)) { pg8::StaticOrder S; S.init(M, DM, G, bx); pg8::gemm_phase<pg8::EpiResid, pg8::StaticOrder, true, true>(lds + RING_OFF, g, S, E); }
        else { pg8::LatentOrder S; S.init(DM, G, bx); pg8::gemm_phase<pg8::EpiResid, pg8::LatentOrder, true, true>(lds + RING_OFF, g, S, E); } }
    } }
  }
  if (kind == 10) { PH_PROLOG if ((MK_PHSEL >> 10) & 1) for (int rp = 0; rp < args.rep[10]; ++rp) {
    { const float* gf = AIN(I_GFIN);
      for (int m = gw; m < NB * T; m += NGW) { f32x4* xr = (f32x4*)((args.out) + (size_t)m * DM) + lane; f32x4 v[4]; float s = 0.f;
#pragma unroll
        for (int j = 0; j < 4; ++j) { v[j] = xr[64 * j]; s += (v[j].x * v[j].x + v[j].y * v[j].y) + (v[j].z * v[j].z + v[j].w * v[j].w); }
        const float rs = rsqrtf(wave_sum(s) * (1.f / DM) + EPS);
#pragma unroll
        for (int j = 0; j < 4; ++j) xr[64 * j] = v[j] * rs * ((const f32x4*)gf)[64 * j + lane]; } }
  } }
  if (ph + 1 < args.ph_hi) { if (args.use_cg && ph == args.ph_lo) cooperative_groups::this_grid().sync(); else xcd_barrier(bar); }
  }
#undef PH_PROLOG
#undef AIN
}
constexpr int N_PHASES = 1 + 2 * 9 + 1;

static void launch(void* const* d_in, float* out, void* d_ws, hipStream_t stream, int n_launch_mode  , int n_layers) {
  static int grid = 0;
  if (grid == 0) {
    int dev = 0, cus = 0, per_cu = 0;
    (void)hipGetDevice(&dev); (void)hipDeviceGetAttribute(&cus, hipDeviceAttributeMultiprocessorCount, dev);
    (void)hipFuncSetAttribute((const void*)mk_fwd, hipFuncAttributeMaxDynamicSharedMemorySize, LDS_BYTES);
    (void)hipOccupancyMaxActiveBlocksPerMultiprocessor(&per_cu, (const void*)mk_fwd, NWAVES * 64, LDS_BYTES);
    (void)hipGetLastError();
    if (per_cu < 1) fprintf(stderr, "mk: occupancy query says %d blocks per CU\n", per_cu);
    grid = cus;
  }
  (void)hipMemsetAsync((char*)d_ws + WS_CTL, 0, CTL_ZERO_BYTES, stream);
  Args a{}; for (int i = 0; i < 25; ++i) a.in[i] = (const float*)d_in[i];
  a.out = out; a.ws = (unsigned char*)d_ws; a.n_layers = n_layers;
  for (int k = 0; k < 12; ++k) a.rep[k] = 1;
#ifdef MK_REP_MASK
  for (int k = 0; k < 12; ++k) if ((MK_REP_MASK >> k) & 1) a.rep[k] = MK_REP_N;
#endif
  const int nph = 1 + n_layers * 9 + 1;
  if (n_launch_mode == 0) {
    a.ph_lo = 0; a.ph_hi = nph; a.use_cg = 1;
    void* kargs[] = {&a};
    hipError_t e = hipLaunchCooperativeKernel((const void*)mk_fwd, dim3(grid), dim3(NWAVES * 64), kargs, LDS_BYTES, stream);
    if (e != hipSuccess) { fprintf(stderr, "mk: cooperative launch failed (%s), plain launch instead\n", hipGetErrorName(e)); (void)hipGetLastError(); a.use_cg = 0; hipLaunchKernelGGL(mk_fwd, dim3(grid), dim3(NWAVES * 64), LDS_BYTES, stream, a); }
  }
  else for (int p = 0; p < nph; ++p) { a.ph_lo = p; a.ph_hi = p + 1; hipLaunchKernelGGL(mk_fwd, dim3(grid), dim3(NWAVES * 64), LDS_BYTES, stream, a); }
  const hipError_t le = hipPeekAtLastError(); if (le != hipSuccess) fprintf(stderr, "mk: launch failed: %s\n", hipGetErrorName(le));
}
}
extern "C" void kernel_launch(void* const* d_in, const int* in_sizes, int n_in, void* d_out, int out_size, void* d_ws, size_t ws_size, hipStream_t stream) {
  mk::launch(d_in, (float*)d_out, d_ws, stream, MK_LAUNCH_MODE, 2);
}
```

```cpp
#define MK_LAUNCH_MODE 0
#include <hip/hip_runtime.h>
#include <hip/hip_bf16.h>
#include <hip/hip_cooperative_groups.h>
#include <cstdint>
#include <cstdio>
#include <cmath>
#define GAS __attribute__((address_space(1)))
#define LAS __attribute__((address_space(3)))
namespace mk {
constexpr int NB = 8, T = 4096, NC = 256, RB = T + NC, M = NB * RB, DM = 1024, NP = 3328, DFF = 4096, TPB = RB / 256, NINO = 3096;
constexpr float EPS = 1e-6f, L2E = 1.4426950408889634f;
constexpr float QC2 = 0.125f * 1.4426950408889634f;
typedef unsigned short bf16;
typedef unsigned u32x4 __attribute__((ext_vector_type(4)));
typedef unsigned u32x2 __attribute__((ext_vector_type(2)));
typedef float f32x4 __attribute__((ext_vector_type(4)));
typedef float f32x16 __attribute__((ext_vector_type(16)));
typedef short bf16x8 __attribute__((ext_vector_type(8)));
typedef short s16x4 __attribute__((ext_vector_type(4)));
typedef float f32x2v __attribute__((ext_vector_type(2)));
typedef __bf16 bf16x2v __attribute__((ext_vector_type(2)));

constexpr size_t MiB = 1u << 20;
constexpr size_t WS_CTL = 0, CTL_ZERO_BYTES = 1 * MiB;
constexpr size_t WS_MOD = 1 * MiB;
constexpr size_t WS_CS = 2 * MiB;
constexpr size_t WS_G = 4 * MiB;
constexpr size_t WS_XC = 9 * MiB;
constexpr size_t WS_W = 17 * MiB;
constexpr size_t W_LAYER = (size_t)(NP + DM + DFF + DFF) * 1024 * 2;
constexpr size_t WO_IN = 0, WO_OUT = (size_t)NP * DM * 2, WO_1 = WO_OUT + (size_t)DM * DM * 2, WO_2 = WO_1 + (size_t)DFF * DM * 2;
constexpr size_t WS_H = 66 * MiB;
constexpr size_t WS_P = 134 * MiB;
constexpr size_t WS_Y = 355 * MiB;
constexpr size_t WS_U = WS_P;
constexpr size_t WS_UC = 423 * MiB;
constexpr size_t WS_SLAB = WS_UC;
constexpr size_t WS_END = 487 * MiB;
static_assert(WS_W + 2 * W_LAYER <= WS_H && WS_H + (size_t)M * DM * 2 <= WS_P && WS_P + (size_t)M * NP * 2 <= WS_Y && WS_U + (size_t)M * DFF * 2 <= WS_UC && WS_UC + (size_t)M * 768 * 2 <= WS_END, "ws map");
constexpr size_t WS_HC = WS_H, WS_YD = WS_H + (size_t)2 * M * 256 * 2;
constexpr int CW_BAR = 4096;
constexpr int CW_QUEUE = 16384;

__device__ __forceinline__ unsigned cvtpk(float lo, float hi) { f32x2v v = {lo, hi}; bf16x2v b = __builtin_convertvector(v, bf16x2v); return __builtin_bit_cast(unsigned, b); }
__device__ __forceinline__ float bf_lo(unsigned w) { return __uint_as_float(w << 16); }
__device__ __forceinline__ float bf_hi(unsigned w) { return __uint_as_float(w & 0xffff0000u); }
__device__ __forceinline__ float bf2f(bf16 v) { return __uint_as_float(((unsigned)v) << 16); }
__device__ __forceinline__ bf16 f2bf(float f) { return (bf16)(cvtpk(f, 0.f) & 0xffffu); }
__device__ __forceinline__ float wave_sum(float v) {
#pragma unroll
  for (int o = 1; o < 64; o <<= 1) v += __shfl_xor(v, o);
  return v;
}
__device__ __forceinline__ int crow(int r, int hi) { return (r & 3) + 8 * (r >> 2) + 4 * hi; }
__device__ __forceinline__ size_t lat_off(int b, int t) { return ((size_t)b * T + t) * DM; }
__device__ __forceinline__ size_t ctx_off(int b, int j) { return ((size_t)b * NC + j) * DM; }
}
typedef GAS unsigned gu32;
typedef GAS unsigned long long gu64;

#define XB_TMO      128
#define XB_XCNT(j)  (256  + 64 * (j))
#define XB_XSUB(j)  (1280 + 64 * (j))
#define XB_XGEN(j)  (2304 + 64 * (j))
#define XB_TOP      3328
#define XB_TOPGEN   3392
#define XCD_BAR_WORDS 3456
#define XB_SPIN_CAP (1u << 18)

__device__ __forceinline__ unsigned xb_ld(unsigned* p)              { return __hip_atomic_load(p, __ATOMIC_RELAXED, __HIP_MEMORY_SCOPE_AGENT); }
__device__ __forceinline__ unsigned xb_add(unsigned* p, unsigned v) { return __hip_atomic_fetch_add(p, v, __ATOMIC_RELAXED, __HIP_MEMORY_SCOPE_AGENT); }
__device__ __forceinline__ unsigned xb_xcc_id() { return (unsigned)__builtin_amdgcn_s_getreg((3 << 11) | 20) & 0xFu; }
#define XB_SPIN(cond, bar) do { unsigned _sp = 0; while (cond) { __builtin_amdgcn_s_sleep(1); \
    if ((++_sp & 255u) == 0u) { if (xb_ld(&(bar)[XB_TMO])) break; if (_sp > XB_SPIN_CAP) { atomicAdd(&(bar)[XB_TMO], 1u); break; } } } } while (0)

struct XcdBarrier {
    unsigned* bar; unsigned x;
    volatile LAS unsigned* st;
};

__device__ __forceinline__ XcdBarrier xcd_barrier_post(unsigned* bar, volatile LAS unsigned* st) {
    XcdBarrier b; b.bar = bar; b.x = xb_xcc_id(); b.st = st;
    if (threadIdx.x == 0) (void)xb_add(&bar[XB_XCNT(b.x)], 1u);
    return b;
}
__device__ __forceinline__ void xcd_barrier_complete(unsigned* bar, unsigned x, unsigned& nloc, unsigned& nx) {
    const unsigned G = gridDim.x * gridDim.y * gridDim.z;
    unsigned sum, cnt, mine, sp = 0u;
    for (;;) {
        sum = 0u; cnt = 0u; mine = 0u;
#pragma unroll 1
        for (unsigned j = 0; j < 16; ++j) { const unsigned c = xb_ld(&bar[XB_XCNT(j)]); sum += c; cnt += (c > 0u) ? 1u : 0u; mine = (j == x) ? c : mine; }
        if (sum == G) break;
        __builtin_amdgcn_s_sleep(1);
        if ((++sp & 255u) == 0u) { if (xb_ld(&bar[XB_TMO])) break; if (sp > XB_SPIN_CAP) { atomicAdd(&bar[XB_TMO], 1u); break; } }
    }
    nloc = mine > 0u ? mine : 1u; nx = cnt > 0u ? cnt : 1u;
}

__device__ __forceinline__ void xcd_barrier(const XcdBarrier& b) {
    asm volatile("s_waitcnt vmcnt(0)" ::: "memory");
    __syncthreads();
    if (threadIdx.x == 0) {
        unsigned* bar = b.bar;
        __builtin_amdgcn_s_waitcnt(0);
        unsigned nloc = b.st[0], nx = b.st[1];
        if (nloc == 0u) { xcd_barrier_complete(bar, b.x, nloc, nx); b.st[0] = nloc; b.st[1] = nx; }
        const unsigned old = xb_add(&bar[XB_XSUB(b.x)], 1u);
        const unsigned gen = old / nloc;
        if (old + 1u == (gen + 1u) * nloc) {
            __builtin_amdgcn_fence(__ATOMIC_RELEASE, "agent");
            asm volatile("s_waitcnt vmcnt(0)" ::: "memory");
            const unsigned og = xb_add(&bar[XB_TOP], 1u);
            const unsigned tg = og / nx;
            if (og + 1u == (tg + 1u) * nx) xb_add(&bar[XB_TOPGEN], 1u);
            else XB_SPIN(xb_ld(&bar[XB_TOPGEN]) == tg, bar);
            __builtin_amdgcn_fence(__ATOMIC_ACQUIRE, "agent");
            xb_add(&bar[XB_XGEN(b.x)], 1u);
            asm volatile("s_waitcnt vmcnt(0)" ::: "memory");
        } else {
            XB_SPIN(xb_ld(&bar[XB_XGEN(b.x)]) == gen, bar);
            __builtin_amdgcn_fence(__ATOMIC_ACQUIRE, "agent");
            asm volatile("s_waitcnt vmcnt(0)" ::: "memory");
        }
    }
    __syncthreads();
}
namespace pg8 {
#define PG8_LAS __attribute__((address_space(3)))
typedef unsigned short bf16_t;
typedef short bf16x8 __attribute__((ext_vector_type(8)));
typedef float f32x4 __attribute__((ext_vector_type(4)));
typedef unsigned u32x4 __attribute__((ext_vector_type(4)));
constexpr int BM = 256, BK = 64, HALF = 128, HTB = HALF * BK * 2  , STAGE_BYTES = 8 * HTB, NXCD = 8, WGM = 8;

__host__ __device__ __forceinline__ int lds_byte(int r, int c) { const int st = (r >> 4) * 2 + (c >> 5), rr = r & 15, cc = c & 31, ob = rr * 64 + cc * 2; return st * 1024 + (ob ^ (((ob >> 9) & 1) << 5)); }
__host__ __device__ __forceinline__ void stage_rc(int b, int& R, int& C) { const int st = b / 1024, sb = b % 1024, swz = sb ^ (((sb >> 9) & 1) << 5); R = (st >> 1) * 16 + swz / 64; C = (st & 1) * 32 + (swz % 64) / 2; }
__host__ __device__ __forceinline__ int perm32(int rho) { const int n = rho >> 4, i = rho & 15; return 8 * (i >> 2) + 4 * n + (i & 3); }

struct Unit { int pm, pn; };
struct Gemm { const bf16_t* A; const bf16_t* Bt; int M, N, K, ld; };

struct StaticOrder {
    int nM, nN, nwg, G, c;
    __host__ __device__ void init(int M, int N, int G_, int c_) { nM = M / BM; nN = N / BM; nwg = nM * nN; G = G_; c = c_; }
    __host__ __device__ bool next(int i, Unit& u) const {
        const long L = (long)i * G + c; if (L >= nwg) return false;
        int wgid = (int)L; { const int q = nwg / NXCD, r = nwg % NXCD, xcd = wgid % NXCD, off = wgid / NXCD; wgid = (xcd < r ? xcd * (q + 1) : r * (q + 1) + (xcd - r) * q) + off; }
        const int nig = WGM * nN, gid = wgid / nig, fm = gid * WGM, gsz = (nM - fm) < WGM ? (nM - fm) : WGM;
        u.pm = fm + ((wgid % nig) % gsz); u.pn = (wgid % nig) / gsz; return true;
    }
    __device__ __forceinline__ void a_ready(const Unit&) const {}
    __device__ __forceinline__ void done(const Unit&) const {}
};

__device__ __forceinline__ unsigned cvt_pk_bf16(float lo, float hi) { unsigned r; asm volatile("v_cvt_pk_bf16_f32 %0, %1, %2" : "=v"(r) : "v"(lo), "v"(hi)); return r; }
typedef float f32x2 __attribute__((ext_vector_type(2)));
__device__ __forceinline__ f32x2 gelu_pk(f32x2 v) {
    const f32x2 av = __builtin_elementwise_abs(v), d = av * 0.2316418882f + 1.0f;
    f32x2 t; t.x = __builtin_amdgcn_rcpf(d.x); t.y = __builtin_amdgcn_rcpf(d.y);
    f32x2 q = t * 0.5307027145f + (-0.7265760135f); q = q * t + 0.7107068705f; q = q * t + (-0.142248368f); q = q * t + 0.127414796f; q = q * t;
    const f32x2 s = (v * v) * (-0.72134752044f);
    f32x2 e; e.x = __builtin_amdgcn_exp2f(s.x); e.y = __builtin_amdgcn_exp2f(s.y);
    const f32x2 m = v * (q * e), r = v - m;
    f32x2 o; o.x = v.x < 0.f ? m.x : r.x; o.y = v.y < 0.f ? m.y : r.y; return o;
}

template <int ACT  > struct EpiBf16 {
    static constexpr bool PERM = true, AFTER_DRAIN = false; static_assert(ACT == 0 || ACT == 1, "EpiBf16: ACT is 0 (none) or 1 (gelu_pk)");
    bf16_t* O; int ldc; const float* bias; int split_cols; size_t split_stride; float scale0;
    __device__ __forceinline__ void operator()(const f32x4 (&acc)[2][2][4][2], const Unit& u, int wr, int wc, int fr, int fq) const {
        const int row0 = u.pm * BM + wr * 64 + fr; int colt = u.pn * BM; bf16_t* base = O;
        float sc = 1.f; if (split_cols) { const int t = colt / split_cols; base += (size_t)t * split_stride; colt -= t * split_cols; if (t == 0) sc = scale0; }
        const int col0 = colt + wc * 32 + 8 * fq, bcol0 = u.pn * BM + wc * 32 + 8 * fq;
        f32x4 bv[2][2];
#pragma unroll
        for (int bj = 0; bj < 2; ++bj)
#pragma unroll
            for (int n = 0; n < 2; ++n) bv[bj][n] = bias ? *(const f32x4*)(bias + bcol0 + bj * HALF + 4 * n) : (f32x4){0.f, 0.f, 0.f, 0.f};
#pragma unroll
        for (int ai = 0; ai < 2; ++ai)
#pragma unroll
            for (int m = 0; m < 4; ++m) { bf16_t* rowp = base + (size_t)(row0 + ai * HALF + m * 16) * ldc + col0;
#pragma unroll
                for (int bj = 0; bj < 2; ++bj) { f32x4 v0 = acc[ai][bj][m][0] + bv[bj][0], v1 = acc[ai][bj][m][1] + bv[bj][1];
                    if (ACT == 1) { f32x2 a = gelu_pk((f32x2){v0[0], v0[1]}), b = gelu_pk((f32x2){v0[2], v0[3]}), c = gelu_pk((f32x2){v1[0], v1[1]}), d = gelu_pk((f32x2){v1[2], v1[3]});
                        v0 = (f32x4){a.x, a.y, b.x, b.y}; v1 = (f32x4){c.x, c.y, d.x, d.y}; }
                    v0 = v0 * sc; v1 = v1 * sc; u32x4 w; w.x = cvt_pk_bf16(v0[0], v0[1]); w.y = cvt_pk_bf16(v0[2], v0[3]); w.z = cvt_pk_bf16(v1[0], v1[1]); w.w = cvt_pk_bf16(v1[2], v1[3]);
                    *(u32x4*)(rowp + bj * HALF) = w; } }
    }
};
template <class Epi, class Sched, bool ALIGN_EPI = false, bool SP2 = false>
__device__ __forceinline__ void gemm_phase(PG8_LAS unsigned char* lds, const Gemm g, const Sched& S, const Epi& E) {
    int tid_ = threadIdx.x; asm volatile("" : "+v"(tid_));
    const int tid = tid_, wid = __builtin_amdgcn_readfirstlane(tid >> 6), lane = tid & 63, wr = wid >> 2, wc = wid & 3, fr = lane & 15, fq = lane >> 4;
    const int K = g.K, nt = K / BK, LD = g.ld;
    unsigned voffA[2], voffB[2];
#pragma unroll
    for (int i = 0; i < 2; ++i) { int R, C; stage_rc(tid * 16 + i * 8192, R, C); const int Rb = Epi::PERM ? ((R & ~31) + perm32(R & 31)) : R;
        voffA[i] = (unsigned)(R * LD + C) * 2u; voffB[i] = (unsigned)(Rb * LD + C) * 2u; }
    const size_t kstep = (size_t)(BK * 2);
    const size_t hstep = (size_t)HALF * LD * 2;
    const size_t tstep = 2 * hstep;
    const unsigned ldsw = (unsigned)wid * 1024u;
    const int aoff = lds_byte(wr * 64 + fr, fq * 8), boff = lds_byte(wc * 32 + fr, fq * 8);
#define PG8_SA(b, h) (((b) * 2 + (h)) * HTB)
#define PG8_SB(b, h) ((4 + (b) * 2 + (h)) * HTB)
#define PG8_STAGE(bufoff, gbase, voff) do { _Pragma("unroll") for (int _i = 0; _i < 2; ++_i) \
        __builtin_amdgcn_global_load_lds((const unsigned*)((const char*)(gbase) + (voff)[_i]), (PG8_LAS unsigned*)(lds + (bufoff) + ldsw + _i * 8192), 16, 0, 0); } while (0)
#define PG8_LDA(dst, b, h) do { _Pragma("unroll") for (int m = 0; m < 4; ++m) _Pragma("unroll") for (int k = 0; k < 2; ++k) dst[m][k] = *(const PG8_LAS bf16x8*)(lds + PG8_SA(b, h) + aoff + m * 2048 + k * 1024); } while (0)
#define PG8_LDB(dst, b, h) do { _Pragma("unroll") for (int n = 0; n < 2; ++n) _Pragma("unroll") for (int k = 0; k < 2; ++k) dst[n][k] = *(const PG8_LAS bf16x8*)(lds + PG8_SB(b, h) + boff + n * 2048 + k * 1024); } while (0)
#define PG8_MMA(ai, bj, At, Bt) do { __builtin_amdgcn_s_setprio(1); _Pragma("unroll") for (int m = 0; m < 4; ++m) _Pragma("unroll") for (int n = 0; n < 2; ++n) _Pragma("unroll") for (int k = 0; k < 2; ++k) \
        acc[ai][bj][m][n] = __builtin_amdgcn_mfma_f32_16x16x32_bf16(Bt[n][k], At[m][k], acc[ai][bj][m][n], 0, 0, 0); __builtin_amdgcn_s_setprio(0); } while (0)
#define PG8_WAIT_V(n) asm volatile("s_waitcnt vmcnt(" #n ")" ::: "memory")
#define PG8_WAIT_L(n) asm volatile("s_waitcnt lgkmcnt(" #n ")" ::: "memory")
#define PG8_BAR __builtin_amdgcn_s_barrier()
#define PG8_SCHED __builtin_amdgcn_sched_barrier(0)
    Unit cur, nxt; int ui = 0;
    if (!S.next(0, cur)) return;
    f32x4 acc[2][2][4][2];
#pragma unroll
    for (int a = 0; a < 2; ++a)
#pragma unroll
        for (int b = 0; b < 2; ++b)
#pragma unroll
            for (int m = 0; m < 4; ++m)
#pragma unroll
                for (int n = 0; n < 2; ++n) acc[a][b][m][n] = (f32x4){0.f, 0.f, 0.f, 0.f};
    bf16x8 At[4][2], B0[2][2], B1[2][2];
    const char* cA = (const char*)g.A + (size_t)cur.pm * tstep; const char* cB = (const char*)g.Bt + (size_t)cur.pn * tstep;
    S.a_ready(cur);
    if constexpr (SP2) {
        PG8_STAGE(PG8_SB(0, 0), cB, voffB); PG8_STAGE(PG8_SB(0, 1), cB + hstep, voffB); PG8_STAGE(PG8_SA(0, 0), cA, voffA); PG8_STAGE(PG8_SA(0, 1), cA + hstep, voffA);
        if (wr == 1) PG8_BAR;
        PG8_WAIT_V(2); PG8_BAR;
        PG8_STAGE(PG8_SB(1, 0), cB + kstep, voffB); PG8_STAGE(PG8_SA(1, 0), cA + kstep, voffA); PG8_STAGE(PG8_SB(1, 1), cB + hstep + kstep, voffB);
        PG8_WAIT_V(6); PG8_BAR;
    } else {
        PG8_STAGE(PG8_SB(0, 0), cB, voffB); PG8_STAGE(PG8_SA(0, 0), cA, voffA); PG8_STAGE(PG8_SB(0, 1), cB + hstep, voffB); PG8_STAGE(PG8_SA(0, 1), cA + hstep, voffA);
        if (wr == 1) PG8_BAR;
        PG8_WAIT_V(4); PG8_BAR;
        PG8_STAGE(PG8_SB(1, 0), cB + kstep, voffB); PG8_STAGE(PG8_SA(1, 0), cA + kstep, voffA); PG8_STAGE(PG8_SB(1, 1), cB + hstep + kstep, voffB);
        PG8_WAIT_V(6); PG8_BAR;
    }
    for (;;) {
        const bool has_next = S.next(ui + 1, nxt);
        const char* nA = has_next ? (const char*)g.A + (size_t)nxt.pm * tstep : cA; const char* nB = has_next ? (const char*)g.Bt + (size_t)nxt.pn * tstep : cB;
        for (int t = 0; t < nt; t += 2) {
            const bool last = (t == nt - 2);
            const char* a1 = cA + (size_t)(t + 1) * kstep;
            const char* a2 = last ? nA : cA + (size_t)(t + 2) * kstep; const char* b2 = last ? nB : cB + (size_t)(t + 2) * kstep;
            const char* a3 = a2 + kstep; const char* b3 = b2 + kstep;
            if (last && has_next) S.a_ready(nxt);
            if constexpr (SP2) {
            PG8_LDB(B0, 0, 0); PG8_LDB(B1, 0, 1); PG8_SCHED; PG8_LDA(At, 0, 0); PG8_STAGE(PG8_SA(1, 1), a1 + hstep, voffA);
            PG8_WAIT_V(8); PG8_WAIT_L(0); PG8_BAR; PG8_MMA(0, 0, At, B0); PG8_MMA(0, 1, At, B1); PG8_BAR; PG8_SCHED;
            PG8_LDA(At, 0, 1); PG8_STAGE(PG8_SB(0, 0), b2, voffB); PG8_STAGE(PG8_SB(0, 1), b2 + hstep, voffB); PG8_STAGE(PG8_SA(0, 0), a2, voffA);
            PG8_WAIT_V(8); PG8_WAIT_L(0); PG8_BAR; PG8_MMA(1, 0, At, B0); PG8_MMA(1, 1, At, B1); PG8_BAR; PG8_SCHED;
            PG8_LDB(B0, 1, 0); PG8_LDB(B1, 1, 1); PG8_SCHED; PG8_LDA(At, 1, 0); PG8_STAGE(PG8_SA(0, 1), a2 + hstep, voffA);
            PG8_WAIT_V(8); PG8_WAIT_L(0); PG8_BAR; PG8_MMA(0, 0, At, B0); PG8_MMA(0, 1, At, B1); PG8_BAR; PG8_SCHED;
            PG8_LDA(At, 1, 1); PG8_STAGE(PG8_SB(1, 0), b3, voffB); PG8_STAGE(PG8_SB(1, 1), b3 + hstep, voffB); PG8_STAGE(PG8_SA(1, 0), a3, voffA);
            PG8_WAIT_V(8); PG8_WAIT_L(0); PG8_BAR; PG8_MMA(1, 0, At, B0); PG8_MMA(1, 1, At, B1); PG8_BAR; PG8_SCHED;
            } else {
            PG8_LDB(B0, 0, 0); PG8_SCHED; PG8_LDA(At, 0, 0); PG8_STAGE(PG8_SA(1, 1), a1 + hstep, voffA);
            PG8_WAIT_L(8); PG8_BAR; PG8_WAIT_L(0); PG8_MMA(0, 0, At, B0); PG8_BAR; PG8_SCHED;
            PG8_LDB(B1, 0, 1); PG8_STAGE(PG8_SB(0, 0), b2, voffB);
            PG8_BAR; PG8_WAIT_L(0); PG8_MMA(0, 1, At, B1); PG8_BAR;
            PG8_LDA(At, 0, 1); PG8_STAGE(PG8_SA(0, 0), a2, voffA);
            PG8_BAR; PG8_WAIT_L(0); PG8_MMA(1, 0, At, B0); PG8_BAR; PG8_SCHED;
            PG8_STAGE(PG8_SB(0, 1), b2 + hstep, voffB);
            PG8_WAIT_V(6); PG8_BAR; PG8_MMA(1, 1, At, B1); PG8_BAR;
            PG8_LDB(B0, 1, 0); PG8_SCHED; PG8_LDA(At, 1, 0); PG8_STAGE(PG8_SA(0, 1), a2 + hstep, voffA);
            PG8_WAIT_L(8); PG8_BAR; PG8_WAIT_L(0); PG8_MMA(0, 0, At, B0); PG8_BAR; PG8_SCHED;
            PG8_LDB(B1, 1, 1); PG8_STAGE(PG8_SB(1, 0), b3, voffB);
            PG8_BAR; PG8_WAIT_L(0); PG8_MMA(0, 1, At, B1); PG8_BAR;
            PG8_LDA(At, 1, 1); PG8_STAGE(PG8_SA(1, 0), a3, voffA);
            PG8_BAR; PG8_WAIT_L(0); PG8_MMA(1, 0, At, B0); PG8_BAR; PG8_SCHED;
            PG8_STAGE(PG8_SB(1, 1), b3 + hstep, voffB);
            PG8_WAIT_V(6); PG8_BAR; PG8_MMA(1, 1, At, B1); PG8_BAR;
            }
        }
        if constexpr (ALIGN_EPI) { if (wr == 0) PG8_BAR; }
        if constexpr (!Epi::AFTER_DRAIN) { E(acc, cur, wr, wc, fr, fq); S.done(cur); }
        if (!has_next) break;
#pragma unroll
        for (int a = 0; a < 2; ++a)
#pragma unroll
            for (int b = 0; b < 2; ++b)
#pragma unroll
                for (int m = 0; m < 4; ++m)
#pragma unroll
                    for (int n = 0; n < 2; ++n) acc[a][b][m][n] = (f32x4){0.f, 0.f, 0.f, 0.f};
        cur = nxt; cA = nA; cB = nB; ++ui;
        if constexpr (ALIGN_EPI) { if (wr == 1) PG8_BAR; }
    }
    PG8_WAIT_V(0);
    if constexpr (!ALIGN_EPI) { if (wr == 0) PG8_BAR; }
    PG8_BAR;
    if constexpr (Epi::AFTER_DRAIN) { E.fused(acc, cur, wr, wc, fr, fq, lds, wid, lane); S.done(cur); }
#undef PG8_SA
#undef PG8_SB
#undef PG8_STAGE
#undef PG8_LDA
#undef PG8_LDB
#undef PG8_MMA
#undef PG8_WAIT_V
#undef PG8_WAIT_L
#undef PG8_BAR
#undef PG8_SCHED
}
}
namespace attn_body {
using bf16=__hip_bfloat16;
using bf16x8=__attribute__((ext_vector_type(8)))short;
using s16x4=__attribute__((ext_vector_type(4)))short;
using f32x16=__attribute__((ext_vector_type(16)))float;
using u32x4=__attribute__((ext_vector_type(4)))unsigned;
constexpr int D=64,PQ=3328,PO=1024;
constexpr int NW=8,QBLK=32,QB=QBLK*NW,KVBLK=64;
__device__ __forceinline__ int crow(int r,int hi){return (r&3)+8*(r>>2)+4*hi;}
#define SBAR() __builtin_amdgcn_sched_barrier(0)
__device__ __forceinline__ void wmask(f32x16&p0,f32x16&p1,int dq,int hi){
  const float NEG=-INFINITY; int kb=4*hi;
  #pragma unroll
  for(int r=0;r<16;++r){int kv=kb+(r&3)+8*(r>>2); int d0=dq-kv; if(d0>128||d0<-128)p0[r]=NEG; int d1=d0-32; if(d1>128||d1<-128)p1[r]=NEG;}
}

constexpr int NSLOT=3, SLOTB=8192;
constexpr int LDS_K=0, LDS_V=NSLOT*SLOTB, LDS_WS=2*NSLOT*SLOTB, LDS_OST=LDS_WS+NW*64*4, LDS_BYTES=LDS_OST+NW*4096;
constexpr float C2=0.125f*1.4426950408889634f;
__device__ __forceinline__ void glds16(const void*gsrc,unsigned lds_dst){unsigned keep;
  asm volatile("s_mov_b32 %0, m0\n\ts_mov_b32 m0, %2\n\ts_nop 0\n\tglobal_load_lds_dwordx4 %1, off\n\ts_mov_b32 m0, %0":"=&s"(keep):"v"(gsrc),"s"(lds_dst):"memory");}
__device__ __forceinline__ float max3f(float a,float b,float c){float r;asm("v_max3_f32 %0, %1, %2, %3":"=v"(r):"v"(a),"v"(b),"v"(c));return r;}
__device__ __forceinline__ float max2f(float a,float b){float r;asm("v_max_f32_e32 %0, %1, %2":"=v"(r):"v"(a),"v"(b));return r;}
__device__ __forceinline__ float fadd_s(float a,float b){float r;asm("v_add_f32_e32 %0, %1, %2":"=v"(r):"v"(a),"v"(b));return r;}
__device__ __forceinline__ float fsub_s(float a,float b){float r;asm("v_sub_f32_e32 %0, %1, %2":"=v"(r):"v"(a),"v"(b));return r;}
typedef float f32x2_t __attribute__((ext_vector_type(2))); typedef __bf16 bf16x2_t __attribute__((ext_vector_type(2)));
__device__ __forceinline__ unsigned cvtpk_s(float lo,float hi){f32x2_t v={lo,hi};bf16x2_t b=__builtin_convertvector(v,bf16x2_t);return __builtin_bit_cast(unsigned,b);}
#define WAIT_BAR(N) asm volatile("s_waitcnt vmcnt(" #N ") lgkmcnt(0)\n\ts_barrier":::"memory")

__device__ __forceinline__ void qkt(f32x16&p0,f32x16&p1,const char*Kslot,const bf16x8*qr,const f32x16&negm,int r32,int hi){
  const char*kb=Kslot+hi*1024+r32*16;
  #pragma unroll
  for(int d0=0;d0<4;++d0){
    const bf16x8 b0=*reinterpret_cast<const bf16x8*>(kb+d0*2048);
    const bf16x8 b1=*reinterpret_cast<const bf16x8*>(kb+d0*2048+512);
    if(d0==0){p0=__builtin_amdgcn_mfma_f32_32x32x16_bf16(b0,qr[0],negm,0,0,0);p1=__builtin_amdgcn_mfma_f32_32x32x16_bf16(b1,qr[0],negm,0,0,0);}
    else{p0=__builtin_amdgcn_mfma_f32_32x32x16_bf16(b0,qr[d0],p0,0,0,0);p1=__builtin_amdgcn_mfma_f32_32x32x16_bf16(b1,qr[d0],p1,0,0,0);}}
}
typedef __attribute__((address_space(3))) const char* lds_cptr;
typedef short v4i16_t __attribute__((ext_vector_type(4)));
__device__ __forceinline__ void kload8(bf16x8*kf,lds_cptr kp){
  kf[0]=*(const __attribute__((address_space(3))) bf16x8*)(kp);      kf[1]=*(const __attribute__((address_space(3))) bf16x8*)(kp+512);
  kf[2]=*(const __attribute__((address_space(3))) bf16x8*)(kp+2048); kf[3]=*(const __attribute__((address_space(3))) bf16x8*)(kp+2560);
  kf[4]=*(const __attribute__((address_space(3))) bf16x8*)(kp+4096); kf[5]=*(const __attribute__((address_space(3))) bf16x8*)(kp+4608);
  kf[6]=*(const __attribute__((address_space(3))) bf16x8*)(kp+6144); kf[7]=*(const __attribute__((address_space(3))) bf16x8*)(kp+6656);
}
__device__ __forceinline__ void kload2(bf16x8*kf,lds_cptr kp,int j){ kf[2*j]=*(const __attribute__((address_space(3))) bf16x8*)(kp+j*2048); kf[2*j+1]=*(const __attribute__((address_space(3))) bf16x8*)(kp+j*2048+512); }
__device__ __forceinline__ s16x4 vtr(lds_cptr p){ return __builtin_bit_cast(s16x4,__builtin_amdgcn_ds_read_tr16_b64_v4i16((__attribute__((address_space(3))) v4i16_t*)p)); }
__device__ __forceinline__ float rowmax(const f32x16&p0,const f32x16&p1){
  float a=max3f(p0[0],p0[1],p1[0]),b=max3f(p0[2],p0[3],p1[1]);a=max3f(a,p1[2],p1[3]);
  #pragma unroll
  for(int r=4;r<16;r+=4){a=max3f(a,p0[r],p0[r+1]);b=max3f(b,p0[r+2],p0[r+3]);a=max3f(a,p1[r],p1[r+1]);b=max3f(b,p1[r+2],p1[r+3]);}
  const float m=max2f(a,b);
  auto rr=__builtin_amdgcn_permlane32_swap(__float_as_uint(m),__float_as_uint(m),false,false);
  return max2f(__uint_as_float(rr[0]),__uint_as_float(rr[1]));
}
__device__ __forceinline__ void pv(f32x16*o,int vb,bf16x8 pa0,bf16x8 pa1,bf16x8 pa2,bf16x8 pa3){
  #pragma unroll
  for(int d0=0;d0<2;++d0){s16x4 lo[4],hi[4];
    #pragma unroll
    for(int ks=0;ks<4;++ks){
      asm volatile("ds_read_b64_tr_b16 %0,%1 offset:%c2":"=&v"(lo[ks]):"v"(vb),"i"(d0*4096+ks*1024):"memory");
      asm volatile("ds_read_b64_tr_b16 %0,%1 offset:%c2":"=&v"(hi[ks]):"v"(vb),"i"(d0*4096+ks*1024+512):"memory");}
    asm volatile("s_waitcnt lgkmcnt(0)":::"memory");SBAR();
    #define PK(k) (bf16x8){lo[k][0],lo[k][1],lo[k][2],lo[k][3],hi[k][0],hi[k][1],hi[k][2],hi[k][3]}
    o[d0]=__builtin_amdgcn_mfma_f32_32x32x16_bf16(pa0,PK(0),o[d0],0,0,0);
    o[d0]=__builtin_amdgcn_mfma_f32_32x32x16_bf16(pa1,PK(1),o[d0],0,0,0);
    o[d0]=__builtin_amdgcn_mfma_f32_32x32x16_bf16(pa2,PK(2),o[d0],0,0,0);
    o[d0]=__builtin_amdgcn_mfma_f32_32x32x16_bf16(pa3,PK(3),o[d0],0,0,0);
    #undef PK
  }
}

#ifndef ATTN_STORE16
#define ATTN_STORE16(p,v) (*(u32x4*)(p)=(v))
#endif
template<int THRL,int MODE> __device__ __forceinline__ void attn_unit(const bf16*Q0,const bf16*__restrict__ Kh,const bf16*__restrict__ Vh,bf16*O0,const int NT,const int band_row0,const int qpos0,const int band_s0,const float sink_l2,char*shm){
  int tid_=threadIdx.x; asm volatile("":"+v"(tid_));
  const int tid=tid_,lane=tid&63,r32=lane&31,hi=lane>>5; const int wid=__builtin_amdgcn_readfirstlane(tid>>6);
  const bf16*Qw=Q0+(long)(wid*QBLK)*PQ;
  #define TROW(t) ((MODE==1&&(t)>=4)?(band_row0+((t)-4)*KVBLK):((t)*KVBLK))
  const unsigned lds0=(unsigned)(uintptr_t)shm;
  float*wsf=(float*)(shm+LDS_WS)+wid*64;
  const bf16*ksrc=Kh+(long)lane*PQ+wid*8;
  const bf16*vsrc=Vh+(long)(16*(wid&3)+(lane>>2))*PQ+(wid>>2)*32+(lane&3)*8;
  const unsigned kdst=lds0+LDS_K+wid*1024, vdst=lds0+LDS_V+wid*1024;
  #define DMA_K(t,slot) glds16(ksrc+(long)TROW(t)*PQ,(unsigned)__builtin_amdgcn_readfirstlane(kdst+(slot)))
  #define DMA_V(t,slot) glds16(vsrc+(long)TROW(t)*PQ,(unsigned)__builtin_amdgcn_readfirstlane(vdst+(slot)))
  const int vb0=(int)(lds0+LDS_V)+((lane>>4)&1)*32+(lane&3)*8+(4*hi+((lane&15)>>2))*64;
  const char*Kbase=shm+LDS_K; bf16x8 kf[8];
  const lds_cptr shm3=(lds_cptr)shm; const lds_cptr kp0=shm3+LDS_K+hi*1024+r32*16; const lds_cptr vp0=shm3+LDS_V+((lane>>4)&1)*32+(lane&3)*8+(4*hi+((lane&15)>>2))*64;
  DMA_K(0,0);DMA_V(0,0);DMA_K(1,SLOTB);
  bf16x8 qr[4];
  #pragma unroll
  for(int d0=0;d0<4;++d0)qr[d0]=*reinterpret_cast<const bf16x8*>(&Qw[(long)r32*PQ+d0*16+hi*8]);
  float mhat=0.f,l_reg=0.f;f32x16 o[2];o[0]=f32x16{};o[1]=f32x16{};f32x16 negm=f32x16{};asm volatile("":"+v"(negm));
  const int qrel=wid*QBLK+r32;
  #define CMASK(P0,P1,t) do{ if(MODE==1&&(t)>=4){ wmask(P0,P1,qpos0+qrel-(band_s0+((t)-4)*KVBLK),hi); } }while(0)
  bool resc=false;
  #define START(P0,P1) do{ const float rm=rowmax(P0,P1); resc=false; \
    { const float dl=rm; mhat=fadd_s(mhat,dl); \
      _Pragma("unroll") for(int r=0;r<16;++r){P0[r]=fsub_s(P0[r],dl);P1[r]=fsub_s(P1[r],dl);} \
      _Pragma("unroll") for(int r=0;r<16;++r)negm[r]=-mhat; asm volatile("":"+v"(negm)); } \
    _Pragma("unroll") for(int r=0;r<16;++r)P0[r]=__builtin_amdgcn_exp2f(P0[r]); }while(0)
  #define RESC() do{ if(resc){ asm volatile("s_waitcnt lgkmcnt(0)":::"memory"); \
      _Pragma("unroll") for(int d_=0;d_<2;++d_) _Pragma("unroll") for(int r=0;r<16;++r)o[d_][r]*=wsf[crow(r,hi)]; } }while(0)
  f32x16 pA0,pA1,pB0,pB1;
  int sl_prev=0,sl_cur=0,sl_next=SLOTB;
  #define ROT() do{sl_prev=sl_cur;sl_cur=sl_next;sl_next=(sl_next==(NSLOT-1)*SLOTB)?0:sl_next+SLOTB;}while(0)
  DMA_K(2,2*SLOTB);
  WAIT_BAR(3);
  qkt(pA0,pA1,Kbase,qr,negm,r32,hi);asm volatile("s_nop 15\n\ts_nop 7":"+v"(pA0),"+v"(pA1));CMASK(pA0,pA1,0);
  START(pA0,pA1);
  _Pragma("unroll") for(int r=0;r<16;++r)pA1[r]=__builtin_amdgcn_exp2f(pA1[r]);
  WAIT_BAR(0);
  DMA_K(3,0);DMA_V(1,SLOTB);
  ROT();
  kload8(kf,kp0+sl_cur);
  WAIT_BAR(2);
  s16x4 vlo[8],vhi[8]; u32x4 pw0,pw1,pw2,pw3;
  #define PKW(P,B) cvtpk_s(P[B],P[B+1])
  #define PAF(k) __builtin_bit_cast(bf16x8,pw##k)
  #define VFR(i) (bf16x8){vlo[i][0],vlo[i][1],vlo[i][2],vlo[i][3],vhi[i][0],vhi[i][1],vhi[i][2],vhi[i][3]}
  #define PIN(x) asm volatile("":"+v"(x))
  #define MX3(a,b,c) __builtin_fmaxf(__builtin_fmaxf((a),(b)),(c))
  #define GAPA(MF,A0,A1,A2,A3,W0,W1,PW) do{ MF; sacc+=A0; sacc+=A1; sacc+=A2; sacc+=A3; PIN(sacc); W0; W1; PIN(PW); SBAR(); }while(0)
  #define EX(v) __builtin_amdgcn_exp2f(v)
  #define GAPB(MF,X,B) do{ MF; X[B]=EX(X[B]); X[B+1]=EX(X[B+1]); X[B+2]=EX(X[B+2]); X[B+3]=EX(X[B+3]); PIN(X); SBAR(); }while(0)
  #define VRD(i) do{ vlo[i]=vtr(vp_+(((i)>>2)*4096+((i)&3)*1024)); vhi[i]=vtr(vp_+(((i)>>2)*4096+((i)&3)*1024+512)); }while(0)
  #define KRD(G,j) do{ if(G){ kload2(kf,kp0+sl_next,j); SBAR(); } }while(0)
  #define STEP(C0,C1,P0,P1,t,GK,GV,GL) do{ SBAR(); \
    const lds_cptr vp_=vp0+sl_prev; \
    VRD(0); SBAR(); float sacc=(P0[0]+P0[1]); \
    GAPA(C0=__builtin_amdgcn_mfma_f32_32x32x16_bf16(kf[0],qr[0],negm,0,0,0), P0[2],P0[3],P0[4],P0[5],     pw0[0]=PKW(P0,0), pw0[1]=PKW(P0,2), pw0); \
    VRD(4); SBAR(); GAPA(C1=__builtin_amdgcn_mfma_f32_32x32x16_bf16(kf[1],qr[0],negm,0,0,0), P0[6],P0[7],P0[8],P0[9],     pw0[2]=PKW(P0,4), pw0[3]=PKW(P0,6), pw0); \
    VRD(1); SBAR(); GAPA(C0=__builtin_amdgcn_mfma_f32_32x32x16_bf16(kf[2],qr[1],C0,0,0,0),   P0[10],P0[11],P0[12],P0[13], pw1[0]=PKW(P0,8), pw1[1]=PKW(P0,10), pw1); \
    VRD(5); SBAR(); GAPA(C1=__builtin_amdgcn_mfma_f32_32x32x16_bf16(kf[3],qr[1],C1,0,0,0),   P0[14],P0[15],P1[0],P1[1],   pw1[2]=PKW(P0,12),pw1[3]=PKW(P0,14), pw1); \
    VRD(2); SBAR(); GAPA(C0=__builtin_amdgcn_mfma_f32_32x32x16_bf16(kf[4],qr[2],C0,0,0,0),   P1[2],P1[3],P1[4],P1[5],     pw2[0]=PKW(P1,0), pw2[1]=PKW(P1,2), pw2); \
    VRD(6); SBAR(); GAPA(C1=__builtin_amdgcn_mfma_f32_32x32x16_bf16(kf[5],qr[2],C1,0,0,0),   P1[6],P1[7],P1[8],P1[9],     pw2[2]=PKW(P1,4), pw2[3]=PKW(P1,6), pw2); \
    VRD(3); SBAR(); GAPA(C0=__builtin_amdgcn_mfma_f32_32x32x16_bf16(kf[6],qr[3],C0,0,0,0),   P1[10],P1[11],P1[12],P1[13], pw3[0]=PKW(P1,8), pw3[1]=PKW(P1,10), pw3); \
    VRD(7); SBAR(); GAPA(C1=__builtin_amdgcn_mfma_f32_32x32x16_bf16(kf[7],qr[3],C1,0,0,0),   P1[14],P1[15],0.f,0.f,       pw3[2]=PKW(P1,12),pw3[3]=PKW(P1,14), pw3); \
    l_reg+=sacc; \
    if(GK){DMA_K((t)+3,sl_cur);} if(GV){DMA_V((t)+1,sl_next);} \
    CMASK(C0,C1,t); \
    { float a=MX3(C0[0],C0[1],C1[0]),b=MX3(C0[2],C0[3],C1[1]); a=MX3(a,C1[2],C1[3]); \
      _Pragma("unroll") for(int r=4;r<16;r+=4){a=MX3(a,C0[r],C0[r+1]);b=MX3(b,C0[r+2],C0[r+3]);a=MX3(a,C1[r],C1[r+1]);b=MX3(b,C1[r+2],C1[r+3]);} \
      float rm=__builtin_fmaxf(a,b); { auto rr=__builtin_amdgcn_permlane32_swap(__float_as_uint(rm),__float_as_uint(rm),false,false); rm=__builtin_fmaxf(__uint_as_float(rr[0]),__uint_as_float(rr[1])); } \
      resc=false; \
      if(__builtin_expect(__any(rm>(float)THRL),0)){ const float dl=__builtin_fmaxf(rm,0.f); mhat+=dl; \
        _Pragma("unroll") for(int r=0;r<16;++r){C0[r]-=dl;C1[r]-=dl;} \
        _Pragma("unroll") for(int r=0;r<16;++r)negm[r]=-mhat; asm volatile("":"+v"(negm)); \
        const float f=__builtin_amdgcn_exp2f(-dl); l_reg*=f; if(hi==0)wsf[r32]=f; resc=true; } } \
    SBAR(); \
    GAPB(o[0]=__builtin_amdgcn_mfma_f32_32x32x16_bf16(PAF(0),VFR(0),o[0],0,0,0), C0,0); \
    GAPB(o[1]=__builtin_amdgcn_mfma_f32_32x32x16_bf16(PAF(0),VFR(4),o[1],0,0,0), C0,4); \
    KRD(GL,0); GAPB(o[0]=__builtin_amdgcn_mfma_f32_32x32x16_bf16(PAF(1),VFR(1),o[0],0,0,0), C0,8); \
    KRD(GL,1); GAPB(o[1]=__builtin_amdgcn_mfma_f32_32x32x16_bf16(PAF(1),VFR(5),o[1],0,0,0), C0,12); \
    KRD(GL,2); GAPB(o[0]=__builtin_amdgcn_mfma_f32_32x32x16_bf16(PAF(2),VFR(2),o[0],0,0,0), C1,0); \
    KRD(GL,3); GAPB(o[1]=__builtin_amdgcn_mfma_f32_32x32x16_bf16(PAF(2),VFR(6),o[1],0,0,0), C1,4); \
    GAPB(o[0]=__builtin_amdgcn_mfma_f32_32x32x16_bf16(PAF(3),VFR(3),o[0],0,0,0), C1,8); \
    GAPB(o[1]=__builtin_amdgcn_mfma_f32_32x32x16_bf16(PAF(3),VFR(7),o[1],0,0,0), C1,12); \
    }while(0)
  int t=1;
  for(;t+5<NT;t+=2){
    STEP(pB0,pB1,pA0,pA1,t,true,true,true);     WAIT_BAR(2); RESC(); ROT();
    STEP(pA0,pA1,pB0,pB1,t+1,true,true,true);   WAIT_BAR(2); RESC(); ROT();
  }
  #define ENDW(tt) do{ if((tt)+3<NT){WAIT_BAR(2);} else if((tt)+2<NT){WAIT_BAR(1);} else {WAIT_BAR(0);} }while(0)
  for(;t+1<NT;t+=2){
    STEP(pB0,pB1,pA0,pA1,t,(t+3<NT),(t+1<NT),(t+1<NT));       ENDW(t);   RESC(); ROT();
    STEP(pA0,pA1,pB0,pB1,t+1,(t+4<NT),(t+2<NT),(t+2<NT));     ENDW(t+1); RESC(); ROT();
  }
  STEP(pB0,pB1,pA0,pA1,NT-1,false,false,false); RESC();
  { float sacc=pB0[0]+pB0[1]; _Pragma("unroll") for(int r=2;r<16;++r)sacc+=pB0[r]; _Pragma("unroll") for(int r=0;r<16;++r)sacc+=pB1[r]; l_reg+=sacc;
    pw0=(u32x4){PKW(pB0,0),PKW(pB0,2),PKW(pB0,4),PKW(pB0,6)};pw1=(u32x4){PKW(pB0,8),PKW(pB0,10),PKW(pB0,12),PKW(pB0,14)};pw2=(u32x4){PKW(pB1,0),PKW(pB1,2),PKW(pB1,4),PKW(pB1,6)};pw3=(u32x4){PKW(pB1,8),PKW(pB1,10),PKW(pB1,12),PKW(pB1,14)};
    SBAR(); pv(o,vb0+sl_cur,PAF(0),PAF(1),PAF(2),PAF(3)); }
  #undef PKW
  #undef PAF
  #undef VFR
  #undef PIN
  #undef MX3
  #undef GAPA
  #undef GAPB
  #undef EX
  #undef VRD
  #undef KRD
  #undef STEP
  #undef ENDW
  {auto rr=__builtin_amdgcn_permlane32_swap(__float_as_uint(l_reg),__float_as_uint(l_reg),false,false);l_reg=__uint_as_float(rr[0])+__uint_as_float(rr[1]);}
  if(MODE==1)l_reg+=__builtin_amdgcn_exp2f(sink_l2-mhat);
  if(hi==0)wsf[32+r32]=l_reg;asm volatile("s_waitcnt lgkmcnt(0)":::"memory");
  float rli[16];
  #pragma unroll
  for(int r=0;r<16;++r)rli[r]=__builtin_amdgcn_rcpf(wsf[32+crow(r,hi)]);
  bf16*Ow=O0+(long)(wid*QBLK)*PO;
  { bf16*stg=(bf16*)(shm+LDS_OST)+wid*2048;
    #pragma unroll
    for(int r=0;r<16;++r){const int orow=crow(r,hi);
      #pragma unroll
      for(int d0=0;d0<2;++d0)stg[orow*64+d0*32+r32]=__float2bfloat16(o[d0][r]*rli[r]);}
    asm volatile("s_waitcnt lgkmcnt(0)":::"memory");
    #pragma unroll
    for(int i=0;i<4;++i){const int row=i*8+(lane>>3),ch=lane&7; const u32x4 v=*(const u32x4*)(stg+row*64+ch*8); ATTN_STORE16(Ow+(long)row*PO+ch*8,v);} }
  asm volatile("s_waitcnt lgkmcnt(0)\n\ts_barrier":::"memory");
  #undef DMA_K
  #undef DMA_V
  #undef TROW
  #undef CMASK
  #undef START
  #undef RESC
  #undef ROT
}
constexpr int ATTN_LDS_BYTES=LDS_BYTES;
#undef SBAR
#undef WAIT_BAR
}
namespace scan {
using namespace mk;
template <int NROWS> __device__ __forceinline__ int img_off(int row, int c) { return (((c >> 5) * (NROWS / 16) + (row >> 4)) << 10) + ((row & 15) << 6) + (((((c & 31) >> 3) ^ ((row >> 2) & 3))) << 4) + ((c & 7) << 1); }
__device__ __forceinline__ int tlane(int lane) { const int hh = lane >> 5, q = (lane & 15) >> 2, ch = 2 * ((lane >> 4) & 1) + ((lane & 3) >> 1), rowb = (4 * hh + q) * 64 + (lane & 1) * 8;
  const int lo = rowb + ((ch ^ hh) << 4), hi = 512 + rowb + ((ch ^ (hh + 2)) << 4); return lo | (hi << 16); }
__device__ __forceinline__ bf16x8 rfrag(LAS const char* p) { return *(LAS const bf16x8*)p; }
__device__ __forceinline__ s16x4 tr4(LAS const char* p) { return __builtin_bit_cast(s16x4, __builtin_amdgcn_ds_read_tr16_b64_v4i16((LAS s16x4*)p)); }
__device__ __forceinline__ bf16x8 tfrag(LAS const char* base, int tl) { const s16x4 lo = tr4(base + (tl & 0xffff)), hi = tr4(base + (tl >> 16)); return (bf16x8){lo[0], lo[1], lo[2], lo[3], hi[0], hi[1], hi[2], hi[3]}; }
__device__ __forceinline__ bf16x8 pack8(const f32x16& s, int b) {
  u32x4 w; w.x = cvtpk(s[b], s[b + 1]); w.y = cvtpk(s[b + 2], s[b + 3]); w.z = cvtpk(s[b + 4], s[b + 5]); w.w = cvtpk(s[b + 6], s[b + 7]); return __builtin_bit_cast(bf16x8, w);
}
#define MFMA32(a, b, c) __builtin_amdgcn_mfma_f32_32x32x16_bf16(a, b, c, 0, 0, 0)

template <int DK, int DV>
__device__ __forceinline__ void chunk_core(LAS const char* Qm, LAS const char* Km, LAS const char* Vm, LAS const char* Ss, LAS const float* rowexp, LAS const float* colexp, LAS const float* isc,
                                           f32x16& res0, f32x16& res1, int wid, int lane) {
  constexpr int KS = DK / 16, NVT = DV / 32;
  const int vp = wid >> 2, tb = vp ? 3 - (wid & 3) : (wid & 3), r32 = lane & 31, hh = lane >> 5, tl = tlane(lane);
  constexpr bool HOLDQ = (KS <= 4);
  bf16x8 qf[HOLDQ ? KS : 1];
  if (HOLDQ) {
#pragma unroll
    for (int ks = 0; ks < KS; ++ks) qf[ks] = rfrag(Qm + img_off<128>(32 * tb + r32, 16 * ks + 8 * hh)); }
#define QF(ks) (HOLDQ ? qf[HOLDQ ? (ks) : 0] : rfrag(Qm + img_off<128>(32 * tb + r32, 16 * (ks) + 8 * hh)))
  f32x16 o0 = {}, o1 = {};
  const float re = rowexp[32 * tb + r32];
#pragma unroll 1
  for (int st = 0; st <= tb; ++st) {
    f32x16 s = {};
#pragma unroll
    for (int ks = 0; ks < KS; ++ks) { const bf16x8 kf = rfrag(Km + img_off<128>(32 * st + r32, 16 * ks + 8 * hh)); s = MFMA32(kf, QF(ks), s); }
#pragma unroll
    for (int r = 0; r < 16; ++r) { const int sl = crow(r, hh); float w = __builtin_amdgcn_exp2f(re + colexp[32 * st + sl]); if (st == tb && sl > r32) w = 0.f; s[r] *= w; }
    const bf16x8 pa0 = pack8(s, 0), pa1 = pack8(s, 8);
    { const bf16x8 v0 = tfrag(Vm + ((vp * 8 + 2 * st) << 10), tl), v1 = tfrag(Vm + ((vp * 8 + 2 * st + 1) << 10), tl); o0 = MFMA32(pa0, v0, o0); o0 = MFMA32(pa1, v1, o0); }
    if (NVT > 2 && vp == 0) { const bf16x8 v0 = tfrag(Vm + ((2 * 8 + 2 * st) << 10), tl), v1 = tfrag(Vm + ((2 * 8 + 2 * st + 1) << 10), tl); o1 = MFMA32(pa0, v0, o1); o1 = MFMA32(pa1, v1, o1); }
  }
  f32x16 i0 = {}, i1 = {};
#pragma unroll
  for (int ks = 0; ks < KS; ++ks) { const bf16x8 sf = rfrag(Ss + img_off<DV>(32 * vp + r32, 16 * ks + 8 * hh)); i0 = MFMA32(QF(ks), sf, i0); }
  if (NVT > 2 && vp == 0) {
#pragma unroll
    for (int ks = 0; ks < KS; ++ks) { const bf16x8 sf = rfrag(Ss + img_off<DV>(64 + r32, 16 * ks + 8 * hh)); i1 = MFMA32(QF(ks), sf, i1); }
  }
#pragma unroll
  for (int r = 0; r < 16; ++r) { const float sc = isc[32 * tb + crow(r, hh)]; res0[r] = o0[r] + sc * i0[r]; res1[r] = o1[r] + sc * i1[r]; }
#undef QF
}
template <int DK, int DV>
__device__ __forceinline__ void state_update(LAS const char* Km, LAS const char* Vw, LAS char* Ss, f32x16& st_acc, float sd, int wid, int lane) {
  constexpr int NVT = DV / 32, NDT = DK / 32;
  if (wid < NVT * NDT) {
    const int vt = wid / NDT, dt_ = wid % NDT, r32 = lane & 31, hh = lane >> 5, tl = tlane(lane);
#pragma unroll
    for (int r = 0; r < 16; ++r) st_acc[r] *= sd;
#pragma unroll
    for (int ks = 0; ks < 8; ++ks) { const bf16x8 af = tfrag(Vw + ((vt * 8 + ks) << 10), tl), bfr = tfrag(Km + ((dt_ * 8 + ks) << 10), tl); st_acc = MFMA32(af, bfr, st_acc); }
#pragma unroll
    for (int r = 0; r < 16; ++r) *(LAS bf16*)(Ss + img_off<DV>(32 * vt + crow(r, hh), 32 * dt_ + r32)) = f2bf(st_acc[r]);
  }
}
__device__ __forceinline__ float wscan_add(float x, int lane) {
#pragma unroll
  for (int o = 1; o < 64; o <<= 1) { const float y = __shfl_up(x, o); if (lane >= o) x += y; }
  return x;
}
__device__ __forceinline__ float wscan_max(float x, int lane) {
#pragma unroll
  for (int o = 1; o < 64; o <<= 1) { const float y = __shfl_up(x, o); if (lane >= o) x = fmaxf(x, y); }
  return x;
}
__device__ __forceinline__ void chunk_rows(int cc, int dir, int& row0, int& seg0, int& seglen) {
  if (cc < 2) { const int ci = dir ? 1 - cc : cc; row0 = 128 * ci; seg0 = 0; seglen = NC; }
  else { const int ci = dir ? 31 - (cc - 2) : (cc - 2); row0 = NC + 128 * ci; seg0 = NC; seglen = T; }
}
#define SCAN_BAR() do { asm volatile("s_waitcnt vmcnt(0) lgkmcnt(0)" ::: "memory"); __builtin_amdgcn_s_barrier(); asm volatile("" ::: "memory"); } while (0)

#define SCAN_BAR_L() do { asm volatile("s_waitcnt lgkmcnt(0)" ::: "memory"); __builtin_amdgcn_s_barrier(); asm volatile("" ::: "memory"); } while (0)

__device__ __forceinline__ void mamba_chain(LAS char* lds, const bf16* __restrict__ UC, const float* __restrict__ G, const float* __restrict__ a_log, bf16* __restrict__ YD, int b, int h, int dir, int pm = 15) {
  int tid_ = threadIdx.x; asm volatile("" : "+v"(tid_));
  const int tid = tid_, lane = tid & 63, wid = __builtin_amdgcn_readfirstlane(tid >> 6), g = h >> 1;
  LAS char* Qm = lds; LAS char* Km = lds + 32768; LAS char* Vm = lds + 65536; LAS char* Vw = lds + 81920; LAS char* Ss = lds + 98304;
  LAS float* rowexp = (LAS float*)(lds + 114688); LAS float* colexp = rowexp + 128; LAS float* isc = rowexp + 256; LAS float* vw = rowexp + 384; LAS float* misc = rowexp + 512;
  for (int i = tid; i < 16384 / 4; i += 512) ((LAS unsigned*)Ss)[i] = 0u;
  f32x16 st_acc = {};
  const float a = -__expf(a_log[dir * 4 + h]);
  const size_t rowb = (size_t)b * RB;
  u32x4 pb[4], pcq[4], px[2]; float dtn[2] = {0.f, 0.f};
  const int rB = tid >> 4, cB = tid & 15, rX = tid >> 3, cX = tid & 7;
  const int iB = dir ? 127 - rB : rB, iX = dir ? 127 - rX : rX; const int oB = img_off<128>(iB, cB * 8), oX = img_off<128>(iX, cX * 8); const int stB = dir ? -2048 : 2048, stX = dir ? -4096 : 4096;
#define MAMBA_LOAD(cc_) do { int row0_, seg0_, seglen_; chunk_rows((cc_), dir, row0_, seg0_, seglen_); \
    const bf16* ub_ = UC + (rowb + row0_ + rB) * 768 + 256 + g * 128 + cB * 8; const bf16* ux_ = UC + (rowb + row0_ + rX) * 768 + h * 64 + cX * 8; \
    _Pragma("unroll") for (int k = 0; k < 4; ++k) { pb[k] = *(const u32x4*)(ub_ + (size_t)k * 32 * 768); pcq[k] = *(const u32x4*)(ub_ + (size_t)k * 32 * 768 + 256); } \
    _Pragma("unroll") for (int k = 0; k < 2; ++k) px[k] = *(const u32x4*)(ux_ + (size_t)k * 64 * 768); \
    if (wid == 0) { _Pragma("unroll") for (int e = 0; e < 2; ++e) { const int i = 2 * lane + e, io = dir ? 127 - i : i; dtn[e] = G[(rowb + row0_ + io) * 32 + 16 + dir * 4 + h]; } } } while (0)
  MAMBA_LOAD(0);
  SCAN_BAR();
#pragma unroll 1
  for (int cc = 0; cc < 34; ++cc) {
    int row0, seg0, seglen; chunk_rows(cc, dir, row0, seg0, seglen);
    if (wid == 0 && (pm & 1)) {
      float cum2[2];
      const float p0 = dtn[0] * a, p1 = p0 + dtn[1] * a; const float inc = wscan_add(p1, lane); const float exc = inc - p1;
      cum2[0] = exc + p0; cum2[1] = exc + p1; const float cend = __shfl(inc, 63);
#pragma unroll
      for (int e = 0; e < 2; ++e) { const int i = 2 * lane + e; rowexp[i] = cum2[e] * L2E; colexp[i] = -cum2[e] * L2E + __builtin_amdgcn_logf(dtn[e]); isc[i] = __builtin_amdgcn_exp2f(cum2[e] * L2E); vw[i] = __builtin_amdgcn_exp2f((cend - cum2[e]) * L2E) * dtn[e]; }
      if (lane == 0) misc[0] = __builtin_amdgcn_exp2f(cend * L2E);
    }
    SCAN_BAR_L();
    if (pm & 2) {
#pragma unroll
      for (int k = 0; k < 4; ++k) { *(LAS u32x4*)(Km + oB + k * stB) = pb[k]; *(LAS u32x4*)(Qm + oB + k * stB) = pcq[k]; }
#pragma unroll
      for (int k = 0; k < 2; ++k) { const int i = dir ? iX - 64 * k : iX + 64 * k; const float sv = vw[i]; u32x4 pw;
#pragma unroll
        for (int e = 0; e < 4; ++e) pw[e] = cvtpk(bf_lo(px[k][e]) * sv, bf_hi(px[k][e]) * sv);
        *(LAS u32x4*)(Vm + oX + k * stX) = px[k]; *(LAS u32x4*)(Vw + oX + k * stX) = pw; }
    }
    SCAN_BAR_L();
    if (cc + 1 < 34 && (pm & 2)) MAMBA_LOAD(cc + 1);
    f32x16 res0 = {}, res1 = {}; if (pm & 4) chunk_core<128, 64>(Qm, Km, Vm, Ss, rowexp, colexp, isc, res0, res1, wid, lane);
    if (pm == 15) { const int vp = wid >> 2, tb = vp ? 3 - (wid & 3) : (wid & 3), r32 = lane & 31, hh = lane >> 5;
#pragma unroll
      for (int r = 0; r < 16; ++r) { const int t = 32 * tb + crow(r, hh), io = dir ? 127 - t : t; YD[((size_t)dir * M + rowb + row0 + io) * 256 + h * 64 + 32 * vp + r32] = f2bf(res0[r]); } }
    const float sd = misc[0];
    SCAN_BAR_L();
    if (pm & 8) state_update<128, 64>(Km, Vw, Ss, st_acc, sd, wid, lane);
  }
#undef MAMBA_LOAD
  SCAN_BAR();
}

__device__ __forceinline__ void mlstm_chain(LAS char* lds, const bf16* __restrict__ P, const float* __restrict__ G, bf16* __restrict__ HC, int b, int h, int dir) {
  int tid_ = threadIdx.x; asm volatile("" : "+v"(tid_));
  const int tid = tid_, lane = tid & 63, wid = __builtin_amdgcn_readfirstlane(tid >> 6);
  LAS char* Qm = lds; LAS char* Km = lds + 16384; LAS char* Vm = lds + 32768; LAS char* Vw = lds + 57344; LAS char* Ss = lds + 81920;
  LAS float* rowexp = (LAS float*)(lds + 94208); LAS float* colexp = rowexp + 128; LAS float* isc = rowexp + 256; LAS float* vw = rowexp + 384; LAS float* emn = rowexp + 512; LAS float* den = rowexp + 640; LAS float* misc = rowexp + 768;
  for (int i = tid; i < 12288 / 4; i += 512) ((LAS unsigned*)Ss)[i] = 0u;
  f32x16 st_acc = {};
  float m_prev = 0.f;
  const size_t rowb = (size_t)b * RB;
  const int io = tid >> 2, part = tid & 3, i = dir ? 127 - io : io;
  u32x4 q0, q1, k0, k1, v0, v1; float ign[2] = {0.f, 0.f}, lfn[2] = {0.f, 0.f};
#define MLSTM_LOAD(cc_) do { int row0_, seg0_, seglen_; chunk_rows((cc_), dir, row0_, seg0_, seglen_); \
    const bf16* pr = P + (rowb + row0_ + io) * NP + h * 64 + part * 16; \
    q0 = *(const u32x4*)(pr + 1024); q1 = *(const u32x4*)(pr + 1024 + 8); k0 = *(const u32x4*)(pr + 1280); k1 = *(const u32x4*)(pr + 1280 + 8); v0 = *(const u32x4*)(pr + 1536); v1 = *(const u32x4*)(pr + 1536 + 8); \
    if (wid == 0) { _Pragma("unroll") for (int e = 0; e < 2; ++e) { const int ii = 2 * lane + e, ioo = dir ? 127 - ii : ii; const float* gr = G + (rowb + row0_ + ioo) * 32; ign[e] = gr[(2 * dir) * 4 + h]; lfn[e] = gr[(2 * dir + 1) * 4 + h]; } } } while (0)
  MLSTM_LOAD(0);
  SCAN_BAR();
#pragma unroll 1
  for (int cc = 0; cc < 34; ++cc) {
    int row0, seg0, seglen; chunk_rows(cc, dir, row0, seg0, seglen);
    if (wid == 0) {
      float bb[2], aa[2], mm[2];
      const float p1 = lfn[0] + lfn[1]; const float inc = wscan_add(p1, lane); const float exc = inc - p1;
      bb[0] = exc + lfn[0]; bb[1] = exc + p1; aa[0] = ign[0] - bb[0]; aa[1] = ign[1] - bb[1];
      const float q1m = fmaxf(aa[0], aa[1]); const float incm = wscan_max(q1m, lane); float excm = __shfl_up(incm, 1); if (lane == 0) excm = -INFINITY;
      mm[0] = fmaxf(m_prev, fmaxf(excm, aa[0])); mm[1] = fmaxf(m_prev, fmaxf(excm, q1m));
      const float b_end = __shfl(bb[1], 63), mm_end = __shfl(mm[1], 63);
#pragma unroll
      for (int e = 0; e < 2; ++e) { const int ii = 2 * lane + e; rowexp[ii] = -mm[e] * L2E; colexp[ii] = aa[e] * L2E; isc[ii] = __builtin_amdgcn_exp2f((m_prev - mm[e]) * L2E); emn[ii] = __builtin_amdgcn_exp2f(-(bb[e] + mm[e]) * L2E); vw[ii] = __builtin_amdgcn_exp2f((aa[e] - mm_end) * L2E); }
      if (lane == 0) misc[0] = __builtin_amdgcn_exp2f((m_prev - mm_end) * L2E);
      m_prev = b_end + mm_end;
    }
    SCAN_BAR_L();
    {
      const float s = vw[i];
      u32x4 qa, qb, va, vb;
#pragma unroll
      for (int e = 0; e < 4; ++e) { qa[e] = cvtpk(bf_lo(q0[e]) * 0.125f, bf_hi(q0[e]) * 0.125f); qb[e] = cvtpk(bf_lo(q1[e]) * 0.125f, bf_hi(q1[e]) * 0.125f);
        va[e] = cvtpk(bf_lo(v0[e]) * s, bf_hi(v0[e]) * s); vb[e] = cvtpk(bf_lo(v1[e]) * s, bf_hi(v1[e]) * s); }
      const int o0 = img_off<128>(i, part * 16), o1 = img_off<128>(i, part * 16 + 8);
      *(LAS u32x4*)(Qm + o0) = qa; *(LAS u32x4*)(Qm + o1) = qb; *(LAS u32x4*)(Km + o0) = k0; *(LAS u32x4*)(Km + o1) = k1;
      *(LAS u32x4*)(Vm + o0) = v0; *(LAS u32x4*)(Vm + o1) = v1; *(LAS u32x4*)(Vw + o0) = va; *(LAS u32x4*)(Vw + o1) = vb;
      const int o2 = img_off<128>(i, 64 + part * 8);
      const unsigned one = part == 0 ? 0x3f80u : 0u, wkb = part == 0 ? (cvtpk(s, 0.f) & 0xffffu) : 0u;
      *(LAS u32x4*)(Vm + o2) = (u32x4){one, 0u, 0u, 0u}; *(LAS u32x4*)(Vw + o2) = (u32x4){wkb, 0u, 0u, 0u};
    }
    SCAN_BAR_L();
    if (cc + 1 < 34) MLSTM_LOAD(cc + 1);
    f32x16 res0, res1; chunk_core<64, 96>(Qm, Km, Vm, Ss, rowexp, colexp, isc, res0, res1, wid, lane);
    const int vp = wid >> 2, tb = vp ? 3 - (wid & 3) : (wid & 3), r32 = lane & 31, hh = lane >> 5;
    if (vp == 0 && r32 == 0) {
#pragma unroll
      for (int r = 0; r < 16; ++r) den[32 * tb + crow(r, hh)] = res1[r];
    }
    const float sd = misc[0];
    float em[16];
#pragma unroll
    for (int r = 0; r < 16; ++r) em[r] = emn[32 * tb + crow(r, hh)];
    SCAN_BAR_L();
#pragma unroll
    for (int r = 0; r < 16; ++r) { const int t = 32 * tb + crow(r, hh), ioo = dir ? 127 - t : t; const float dn = fmaxf(fabsf(den[t]), em[r]);
      HC[((size_t)dir * M + rowb + row0 + ioo) * 256 + h * 64 + 32 * vp + r32] = f2bf(res0[r] / dn); }
    state_update<64, 96>(Km, Vw, Ss, st_acc, sd, wid, lane);
  }
#undef MLSTM_LOAD
  SCAN_BAR();
}
#undef MFMA32
}
namespace pg8 {
typedef float f32x4e __attribute__((ext_vector_type(4)));
struct EpiInProj {
    static constexpr bool PERM = true, AFTER_DRAIN = false;
    bf16_t* O; float* G;
    __device__ __forceinline__ void operator()(const f32x4 (&acc)[2][2][4][2], const Unit& u, int wr, int wc, int fr, int fq) const {
        const int row0 = u.pm * BM + wr * 64 + fr, col0 = u.pn * BM + wc * 32 + 8 * fq;
#pragma unroll
        for (int ai = 0; ai < 2; ++ai)
#pragma unroll
            for (int m = 0; m < 4; ++m) { bf16_t* rowp = O + (size_t)(row0 + ai * HALF + m * 16) * 3328 + col0;
#pragma unroll
                for (int bj = 0; bj < 2; ++bj) { const f32x4 v0 = acc[ai][bj][m][0], v1 = acc[ai][bj][m][1];
                    u32x4 w; w.x = cvt_pk_bf16(v0[0], v0[1]); w.y = cvt_pk_bf16(v0[2], v0[3]); w.z = cvt_pk_bf16(v1[0], v1[1]); w.w = cvt_pk_bf16(v1[2], v1[3]);
                    *(u32x4*)(rowp + bj * HALF) = w; } }
        if (u.pn == 12 && wc == 0) {
#pragma unroll
            for (int ai = 0; ai < 2; ++ai)
#pragma unroll
                for (int m = 0; m < 4; ++m) { float* gp = G + (size_t)(row0 + ai * HALF + m * 16) * 32 + 8 * fq; *(f32x4*)gp = acc[ai][0][m][0]; *(f32x4*)(gp + 4) = acc[ai][0][m][1]; }
        }
    }
};
struct EpiRelu2 {
    static constexpr bool PERM = true, AFTER_DRAIN = false;
    bf16_t* O;
    __device__ __forceinline__ void operator()(const f32x4 (&acc)[2][2][4][2], const Unit& u, int wr, int wc, int fr, int fq) const {
        const int row0 = u.pm * BM + wr * 64 + fr, col0 = u.pn * BM + wc * 32 + 8 * fq;
#pragma unroll
        for (int ai = 0; ai < 2; ++ai)
#pragma unroll
            for (int m = 0; m < 4; ++m) { bf16_t* rowp = O + (size_t)(row0 + ai * HALF + m * 16) * 4096 + col0;
#pragma unroll
                for (int bj = 0; bj < 2; ++bj) { f32x4 v0 = acc[ai][bj][m][0], v1 = acc[ai][bj][m][1];
#pragma unroll
                    for (int e = 0; e < 4; ++e) { const float a = v0[e] > 0.f ? v0[e] : 0.f, b = v1[e] > 0.f ? v1[e] : 0.f; v0[e] = a * a; v1[e] = b * b; }
                    u32x4 w; w.x = cvt_pk_bf16(v0[0], v0[1]); w.y = cvt_pk_bf16(v0[2], v0[3]); w.z = cvt_pk_bf16(v1[0], v1[1]); w.w = cvt_pk_bf16(v1[2], v1[3]);
                    *(u32x4*)(rowp + bj * HALF) = w; } }
    }
};
struct EpiResid {
    static constexpr bool PERM = false, AFTER_DRAIN = false;
    const float* xin_lat; float* xout_lat; const float* mod; int gate_off; float gsign;
    __device__ __forceinline__ void operator()(const f32x4 (&acc)[2][2][4][2], const Unit& u, int wr, int wc, int fr, int fq) const {
        const int b = u.pm / 17, tp = u.pm % 17;
        const size_t o = ((size_t)b * 4096 + (size_t)(tp - 1) * 256) * 1024; const float* xin = xin_lat + o; float* xout = xout_lat + o; const float* gate = mod + b * 6144 + gate_off;
        const int col0 = u.pn * BM + wc * 32 + 4 * fq;
#pragma unroll
        for (int bj = 0; bj < 2; ++bj)
#pragma unroll
            for (int n = 0; n < 2; ++n) { const int cc = col0 + bj * HALF + n * 16; const f32x4 gv = *(const f32x4*)(gate + cc) * gsign;
#pragma unroll
                for (int ai = 0; ai < 2; ++ai)
#pragma unroll
                    for (int m = 0; m < 4; ++m) { const size_t off = (size_t)(ai * HALF + wr * 64 + m * 16 + fr) * 1024 + cc; const f32x4 bs = *(const f32x4*)(xin + off); *(f32x4*)(xout + off) = bs + gv * acc[ai][bj][m][n]; }
                asm volatile("" ::: "memory"); }
    }
};
struct EpiSlab {
    static constexpr bool PERM = false, AFTER_DRAIN = false;
    float* slab;
    __device__ __forceinline__ void operator()(const f32x4 (&acc)[2][2][4][2], const Unit& u, int wr, int wc, int fr, int fq) const {
#pragma unroll
        for (int ai = 0; ai < 2; ++ai)
#pragma unroll
            for (int m = 0; m < 4; ++m) { float* rp = slab + (size_t)(ai * HALF + wr * 64 + m * 16 + fr) * 256 + wc * 32 + 4 * fq;
#pragma unroll
                for (int bj = 0; bj < 2; ++bj)
#pragma unroll
                    for (int n = 0; n < 2; ++n) *(f32x4*)(rp + bj * HALF + n * 16) = acc[ai][bj][m][n]; }
    }
};
struct OneUnit {
    Unit u;
    __device__ __forceinline__ bool next(int i, Unit& o) const { if (i != 0) return false; o = u; return true; }
    __device__ __forceinline__ void a_ready(const Unit&) const {}
    __device__ __forceinline__ void done(const Unit&) const {}
};
struct LatentOrder {
    StaticOrder base;
    __host__ __device__ void init(int N, int G_, int c_) { base.init(128 * 256, N, G_, c_); }
    __device__ __forceinline__ bool next(int i, Unit& u) const { if (!base.next(i, u)) return false; u.pm = (u.pm >> 4) * 17 + 1 + (u.pm & 15); return true; }
    __device__ __forceinline__ void a_ready(const Unit&) const {}
    __device__ __forceinline__ void done(const Unit&) const {}
};
}

namespace mk {
constexpr int NWAVES = 8;
constexpr int RING_OFF = 0, RING_BYTES = 131072, LDSCTL_OFF = RING_BYTES, MISC_OFF = LDSCTL_OFF + 320, LDS_BYTES = 147456;
#define RLX_AGENT __ATOMIC_RELAXED, __HIP_MEMORY_SCOPE_AGENT

struct Args {
  const float* in[25]; float* out; unsigned char* ws; int ph_lo, ph_hi, n_layers, use_cg; int rep[12];
};
enum { I_X = 0, I_C, I_CTX, I_CCTX, I_WADA, I_BADA, I_GN1, I_GN2, I_WIN, I_SINK, I_GQ, I_GK, I_BI, I_BF, I_GML, I_CW, I_CB, I_ALOG, I_DTB, I_DSK, I_GSSM, I_WOUT, I_W1, I_W2, I_GFIN };

template <class F> __device__ __forceinline__ void transpose_item(const float* W, int K, int N, bf16* WT, LAS float* scr, int item, int nblk, int lane, F srccol) {
  const int kb = item / nblk, nb = item % nblk, k0 = 64 * kb, n0 = 32 * nb;
  const int sc = srccol(n0 + (lane & 31));
#pragma unroll 8
  for (int i = 0; i < 32; ++i) { const int kk = 2 * i + (lane >> 5); scr[kk * 33 + (lane & 31)] = sc >= 0 ? W[(size_t)(k0 + kk) * N + sc] : 0.f; }
  asm volatile("s_waitcnt lgkmcnt(0)" ::: "memory");
  const int c = lane & 7;
#pragma unroll
  for (int j = 0; j < 4; ++j) { const int n = (lane >> 3) + 8 * j; const LAS float* s = scr + (8 * c) * 33 + n;
    u32x4 o; o.x = cvtpk(s[0 * 33], s[1 * 33]); o.y = cvtpk(s[2 * 33], s[3 * 33]); o.z = cvtpk(s[4 * 33], s[5 * 33]); o.w = cvtpk(s[6 * 33], s[7 * 33]);
    *(u32x4*)(WT + (size_t)(n0 + n) * K + k0 + 8 * c) = o; }
  asm volatile("s_waitcnt lgkmcnt(0)" ::: "memory");
}
__device__ __forceinline__ int win_srccol(int n) { return n < 2048 ? n : (n < 3072 ? n + 16 : (n < 3088 ? n - 1024 : (n < 3096 ? n : -1))); }

__device__ __forceinline__ void norm_row(const float* xrow, const float* g, const float* shv, const float* scv, bf16* orow, int lane, const float* slab = nullptr, const float* gate = nullptr, float* xout = nullptr) {
  const f32x4* xr = (const f32x4*)xrow + lane; f32x4 v[4]; float s = 0.f;
#pragma unroll
  for (int j = 0; j < 4; ++j) v[j] = xr[64 * j];
  if (slab) {
#pragma unroll
    for (int j = 0; j < 4; ++j) { f32x4 a = {0.f, 0.f, 0.f, 0.f};
#pragma unroll
      for (int ks = 0; ks < 8; ++ks) a += *(const f32x4*)(slab + (size_t)(j * 8 + ks) * 65536 + 4 * lane);
      v[j] += ((const f32x4*)gate)[64 * j + lane] * a; if (xout) ((f32x4*)xout)[64 * j + lane] = v[j]; }
  }
#pragma unroll
  for (int j = 0; j < 4; ++j) s += (v[j].x * v[j].x + v[j].y * v[j].y) + (v[j].z * v[j].z + v[j].w * v[j].w);
  const float rs = rsqrtf(wave_sum(s) * (1.f / DM) + EPS);
  unsigned long long* o8 = (unsigned long long*)orow + lane;
#pragma unroll
  for (int j = 0; j < 4; ++j) { const f32x4 gg = ((const f32x4*)g)[64 * j + lane], sh = ((const f32x4*)shv)[64 * j + lane], sc = ((const f32x4*)scv)[64 * j + lane];
    const f32x4 y = v[j] * rs * gg * (sc + 1.f) + sh;
    o8[64 * j] = (unsigned long long)cvtpk(y.x, y.y) | ((unsigned long long)cvtpk(y.z, y.w) << 32); }
}

__device__ __forceinline__ void attn_item(int idx, const bf16* P, bf16* Y, const float* sink, char* shm) {
  using attn_body::attn_unit; typedef attn_body::bf16 abf;
  bool isA; int b, hq, qrow, NT, band_row0 = 0, qpos0 = 0, band_s0 = 0;
  if (idx < 1024) { isA = idx >= 512; const int id = idx & 511; b = id >> 6; hq = (id >> 4) & 3; const int q0 = (id & 15) * 256; qrow = NC + q0; NT = 68;
    if (isA) { const int s_lo = q0 - 128 > 0 ? q0 - 128 : 0, s_hi = q0 + 384 < T ? q0 + 384 : T; NT = 4 + (s_hi - s_lo) / 64; band_row0 = NC + s_lo; qpos0 = q0; band_s0 = s_lo; } }
  else { const int id = idx - 1024; isA = id >= 32; b = (id & 31) >> 2; hq = id & 3; qrow = 0; NT = 4; }
  const int g = hq >> 1; const size_t rowb = (size_t)b * RB; const int cq = isA ? 0 : 512, ck = isA ? 256 : 768, cv = isA ? 384 : 896, cy = isA ? 0 : 256;
  const abf* Q0 = (const abf*)(P + (rowb + qrow) * NP + cq + hq * 64); const abf* Kh = (const abf*)(P + rowb * NP + ck + g * 64); const abf* Vh = (const abf*)(P + rowb * NP + cv + g * 64);
  abf* O0 = (abf*)(Y + (rowb + qrow) * DM + cy + hq * 64);
#ifndef MK_NO_B
  if (!isA) attn_unit<8, 0>(Q0, Kh, Vh, O0, NT, 0, 0, 0, 0.f, shm);
#endif
#ifndef MK_NO_A
  if (isA) attn_unit<8, 1>(Q0, Kh, Vh, O0, NT, band_row0, qpos0, band_s0, sink[hq] * L2E, shm);
#endif
}

__global__ void __launch_bounds__(NWAVES * 64, 2) mk_fwd(Args args) {
  extern __shared__ __attribute__((aligned(16))) unsigned char lds_raw[];
  LAS unsigned char* lds = (LAS unsigned char*)lds_raw;
  volatile LAS unsigned* MISC = (volatile LAS unsigned*)(lds + MISC_OFF);
  const int tid0 = threadIdx.x, wave = __builtin_amdgcn_readfirstlane(tid0 >> 6);
  for (int u = tid0; u < (LDS_BYTES - LDSCTL_OFF) / 4; u += NWAVES * 64) ((LAS unsigned*)(lds + LDSCTL_OFF))[u] = 0u;
  __syncthreads();
  if (tid0 < 25) ((volatile LAS unsigned long long*)(lds + MISC_OFF + 256))[tid0] = (unsigned long long)(uintptr_t)args.in[tid0];
  __syncthreads();
  XcdBarrier bar = xcd_barrier_post(((unsigned*)(args.ws + WS_CTL)) + CW_BAR, MISC + 8);
#ifndef MK_PHSEL
#define MK_PHSEL 0xFFFF
#endif
#ifndef MK_PROBE_NOCHAIN
#define MK_PROBE_NOCHAIN 0
#endif
#ifndef MK_PROBE_PM
#define MK_PROBE_PM 15
#endif
#ifndef MK_PROBE_NOATTN
#define MK_PROBE_NOATTN 0
#endif
#ifndef MK_PROBE_NOMAMBA
#define MK_PROBE_NOMAMBA 0
#endif
#ifndef MK_PROBE_NOMLSTM
#define MK_PROBE_NOMLSTM 0
#endif
#define AIN(k) ((const float*)(GAS const float*)(uintptr_t)(((unsigned long long)(unsigned)__builtin_amdgcn_readfirstlane((int)MISC[64 + 2 * (k) + 1]) << 32) | (unsigned long long)(unsigned)__builtin_amdgcn_readfirstlane((int)MISC[64 + 2 * (k)])))
#define PH_PROLOG int tid = threadIdx.x; asm volatile("" : "+v"(tid)); const int lane = tid & 63; (void)lane; int bx_ = blockIdx.x, G_ = gridDim.x; if (kind != 0) asm volatile("" : "+s"(bx_), "+s"(G_)); const int bx = bx_, G = G_, vcu = (G % 8 == 0) ? (bx % 8) * (G / 8) + bx / 8 : bx, gw = vcu * NWAVES + wave, NGW = G * NWAVES; (void)gw; (void)NGW; (void)vcu; GAS unsigned char* wsg_ = (GAS unsigned char*)args.ws; asm volatile("" : "+s"(wsg_)); unsigned char* wsp = (unsigned char*)wsg_;

  const int nph = 1 + 9 * args.n_layers + 1;
#pragma unroll 1
  for (int ph = args.ph_lo; ph < args.ph_hi; ++ph) {
  int kind, l = 0;
  if (ph == 0) kind = 0; else if (ph == nph - 1) kind = 10; else { l = (ph - 1) / 9; kind = 1 + (ph - 1) % 9; }
  const int nrep = args.rep[kind];
  if (kind == 0) { PH_PROLOG if ((MK_PHSEL >> 0) & 1) for (int rp = 0; rp < nrep; ++rp) {
    {
      if (vcu < 192) {
        LAS float* sc = (LAS float*)(lds + RING_OFF);
        LAS float* red = (LAS float*)(lds + RING_OFF + 36864);
        for (int i = tid; i < 9 * DM; i += NWAVES * 64) { const int j = i / DM, k = i % DM; const float v = j < 8 ? AIN(I_C)[j * DM + k] : AIN(I_CCTX)[k]; sc[i] = v / (1.f + __expf(-v)); }
        __syncthreads();
        const int col = vcu * 64 + lane, l = col / 6144, n = col % 6144; const float* w = AIN(I_WADA) + (size_t)l * DM * 6144 + n + (size_t)(wave * 128) * 6144;
        float acc[9];
#pragma unroll
        for (int j = 0; j < 9; ++j) acc[j] = 0.f;
#pragma unroll 1
        for (int k0 = 0; k0 < 128; k0 += 8) { float wv[8];
#pragma unroll
          for (int u = 0; u < 8; ++u) wv[u] = w[(size_t)(k0 + u) * 6144];
#pragma unroll
          for (int u = 0; u < 8; ++u)
#pragma unroll
            for (int j = 0; j < 9; ++j) acc[j] += sc[j * DM + wave * 128 + k0 + u] * wv[u]; }
#pragma unroll
        for (int j = 0; j < 9; ++j) red[(wave * 9 + j) * 64 + lane] = acc[j];
        __syncthreads();
        if (wave == 0) { const float bb = AIN(I_BADA)[l * 6144 + n];
#pragma unroll
          for (int j = 0; j < 9; ++j) { float sum = bb;
#pragma unroll
            for (int wv_ = 0; wv_ < 8; ++wv_) sum += red[(wv_ * 9 + j) * 64 + lane];
            ((float*)(wsp + WS_MOD))[(size_t)(l * 9 + j) * 6144 + n] = sum; } }
        __syncthreads();
      }
      for (int i = gw * 64 + lane; i < T * 32; i += NGW * 64) { const int t = i >> 5, e = i & 31, fi = e & 15; const float invf = __builtin_amdgcn_exp2f(-(float)fi * (13.287712379549449f / 16.f));
        const float ang = (float)(e < 16 ? (t >> 6) : (t & 63)) * invf; ((float*)(wsp + WS_CS))[i] = __cosf(ang); ((float*)(wsp + WS_CS))[T * 32 + i] = __sinf(ang); }
      LAS float* scr = (LAS float*)(lds + RING_OFF + 57344 + wave * 8704);
      constexpr int I_IN = 16 * 104, I_OUT = 16 * 32, I_1 = 16 * 128, I_2 = 64 * 32, I_L = I_IN + I_OUT + I_1 + I_2;
      for (int it = gw; it < 2 * I_L; it += NGW) {
        const int l = it / I_L; int r = it % I_L; unsigned char* wl = (wsp) + WS_W + (size_t)l * W_LAYER;
        if (r < I_IN) { transpose_item(AIN(I_WIN) + (size_t)l * DM * NINO, DM, NINO, (bf16*)(wl + WO_IN), scr, r, 104, lane, [](int n) { return win_srccol(n); }); continue; } r -= I_IN;
        if (r < I_OUT) { transpose_item(AIN(I_WOUT) + (size_t)l * DM * DM, DM, DM, (bf16*)(wl + WO_OUT), scr, r, 32, lane, [](int n) { return n; }); continue; } r -= I_OUT;
        if (r < I_1) { transpose_item(AIN(I_W1) + (size_t)l * DM * DFF, DM, DFF, (bf16*)(wl + WO_1), scr, r, 128, lane, [](int n) { return n; }); continue; } r -= I_1;
        transpose_item(AIN(I_W2) + (size_t)l * DFF * DM, DFF, DM, (bf16*)(wl + WO_2), scr, r, 32, lane, [](int n) { return n; });
      }
    }
  } }

  {
    if (kind == 1) { PH_PROLOG if ((MK_PHSEL >> 1) & 1) for (int rp = 0; rp < nrep; ++rp) {
      for (int m = gw; m < M; m += NGW) { const int b = m / RB, r = m % RB; const bool isc = r < NC;
        const float* xr = isc ? (l == 0 ? AIN(I_CTX) : (const float*)(wsp + WS_XC)) + ctx_off(b, r) : (l == 0 ? AIN(I_X) : (const float*)args.out) + lat_off(b, r - NC); const float* mr = (((float*)(wsp + WS_MOD)) + (size_t)l * 9 * 6144) + (isc ? 8 : b) * 6144;
        const bool sl = isc && l == 1;
        norm_row(xr, AIN(I_GN1) + l * DM, mr, mr + 1024, ((bf16*)(wsp + WS_H)) + (size_t)m * DM, lane, sl ? ((const float*)(wsp + WS_SLAB)) + (size_t)(b * 32) * 65536 + (size_t)r * 256 : nullptr, ((const float*)(wsp + WS_MOD)) + 8 * 6144 + 5120, nullptr); }
    } }
    if (kind == 2) { PH_PROLOG if ((MK_PHSEL >> 2) & 1) for (int rp = 0; rp < nrep; ++rp) {
      { pg8::Gemm g{((bf16*)(wsp + WS_H)), (const bf16*)((wsp + WS_W + (size_t)l * W_LAYER) + WO_IN), M, NP, DM, DM}; pg8::StaticOrder S; S.init(M, NP, G, bx);
        pg8::EpiInProj E{((bf16*)(wsp + WS_P)), ((float*)(wsp + WS_G))}; pg8::gemm_phase<pg8::EpiInProj, pg8::StaticOrder, true, true>(lds + RING_OFF, g, S, E); }
    } }
    if (kind == 3) { PH_PROLOG if ((MK_PHSEL >> 3) & 1) for (int rp = 0; rp < nrep; ++rp) {
      { const float* gq = AIN(I_GQ) + l * 64; const float* gk = AIN(I_GK) + l * 64; const float* cw = AIN(I_CW) + l * 3 * 768; const float* cb = AIN(I_CB) + l * 768;
        bf16* Pq = ((bf16*)(wsp + WS_P)); bf16* UCb = ((bf16*)(wsp + WS_UC)); float* Gp = ((float*)(wsp + WS_G)); const float* cst = ((const float*)(wsp + WS_CS));
        const int hw = 2 * gw + (lane >> 5), l32 = lane & 31, which = hw % 3, j = l32 & 7, slot = 4 * which + (l32 >> 3);
        const int blk = slot < 6 ? slot : slot + 2;
        const bool isq = slot < 4 || (slot >= 6 && slot < 10), isB = slot >= 6;
        const float* gv = isq ? gq : gk; float gn[8];
#pragma unroll
        for (int e = 0; e < 8; ++e) gn[e] = gv[8 * j + e];
        const int cch = 256 * which + 8 * l32, pcol = (which == 0 ? 2048 : (which == 1 ? 2560 : 2816)) + 8 * l32;
        f32x4 w0[2], w1[2], w2[2], bb[2];
#pragma unroll
        for (int q = 0; q < 2; ++q) { w0[q] = *(const f32x4*)(cw + cch + 4 * q); w1[q] = *(const f32x4*)(cw + 768 + cch + 4 * q); w2[q] = *(const f32x4*)(cw + 1536 + cch + 4 * q); bb[q] = *(const f32x4*)(cb + cch + 4 * q); }
        const float bgate = l32 < 16 ? (((l32 >> 2) & 1) ? AIN(I_BF)[l * 8 + (l32 >> 3) * 4 + (l32 & 3)] : AIN(I_BI)[l * 8 + (l32 >> 3) * 4 + (l32 & 3)]) : (l32 < 24 ? AIN(I_DTB)[l * 8 + (l32 - 16)] : 0.f);
        if (hw < 4095)
        for (int m = hw / 3; m < M; m += 1365) { const int r = m % RB;
          { bf16* p = Pq + (size_t)m * NP + blk * 64 + 8 * j; const u32x4 w = *(const u32x4*)p; float x[8] = {bf_lo(w.x), bf_hi(w.x), bf_lo(w.y), bf_hi(w.y), bf_lo(w.z), bf_hi(w.z), bf_lo(w.w), bf_hi(w.w)};
            if (isB) { float ss = 0.f;
#pragma unroll
              for (int e = 0; e < 8; ++e) ss += x[e] * x[e];
              ss += __shfl_xor(ss, 1); ss += __shfl_xor(ss, 2); ss += __shfl_xor(ss, 4); const float rs = rsqrtf(ss * (1.f / 64.f) + EPS);
#pragma unroll
              for (int e = 0; e < 8; ++e) x[e] = x[e] * rs * gn[e]; }
            if (r >= NC) { const int t = r - NC; const float* cp = cst + t * 32 + (j >> 2) * 16 + (j & 1) * 8; const f32x4 c0 = *(const f32x4*)cp, c1 = *(const f32x4*)(cp + 4), s0 = *(const f32x4*)(cp + T * 32), s1 = *(const f32x4*)(cp + T * 32 + 4);
              const float cc[8] = {c0[0], c0[1], c0[2], c0[3], c1[0], c1[1], c1[2], c1[3]}, sn[8] = {s0[0], s0[1], s0[2], s0[3], s1[0], s1[1], s1[2], s1[3]};
#pragma unroll
              for (int e = 0; e < 8; ++e) { const float other = __shfl_xor(x[e], 2); x[e] = (j & 2) ? x[e] * cc[e] + other * sn[e] : x[e] * cc[e] - other * sn[e]; } }
            if (isq) {
#pragma unroll
              for (int e = 0; e < 8; ++e) x[e] *= QC2; }
            *(u32x4*)p = (u32x4){cvtpk(x[0], x[1]), cvtpk(x[2], x[3]), cvtpk(x[4], x[5]), cvtpk(x[6], x[7])}; }
          { const int seg0 = r < NC ? 0 : NC, seglen = r < NC ? NC : T, sl = r - seg0; const bf16* px = Pq + (size_t)m * NP + pcol; const u32x4 z4 = {0u, 0u, 0u, 0u};
            const u32x4 xm = sl > 0 ? *(const u32x4*)(px - NP) : z4, x0 = *(const u32x4*)px, xp = sl + 1 < seglen ? *(const u32x4*)(px + NP) : z4; float u[8];
#pragma unroll
            for (int e = 0; e < 4; ++e) { const int q = e >> 1, o = (e & 1) * 2;
              const float y0 = bb[q][o] + w0[q][o] * bf_lo(xm[e]) + w1[q][o] * bf_lo(x0[e]) + w2[q][o] * bf_lo(xp[e]);
              const float y1 = bb[q][o + 1] + w0[q][o + 1] * bf_hi(xm[e]) + w1[q][o + 1] * bf_hi(x0[e]) + w2[q][o + 1] * bf_hi(xp[e]);
              u[2 * e] = y0 / (1.f + __expf(-y0)); u[2 * e + 1] = y1 / (1.f + __expf(-y1)); }
            *(u32x4*)(UCb + (size_t)m * 768 + cch) = (u32x4){cvtpk(u[0], u[1]), cvtpk(u[2], u[3]), cvtpk(u[4], u[5]), cvtpk(u[6], u[7])}; }
          if (which == 0 && l32 < 24) { float* gp = Gp + (size_t)m * 32 + l32; const float v = *gp + bgate; float o;
            if (l32 < 16) o = ((l32 >> 2) & 1) ? fminf(v, 0.f) - __logf(1.f + __expf(-fabsf(v))) : v; else o = v > 20.f ? v : __logf(1.f + __expf(v));
            *gp = o; }
        } }
    } }
    if (kind == 4) { PH_PROLOG if ((MK_PHSEL >> 4) & 1) for (int rp = 0; rp < nrep; ++rp) {
      {
#ifndef MK_NO_MAMBA
        if (bx < 64 && (rp == 0 || !(MK_PROBE_NOCHAIN || MK_PROBE_NOMAMBA))) scan::mamba_chain((LAS char*)lds, ((bf16*)(wsp + WS_UC)), ((float*)(wsp + WS_G)), AIN(I_ALOG) + l * 8, ((bf16*)(wsp + WS_YD)), bx >> 3, (bx >> 1) & 3, bx & 1, rp == 0 ? 15 : MK_PROBE_PM);
#endif
#ifndef MK_NO_MLSTM
        if (bx >= 64 && bx < 128 && (rp == 0 || !(MK_PROBE_NOCHAIN || MK_PROBE_NOMLSTM))) { const int c = bx - 64; scan::mlstm_chain((LAS char*)lds, ((bf16*)(wsp + WS_P)), ((float*)(wsp + WS_G)), ((bf16*)(wsp + WS_HC)), c >> 3, (c >> 1) & 3, c & 1); }
#endif
        const int nunits = (l == 1) ? 1024 : 1088;
        if (rp == 0 || !MK_PROBE_NOATTN)
        for (;;) {
          if (tid == 0) MISC[16] = __hip_atomic_fetch_add(((unsigned*)(wsp + WS_CTL)) + CW_QUEUE + 64 * (l * 4 + rp), 1u, RLX_AGENT);
          __syncthreads(); const int idx = __builtin_amdgcn_readfirstlane((int)MISC[16]); __syncthreads();
          if (idx >= nunits) break;
          attn_item(idx, ((bf16*)(wsp + WS_P)), ((bf16*)(wsp + WS_Y)), AIN(I_SINK) + l * 4, (char*)lds_raw + RING_OFF);
        } }
    } }
    if (kind == 5) { PH_PROLOG if ((MK_PHSEL >> 5) & 1) for (int rp = 0; rp < nrep; ++rp) {
      { const float* gml = AIN(I_GML) + l * 256; const float* gss = AIN(I_GSSM) + l * 256; const float* dsk = AIN(I_DSK) + l * 4;
        for (int m = gw; m < M; m += NGW) { const int r = m % RB; if ((l == 1) && r < NC) continue;
          const int c0 = 4 * lane;
          { const u32x2 a = *(const u32x2*)(((bf16*)(wsp + WS_HC)) + (size_t)m * 256 + c0), bq = *(const u32x2*)(((bf16*)(wsp + WS_HC)) + ((size_t)M + m) * 256 + c0);
            float hs[4] = {bf_lo(a.x) + bf_lo(bq.x), bf_hi(a.x) + bf_hi(bq.x), bf_lo(a.y) + bf_lo(bq.y), bf_hi(a.y) + bf_hi(bq.y)};
            float ss = hs[0] * hs[0] + hs[1] * hs[1] + hs[2] * hs[2] + hs[3] * hs[3];
            ss += __shfl_xor(ss, 1); ss += __shfl_xor(ss, 2); ss += __shfl_xor(ss, 4); ss += __shfl_xor(ss, 8);
            const float rs = rsqrtf(ss * (1.f / 64.f) + EPS); const u32x2 ow = *(const u32x2*)(((bf16*)(wsp + WS_P)) + (size_t)m * NP + 1792 + c0); const f32x4 gg = *(const f32x4*)(gml + c0);
            const float o4[4] = {bf_lo(ow.x), bf_hi(ow.x), bf_lo(ow.y), bf_hi(ow.y)}; float y[4];
#pragma unroll
            for (int e = 0; e < 4; ++e) y[e] = hs[e] * rs * gg[e] / (1.f + __expf(-o4[e]));
            *(u32x2*)(((bf16*)(wsp + WS_Y)) + (size_t)m * DM + 512 + c0) = (u32x2){cvtpk(y[0], y[1]), cvtpk(y[2], y[3])}; }
          { const u32x2 a = *(const u32x2*)(((bf16*)(wsp + WS_YD)) + (size_t)m * 256 + c0), bq = *(const u32x2*)(((bf16*)(wsp + WS_YD)) + ((size_t)M + m) * 256 + c0);
            const u32x2 xw = *(const u32x2*)(((bf16*)(wsp + WS_UC)) + (size_t)m * 768 + c0); const float xs4[4] = {bf_lo(xw.x), bf_hi(xw.x), bf_lo(xw.y), bf_hi(xw.y)};
            const u32x2 zw = *(const u32x2*)(((bf16*)(wsp + WS_P)) + (size_t)m * NP + 2304 + c0); const float z4[4] = {bf_lo(zw.x), bf_hi(zw.x), bf_lo(zw.y), bf_hi(zw.y)};
            const float ys[4] = {bf_lo(a.x) + bf_lo(bq.x), bf_hi(a.x) + bf_hi(bq.x), bf_lo(a.y) + bf_lo(bq.y), bf_hi(a.y) + bf_hi(bq.y)};
            const float dk = dsk[lane >> 4]; float v[4]; float ss = 0.f;
#pragma unroll
            for (int e = 0; e < 4; ++e) { v[e] = (ys[e] + dk * xs4[e]) * (z4[e] / (1.f + __expf(-z4[e]))); ss += v[e] * v[e]; }
            const float rs = rsqrtf(wave_sum(ss) * (1.f / 256.f) + EPS); const f32x4 gg = *(const f32x4*)(gss + c0);
            *(u32x2*)(((bf16*)(wsp + WS_Y)) + (size_t)m * DM + 768 + c0) = (u32x2){cvtpk(v[0] * rs * gg[0], v[1] * rs * gg[1]), cvtpk(v[2] * rs * gg[2], v[3] * rs * gg[3])}; }
        } }
    } }
    if (kind == 6) { PH_PROLOG if ((MK_PHSEL >> 6) & 1) for (int rp = 0; rp < nrep; ++rp) {
      { pg8::Gemm g{((bf16*)(wsp + WS_Y)), (const bf16*)((wsp + WS_W + (size_t)l * W_LAYER) + WO_OUT), M, DM, DM, DM}; pg8::EpiResid E{(l == 0 ? AIN(I_X) : (const float*)args.out), (args.out), (((float*)(wsp + WS_MOD)) + (size_t)l * 9 * 6144), 2048, (rp & 1) ? -1.f : 1.f};
        { pg8::LatentOrder S; S.init(DM, G, bx); pg8::gemm_phase<pg8::EpiResid, pg8::LatentOrder, true, true>(lds + RING_OFF, g, S, E); }
        if (l == 0) for (int sid = bx; sid < 256; sid += G) {
          const int un = sid >> 3, ks = sid & 7; pg8::Gemm gs{g.A + 128 * ks, g.Bt + 128 * ks, M, DM, 128, DM}; pg8::OneUnit S1{{(un >> 2) * 17, un & 3}}; pg8::EpiSlab ES{((float*)(wsp + WS_SLAB)) + (size_t)sid * 65536};
          pg8::gemm_phase<pg8::EpiSlab, pg8::OneUnit, true, true>(lds + RING_OFF, gs, S1, ES); } }
    } }
    if (kind == 7) { PH_PROLOG if ((MK_PHSEL >> 7) & 1) for (int rp = 0; rp < nrep; ++rp) {
      for (int m = gw; m < M; m += NGW) { const int b = m / RB, r = m % RB; const bool isc = r < NC; if ((l == 1) && isc) continue;
        const float* xr = isc ? ((float*)(wsp + WS_XC)) + ctx_off(b, r) : (args.out) + lat_off(b, r - NC); const float* mr = (((float*)(wsp + WS_MOD)) + (size_t)l * 9 * 6144) + (isc ? 8 : b) * 6144;
        const bool sl = isc && l == 0;
        norm_row(sl ? AIN(I_CTX) + ctx_off(b, r) : xr, AIN(I_GN2) + l * DM, mr + 3072, mr + 4096, ((bf16*)(wsp + WS_H)) + (size_t)m * DM, lane, sl ? ((const float*)(wsp + WS_SLAB)) + (size_t)(b * 32) * 65536 + (size_t)r * 256 : nullptr, mr + 2048, sl ? ((float*)(wsp + WS_XC)) + ctx_off(b, r) : nullptr); }
    } }
    if (kind == 8) { PH_PROLOG if ((MK_PHSEL >> 8) & 1) for (int rp = 0; rp < nrep; ++rp) {
      { pg8::Gemm g{((bf16*)(wsp + WS_H)), (const bf16*)((wsp + WS_W + (size_t)l * W_LAYER) + WO_1), M, DFF, DM, DM}; pg8::EpiRelu2 E{((bf16*)(wsp + WS_U))};
        if (!(l == 1)) { pg8::StaticOrder S; S.init(M, DFF, G, bx); pg8::gemm_phase<pg8::EpiRelu2, pg8::StaticOrder, true, true>(lds + RING_OFF, g, S, E); }
        else { pg8::LatentOrder S; S.init(DFF, G, bx); pg8::gemm_phase<pg8::EpiRelu2, pg8::LatentOrder, true, true>(lds + RING_OFF, g, S, E); } }
    } }
    if (kind == 9) { PH_PROLOG if ((MK_PHSEL >> 9) & 1) for (int rp = 0; rp < nrep; ++rp) {
      { pg8::Gemm g{((bf16*)(wsp + WS_U)), (const bf16*)((wsp + WS_W + (size_t)l * W_LAYER) + WO_2), M, DM, DFF, DFF}; pg8::EpiResid E{(args.out), (args.out), (((float*)(wsp + WS_MOD)) + (size_t)l * 9 * 6144), 5120, (rp & 1) ? -1.f : 1.f};
        { pg8::LatentOrder S; S.init(DM, G, bx); pg8::gemm_phase<pg8::EpiResid, pg8::LatentOrder, true, true>(lds + RING_OFF, g, S, E); }
        if (l == 0) for (int sid = bx; sid < 256; sid += G) {
          const int un = sid >> 3, ks = sid & 7; pg8::Gemm gs{g.A + 512 * ks, g.Bt + 512 * ks, M, DM, 512, DFF}; pg8::OneUnit S1{{(un >> 2) * 17, un & 3}}; pg8::EpiSlab ES{((float*)(wsp + WS_SLAB)) + (size_t)sid * 65536};
          pg8::gemm_phase<pg8::EpiSlab, pg8::OneUnit, true, true>(lds + RING_OFF, gs, S1, ES); } }
    } }
  }
  if (kind == 10) { PH_PROLOG if ((MK_PHSEL >> 10) & 1) for (int rp = 0; rp < nrep; ++rp) {
    { const float* gf = AIN(I_GFIN);
      for (int m = gw; m < NB * T; m += NGW) { f32x4* xr = (f32x4*)((args.out) + (size_t)m * DM) + lane; f32x4 v[4]; float s = 0.f;
#pragma unroll
        for (int j = 0; j < 4; ++j) { v[j] = xr[64 * j]; s += (v[j].x * v[j].x + v[j].y * v[j].y) + (v[j].z * v[j].z + v[j].w * v[j].w); }
        const float rs = rsqrtf(wave_sum(s) * (1.f / DM) + EPS);
#pragma unroll
        for (int j = 0; j < 4; ++j) xr[64 * j] = v[j] * rs * ((const f32x4*)gf)[64 * j + lane]; } }
  } }
  if (ph + 1 < args.ph_hi) { if (args.use_cg && ph == args.ph_lo) cooperative_groups::this_grid().sync(); else xcd_barrier(bar); }
  }
#undef PH_PROLOG
#undef AIN
}
constexpr int N_PHASES = 1 + 2 * 9 + 1;

static void launch(void* const* d_in, float* out, void* d_ws, hipStream_t stream, int n_launch_mode  , int n_layers) {
  static int grid = 0;
  if (grid == 0) {
    int dev = 0, cus = 0, per_cu = 0;
    (void)hipGetDevice(&dev); (void)hipDeviceGetAttribute(&cus, hipDeviceAttributeMultiprocessorCount, dev);
    (void)hipFuncSetAttribute((const void*)mk_fwd, hipFuncAttributeMaxDynamicSharedMemorySize, LDS_BYTES);
    (void)hipOccupancyMaxActiveBlocksPerMultiprocessor(&per_cu, (const void*)mk_fwd, NWAVES * 64, LDS_BYTES);
    (void)hipGetLastError();
    if (per_cu < 1) fprintf(stderr, "mk: occupancy query says %d blocks per CU\n", per_cu);
    grid = cus;
  }
  (void)hipMemsetAsync((char*)d_ws + WS_CTL, 0, CTL_ZERO_BYTES, stream);
  Args a{}; for (int i = 0; i < 25; ++i) a.in[i] = (const float*)d_in[i];
  a.out = out; a.ws = (unsigned char*)d_ws; a.n_layers = n_layers;
  for (int k = 0; k < 12; ++k) a.rep[k] = 1;
#ifdef MK_REP_MASK
  for (int k = 0; k < 12; ++k) if ((MK_REP_MASK >> k) & 1) a.rep[k] = MK_REP_N;
#endif
  const int nph = 1 + n_layers * 9 + 1;
  if (n_launch_mode == 0) {
    a.ph_lo = 0; a.ph_hi = nph; a.use_cg = 1;
    void* kargs[] = {&a};
    hipError_t e = hipLaunchCooperativeKernel((const void*)mk_fwd, dim3(grid), dim3(NWAVES * 64), kargs, LDS_BYTES, stream);
    if (e != hipSuccess) { fprintf(stderr, "mk: cooperative launch failed (%s), plain launch instead\n", hipGetErrorName(e)); (void)hipGetLastError(); a.use_cg = 0; hipLaunchKernelGGL(mk_fwd, dim3(grid), dim3(NWAVES * 64), LDS_BYTES, stream, a); }
  }
  else for (int p = 0; p < nph; ++p) { a.ph_lo = p; a.ph_hi = p + 1; hipLaunchKernelGGL(mk_fwd, dim3(grid), dim3(NWAVES * 64), LDS_BYTES, stream, a); }
  const hipError_t le = hipPeekAtLastError(); if (le != hipSuccess) fprintf(stderr, "mk: launch failed: %s\n", hipGetErrorName(le));
}
}
extern "C" void kernel_launch(void* const* d_in, const int* in_sizes, int n_in, void* d_out, int out_size, void* d_ws, size_t ws_size, hipStream_t stream) {
  mk::launch(d_in, (float*)d_out, d_ws, stream, MK_LAUNCH_MODE, 2);
}
```

```cpp
#ifndef MK_LAUNCH_MODE
#define MK_LAUNCH_MODE 0
#endif
#include <hip/hip_runtime.h>
#include <hip/hip_bf16.h>
#include <hip/hip_cooperative_groups.h>
#include <cstdint>
#include <cstdio>
#include <cmath>
#define GAS __attribute__((address_space(1)))
#define LAS __attribute__((address_space(3)))
namespace mk {
constexpr int NB = 8, T = 4096, NC = 256, RB = T + NC, M = NB * RB, DM = 1024, NP = 3328, DFF = 4096, TPB = RB / 256, NINO = 3096;
constexpr float EPS = 1e-6f, L2E = 1.4426950408889634f;
constexpr float QC2 = 0.125f * 1.4426950408889634f;
typedef unsigned short bf16;
typedef unsigned u32x4 __attribute__((ext_vector_type(4)));
typedef unsigned u32x2 __attribute__((ext_vector_type(2)));
typedef float f32x4 __attribute__((ext_vector_type(4)));
typedef float f32x16 __attribute__((ext_vector_type(16)));
typedef short bf16x8 __attribute__((ext_vector_type(8)));
typedef short s16x4 __attribute__((ext_vector_type(4)));
typedef float f32x2v __attribute__((ext_vector_type(2)));
typedef __bf16 bf16x2v __attribute__((ext_vector_type(2)));

constexpr size_t MiB = 1u << 20;
constexpr size_t WS_CTL = 0, CTL_ZERO_BYTES = 1 * MiB;
constexpr size_t WS_MOD = 1 * MiB;
constexpr size_t WS_CS = 2 * MiB;
constexpr size_t WS_G = 4 * MiB;
constexpr size_t WS_XS = 423 * MiB;
constexpr size_t WS_W = 17 * MiB;
constexpr size_t W_LAYER = (size_t)(NP + DM + DFF + DFF) * 1024 * 2;
constexpr size_t WO_IN = 0, WO_OUT = (size_t)NP * DM * 2, WO_1 = WO_OUT + (size_t)DM * DM * 2, WO_2 = WO_1 + (size_t)DFF * DM * 2;
constexpr size_t WS_H = 66 * MiB;
constexpr size_t WS_P = 134 * MiB;
constexpr size_t WS_Y = 355 * MiB;
constexpr size_t WS_U = WS_P;
constexpr size_t WS_SS = 491 * MiB;
constexpr size_t WS_BIAS = 3 * MiB;
constexpr size_t WS_G2 = 8 * MiB + 512 * 1024;
constexpr size_t WS_END = 494 * MiB;
static_assert(WS_W + 2 * W_LAYER <= WS_H && WS_H + (size_t)M * DM * 2 <= WS_P && WS_P + (size_t)M * NP * 2 <= WS_Y && WS_U + (size_t)M * DFF * 2 <= WS_XS && WS_XS + (size_t)M * DM * 2 <= WS_SS && WS_SS + (size_t)M * 16 * 4 <= WS_END && WS_G + (size_t)M * 32 * 4 <= WS_G2 && WS_G2 + (size_t)M * 64 * 4 <= WS_W, "ws map");
constexpr size_t WS_HC = WS_H, WS_YD = WS_H + (size_t)2 * M * 256 * 2;
constexpr int CW_BAR = 4096;
constexpr int CW_SUBBAR = 24576;
constexpr int CW_QUEUE = 16384;

__device__ __forceinline__ unsigned cvtpk(float lo, float hi) { f32x2v v = {lo, hi}; bf16x2v b = __builtin_convertvector(v, bf16x2v); return __builtin_bit_cast(unsigned, b); }
__device__ __forceinline__ float bf_lo(unsigned w) { return __uint_as_float(w << 16); }
__device__ __forceinline__ float bf_hi(unsigned w) { return __uint_as_float(w & 0xffff0000u); }
__device__ __forceinline__ float bf2f(bf16 v) { return __uint_as_float(((unsigned)v) << 16); }
__device__ __forceinline__ bf16 f2bf(float f) { return (bf16)(cvtpk(f, 0.f) & 0xffffu); }
__device__ __forceinline__ float wave_sum(float v) {
#pragma unroll
  for (int o = 1; o < 64; o <<= 1) v += __shfl_xor(v, o);
  return v;
}
__device__ __forceinline__ int crow(int r, int hi) { return (r & 3) + 8 * (r >> 2) + 4 * hi; }
__device__ __forceinline__ size_t lat_off(int b, int t) { return ((size_t)b * T + t) * DM; }
__device__ __forceinline__ size_t ctx_off(int b, int j) { return ((size_t)b * NC + j) * DM; }
}
typedef GAS unsigned gu32;
typedef GAS unsigned long long gu64;

#define XB_TMO      128
#define XB_XCNT(j)  (256  + 64 * (j))
#define XB_XSUB(j)  (1280 + 64 * (j))
#define XB_XGEN(j)  (2304 + 64 * (j))
#define XB_TOP      3328
#define XB_TOPGEN   3392
#define XCD_BAR_WORDS 3456
#define XB_SPIN_CAP (1u << 18)

__device__ __forceinline__ unsigned xb_ld(unsigned* p)              { return __hip_atomic_load(p, __ATOMIC_RELAXED, __HIP_MEMORY_SCOPE_AGENT); }
__device__ __forceinline__ unsigned xb_add(unsigned* p, unsigned v) { return __hip_atomic_fetch_add(p, v, __ATOMIC_RELAXED, __HIP_MEMORY_SCOPE_AGENT); }
__device__ __forceinline__ unsigned xb_xcc_id() { return (unsigned)__builtin_amdgcn_s_getreg((3 << 11) | 20) & 0xFu; }
#define XB_SPIN(cond, bar) do { unsigned _sp = 0; while (cond) { __builtin_amdgcn_s_sleep(1); \
    if ((++_sp & 255u) == 0u) { if (xb_ld(&(bar)[XB_TMO])) break; if (_sp > XB_SPIN_CAP) { atomicAdd(&(bar)[XB_TMO], 1u); break; } } } } while (0)

struct XcdBarrier {
    unsigned* bar; unsigned x;
    volatile LAS unsigned* st;
};

__device__ __forceinline__ XcdBarrier xcd_barrier_post(unsigned* bar, volatile LAS unsigned* st) {
    XcdBarrier b; b.bar = bar; b.x = xb_xcc_id(); b.st = st;
    if (threadIdx.x == 0) (void)xb_add(&bar[XB_XCNT(b.x)], 1u);
    return b;
}
__device__ __forceinline__ void xcd_barrier_complete(unsigned* bar, unsigned x, unsigned& nloc, unsigned& nx) {
    const unsigned G = gridDim.x * gridDim.y * gridDim.z;
    unsigned sum, cnt, mine, sp = 0u;
    for (;;) {
        sum = 0u; cnt = 0u; mine = 0u;
#pragma unroll 1
        for (unsigned j = 0; j < 16; ++j) { const unsigned c = xb_ld(&bar[XB_XCNT(j)]); sum += c; cnt += (c > 0u) ? 1u : 0u; mine = (j == x) ? c : mine; }
        if (sum == G) break;
        __builtin_amdgcn_s_sleep(1);
        if ((++sp & 255u) == 0u) { if (xb_ld(&bar[XB_TMO])) break; if (sp > XB_SPIN_CAP) { atomicAdd(&bar[XB_TMO], 1u); break; } }
    }
    nloc = mine > 0u ? mine : 1u; nx = cnt > 0u ? cnt : 1u;
}

__device__ __forceinline__ void xcd_barrier(const XcdBarrier& b) {
    asm volatile("s_waitcnt vmcnt(0)" ::: "memory");
    __syncthreads();
    if (threadIdx.x == 0) {
        unsigned* bar = b.bar;
        __builtin_amdgcn_s_waitcnt(0);
        unsigned nloc = b.st[0], nx = b.st[1];
        if (nloc == 0u) { xcd_barrier_complete(bar, b.x, nloc, nx); b.st[0] = nloc; b.st[1] = nx; }
        const unsigned old = xb_add(&bar[XB_XSUB(b.x)], 1u);
        const unsigned gen = old / nloc;
        if (old + 1u == (gen + 1u) * nloc) {
            __builtin_amdgcn_fence(__ATOMIC_RELEASE, "agent");
            asm volatile("s_waitcnt vmcnt(0)" ::: "memory");
            const unsigned og = xb_add(&bar[XB_TOP], 1u);
            const unsigned tg = og / nx;
            if (og + 1u == (tg + 1u) * nx) xb_add(&bar[XB_TOPGEN], 1u);
            else XB_SPIN(xb_ld(&bar[XB_TOPGEN]) == tg, bar);
            __builtin_amdgcn_fence(__ATOMIC_ACQUIRE, "agent");
            xb_add(&bar[XB_XGEN(b.x)], 1u);
            asm volatile("s_waitcnt vmcnt(0)" ::: "memory");
        } else {
            XB_SPIN(xb_ld(&bar[XB_XGEN(b.x)]) == gen, bar);
            __builtin_amdgcn_fence(__ATOMIC_ACQUIRE, "agent");
            asm volatile("s_waitcnt vmcnt(0)" ::: "memory");
        }
    }
    __syncthreads();
}
namespace pg8 {
#define PG8_LAS __attribute__((address_space(3)))
typedef unsigned short bf16_t;
typedef short bf16x8 __attribute__((ext_vector_type(8)));
typedef float f32x4 __attribute__((ext_vector_type(4)));
typedef unsigned u32x4 __attribute__((ext_vector_type(4)));
#ifndef PG8_WGM
#define PG8_WGM 8
#endif
constexpr int BM = 256, BK = 64, HALF = 128, HTB = HALF * BK * 2  , STAGE_BYTES = 8 * HTB, NXCD = 8, WGM = PG8_WGM;

__host__ __device__ __forceinline__ int lds_byte(int r, int c) { const int st = (r >> 4) * 2 + (c >> 5), rr = r & 15, cc = c & 31, ob = rr * 64 + cc * 2; return st * 1024 + (ob ^ (((ob >> 9) & 1) << 5)); }
__host__ __device__ __forceinline__ void stage_rc(int b, int& R, int& C) { const int st = b / 1024, sb = b % 1024, swz = sb ^ (((sb >> 9) & 1) << 5); R = (st >> 1) * 16 + swz / 64; C = (st & 1) * 32 + (swz % 64) / 2; }
__host__ __device__ __forceinline__ int perm32(int rho) { const int n = rho >> 4, i = rho & 15; return 8 * (i >> 2) + 4 * n + (i & 3); }

struct Unit { int pm, pn; };
struct Gemm { const bf16_t* A; const bf16_t* Bt; int M, N, K, ld; };

struct StaticOrder {
    int nM, nN, nwg, G, c;
    __host__ __device__ void init(int M, int N, int G_, int c_) { nM = M / BM; nN = N / BM; nwg = nM * nN; G = G_; c = c_; }
    __host__ __device__ bool next(int i, Unit& u) const {
        const long L = (long)i * G + c; if (L >= nwg) return false;
        int wgid = (int)L; { const int q = nwg / NXCD, r = nwg % NXCD, xcd = wgid % NXCD, off = wgid / NXCD; wgid = (xcd < r ? xcd * (q + 1) : r * (q + 1) + (xcd - r) * q) + off; }
        const int nig = WGM * nN, gid = wgid / nig, fm = gid * WGM, gsz = (nM - fm) < WGM ? (nM - fm) : WGM;
        u.pm = fm + ((wgid % nig) % gsz); u.pn = (wgid % nig) / gsz; return true;
    }
    __device__ __forceinline__ void a_ready(const Unit&) const {}
    __device__ __forceinline__ void done(const Unit&) const {}
};

__device__ __forceinline__ unsigned cvt_pk_bf16(float lo, float hi) { unsigned r; asm volatile("v_cvt_pk_bf16_f32 %0, %1, %2" : "=v"(r) : "v"(lo), "v"(hi)); return r; }
typedef float f32x2 __attribute__((ext_vector_type(2)));
__device__ __forceinline__ f32x2 gelu_pk(f32x2 v) {
    const f32x2 av = __builtin_elementwise_abs(v), d = av * 0.2316418882f + 1.0f;
    f32x2 t; t.x = __builtin_amdgcn_rcpf(d.x); t.y = __builtin_amdgcn_rcpf(d.y);
    f32x2 q = t * 0.5307027145f + (-0.7265760135f); q = q * t + 0.7107068705f; q = q * t + (-0.142248368f); q = q * t + 0.127414796f; q = q * t;
    const f32x2 s = (v * v) * (-0.72134752044f);
    f32x2 e; e.x = __builtin_amdgcn_exp2f(s.x); e.y = __builtin_amdgcn_exp2f(s.y);
    const f32x2 m = v * (q * e), r = v - m;
    f32x2 o; o.x = v.x < 0.f ? m.x : r.x; o.y = v.y < 0.f ? m.y : r.y; return o;
}

template <int ACT  > struct EpiBf16 {
    static constexpr bool PERM = true, AFTER_DRAIN = false; static_assert(ACT == 0 || ACT == 1, "EpiBf16: ACT is 0 (none) or 1 (gelu_pk)");
    bf16_t* O; int ldc; const float* bias; int split_cols; size_t split_stride; float scale0;
    __device__ __forceinline__ void operator()(const f32x4 (&acc)[2][2][4][2], const Unit& u, int wr, int wc, int fr, int fq) const {
        const int row0 = u.pm * BM + wr * 64 + fr; int colt = u.pn * BM; bf16_t* base = O;
        float sc = 1.f; if (split_cols) { const int t = colt / split_cols; base += (size_t)t * split_stride; colt -= t * split_cols; if (t == 0) sc = scale0; }
        const int col0 = colt + wc * 32 + 8 * fq, bcol0 = u.pn * BM + wc * 32 + 8 * fq;
        f32x4 bv[2][2];
#pragma unroll
        for (int bj = 0; bj < 2; ++bj)
#pragma unroll
            for (int n = 0; n < 2; ++n) bv[bj][n] = bias ? *(const f32x4*)(bias + bcol0 + bj * HALF + 4 * n) : (f32x4){0.f, 0.f, 0.f, 0.f};
#pragma unroll
        for (int ai = 0; ai < 2; ++ai)
#pragma unroll
            for (int m = 0; m < 4; ++m) { bf16_t* rowp = base + (size_t)(row0 + ai * HALF + m * 16) * ldc + col0;
#pragma unroll
                for (int bj = 0; bj < 2; ++bj) { f32x4 v0 = acc[ai][bj][m][0] + bv[bj][0], v1 = acc[ai][bj][m][1] + bv[bj][1];
                    if (ACT == 1) { f32x2 a = gelu_pk((f32x2){v0[0], v0[1]}), b = gelu_pk((f32x2){v0[2], v0[3]}), c = gelu_pk((f32x2){v1[0], v1[1]}), d = gelu_pk((f32x2){v1[2], v1[3]});
                        v0 = (f32x4){a.x, a.y, b.x, b.y}; v1 = (f32x4){c.x, c.y, d.x, d.y}; }
                    v0 = v0 * sc; v1 = v1 * sc; u32x4 w; w.x = cvt_pk_bf16(v0[0], v0[1]); w.y = cvt_pk_bf16(v0[2], v0[3]); w.z = cvt_pk_bf16(v1[0], v1[1]); w.w = cvt_pk_bf16(v1[2], v1[3]);
                    *(u32x4*)(rowp + bj * HALF) = w; } }
    }
};
template <class Epi, class Sched, bool ALIGN_EPI = false, bool SP2 = false>
__device__ __forceinline__ void gemm_phase(PG8_LAS unsigned char* lds, const Gemm g, const Sched& S, const Epi& E) {
    int tid_ = threadIdx.x; asm volatile("" : "+v"(tid_));
    const int tid = tid_, wid = __builtin_amdgcn_readfirstlane(tid >> 6), lane = tid & 63, wr = wid >> 2, wc = wid & 3, fr = lane & 15, fq = lane >> 4;
    const int K = g.K, nt = K / BK, LD = g.ld;
    unsigned voffA[2], voffB[2];
#pragma unroll
    for (int i = 0; i < 2; ++i) { int R, C; stage_rc(tid * 16 + i * 8192, R, C); const int Rb = Epi::PERM ? ((R & ~31) + perm32(R & 31)) : R;
        voffA[i] = (unsigned)(R * LD + C) * 2u; voffB[i] = (unsigned)(Rb * LD + C) * 2u; }
    const size_t kstep = (size_t)(BK * 2);
    const size_t hstep = (size_t)HALF * LD * 2;
    const size_t tstep = 2 * hstep;
    const unsigned ldsw = (unsigned)wid * 1024u;
    const int aoff = lds_byte(wr * 64 + fr, fq * 8), boff = lds_byte(wc * 32 + fr, fq * 8);
#define PG8_SA(b, h) (((b) * 2 + (h)) * HTB)
#define PG8_SB(b, h) ((4 + (b) * 2 + (h)) * HTB)
#define PG8_STAGE(bufoff, gbase, voff) do { _Pragma("unroll") for (int _i = 0; _i < 2; ++_i) \
        __builtin_amdgcn_global_load_lds((const unsigned*)((const char*)(gbase) + (voff)[_i]), (PG8_LAS unsigned*)(lds + (bufoff) + ldsw + _i * 8192), 16, 0, 0); } while (0)
#define PG8_LDA(dst, b, h) do { _Pragma("unroll") for (int m = 0; m < 4; ++m) _Pragma("unroll") for (int k = 0; k < 2; ++k) dst[m][k] = *(const PG8_LAS bf16x8*)(lds + PG8_SA(b, h) + aoff + m * 2048 + k * 1024); } while (0)
#define PG8_LDB(dst, b, h) do { _Pragma("unroll") for (int n = 0; n < 2; ++n) _Pragma("unroll") for (int k = 0; k < 2; ++k) dst[n][k] = *(const PG8_LAS bf16x8*)(lds + PG8_SB(b, h) + boff + n * 2048 + k * 1024); } while (0)
#define PG8_MMA(ai, bj, At, Bt) do { __builtin_amdgcn_s_setprio(1); _Pragma("unroll") for (int m = 0; m < 4; ++m) _Pragma("unroll") for (int n = 0; n < 2; ++n) _Pragma("unroll") for (int k = 0; k < 2; ++k) \
        acc[ai][bj][m][n] = __builtin_amdgcn_mfma_f32_16x16x32_bf16(Bt[n][k], At[m][k], acc[ai][bj][m][n], 0, 0, 0); __builtin_amdgcn_s_setprio(0); } while (0)
#define PG8_WAIT_V(n) asm volatile("s_waitcnt vmcnt(" #n ")" ::: "memory")
#define PG8_WAIT_L(n) asm volatile("s_waitcnt lgkmcnt(" #n ")" ::: "memory")
#define PG8_BAR __builtin_amdgcn_s_barrier()
#define PG8_SCHED __builtin_amdgcn_sched_barrier(0)
    Unit cur, nxt; int ui = 0;
    if (!S.next(0, cur)) return;
    f32x4 acc[2][2][4][2];
#pragma unroll
    for (int a = 0; a < 2; ++a)
#pragma unroll
        for (int b = 0; b < 2; ++b)
#pragma unroll
            for (int m = 0; m < 4; ++m)
#pragma unroll
                for (int n = 0; n < 2; ++n) acc[a][b][m][n] = (f32x4){0.f, 0.f, 0.f, 0.f};
    bf16x8 At[4][2], B0[2][2], B1[2][2];
    const char* cA = (const char*)g.A + (size_t)cur.pm * tstep; const char* cB = (const char*)g.Bt + (size_t)cur.pn * tstep;
    S.a_ready(cur);
    if constexpr (SP2) {
        PG8_STAGE(PG8_SB(0, 0), cB, voffB); PG8_STAGE(PG8_SB(0, 1), cB + hstep, voffB); PG8_STAGE(PG8_SA(0, 0), cA, voffA); PG8_STAGE(PG8_SA(0, 1), cA + hstep, voffA);
        if (wr == 1) PG8_BAR;
        PG8_WAIT_V(2); PG8_BAR;
        PG8_STAGE(PG8_SB(1, 0), cB + kstep, voffB); PG8_STAGE(PG8_SA(1, 0), cA + kstep, voffA); PG8_STAGE(PG8_SB(1, 1), cB + hstep + kstep, voffB);
        PG8_WAIT_V(6); PG8_BAR;
    } else {
        PG8_STAGE(PG8_SB(0, 0), cB, voffB); PG8_STAGE(PG8_SA(0, 0), cA, voffA); PG8_STAGE(PG8_SB(0, 1), cB + hstep, voffB); PG8_STAGE(PG8_SA(0, 1), cA + hstep, voffA);
        if (wr == 1) PG8_BAR;
        PG8_WAIT_V(4); PG8_BAR;
        PG8_STAGE(PG8_SB(1, 0), cB + kstep, voffB); PG8_STAGE(PG8_SA(1, 0), cA + kstep, voffA); PG8_STAGE(PG8_SB(1, 1), cB + hstep + kstep, voffB);
        PG8_WAIT_V(6); PG8_BAR;
    }
    for (;;) {
        const bool has_next = S.next(ui + 1, nxt);
        const char* nA = has_next ? (const char*)g.A + (size_t)nxt.pm * tstep : cA; const char* nB = has_next ? (const char*)g.Bt + (size_t)nxt.pn * tstep : cB;
        for (int t = 0; t < nt; t += 2) {
            const bool last = (t == nt - 2);
            const char* a1 = cA + (size_t)(t + 1) * kstep;
            const char* a2 = last ? nA : cA + (size_t)(t + 2) * kstep; const char* b2 = last ? nB : cB + (size_t)(t + 2) * kstep;
            const char* a3 = a2 + kstep; const char* b3 = b2 + kstep;
            if (last && has_next) S.a_ready(nxt);
            if constexpr (SP2) {
            PG8_LDB(B0, 0, 0); PG8_LDB(B1, 0, 1); PG8_SCHED; PG8_LDA(At, 0, 0); PG8_STAGE(PG8_SA(1, 1), a1 + hstep, voffA);
            PG8_WAIT_V(8); PG8_WAIT_L(0); PG8_BAR; PG8_MMA(0, 0, At, B0); PG8_MMA(0, 1, At, B1); PG8_BAR; PG8_SCHED;
            PG8_LDA(At, 0, 1); PG8_STAGE(PG8_SB(0, 0), b2, voffB); PG8_STAGE(PG8_SB(0, 1), b2 + hstep, voffB); PG8_STAGE(PG8_SA(0, 0), a2, voffA);
            PG8_WAIT_V(8); PG8_WAIT_L(0); PG8_BAR; PG8_MMA(1, 0, At, B0); PG8_MMA(1, 1, At, B1); PG8_BAR; PG8_SCHED;
            PG8_LDB(B0, 1, 0); PG8_LDB(B1, 1, 1); PG8_SCHED; PG8_LDA(At, 1, 0); PG8_STAGE(PG8_SA(0, 1), a2 + hstep, voffA);
            PG8_WAIT_V(8); PG8_WAIT_L(0); PG8_BAR; PG8_MMA(0, 0, At, B0); PG8_MMA(0, 1, At, B1); PG8_BAR; PG8_SCHED;
            PG8_LDA(At, 1, 1); PG8_STAGE(PG8_SB(1, 0), b3, voffB); PG8_STAGE(PG8_SB(1, 1), b3 + hstep, voffB); PG8_STAGE(PG8_SA(1, 0), a3, voffA);
            PG8_WAIT_V(8); PG8_WAIT_L(0); PG8_BAR; PG8_MMA(1, 0, At, B0); PG8_MMA(1, 1, At, B1); PG8_BAR; PG8_SCHED;
            } else {
            PG8_LDB(B0, 0, 0); PG8_SCHED; PG8_LDA(At, 0, 0); PG8_STAGE(PG8_SA(1, 1), a1 + hstep, voffA);
            PG8_WAIT_L(8); PG8_BAR; PG8_WAIT_L(0); PG8_MMA(0, 0, At, B0); PG8_BAR; PG8_SCHED;
            PG8_LDB(B1, 0, 1); PG8_STAGE(PG8_SB(0, 0), b2, voffB);
            PG8_BAR; PG8_WAIT_L(0); PG8_MMA(0, 1, At, B1); PG8_BAR;
            PG8_LDA(At, 0, 1); PG8_STAGE(PG8_SA(0, 0), a2, voffA);
            PG8_BAR; PG8_WAIT_L(0); PG8_MMA(1, 0, At, B0); PG8_BAR; PG8_SCHED;
            PG8_STAGE(PG8_SB(0, 1), b2 + hstep, voffB);
            PG8_WAIT_V(6); PG8_BAR; PG8_MMA(1, 1, At, B1); PG8_BAR;
            PG8_LDB(B0, 1, 0); PG8_SCHED; PG8_LDA(At, 1, 0); PG8_STAGE(PG8_SA(0, 1), a2 + hstep, voffA);
            PG8_WAIT_L(8); PG8_BAR; PG8_WAIT_L(0); PG8_MMA(0, 0, At, B0); PG8_BAR; PG8_SCHED;
            PG8_LDB(B1, 1, 1); PG8_STAGE(PG8_SB(1, 0), b3, voffB);
            PG8_BAR; PG8_WAIT_L(0); PG8_MMA(0, 1, At, B1); PG8_BAR;
            PG8_LDA(At, 1, 1); PG8_STAGE(PG8_SA(1, 0), a3, voffA);
            PG8_BAR; PG8_WAIT_L(0); PG8_MMA(1, 0, At, B0); PG8_BAR; PG8_SCHED;
            PG8_STAGE(PG8_SB(1, 1), b3 + hstep, voffB);
            PG8_WAIT_V(6); PG8_BAR; PG8_MMA(1, 1, At, B1); PG8_BAR;
            }
        }
        if constexpr (ALIGN_EPI) { if (wr == 0) PG8_BAR; }
        if constexpr (!Epi::AFTER_DRAIN) { E(acc, cur, wr, wc, fr, fq); S.done(cur); }
        if (!has_next) break;
#pragma unroll
        for (int a = 0; a < 2; ++a)
#pragma unroll
            for (int b = 0; b < 2; ++b)
#pragma unroll
                for (int m = 0; m < 4; ++m)
#pragma unroll
                    for (int n = 0; n < 2; ++n) acc[a][b][m][n] = (f32x4){0.f, 0.f, 0.f, 0.f};
        cur = nxt; cA = nA; cB = nB; ++ui;
        if constexpr (ALIGN_EPI) { if (wr == 1) PG8_BAR; }
    }
    PG8_WAIT_V(0);
    if constexpr (!ALIGN_EPI) { if (wr == 0) PG8_BAR; }
    PG8_BAR;
    if constexpr (Epi::AFTER_DRAIN) { E.fused(acc, cur, wr, wc, fr, fq, lds, wid, lane); S.done(cur); }
#undef PG8_SA
#undef PG8_SB
#undef PG8_STAGE
#undef PG8_LDA
#undef PG8_LDB
#undef PG8_MMA
#undef PG8_WAIT_V
#undef PG8_WAIT_L
#undef PG8_BAR
#undef PG8_SCHED
}
}
namespace attn_body {
using bf16=__hip_bfloat16;
using bf16x8=__attribute__((ext_vector_type(8)))short;
using s16x4=__attribute__((ext_vector_type(4)))short;
using f32x16=__attribute__((ext_vector_type(16)))float;
using u32x4=__attribute__((ext_vector_type(4)))unsigned;
constexpr int D=64,PQ=3328,PO=1024;
constexpr int NW=8,QBLK=32,QB=QBLK*NW,KVBLK=64;
__device__ __forceinline__ int crow(int r,int hi){return (r&3)+8*(r>>2)+4*hi;}
#define SBAR() __builtin_amdgcn_sched_barrier(0)
__device__ __forceinline__ void wmask(f32x16&p0,f32x16&p1,int dq,int hi){
  const float NEG=-INFINITY; int kb=4*hi;
  #pragma unroll
  for(int r=0;r<16;++r){int kv=kb+(r&3)+8*(r>>2); int d0=dq-kv; if(d0>128||d0<-128)p0[r]=NEG; int d1=d0-32; if(d1>128||d1<-128)p1[r]=NEG;}
}

constexpr int NSLOT=3, SLOTB=8192;
constexpr int LDS_K=0, LDS_V=NSLOT*SLOTB, LDS_WS=2*NSLOT*SLOTB, LDS_OST=LDS_WS+NW*64*4, LDS_BYTES=LDS_OST+NW*4096;
constexpr float C2=0.125f*1.4426950408889634f;
__device__ __forceinline__ void glds16(const void*gsrc,unsigned lds_dst){unsigned keep;
  asm volatile("s_mov_b32 %0, m0\n\ts_mov_b32 m0, %2\n\ts_nop 0\n\tglobal_load_lds_dwordx4 %1, off\n\ts_mov_b32 m0, %0":"=&s"(keep):"v"(gsrc),"s"(lds_dst):"memory");}
__device__ __forceinline__ float max3f(float a,float b,float c){float r;asm("v_max3_f32 %0, %1, %2, %3":"=v"(r):"v"(a),"v"(b),"v"(c));return r;}
__device__ __forceinline__ float max2f(float a,float b){float r;asm("v_max_f32_e32 %0, %1, %2":"=v"(r):"v"(a),"v"(b));return r;}
__device__ __forceinline__ float fadd_s(float a,float b){float r;asm("v_add_f32_e32 %0, %1, %2":"=v"(r):"v"(a),"v"(b));return r;}
__device__ __forceinline__ float fsub_s(float a,float b){float r;asm("v_sub_f32_e32 %0, %1, %2":"=v"(r):"v"(a),"v"(b));return r;}
typedef float f32x2_t __attribute__((ext_vector_type(2))); typedef __bf16 bf16x2_t __attribute__((ext_vector_type(2)));
__device__ __forceinline__ unsigned cvtpk_s(float lo,float hi){f32x2_t v={lo,hi};bf16x2_t b=__builtin_convertvector(v,bf16x2_t);return __builtin_bit_cast(unsigned,b);}
#define WAIT_BAR(N) asm volatile("s_waitcnt vmcnt(" #N ") lgkmcnt(0)\n\ts_barrier":::"memory")

__device__ __forceinline__ void qkt(f32x16&p0,f32x16&p1,const char*Kslot,const bf16x8*qr,const f32x16&negm,int r32,int hi){
  const char*kb=Kslot+hi*1024+r32*16;
  #pragma unroll
  for(int d0=0;d0<4;++d0){
    const bf16x8 b0=*reinterpret_cast<const bf16x8*>(kb+d0*2048);
    const bf16x8 b1=*reinterpret_cast<const bf16x8*>(kb+d0*2048+512);
    if(d0==0){p0=__builtin_amdgcn_mfma_f32_32x32x16_bf16(b0,qr[0],negm,0,0,0);p1=__builtin_amdgcn_mfma_f32_32x32x16_bf16(b1,qr[0],negm,0,0,0);}
    else{p0=__builtin_amdgcn_mfma_f32_32x32x16_bf16(b0,qr[d0],p0,0,0,0);p1=__builtin_amdgcn_mfma_f32_32x32x16_bf16(b1,qr[d0],p1,0,0,0);}}
}
typedef __attribute__((address_space(3))) const char* lds_cptr;
typedef short v4i16_t __attribute__((ext_vector_type(4)));
__device__ __forceinline__ void kload8(bf16x8*kf,lds_cptr kp){
  kf[0]=*(const __attribute__((address_space(3))) bf16x8*)(kp);      kf[1]=*(const __attribute__((address_space(3))) bf16x8*)(kp+512);
  kf[2]=*(const __attribute__((address_space(3))) bf16x8*)(kp+2048); kf[3]=*(const __attribute__((address_space(3))) bf16x8*)(kp+2560);
  kf[4]=*(const __attribute__((address_space(3))) bf16x8*)(kp+4096); kf[5]=*(const __attribute__((address_space(3))) bf16x8*)(kp+4608);
  kf[6]=*(const __attribute__((address_space(3))) bf16x8*)(kp+6144); kf[7]=*(const __attribute__((address_space(3))) bf16x8*)(kp+6656);
}
__device__ __forceinline__ void kload2(bf16x8*kf,lds_cptr kp,int j){ kf[2*j]=*(const __attribute__((address_space(3))) bf16x8*)(kp+j*2048); kf[2*j+1]=*(const __attribute__((address_space(3))) bf16x8*)(kp+j*2048+512); }
__device__ __forceinline__ s16x4 vtr(lds_cptr p){ return __builtin_bit_cast(s16x4,__builtin_amdgcn_ds_read_tr16_b64_v4i16((__attribute__((address_space(3))) v4i16_t*)p)); }
__device__ __forceinline__ float rowmax(const f32x16&p0,const f32x16&p1){
  float a=max3f(p0[0],p0[1],p1[0]),b=max3f(p0[2],p0[3],p1[1]);a=max3f(a,p1[2],p1[3]);
  #pragma unroll
  for(int r=4;r<16;r+=4){a=max3f(a,p0[r],p0[r+1]);b=max3f(b,p0[r+2],p0[r+3]);a=max3f(a,p1[r],p1[r+1]);b=max3f(b,p1[r+2],p1[r+3]);}
  const float m=max2f(a,b);
  auto rr=__builtin_amdgcn_permlane32_swap(__float_as_uint(m),__float_as_uint(m),false,false);
  return max2f(__uint_as_float(rr[0]),__uint_as_float(rr[1]));
}
__device__ __forceinline__ void pv(f32x16*o,int vb,bf16x8 pa0,bf16x8 pa1,bf16x8 pa2,bf16x8 pa3){
  #pragma unroll
  for(int d0=0;d0<2;++d0){s16x4 lo[4],hi[4];
    #pragma unroll
    for(int ks=0;ks<4;++ks){
      asm volatile("ds_read_b64_tr_b16 %0,%1 offset:%c2":"=&v"(lo[ks]):"v"(vb),"i"(d0*4096+ks*1024):"memory");
      asm volatile("ds_read_b64_tr_b16 %0,%1 offset:%c2":"=&v"(hi[ks]):"v"(vb),"i"(d0*4096+ks*1024+512):"memory");}
    asm volatile("s_waitcnt lgkmcnt(0)":::"memory");SBAR();
    #define PK(k) (bf16x8){lo[k][0],lo[k][1],lo[k][2],lo[k][3],hi[k][0],hi[k][1],hi[k][2],hi[k][3]}
    o[d0]=__builtin_amdgcn_mfma_f32_32x32x16_bf16(pa0,PK(0),o[d0],0,0,0);
    o[d0]=__builtin_amdgcn_mfma_f32_32x32x16_bf16(pa1,PK(1),o[d0],0,0,0);
    o[d0]=__builtin_amdgcn_mfma_f32_32x32x16_bf16(pa2,PK(2),o[d0],0,0,0);
    o[d0]=__builtin_amdgcn_mfma_f32_32x32x16_bf16(pa3,PK(3),o[d0],0,0,0);
    #undef PK
  }
}

#ifndef ATTN_STORE16
#define ATTN_STORE16(p,v) (*(u32x4*)(p)=(v))
#endif
template<int THRL,int MODE> __device__ __forceinline__ void attn_unit(const bf16*Q0,const bf16*__restrict__ Kh,const bf16*__restrict__ Vh,bf16*O0,const int NT,const int band_row0,const int qpos0,const int band_s0,const float sink_l2,char*shm){
  int tid_=threadIdx.x; asm volatile("":"+v"(tid_));
  const int tid=tid_,lane=tid&63,r32=lane&31,hi=lane>>5; const int wid=__builtin_amdgcn_readfirstlane(tid>>6);
  const bf16*Qw=Q0+(long)(wid*QBLK)*PQ;
  #define TROW(t) ((MODE==1&&(t)>=4)?(band_row0+((t)-4)*KVBLK):((t)*KVBLK))
  const unsigned lds0=(unsigned)(uintptr_t)shm;
  float*wsf=(float*)(shm+LDS_WS)+wid*64;
  const bf16*ksrc=Kh+(long)lane*PQ+wid*8;
  const bf16*vsrc=Vh+(long)(16*(wid&3)+(lane>>2))*PQ+(wid>>2)*32+(lane&3)*8;
  const unsigned kdst=lds0+LDS_K+wid*1024, vdst=lds0+LDS_V+wid*1024;
  #define DMA_K(t,slot) glds16(ksrc+(long)TROW(t)*PQ,(unsigned)__builtin_amdgcn_readfirstlane(kdst+(slot)))
  #define DMA_V(t,slot) glds16(vsrc+(long)TROW(t)*PQ,(unsigned)__builtin_amdgcn_readfirstlane(vdst+(slot)))
  const int vb0=(int)(lds0+LDS_V)+((lane>>4)&1)*32+(lane&3)*8+(4*hi+((lane&15)>>2))*64;
  const char*Kbase=shm+LDS_K; bf16x8 kf[8];
  const lds_cptr shm3=(lds_cptr)shm; const lds_cptr kp0=shm3+LDS_K+hi*1024+r32*16; const lds_cptr vp0=shm3+LDS_V+((lane>>4)&1)*32+(lane&3)*8+(4*hi+((lane&15)>>2))*64;
  DMA_K(0,0);DMA_V(0,0);DMA_K(1,SLOTB);
  bf16x8 qr[4];
  #pragma unroll
  for(int d0=0;d0<4;++d0)qr[d0]=*reinterpret_cast<const bf16x8*>(&Qw[(long)r32*PQ+d0*16+hi*8]);
  float mhat=0.f,l_reg=0.f;f32x16 o[2];o[0]=f32x16{};o[1]=f32x16{};f32x16 negm=f32x16{};asm volatile("":"+v"(negm));
  const int qrel=wid*QBLK+r32;
  #define CMASK(P0,P1,t) do{ if(MODE==1&&(t)>=4){ wmask(P0,P1,qpos0+qrel-(band_s0+((t)-4)*KVBLK),hi); } }while(0)
  bool resc=false;
  #define START(P0,P1) do{ const float rm=rowmax(P0,P1); resc=false; \
    { const float dl=rm; mhat=fadd_s(mhat,dl); \
      _Pragma("unroll") for(int r=0;r<16;++r){P0[r]=fsub_s(P0[r],dl);P1[r]=fsub_s(P1[r],dl);} \
      _Pragma("unroll") for(int r=0;r<16;++r)negm[r]=-mhat; asm volatile("":"+v"(negm)); } \
    _Pragma("unroll") for(int r=0;r<16;++r)P0[r]=__builtin_amdgcn_exp2f(P0[r]); }while(0)
  #define RESC() do{ if(resc){ asm volatile("s_waitcnt lgkmcnt(0)":::"memory"); \
      _Pragma("unroll") for(int d_=0;d_<2;++d_) _Pragma("unroll") for(int r=0;r<16;++r)o[d_][r]*=wsf[crow(r,hi)]; } }while(0)
  f32x16 pA0,pA1,pB0,pB1;
  int sl_prev=0,sl_cur=0,sl_next=SLOTB;
  #define ROT() do{sl_prev=sl_cur;sl_cur=sl_next;sl_next=(sl_next==(NSLOT-1)*SLOTB)?0:sl_next+SLOTB;}while(0)
  DMA_K(2,2*SLOTB);
  WAIT_BAR(3);
  qkt(pA0,pA1,Kbase,qr,negm,r32,hi);asm volatile("s_nop 15\n\ts_nop 7":"+v"(pA0),"+v"(pA1));CMASK(pA0,pA1,0);
  START(pA0,pA1);
  _Pragma("unroll") for(int r=0;r<16;++r)pA1[r]=__builtin_amdgcn_exp2f(pA1[r]);
  WAIT_BAR(0);
  DMA_K(3,0);DMA_V(1,SLOTB);
  ROT();
  kload8(kf,kp0+sl_cur);
  WAIT_BAR(2);
  s16x4 vlo[8],vhi[8]; u32x4 pw0,pw1,pw2,pw3;
  #define PKW(P,B) cvtpk_s(P[B],P[B+1])
  #define PAF(k) __builtin_bit_cast(bf16x8,pw##k)
  #define VFR(i) (bf16x8){vlo[i][0],vlo[i][1],vlo[i][2],vlo[i][3],vhi[i][0],vhi[i][1],vhi[i][2],vhi[i][3]}
  #define PIN(x) asm volatile("":"+v"(x))
  #define MX3(a,b,c) __builtin_fmaxf(__builtin_fmaxf((a),(b)),(c))
  #define GAPA(MF,A0,A1,A2,A3,W0,W1,PW) do{ MF; sacc+=A0; sacc+=A1; sacc+=A2; sacc+=A3; PIN(sacc); W0; W1; PIN(PW); SBAR(); }while(0)
  #define EX(v) __builtin_amdgcn_exp2f(v)
  #define GAPB(MF,X,B) do{ MF; X[B]=EX(X[B]); X[B+1]=EX(X[B+1]); X[B+2]=EX(X[B+2]); X[B+3]=EX(X[B+3]); PIN(X); SBAR(); }while(0)
  #define VRD(i) do{ vlo[i]=vtr(vp_+(((i)>>2)*4096+((i)&3)*1024)); vhi[i]=vtr(vp_+(((i)>>2)*4096+((i)&3)*1024+512)); }while(0)
  #define KRD(G,j) do{ if(G){ kload2(kf,kp0+sl_next,j); SBAR(); } }while(0)
  #define STEP(C0,C1,P0,P1,t,GK,GV,GL) do{ SBAR(); \
    const lds_cptr vp_=vp0+sl_prev; \
    VRD(0); SBAR(); float sacc=(P0[0]+P0[1]); \
    GAPA(C0=__builtin_amdgcn_mfma_f32_32x32x16_bf16(kf[0],qr[0],negm,0,0,0), P0[2],P0[3],P0[4],P0[5],     pw0[0]=PKW(P0,0), pw0[1]=PKW(P0,2), pw0); \
    VRD(4); SBAR(); GAPA(C1=__builtin_amdgcn_mfma_f32_32x32x16_bf16(kf[1],qr[0],negm,0,0,0), P0[6],P0[7],P0[8],P0[9],     pw0[2]=PKW(P0,4), pw0[3]=PKW(P0,6), pw0); \
    VRD(1); SBAR(); GAPA(C0=__builtin_amdgcn_mfma_f32_32x32x16_bf16(kf[2],qr[1],C0,0,0,0),   P0[10],P0[11],P0[12],P0[13], pw1[0]=PKW(P0,8), pw1[1]=PKW(P0,10), pw1); \
    VRD(5); SBAR(); GAPA(C1=__builtin_amdgcn_mfma_f32_32x32x16_bf16(kf[3],qr[1],C1,0,0,0),   P0[14],P0[15],P1[0],P1[1],   pw1[2]=PKW(P0,12),pw1[3]=PKW(P0,14), pw1); \
    VRD(2); SBAR(); GAPA(C0=__builtin_amdgcn_mfma_f32_32x32x16_bf16(kf[4],qr[2],C0,0,0,0),   P1[2],P1[3],P1[4],P1[5],     pw2[0]=PKW(P1,0), pw2[1]=PKW(P1,2), pw2); \
    VRD(6); SBAR(); GAPA(C1=__builtin_amdgcn_mfma_f32_32x32x16_bf16(kf[5],qr[2],C1,0,0,0),   P1[6],P1[7],P1[8],P1[9],     pw2[2]=PKW(P1,4), pw2[3]=PKW(P1,6), pw2); \
    VRD(3); SBAR(); GAPA(C0=__builtin_amdgcn_mfma_f32_32x32x16_bf16(kf[6],qr[3],C0,0,0,0),   P1[10],P1[11],P1[12],P1[13], pw3[0]=PKW(P1,8), pw3[1]=PKW(P1,10), pw3); \
    VRD(7); SBAR(); GAPA(C1=__builtin_amdgcn_mfma_f32_32x32x16_bf16(kf[7],qr[3],C1,0,0,0),   P1[14],P1[15],0.f,0.f,       pw3[2]=PKW(P1,12),pw3[3]=PKW(P1,14), pw3); \
    l_reg+=sacc; \
    if(GK){DMA_K((t)+3,sl_cur);} if(GV){DMA_V((t)+1,sl_next);} \
    CMASK(C0,C1,t); \
    { float a=MX3(C0[0],C0[1],C1[0]),b=MX3(C0[2],C0[3],C1[1]); a=MX3(a,C1[2],C1[3]); \
      _Pragma("unroll") for(int r=4;r<16;r+=4){a=MX3(a,C0[r],C0[r+1]);b=MX3(b,C0[r+2],C0[r+3]);a=MX3(a,C1[r],C1[r+1]);b=MX3(b,C1[r+2],C1[r+3]);} \
      float rm=__builtin_fmaxf(a,b); { auto rr=__builtin_amdgcn_permlane32_swap(__float_as_uint(rm),__float_as_uint(rm),false,false); rm=__builtin_fmaxf(__uint_as_float(rr[0]),__uint_as_float(rr[1])); } \
      resc=false; \
      if(__builtin_expect(__any(rm>(float)THRL),0)){ const float dl=__builtin_fmaxf(rm,0.f); mhat+=dl; \
        _Pragma("unroll") for(int r=0;r<16;++r){C0[r]-=dl;C1[r]-=dl;} \
        _Pragma("unroll") for(int r=0;r<16;++r)negm[r]=-mhat; asm volatile("":"+v"(negm)); \
        const float f=__builtin_amdgcn_exp2f(-dl); l_reg*=f; if(hi==0)wsf[r32]=f; resc=true; } } \
    SBAR(); \
    GAPB(o[0]=__builtin_amdgcn_mfma_f32_32x32x16_bf16(PAF(0),VFR(0),o[0],0,0,0), C0,0); \
    GAPB(o[1]=__builtin_amdgcn_mfma_f32_32x32x16_bf16(PAF(0),VFR(4),o[1],0,0,0), C0,4); \
    KRD(GL,0); GAPB(o[0]=__builtin_amdgcn_mfma_f32_32x32x16_bf16(PAF(1),VFR(1),o[0],0,0,0), C0,8); \
    KRD(GL,1); GAPB(o[1]=__builtin_amdgcn_mfma_f32_32x32x16_bf16(PAF(1),VFR(5),o[1],0,0,0), C0,12); \
    KRD(GL,2); GAPB(o[0]=__builtin_amdgcn_mfma_f32_32x32x16_bf16(PAF(2),VFR(2),o[0],0,0,0), C1,0); \
    KRD(GL,3); GAPB(o[1]=__builtin_amdgcn_mfma_f32_32x32x16_bf16(PAF(2),VFR(6),o[1],0,0,0), C1,4); \
    GAPB(o[0]=__builtin_amdgcn_mfma_f32_32x32x16_bf16(PAF(3),VFR(3),o[0],0,0,0), C1,8); \
    GAPB(o[1]=__builtin_amdgcn_mfma_f32_32x32x16_bf16(PAF(3),VFR(7),o[1],0,0,0), C1,12); \
    }while(0)
  int t=1;
  for(;t+5<NT;t+=2){
    STEP(pB0,pB1,pA0,pA1,t,true,true,true);     WAIT_BAR(2); RESC(); ROT();
    STEP(pA0,pA1,pB0,pB1,t+1,true,true,true);   WAIT_BAR(2); RESC(); ROT();
  }
  #define ENDW(tt) do{ if((tt)+3<NT){WAIT_BAR(2);} else if((tt)+2<NT){WAIT_BAR(1);} else {WAIT_BAR(0);} }while(0)
  for(;t+1<NT;t+=2){
    STEP(pB0,pB1,pA0,pA1,t,(t+3<NT),(t+1<NT),(t+1<NT));       ENDW(t);   RESC(); ROT();
    STEP(pA0,pA1,pB0,pB1,t+1,(t+4<NT),(t+2<NT),(t+2<NT));     ENDW(t+1); RESC(); ROT();
  }
  STEP(pB0,pB1,pA0,pA1,NT-1,false,false,false); RESC();
  { float sacc=pB0[0]+pB0[1]; _Pragma("unroll") for(int r=2;r<16;++r)sacc+=pB0[r]; _Pragma("unroll") for(int r=0;r<16;++r)sacc+=pB1[r]; l_reg+=sacc;
    pw0=(u32x4){PKW(pB0,0),PKW(pB0,2),PKW(pB0,4),PKW(pB0,6)};pw1=(u32x4){PKW(pB0,8),PKW(pB0,10),PKW(pB0,12),PKW(pB0,14)};pw2=(u32x4){PKW(pB1,0),PKW(pB1,2),PKW(pB1,4),PKW(pB1,6)};pw3=(u32x4){PKW(pB1,8),PKW(pB1,10),PKW(pB1,12),PKW(pB1,14)};
    SBAR(); pv(o,vb0+sl_cur,PAF(0),PAF(1),PAF(2),PAF(3)); }
  #undef PKW
  #undef PAF
  #undef VFR
  #undef PIN
  #undef MX3
  #undef GAPA
  #undef GAPB
  #undef EX
  #undef VRD
  #undef KRD
  #undef STEP
  #undef ENDW
  {auto rr=__builtin_amdgcn_permlane32_swap(__float_as_uint(l_reg),__float_as_uint(l_reg),false,false);l_reg=__uint_as_float(rr[0])+__uint_as_float(rr[1]);}
  if(MODE==1)l_reg+=__builtin_amdgcn_exp2f(sink_l2-mhat);
  if(hi==0)wsf[32+r32]=l_reg;asm volatile("s_waitcnt lgkmcnt(0)":::"memory");
  float rli[16];
  #pragma unroll
  for(int r=0;r<16;++r)rli[r]=__builtin_amdgcn_rcpf(wsf[32+crow(r,hi)]);
  bf16*Ow=O0+(long)(wid*QBLK)*PO;
  { bf16*stg=(bf16*)(shm+LDS_OST)+wid*2048;
    #pragma unroll
    for(int r=0;r<16;++r){const int orow=crow(r,hi);
      #pragma unroll
      for(int d0=0;d0<2;++d0)stg[orow*64+d0*32+r32]=__float2bfloat16(o[d0][r]*rli[r]);}
    asm volatile("s_waitcnt lgkmcnt(0)":::"memory");
    #pragma unroll
    for(int i=0;i<4;++i){const int row=i*8+(lane>>3),ch=lane&7; const u32x4 v=*(const u32x4*)(stg+row*64+ch*8); ATTN_STORE16(Ow+(long)row*PO+ch*8,v);} }
  asm volatile("s_waitcnt lgkmcnt(0)\n\ts_barrier":::"memory");
  #undef DMA_K
  #undef DMA_V
  #undef TROW
  #undef CMASK
  #undef START
  #undef RESC
  #undef ROT
}
constexpr int ATTN_LDS_BYTES=LDS_BYTES;
#undef SBAR
#undef WAIT_BAR
}
namespace scan {
using namespace mk;
template <int NROWS> __device__ __forceinline__ int img_off(int row, int c) { return (((c >> 5) * (NROWS / 16) + (row >> 4)) << 10) + ((row & 15) << 6) + (((((c & 31) >> 3) ^ ((row >> 2) & 3))) << 4) + ((c & 7) << 1); }
__device__ __forceinline__ int tlane(int lane) { const int hh = lane >> 5, q = (lane & 15) >> 2, ch = 2 * ((lane >> 4) & 1) + ((lane & 3) >> 1), rowb = (4 * hh + q) * 64 + (lane & 1) * 8;
  const int lo = rowb + ((ch ^ hh) << 4), hi = 512 + rowb + ((ch ^ (hh + 2)) << 4); return lo | (hi << 16); }
__device__ __forceinline__ bf16x8 rfrag(LAS const char* p) { return *(LAS const bf16x8*)p; }
__device__ __forceinline__ s16x4 tr4(LAS const char* p) { return __builtin_bit_cast(s16x4, __builtin_amdgcn_ds_read_tr16_b64_v4i16((LAS s16x4*)p)); }
__device__ __forceinline__ bf16x8 tfrag(LAS const char* base, int tl) { const s16x4 lo = tr4(base + (tl & 0xffff)), hi = tr4(base + (tl >> 16)); return (bf16x8){lo[0], lo[1], lo[2], lo[3], hi[0], hi[1], hi[2], hi[3]}; }
__device__ __forceinline__ bf16x8 pack8(const f32x16& s, int b) {
  u32x4 w; w.x = cvtpk(s[b], s[b + 1]); w.y = cvtpk(s[b + 2], s[b + 3]); w.z = cvtpk(s[b + 4], s[b + 5]); w.w = cvtpk(s[b + 6], s[b + 7]); return __builtin_bit_cast(bf16x8, w);
}
#define MFMA32(a, b, c) __builtin_amdgcn_mfma_f32_32x32x16_bf16(a, b, c, 0, 0, 0)

template <int DK, int DV>
__device__ __forceinline__ void chunk_core(LAS const char* Qm, LAS const char* Km, LAS const char* Vm, LAS const char* Ss, LAS const float* rowexp, LAS const float* colexp, LAS const float* isc,
                                           f32x16& res0, f32x16& res1, int wid, int lane) {
  constexpr int KS = DK / 16, NVT = DV / 32;
  const int vp = wid >> 2, tb = vp ? 3 - (wid & 3) : (wid & 3), r32 = lane & 31, hh = lane >> 5, tl = tlane(lane);
  constexpr bool HOLDQ = (KS <= 4);
  bf16x8 qf[HOLDQ ? KS : 1];
  if (HOLDQ) {
#pragma unroll
    for (int ks = 0; ks < KS; ++ks) qf[ks] = rfrag(Qm + img_off<128>(32 * tb + r32, 16 * ks + 8 * hh)); }
#define QF(ks) (HOLDQ ? qf[HOLDQ ? (ks) : 0] : rfrag(Qm + img_off<128>(32 * tb + r32, 16 * (ks) + 8 * hh)))
  f32x16 o0 = {}, o1 = {};
  const float re = rowexp[32 * tb + r32];
  if (tb >= 2) __builtin_amdgcn_s_setprio(1);
#pragma unroll 1
  for (int st = 0; st <= tb; ++st) {
    f32x16 s = {};
#pragma unroll
    for (int ks = 0; ks < KS; ++ks) { const bf16x8 kf = rfrag(Km + img_off<128>(32 * st + r32, 16 * ks + 8 * hh)); s = MFMA32(kf, QF(ks), s); }
#pragma unroll
    for (int r = 0; r < 16; ++r) { const int sl = crow(r, hh); float w = __builtin_amdgcn_exp2f(re + colexp[32 * st + sl]); if (st == tb && sl > r32) w = 0.f; s[r] *= w; }
    const bf16x8 pa0 = pack8(s, 0), pa1 = pack8(s, 8);
    { const bf16x8 v0 = tfrag(Vm + ((vp * 8 + 2 * st) << 10), tl), v1 = tfrag(Vm + ((vp * 8 + 2 * st + 1) << 10), tl); o0 = MFMA32(pa0, v0, o0); o0 = MFMA32(pa1, v1, o0); }
    if (NVT > 2 && vp == 0) { const bf16x8 v0 = tfrag(Vm + ((2 * 8 + 2 * st) << 10), tl), v1 = tfrag(Vm + ((2 * 8 + 2 * st + 1) << 10), tl); o1 = MFMA32(pa0, v0, o1); o1 = MFMA32(pa1, v1, o1); }
  }
  f32x16 i0 = {}, i1 = {};
#pragma unroll
  for (int ks = 0; ks < KS; ++ks) { const bf16x8 sf = rfrag(Ss + img_off<DV>(32 * vp + r32, 16 * ks + 8 * hh)); i0 = MFMA32(QF(ks), sf, i0); }
  if (NVT > 2 && vp == 0) {
#pragma unroll
    for (int ks = 0; ks < KS; ++ks) { const bf16x8 sf = rfrag(Ss + img_off<DV>(64 + r32, 16 * ks + 8 * hh)); i1 = MFMA32(QF(ks), sf, i1); }
  }
#pragma unroll
  for (int r = 0; r < 16; ++r) { const float sc = isc[32 * tb + crow(r, hh)]; res0[r] = o0[r] + sc * i0[r]; res1[r] = o1[r] + sc * i1[r]; }
  __builtin_amdgcn_s_setprio(0);
#undef QF
}
template <int DK, int DV>
__device__ __forceinline__ void state_update(LAS const char* Km, LAS const char* Vw, LAS char* Ss, f32x16& st_acc, float sd, int wid, int lane) {
  constexpr int NVT = DV / 32, NDT = DK / 32;
  if (wid < NVT * NDT) {
    const int vt = wid / NDT, dt_ = wid % NDT, r32 = lane & 31, hh = lane >> 5, tl = tlane(lane);
#pragma unroll
    for (int r = 0; r < 16; ++r) st_acc[r] *= sd;
    f32x16 st2 = {};
#pragma unroll
    for (int ks = 0; ks < 8; ks += 2) { const bf16x8 af = tfrag(Vw + ((vt * 8 + ks) << 10), tl), bfr = tfrag(Km + ((dt_ * 8 + ks) << 10), tl), af2 = tfrag(Vw + ((vt * 8 + ks + 1) << 10), tl), bf2 = tfrag(Km + ((dt_ * 8 + ks + 1) << 10), tl);
      st_acc = MFMA32(af, bfr, st_acc); st2 = MFMA32(af2, bf2, st2); }
#pragma unroll
    for (int r = 0; r < 16; ++r) st_acc[r] += st2[r];
#pragma unroll
    for (int r = 0; r < 16; ++r) *(LAS bf16*)(Ss + img_off<DV>(32 * vt + crow(r, hh), 32 * dt_ + r32)) = f2bf(st_acc[r]);
  }
}
__device__ __forceinline__ float wscan_add(float x, int lane) {
#pragma unroll
  for (int o = 1; o < 64; o <<= 1) { const float y = __shfl_up(x, o); if (lane >= o) x += y; }
  return x;
}
__device__ __forceinline__ float wscan_max(float x, int lane) {
#pragma unroll
  for (int o = 1; o < 64; o <<= 1) { const float y = __shfl_up(x, o); if (lane >= o) x = fmaxf(x, y); }
  return x;
}
__device__ __forceinline__ void chunk_rows(int cc, int dir, int& row0, int& seg0, int& seglen) {
  if (cc < 2) { const int ci = dir ? 1 - cc : cc; row0 = 128 * ci; seg0 = 0; seglen = NC; }
  else { const int ci = dir ? 31 - (cc - 2) : (cc - 2); row0 = NC + 128 * ci; seg0 = NC; seglen = T; }
}
#define SCAN_BAR() do { asm volatile("s_waitcnt vmcnt(0) lgkmcnt(0)" ::: "memory"); __builtin_amdgcn_s_barrier(); asm volatile("" ::: "memory"); } while (0)

__device__ __forceinline__ size_t g2_block(int b, int c, int dh) { return ((size_t)(b * 34 + c) * 8 + dh) * 1024; }
__device__ __forceinline__ void chunk_scalars(const float* __restrict__ G, float* __restrict__ G2, const float* __restrict__ a_log, const float* __restrict__ dt_bias, const float* __restrict__ b_i, const float* __restrict__ b_f, int b, int c, int dh, int lane) {
  const size_t rowb = (size_t)b * RB; const int row0 = c < 2 ? 128 * c : NC + 128 * (c - 2);
  { const int dir = dh >> 2, h = dh & 3;
    size_t rr[2];
#pragma unroll
    for (int e = 0; e < 2; ++e) { const int i = 2 * lane + e, io = dir ? 127 - i : i; rr[e] = rowb + row0 + io; }
    {
      const float a = -__expf(a_log[dh]), dtb = dt_bias[dh]; float dt2[2], cum2[2];
#pragma unroll
      for (int e = 0; e < 2; ++e) { const float dr = G[rr[e] * 32 + 16 + dh] + dtb; dt2[e] = dr > 20.f ? dr : __logf(1.f + __expf(dr)); }
      const float p0 = dt2[0] * a, p1 = p0 + dt2[1] * a; const float inc = wscan_add(p1, lane); const float exc = inc - p1;
      cum2[0] = exc + p0; cum2[1] = exc + p1; const float cend = __shfl(inc, 63); const float sdv = __builtin_amdgcn_exp2f(cend * L2E);
      float* gb = G2 + g2_block(b, c, dh) + 2 * lane;
      *(f32x2v*)(gb) = (f32x2v){cum2[0] * L2E, cum2[1] * L2E};
      *(f32x2v*)(gb + 128) = (f32x2v){-cum2[0] * L2E + __builtin_amdgcn_logf(dt2[0]), -cum2[1] * L2E + __builtin_amdgcn_logf(dt2[1])};
      *(f32x2v*)(gb + 256) = (f32x2v){__builtin_amdgcn_exp2f(cum2[0] * L2E), __builtin_amdgcn_exp2f(cum2[1] * L2E)};
      *(f32x2v*)(gb + 384) = (f32x2v){__builtin_amdgcn_exp2f((cend - cum2[0]) * L2E) * dt2[0], __builtin_amdgcn_exp2f((cend - cum2[1]) * L2E) * dt2[1]};
      if (lane == 0) gb[896] = sdv; }
    {
      const float bi = b_i[dh], bfg = b_f[dh]; float ig[2], lf[2];
#pragma unroll
      for (int e = 0; e < 2; ++e) { const float* gr = G + rr[e] * 32; ig[e] = gr[(2 * dir) * 4 + h] + bi; const float fg = gr[(2 * dir + 1) * 4 + h] + bfg; lf[e] = fminf(fg, 0.f) - __logf(1.f + __expf(-fabsf(fg))); }
      const float p1 = lf[0] + lf[1]; const float inc = wscan_add(p1, lane); const float exc = inc - p1;
      const float bb0 = exc + lf[0], bb1 = exc + p1, aa0 = ig[0] - bb0, aa1 = ig[1] - bb1;
      const float q1m = fmaxf(aa0, aa1); const float incm = wscan_max(q1m, lane); float excm = __shfl_up(incm, 1); if (lane == 0) excm = -INFINITY;
      float* gb = G2 + g2_block(b, c, dh) + 512 + 2 * lane;
      *(f32x2v*)(gb) = (f32x2v){aa0, aa1}; *(f32x2v*)(gb + 128) = (f32x2v){fmaxf(excm, aa0), fmaxf(excm, q1m)}; *(f32x2v*)(gb + 256) = (f32x2v){bb0, bb1}; } }
}
#define SCAN_BAR_L() do { asm volatile("s_waitcnt lgkmcnt(0)" ::: "memory"); __builtin_amdgcn_s_barrier(); asm volatile("" ::: "memory"); } while (0)

__device__ __forceinline__ void mamba_chain(LAS char* lds, const bf16* __restrict__ UC, const float* __restrict__ G2, bf16* __restrict__ YD, int b, int h, int dir, int pm = 15) {
  int tid_ = threadIdx.x; asm volatile("" : "+v"(tid_));
  const int tid = tid_, lane = tid & 63, wid = __builtin_amdgcn_readfirstlane(tid >> 6), g = h >> 1;
  LAS char* Qm = lds; LAS char* Km = lds + 32768; LAS char* Vm = lds + 65536; LAS char* Vw = lds + 81920; LAS char* Ss = lds + 98304;
  LAS float* rowexp = (LAS float*)(lds + 114688); LAS float* colexp = rowexp + 128; LAS float* isc = rowexp + 256; LAS float* vw = rowexp + 384; LAS float* misc = rowexp + 512;
  for (int i = tid; i < 16384 / 4; i += 512) ((LAS unsigned*)Ss)[i] = 0u;
  f32x16 st_acc = {};
  const size_t rowb = (size_t)b * RB;
  u32x4 pb[4], pcq[4], px[2]; f32x4 scn = {0.f, 0.f, 0.f, 0.f}; float sdn = 0.f;
  const int rB = tid >> 4, cB = tid & 15, rX = tid >> 3, cX = tid & 7;
  const int iB = dir ? 127 - rB : rB, iX = dir ? 127 - rX : rX; const int oB = img_off<128>(iB, cB * 8), oX = img_off<128>(iX, cX * 8); const int stB = dir ? -2048 : 2048, stX = dir ? -4096 : 4096;
#define MAMBA_LOAD(cc_) do { int row0_, seg0_, seglen_; chunk_rows((cc_), dir, row0_, seg0_, seglen_); \
    const bf16* ub_ = UC + (rowb + row0_ + rB) * 768 + 256 + g * 128 + cB * 8; const bf16* ux_ = UC + (rowb + row0_ + rX) * 768 + h * 64 + cX * 8; \
    _Pragma("unroll") for (int k = 0; k < 4; ++k) { pb[k] = *(const u32x4*)(ub_ + (size_t)k * 32 * 768); pcq[k] = *(const u32x4*)(ub_ + (size_t)k * 32 * 768 + 256); } \
    _Pragma("unroll") for (int k = 0; k < 2; ++k) px[k] = *(const u32x4*)(ux_ + (size_t)k * 64 * 768); \
    { const float* gp_ = G2 + g2_block(b, row0_ < NC ? row0_ >> 7 : 2 + ((row0_ - NC) >> 7), dir * 4 + h); if (tid < 128) { scn = (f32x4){gp_[tid], gp_[128 + tid], gp_[256 + tid], gp_[384 + tid]}; sdn = gp_[896]; } } } while (0)
  MAMBA_LOAD(0);
  SCAN_BAR();
#pragma unroll 1
  for (int cc = 0; cc < 34; ++cc) {
    int row0, seg0, seglen; chunk_rows(cc, dir, row0, seg0, seglen);
    if (tid < 128 && (pm & 1)) { rowexp[tid] = scn[0]; colexp[tid] = scn[1]; isc[tid] = scn[2]; vw[tid] = scn[3]; if (tid == 0) misc[0] = sdn; }
    SCAN_BAR_L();
    if (pm & 2) {
#pragma unroll
      for (int k = 0; k < 4; ++k) { *(LAS u32x4*)(Km + oB + k * stB) = pb[k]; *(LAS u32x4*)(Qm + oB + k * stB) = pcq[k]; }
#pragma unroll
      for (int k = 0; k < 2; ++k) { const int i = dir ? iX - 64 * k : iX + 64 * k; const float sv = vw[i]; u32x4 pw;
#pragma unroll
        for (int e = 0; e < 4; ++e) pw[e] = cvtpk(bf_lo(px[k][e]) * sv, bf_hi(px[k][e]) * sv);
        *(LAS u32x4*)(Vm + oX + k * stX) = px[k]; *(LAS u32x4*)(Vw + oX + k * stX) = pw; }
    }
    SCAN_BAR_L();
    if (cc + 1 < 34 && (pm & 2)) MAMBA_LOAD(cc + 1);
    f32x16 res0 = {}, res1 = {}; if (pm & 4) chunk_core<128, 64>(Qm, Km, Vm, Ss, rowexp, colexp, isc, res0, res1, wid, lane);
    if (pm == 15) { const int vp = wid >> 2, tb = vp ? 3 - (wid & 3) : (wid & 3), r32 = lane & 31, hh = lane >> 5; LAS char* ot = lds + (vp ? 132096 : 117248);
#pragma unroll
      for (int r = 0; r < 16; ++r) *(LAS bf16*)(ot + (32 * tb + crow(r, hh)) * 64 + r32 * 2) = f2bf(res0[r]); }
    const float sd = misc[0];
    SCAN_BAR_L();
    if (pm == 15) {
#pragma unroll
      for (int k = 0; k < 2; ++k) { const int t = (tid >> 3) + 64 * k, pc = tid & 7, io = dir ? 127 - t : t;
        const u32x4 v = *(LAS const u32x4*)(lds + ((pc >> 2) ? 132096 : 117248) + t * 64 + (pc & 3) * 16);
        *(u32x4*)(YD + ((size_t)dir * M + rowb + row0 + io) * 256 + h * 64 + pc * 8) = v; } }
    if (pm & 8) state_update<128, 64>(Km, Vw, Ss, st_acc, sd, wid, lane);
  }
#undef MAMBA_LOAD
  SCAN_BAR();
}

__device__ __forceinline__ void mlstm_chain(LAS char* lds, const bf16* __restrict__ P, const float* __restrict__ G2, bf16* __restrict__ HC, int b, int h, int dir) {
  int tid_ = threadIdx.x; asm volatile("" : "+v"(tid_));
  const int tid = tid_, lane = tid & 63, wid = __builtin_amdgcn_readfirstlane(tid >> 6);
  LAS char* Qm = lds; LAS char* Km = lds + 16384; LAS char* Vm = lds + 32768; LAS char* Vw = lds + 57344; LAS char* Ss = lds + 81920;
  LAS float* rowexp = (LAS float*)(lds + 94208); LAS float* colexp = rowexp + 128; LAS float* isc = rowexp + 256; LAS float* vw = rowexp + 384; LAS float* emn = rowexp + 512; LAS float* den = rowexp + 640; LAS float* misc = rowexp + 768;
  for (int i = tid; i < 12288 / 4; i += 512) ((LAS unsigned*)Ss)[i] = 0u;
  f32x16 st_acc = {};
  float m_prev = 0.f;
  const size_t rowb = (size_t)b * RB;
  const int io = tid >> 2, part = tid & 3, i = dir ? 127 - io : io;
  u32x4 q0, q1, k0, k1, v0, v1; float an = 0.f, pmn = 0.f, bn = 0.f, pm_end = 0.f, b_end = 0.f;
#define MLSTM_LOAD(cc_) do { int row0_, seg0_, seglen_; chunk_rows((cc_), dir, row0_, seg0_, seglen_); \
    const bf16* pr = P + (rowb + row0_ + io) * NP + h * 64 + part * 16; \
    q0 = *(const u32x4*)(pr + 1024); q1 = *(const u32x4*)(pr + 1024 + 8); k0 = *(const u32x4*)(pr + 1280); k1 = *(const u32x4*)(pr + 1280 + 8); v0 = *(const u32x4*)(pr + 1536); v1 = *(const u32x4*)(pr + 1536 + 8); \
    { const float* gp_ = G2 + g2_block(b, row0_ < NC ? row0_ >> 7 : 2 + ((row0_ - NC) >> 7), dir * 4 + h) + 512; pm_end = gp_[128 + 127]; b_end = gp_[256 + 127]; \
      if (tid < 128) { an = gp_[tid]; pmn = gp_[128 + tid]; bn = gp_[256 + tid]; } } } while (0)
#define MLSTM_FLUSH(r0_) do { _Pragma("unroll") for (int k = 0; k < 2; ++k) { const int t = (tid >> 3) + 64 * k, pc = tid & 7, ioo = dir ? 127 - t : t; \
      const u32x4 v = *(LAS const u32x4*)(lds + 98304 + t * 128 + pc * 16); *(u32x4*)(HC + ((size_t)dir * M + rowb + (r0_) + ioo) * 256 + h * 64 + pc * 8) = v; } } while (0)
  int prow0 = 0;
  MLSTM_LOAD(0);
  SCAN_BAR();
#pragma unroll 1
  for (int cc = 0; cc < 34; ++cc) {
    int row0, seg0, seglen; chunk_rows(cc, dir, row0, seg0, seglen);
    { const float mm_end = fmaxf(m_prev, pm_end);
      if (tid < 128) { const float mm = fmaxf(m_prev, pmn); rowexp[tid] = -mm * L2E; colexp[tid] = an * L2E; isc[tid] = __builtin_amdgcn_exp2f((m_prev - mm) * L2E); emn[tid] = __builtin_amdgcn_exp2f(-(bn + mm) * L2E); vw[tid] = __builtin_amdgcn_exp2f((an - mm_end) * L2E);
        if (tid == 0) misc[0] = __builtin_amdgcn_exp2f((m_prev - mm_end) * L2E); }
      m_prev = b_end + mm_end; }
    SCAN_BAR_L();
    if (cc > 0) MLSTM_FLUSH(prow0);
    prow0 = row0;
    {
      const float s = vw[i];
      u32x4 qa, qb, va, vb;
#pragma unroll
      for (int e = 0; e < 4; ++e) { qa[e] = cvtpk(bf_lo(q0[e]) * 0.125f, bf_hi(q0[e]) * 0.125f); qb[e] = cvtpk(bf_lo(q1[e]) * 0.125f, bf_hi(q1[e]) * 0.125f);
        va[e] = cvtpk(bf_lo(v0[e]) * s, bf_hi(v0[e]) * s); vb[e] = cvtpk(bf_lo(v1[e]) * s, bf_hi(v1[e]) * s); }
      const int o0 = img_off<128>(i, part * 16), o1 = img_off<128>(i, part * 16 + 8);
      *(LAS u32x4*)(Qm + o0) = qa; *(LAS u32x4*)(Qm + o1) = qb; *(LAS u32x4*)(Km + o0) = k0; *(LAS u32x4*)(Km + o1) = k1;
      *(LAS u32x4*)(Vm + o0) = v0; *(LAS u32x4*)(Vm + o1) = v1; *(LAS u32x4*)(Vw + o0) = va; *(LAS u32x4*)(Vw + o1) = vb;
      const int o2 = img_off<128>(i, 64 + part * 8);
      const unsigned one = part == 0 ? 0x3f80u : 0u, wkb = part == 0 ? (cvtpk(s, 0.f) & 0xffffu) : 0u;
      *(LAS u32x4*)(Vm + o2) = (u32x4){one, 0u, 0u, 0u}; *(LAS u32x4*)(Vw + o2) = (u32x4){wkb, 0u, 0u, 0u};
    }
    SCAN_BAR_L();
    if (cc + 1 < 34) MLSTM_LOAD(cc + 1);
    f32x16 res0, res1; chunk_core<64, 96>(Qm, Km, Vm, Ss, rowexp, colexp, isc, res0, res1, wid, lane);
    const int vp = wid >> 2, tb = vp ? 3 - (wid & 3) : (wid & 3), r32 = lane & 31, hh = lane >> 5;
    if (vp == 0 && r32 == 0) {
#pragma unroll
      for (int r = 0; r < 16; ++r) den[32 * tb + crow(r, hh)] = res1[r];
    }
    const float sd = misc[0];
    float em[16];
#pragma unroll
    for (int r = 0; r < 16; ++r) em[r] = emn[32 * tb + crow(r, hh)];
    SCAN_BAR_L();
#pragma unroll
    for (int r = 0; r < 16; ++r) { const int t = 32 * tb + crow(r, hh); const float dn = fmaxf(fabsf(den[t]), em[r]);
      *(LAS bf16*)(lds + 98304 + t * 128 + (32 * vp + r32) * 2) = f2bf(res0[r] / dn); }
    state_update<64, 96>(Km, Vw, Ss, st_acc, sd, wid, lane);
  }
#undef MLSTM_LOAD
  SCAN_BAR();
  MLSTM_FLUSH(prow0);
#undef MLSTM_FLUSH
  SCAN_BAR();
}
#undef MFMA32
}
namespace pg8 {
typedef float f32x4e __attribute__((ext_vector_type(4)));
typedef unsigned u32x2 __attribute__((ext_vector_type(2)));
struct FusedNorm {
    const float* SS; const float* bias; int fused, fused_ctx; const PG8_LAS float* rsT; mutable int ui;
    __device__ __forceinline__ bool on(const Unit& u) const { return fused && (fused_ctx || (u.pm % 17) != 0); }
    __device__ __forceinline__ void load(const Unit& u, int wr, int fr, int col0, float (&rs)[2][4], f32x4 (&bv)[2][2]) const {
        const int b = u.pm / 17, tp = u.pm % 17; const __attribute__((address_space(1))) float* bp = (const __attribute__((address_space(1))) float*)bias + (tp == 0 ? 8 : b) * 4096 + col0;
#pragma unroll
        for (int bj = 0; bj < 2; ++bj) { bv[bj][0] = *(const __attribute__((address_space(1))) f32x4*)(bp + bj * HALF); bv[bj][1] = *(const __attribute__((address_space(1))) f32x4*)(bp + bj * HALF + 4); }
#pragma unroll
        for (int ai = 0; ai < 2; ++ai)
#pragma unroll
            for (int m = 0; m < 4; ++m) rs[ai][m] = rsT[ui * 256 + ai * HALF + wr * 64 + m * 16 + fr];
    }
    template <class Sched> __device__ __forceinline__ void fill(const Sched& S, PG8_LAS float* tab, int tid) const {
        Unit u;
        for (int i = 0; S.next(i, u); ++i) { const int row = tid >> 1, half = tid & 1; float v = 1.f;
            if (on(u)) { const __attribute__((address_space(1))) f32x4* p = (const __attribute__((address_space(1))) f32x4*)(SS + ((size_t)u.pm * BM + row) * 16 + half * 8); const f32x4 t = p[0] + p[1]; float sum = (t[0] + t[1]) + (t[2] + t[3]); sum += __shfl_xor(sum, 1);
                v = __builtin_amdgcn_rsqf(sum * (1.f / 1024.f) + 1e-6f); }
            if (half == 0) tab[i * 256 + row] = v; }
        __syncthreads();
    }
};
__host__ __device__ __forceinline__ int lcol(int p) { return (p & ~255) + ((p >> 5) & 3) * 64 + ((p >> 7) & 1) * 32 + (p & 31); }
__device__ __forceinline__ u32x4 ror8(const u32x4 v) { u32x4 r;
#pragma unroll
    for (int e = 0; e < 4; ++e) r[e] = (unsigned)__builtin_amdgcn_update_dpp(0, (int)v[e], 0x128, 0xF, 0xF, true);
    return r; }
__device__ __forceinline__ void store_rows128(bf16_t* rp, int ld, int fr, int fq, const u32x4 w0, const u32x4 w1) {
    const u32x4 x0 = ror8(w0), x1 = ror8(w1); const bool lo = fr < 8; u32x4 dA, dB;
#pragma unroll
    for (int e = 0; e < 4; ++e) { dA[e] = lo ? w0[e] : x1[e]; dB[e] = lo ? x0[e] : w1[e]; }
    bf16_t* q = rp + (size_t)(fr & 7) * ld + (lo ? 0 : 32) + 8 * fq;
    *(u32x4*)q = dA; *(u32x4*)(q + (size_t)8 * ld) = dB;
}
struct EpiInProj {
    static constexpr bool PERM = true, AFTER_DRAIN = false;
    bf16_t* O; float* G; FusedNorm F;
    __device__ __forceinline__ void operator()(const f32x4 (&acc)[2][2][4][2], const Unit& u, int wr, int wc, int fr, int fq) const {
        const int row0 = u.pm * BM + wr * 64 + fr, col0 = u.pn * BM + wc * 32 + 8 * fq;
        float rs[2][4]; f32x4 bv[2][2]; const bool fz = F.on(u);
        if (fz) F.load(u, wr, fr, col0, rs, bv);
        else {
#pragma unroll
            for (int ai = 0; ai < 2; ++ai)
#pragma unroll
                for (int m = 0; m < 4; ++m) rs[ai][m] = 1.f;
#pragma unroll
            for (int bj = 0; bj < 2; ++bj) { bv[bj][0] = (f32x4){0.f, 0.f, 0.f, 0.f}; bv[bj][1] = (f32x4){0.f, 0.f, 0.f, 0.f}; } }
#pragma unroll
        for (int ai = 0; ai < 2; ++ai)
#pragma unroll
            for (int m = 0; m < 4; ++m) { const float r_ = rs[ai][m]; u32x4 w[2];
#pragma unroll
                for (int bj = 0; bj < 2; ++bj) { const f32x4 v0 = acc[ai][bj][m][0] * r_ + bv[bj][0], v1 = acc[ai][bj][m][1] * r_ + bv[bj][1];
                    w[bj].x = cvt_pk_bf16(v0[0], v0[1]); w[bj].y = cvt_pk_bf16(v0[2], v0[3]); w[bj].z = cvt_pk_bf16(v1[0], v1[1]); w[bj].w = cvt_pk_bf16(v1[2], v1[3]); }
                store_rows128(O + (size_t)(u.pm * BM + wr * 64 + ai * HALF + m * 16) * 3328 + u.pn * BM + wc * 64, 3328, fr, fq, w[0], w[1]); }
        if (u.pn == 12 && wc == 0) {
#pragma unroll
            for (int ai = 0; ai < 2; ++ai)
#pragma unroll
                for (int m = 0; m < 4; ++m) { float* gp = G + (size_t)(row0 + ai * HALF + m * 16) * 32 + 8 * fq; const float r_ = rs[ai][m]; *(f32x4*)gp = acc[ai][0][m][0] * r_ + bv[0][0]; *(f32x4*)(gp + 4) = acc[ai][0][m][1] * r_ + bv[0][1]; }
        }
        ++F.ui;
    }
};
struct EpiRelu2 {
    static constexpr bool PERM = true, AFTER_DRAIN = false;
    bf16_t* O; FusedNorm F;
    __device__ __forceinline__ void operator()(const f32x4 (&acc)[2][2][4][2], const Unit& u, int wr, int wc, int fr, int fq) const {
        const int row0 = u.pm * BM + wr * 64 + fr, col0 = u.pn * BM + wc * 32 + 8 * fq;
        float rs[2][4]; f32x4 bv[2][2]; const bool fz = F.on(u);
        if (fz) F.load(u, wr, fr, col0, rs, bv);
        else {
#pragma unroll
            for (int ai = 0; ai < 2; ++ai)
#pragma unroll
                for (int m = 0; m < 4; ++m) rs[ai][m] = 1.f;
#pragma unroll
            for (int bj = 0; bj < 2; ++bj) { bv[bj][0] = (f32x4){0.f, 0.f, 0.f, 0.f}; bv[bj][1] = (f32x4){0.f, 0.f, 0.f, 0.f}; } }
#pragma unroll
        for (int ai = 0; ai < 2; ++ai)
#pragma unroll
            for (int m = 0; m < 4; ++m) { const float r_ = rs[ai][m]; u32x4 w[2];
#pragma unroll
                for (int bj = 0; bj < 2; ++bj) { f32x4 v0 = acc[ai][bj][m][0] * r_ + bv[bj][0], v1 = acc[ai][bj][m][1] * r_ + bv[bj][1];
#pragma unroll
                    for (int e = 0; e < 4; ++e) { const float a = v0[e] > 0.f ? v0[e] : 0.f, b = v1[e] > 0.f ? v1[e] : 0.f; v0[e] = a * a; v1[e] = b * b; }
                    w[bj].x = cvt_pk_bf16(v0[0], v0[1]); w[bj].y = cvt_pk_bf16(v0[2], v0[3]); w[bj].z = cvt_pk_bf16(v1[0], v1[1]); w[bj].w = cvt_pk_bf16(v1[2], v1[3]); }
                store_rows128(O + (size_t)(u.pm * BM + wr * 64 + ai * HALF + m * 16) * 4096 + u.pn * BM + wc * 64, 4096, fr, fq, w[0], w[1]); }
        ++F.ui;
    }
};
template <class T> __device__ __forceinline__ T* uni_ptr(T* p) { const unsigned long long v = (unsigned long long)(uintptr_t)p; const unsigned lo = (unsigned)__builtin_amdgcn_readfirstlane((int)(unsigned)v), hi = (unsigned)__builtin_amdgcn_readfirstlane((int)(unsigned)(v >> 32)); return (T*)(uintptr_t)(((unsigned long long)hi << 32) | lo); }
typedef _Float16 h16x2 __attribute__((ext_vector_type(2)));
typedef float f32x2e __attribute__((ext_vector_type(2)));
__device__ __forceinline__ unsigned pk_h16(float lo, float hi) { const f32x2e v = {lo, hi}; return __builtin_bit_cast(unsigned, __builtin_convertvector(v, h16x2)); }
__device__ __forceinline__ float h16_lo(unsigned w) { return (float)__builtin_bit_cast(h16x2, w)[0]; }
__device__ __forceinline__ float h16_hi(unsigned w) { return (float)__builtin_bit_cast(h16x2, w)[1]; }
template <bool XF32>
struct EpiResid {
    static constexpr bool PERM = false, AFTER_DRAIN = false;
    unsigned char* ws; const float* x_in; const float* ctx_in; const float* g_next; int l, flags;
    __device__ __forceinline__ void operator()(const f32x4 (&acc)[2][2][4][2], const Unit& u, int wr, int wc, int fr, int fq) const {
        const int b = u.pm / 17, tp = u.pm % 17, mb = tp == 0 ? 8 : b; const bool is_ff2 = flags & 1, fuse = flags & 2; const float gsign = (flags & 4) ? -1.f : 1.f;
        const float* modl = (const float*)(ws + mk::WS_MOD) + (size_t)l * 9 * 6144;
        const size_t grow0 = (size_t)u.pm * BM;
        bf16_t* xs = (bf16_t*)(ws + mk::WS_XS) + grow0 * 1024;
        const void* xin = xs;
        if (XF32) xin = uni_ptr(tp == 0 ? ctx_in + (size_t)b * 256 * 1024 : x_in + ((size_t)b * 4096 + (size_t)(tp - 1) * 256) * 1024);
        const auto rin = __builtin_amdgcn_make_buffer_rsrc((void*)xin, 0, 256 * 1024 * (XF32 ? 4 : 2), 0x00020000), rxs = __builtin_amdgcn_make_buffer_rsrc((void*)xs, 0, 256 * 1024 * 2, 0x00020000);
        const auto rh = __builtin_amdgcn_make_buffer_rsrc((void*)((bf16_t*)(ws + mk::WS_H) + grow0 * 1024), 0, 256 * 1024 * 2, 0x00020000);
        const auto rgate = __builtin_amdgcn_make_buffer_rsrc((void*)(modl + mb * 6144 + (is_ff2 ? 5120 : 2048)), 0, 4096, 0x00020000);
        const auto rsc = __builtin_amdgcn_make_buffer_rsrc((void*)((is_ff2 ? (const float*)(ws + mk::WS_MOD) + (size_t)9 * 6144 + 1024 : modl + 4096) + mb * 6144), 0, 4096, 0x00020000);
        const auto rgn = __builtin_amdgcn_make_buffer_rsrc((void*)g_next, 0, 4096, 0x00020000);
        typedef __attribute__((address_space(1))) u32x4 gu4; typedef __attribute__((address_space(1))) bf16_t gb16;
        gb16* xsb = (gb16*)uni_ptr(xs); gb16* hb = (gb16*)uni_ptr((bf16_t*)(ws + mk::WS_H) + grow0 * 1024);
        const int colw = u.pn * BM + wc * 32 + (fq & 1) * 16 + (fq >> 1) * 8;
        const unsigned vb = (unsigned)(((wr * 64 + fr) * 1024 + colw) * 2), vc = (unsigned)(colw * 4);
        float ssq[2][4];
#pragma unroll
        for (int ai = 0; ai < 2; ++ai)
#pragma unroll
            for (int m = 0; m < 4; ++m) ssq[ai][m] = 0.f;
#pragma unroll
        for (int bj = 0; bj < 2; ++bj) { const int cb = bj * HALF;
            u32x4 gvr[2], gnr[2], scr_[2], xr[2][4][XF32 ? 2 : 1];
#pragma unroll
            for (int h = 0; h < 2; ++h) { gvr[h] = __builtin_amdgcn_raw_buffer_load_b128(rgate, vc + cb * 4 + h * 16, 0, 0); gnr[h] = __builtin_amdgcn_raw_buffer_load_b128(rgn, vc + cb * 4 + h * 16, 0, 0); scr_[h] = __builtin_amdgcn_raw_buffer_load_b128(rsc, vc + cb * 4 + h * 16, 0, 0); }
#pragma unroll
            for (int h = 0; h < (XF32 ? 2 : 1); ++h)
#pragma unroll
            for (int ai = 0; ai < 2; ++ai)
#pragma unroll
                for (int m = 0; m < 4; ++m) {
                    if (XF32) xr[ai][m][XF32 ? h : 0] = __builtin_amdgcn_raw_buffer_load_b128(rin, vb * 2 + cb * 4 + h * 16, (ai * HALF + m * 16) * 4096, 0);
                    else xr[ai][m][0] = __builtin_amdgcn_raw_buffer_load_b128(rin, vb + cb * 2, (ai * HALF + m * 16) * 2048, 0); }
            float gv[8], gm[8];
#pragma unroll
            for (int e = 0; e < 8; ++e) { gv[e] = __uint_as_float(gvr[e >> 2][e & 3]) * gsign; gm[e] = __uint_as_float(gnr[e >> 2][e & 3]) * (__uint_as_float(scr_[e >> 2][e & 3]) + 1.f); }
#pragma unroll
            for (int ai = 0; ai < 2; ++ai)
#pragma unroll
                for (int m = 0; m < 4; ++m) { float xn[8];
#pragma unroll
                    for (int e = 0; e < 4; ++e) { const auto r = __builtin_amdgcn_permlane16_swap(__float_as_uint(acc[ai][bj][m][0][e]), __float_as_uint(acc[ai][bj][m][1][e]), false, false); xn[e] = __uint_as_float(r[0]); xn[4 + e] = __uint_as_float(r[1]); }
#pragma unroll
                    for (int e = 0; e < 8; ++e) { float xv; if (XF32) xv = __uint_as_float(xr[ai][m][XF32 ? (e >> 2) : 0][e & 3]); else { const unsigned w = xr[ai][m][0][e >> 1]; xv = (e & 1) ? h16_hi(w) : h16_lo(w); }
                        xn[e] = xv + gv[e] * xn[e]; }
                    const unsigned eo = (unsigned)((wr * 64 + fr + ai * HALF + m * 16) * 1024 + colw + cb);
                    *(gu4*)(xsb + eo) = (u32x4){pk_h16(xn[0], xn[1]), pk_h16(xn[2], xn[3]), pk_h16(xn[4], xn[5]), pk_h16(xn[6], xn[7])};
                    if (fuse) { ssq[ai][m] += ((xn[0] * xn[0] + xn[1] * xn[1]) + (xn[2] * xn[2] + xn[3] * xn[3])) + ((xn[4] * xn[4] + xn[5] * xn[5]) + (xn[6] * xn[6] + xn[7] * xn[7]));
                        *(gu4*)(hb + eo) = (u32x4){cvt_pk_bf16(xn[0] * gm[0], xn[1] * gm[1]), cvt_pk_bf16(xn[2] * gm[2], xn[3] * gm[3]), cvt_pk_bf16(xn[4] * gm[4], xn[5] * gm[5]), cvt_pk_bf16(xn[6] * gm[6], xn[7] * gm[7])}; } }
            asm volatile("" ::: "memory"); }
        if (fuse) { typedef __attribute__((address_space(1))) float gf; gf* SSp = (gf*)((float*)(ws + mk::WS_SS) + grow0 * 16);
#pragma unroll
            for (int ai = 0; ai < 2; ++ai)
#pragma unroll
                for (int m = 0; m < 4; ++m) { float sv = ssq[ai][m]; sv += __shfl_xor(sv, 16); sv += __shfl_xor(sv, 32); if (fq == 0) SSp[(unsigned)((ai * HALF + wr * 64 + m * 16 + fr) * 16 + u.pn * 4 + wc)] = sv; } }
    }
};
struct EpiFinal {
    static constexpr bool PERM = false, AFTER_DRAIN = false;
    unsigned char* ws; float* out; const float* gfin; PG8_LAS float* tab; int l;
    __device__ __forceinline__ void operator()(const f32x4 (&acc_)[2][2][4][2], const Unit& u, int wr, int wc, int fr, int fq) const {
        f32x4 (&acc)[2][2][4][2] = const_cast<f32x4 (&)[2][2][4][2]>(acc_);
        const int b = u.pm / 17, tp = u.pm % 17;
        const float* modl = (const float*)(ws + mk::WS_MOD) + (size_t)l * 9 * 6144;
        const size_t grow0 = (size_t)u.pm * BM;
        const auto rin = __builtin_amdgcn_make_buffer_rsrc((void*)((bf16_t*)(ws + mk::WS_XS) + grow0 * 1024), 0, 256 * 1024 * 2, 0x00020000);
        const auto rgate = __builtin_amdgcn_make_buffer_rsrc((void*)(modl + b * 6144 + 5120), 0, 4096, 0x00020000);
        const auto rgf = __builtin_amdgcn_make_buffer_rsrc((void*)gfin, 0, 4096, 0x00020000);
        typedef __attribute__((address_space(1))) f32x4 gf4; typedef __attribute__((address_space(1))) float gfl; gfl* ob = (gfl*)uni_ptr(out + ((size_t)b * 4096 + (size_t)(tp - 1) * 256) * 1024);
        const auto rss = __builtin_amdgcn_make_buffer_rsrc((void*)((float*)(ws + mk::WS_SS) + grow0 * 16), 0, 256 * 64, 0x00020000);
        const int colw = u.pn * BM + wc * 32 + 4 * fq;
        const unsigned vb = (unsigned)(((wr * 64 + fr) * 1024 + colw) * 2), vc = (unsigned)(colw * 4);
        float ssq[2][4];
#pragma unroll
        for (int ai = 0; ai < 2; ++ai)
#pragma unroll
            for (int m = 0; m < 4; ++m) ssq[ai][m] = 0.f;
        const unsigned vb8 = (unsigned)(((wr * 64 + fr) * 1024 + u.pn * BM + wc * 32 + (fq & 1) * 16 + (fq >> 1) * 8) * 2);
#pragma unroll
        for (int bj = 0; bj < 2; ++bj) { u32x4 xq[2][4];
#pragma unroll
            for (int ai = 0; ai < 2; ++ai)
#pragma unroll
                for (int m = 0; m < 4; ++m) xq[ai][m] = __builtin_amdgcn_raw_buffer_load_b128(rin, vb8 + bj * HALF * 2, (ai * HALF + m * 16) * 2048, 0);
            f32x4 gv[2];
#pragma unroll
            for (int n = 0; n < 2; ++n) gv[n] = __builtin_bit_cast(f32x4, __builtin_amdgcn_raw_buffer_load_b128(rgate, vc + (bj * HALF + n * 16) * 4, 0, 0));
#pragma unroll
            for (int ai = 0; ai < 2; ++ai)
#pragma unroll
                for (int m = 0; m < 4; ++m) { const auto r0 = __builtin_amdgcn_permlane16_swap(xq[ai][m].x, xq[ai][m].z, false, false), r1 = __builtin_amdgcn_permlane16_swap(xq[ai][m].y, xq[ai][m].w, false, false);
                    const unsigned xw[2][2] = {{r0[0], r1[0]}, {r0[1], r1[1]}};
#pragma unroll
                    for (int n = 0; n < 2; ++n) { const f32x4 xv = {h16_lo(xw[n][0]), h16_hi(xw[n][0]), h16_lo(xw[n][1]), h16_hi(xw[n][1])};
                        const f32x4 xn = xv + gv[n] * acc[ai][bj][m][n]; acc[ai][bj][m][n] = xn; ssq[ai][m] += (xn[0] * xn[0] + xn[1] * xn[1]) + (xn[2] * xn[2] + xn[3] * xn[3]); } } }
#pragma unroll
        for (int ai = 0; ai < 2; ++ai)
#pragma unroll
            for (int m = 0; m < 4; ++m) { float sv = ssq[ai][m]; sv += __shfl_xor(sv, 16); sv += __shfl_xor(sv, 32);
                if (fq == 0) __builtin_amdgcn_raw_buffer_store_b32(__float_as_uint(sv), rss, (unsigned)(((ai * HALF + wr * 64 + m * 16 + fr) * 16 + u.pn * 4 + wc) * 4), 0, 17); }
        asm volatile("s_waitcnt vmcnt(0)" ::: "memory");
        __builtin_amdgcn_s_barrier();
        int tid_ = threadIdx.x; asm volatile("" : "+v"(tid_));
        if (tid_ == 0) { unsigned* c = (unsigned*)(ws + mk::WS_CTL) + mk::CW_SUBBAR + 16 * u.pm;
            (void)__hip_atomic_fetch_add(c, 1u, __ATOMIC_RELAXED, __HIP_MEMORY_SCOPE_AGENT);
            unsigned sp = 0; while (__hip_atomic_load(c, __ATOMIC_RELAXED, __HIP_MEMORY_SCOPE_AGENT) < 4u && ++sp < (1u << 22)) __builtin_amdgcn_s_sleep(1);
            __builtin_amdgcn_fence(__ATOMIC_ACQUIRE, "agent"); asm volatile("s_waitcnt vmcnt(0)" ::: "memory"); }
        __builtin_amdgcn_s_barrier();
        asm volatile("" ::: "memory");
        if (tid_ < 256) { f32x4 t = {0.f, 0.f, 0.f, 0.f};
#pragma unroll
            for (int q = 0; q < 4; ++q) t += __builtin_bit_cast(f32x4, __builtin_amdgcn_raw_buffer_load_b128(rss, (unsigned)(tid_ * 64 + q * 16), 0, 17));
            tab[tid_] = __builtin_amdgcn_rsqf(((t[0] + t[1]) + (t[2] + t[3])) * (1.f / 1024.f) + 1e-6f); }
        asm volatile("s_waitcnt vmcnt(0) lgkmcnt(0)" ::: "memory");
        __builtin_amdgcn_s_barrier();
        asm volatile("" ::: "memory");
        float rs[2][4];
#pragma unroll
        for (int ai = 0; ai < 2; ++ai)
#pragma unroll
            for (int m = 0; m < 4; ++m) rs[ai][m] = tab[ai * HALF + wr * 64 + m * 16 + fr];
#pragma unroll
        for (int bj = 0; bj < 2; ++bj)
#pragma unroll
            for (int n = 0; n < 2; ++n) { const int ci = bj * HALF + n * 16;
                const f32x4 gf = __builtin_bit_cast(f32x4, __builtin_amdgcn_raw_buffer_load_b128(rgf, vc + ci * 4, 0, 0));
#pragma unroll
                for (int ai = 0; ai < 2; ++ai)
#pragma unroll
                    for (int m = 0; m < 4; ++m) { const f32x4 o = acc[ai][bj][m][n] * rs[ai][m] * gf; *(gf4*)(ob + (unsigned)((wr * 64 + fr + ai * HALF + m * 16) * 1024 + colw + ci)) = o; } }
    }
};
struct EpiSlab {
    static constexpr bool PERM = false, AFTER_DRAIN = false;
    float* slab;
    __device__ __forceinline__ void operator()(const f32x4 (&acc)[2][2][4][2], const Unit& u, int wr, int wc, int fr, int fq) const {
#pragma unroll
        for (int ai = 0; ai < 2; ++ai)
#pragma unroll
            for (int m = 0; m < 4; ++m) { float* rp = slab + (size_t)(ai * HALF + wr * 64 + m * 16 + fr) * 256 + wc * 32 + 4 * fq;
#pragma unroll
                for (int bj = 0; bj < 2; ++bj)
#pragma unroll
                    for (int n = 0; n < 2; ++n) *(f32x4*)(rp + bj * HALF + n * 16) = acc[ai][bj][m][n]; }
    }
};
struct OneUnit {
    Unit u;
    __device__ __forceinline__ bool next(int i, Unit& o) const { if (i != 0) return false; o = u; return true; }
    __device__ __forceinline__ void a_ready(const Unit&) const {}
    __device__ __forceinline__ void done(const Unit&) const {}
};
struct LatentOrder {
    StaticOrder base;
    __host__ __device__ void init(int N, int G_, int c_) { base.init(128 * 256, N, G_, c_); }
    __device__ __forceinline__ bool next(int i, Unit& u) const { if (!base.next(i, u)) return false; u.pm = (u.pm >> 4) * 17 + 1 + (u.pm & 15); return true; }
    __device__ __forceinline__ void a_ready(const Unit&) const {}
    __device__ __forceinline__ void done(const Unit&) const {}
};
}

namespace mk {
constexpr int NWAVES = 8;
constexpr int N_PHASES = 1 + 2 * 7 + 1;
constexpr int RING_OFF = 0, RING_BYTES = 131072, LDSCTL_OFF = RING_BYTES, MISC_OFF = LDSCTL_OFF + 320, LDS_BYTES = 147456;
constexpr int RS_OFF = LDSCTL_OFF + 1024;
static_assert(RS_OFF + 15 * 1024 <= LDS_BYTES, "LDS map");
#define RLX_AGENT __ATOMIC_RELAXED, __HIP_MEMORY_SCOPE_AGENT

struct Args {
  const float* in[25]; float* out; unsigned char* ws; int ph_lo, ph_hi, n_layers, use_cg; int rep[12];
};
enum { I_X = 0, I_C, I_CTX, I_CCTX, I_WADA, I_BADA, I_GN1, I_GN2, I_WIN, I_SINK, I_GQ, I_GK, I_BI, I_BF, I_GML, I_CW, I_CB, I_ALOG, I_DTB, I_DSK, I_GSSM, I_WOUT, I_W1, I_W2, I_GFIN };

template <class F> __device__ __forceinline__ void transpose_item(const float* W, int K, int N, bf16* WT, LAS float* scr, int item, int nblk, int lane, F srccol) {
  const int kb = item / nblk, nb = item % nblk, k0 = 64 * kb, n0 = 32 * nb;
  const int sc = srccol(n0 + (lane & 31));
  float tv[32];
#pragma unroll
  for (int i = 0; i < 32; ++i) { const int kk = 2 * i + (lane >> 5); tv[i] = sc >= 0 ? W[(size_t)(k0 + kk) * N + sc] : 0.f; }
#pragma unroll
  for (int i = 0; i < 32; ++i) { const int kk = 2 * i + (lane >> 5); scr[kk * 33 + (lane & 31)] = tv[i]; }
  asm volatile("s_waitcnt lgkmcnt(0)" ::: "memory");
  const int c = lane & 7;
#pragma unroll
  for (int j = 0; j < 4; ++j) { const int n = (lane >> 3) + 8 * j; const LAS float* s = scr + (8 * c) * 33 + n;
    u32x4 o; o.x = cvtpk(s[0 * 33], s[1 * 33]); o.y = cvtpk(s[2 * 33], s[3 * 33]); o.z = cvtpk(s[4 * 33], s[5 * 33]); o.w = cvtpk(s[6 * 33], s[7 * 33]);
    *(u32x4*)(WT + (size_t)(n0 + n) * K + k0 + 8 * c) = o; }
  asm volatile("s_waitcnt lgkmcnt(0)" ::: "memory");
}
__device__ __forceinline__ int win_srccol(int n) { return n < 2048 ? n : (n < 3072 ? n + 16 : (n < 3088 ? n - 1024 : (n < 3096 ? n : -1))); }

__device__ __forceinline__ void norm_row(const float* xrow, const float* g, const float* shv, const float* scv, bf16* orow, int lane, const float* slab = nullptr, const float* gate = nullptr, float* xout = nullptr) {
  const f32x4* xr = (const f32x4*)xrow + lane; f32x4 v[4]; float s = 0.f;
#pragma unroll
  for (int j = 0; j < 4; ++j) v[j] = xr[64 * j];
  if (slab) {
#pragma unroll
    for (int j = 0; j < 4; ++j) { f32x4 a = {0.f, 0.f, 0.f, 0.f};
#pragma unroll
      for (int ks = 0; ks < 8; ++ks) a += *(const f32x4*)(slab + (size_t)(j * 8 + ks) * 65536 + 4 * lane);
      v[j] += ((const f32x4*)gate)[64 * j + lane] * a; if (xout) ((f32x4*)xout)[64 * j + lane] = v[j]; }
  }
#pragma unroll
  for (int j = 0; j < 4; ++j) s += (v[j].x * v[j].x + v[j].y * v[j].y) + (v[j].z * v[j].z + v[j].w * v[j].w);
  const float rs = rsqrtf(wave_sum(s) * (1.f / DM) + EPS);
  unsigned long long* o8 = (unsigned long long*)orow + lane;
#pragma unroll
  for (int j = 0; j < 4; ++j) { const f32x4 gg = ((const f32x4*)g)[64 * j + lane], sh = ((const f32x4*)shv)[64 * j + lane], sc = ((const f32x4*)scv)[64 * j + lane];
    const f32x4 y = v[j] * rs * gg * (sc + 1.f) + sh;
    o8[64 * j] = (unsigned long long)cvtpk(y.x, y.y) | ((unsigned long long)cvtpk(y.z, y.w) << 32); }
}

__device__ __forceinline__ void norm_row_b(const bf16* xrow, const float* g, const float* shv, const float* scv, bf16* orow, int lane, const float* slab, const float* gate) {
  const u32x2* xr = (const u32x2*)xrow + lane; f32x4 v[4]; float s = 0.f; u32x2 xw[4];
#pragma unroll
  for (int j = 0; j < 4; ++j) xw[j] = xr[64 * j];
#pragma unroll
  for (int j = 0; j < 4; ++j) { f32x4 a = {0.f, 0.f, 0.f, 0.f};
#pragma unroll
    for (int ks = 0; ks < 8; ++ks) a += *(const f32x4*)(slab + (size_t)(j * 8 + ks) * 65536 + 4 * lane);
    v[j] = (f32x4){pg8::h16_lo(xw[j].x), pg8::h16_hi(xw[j].x), pg8::h16_lo(xw[j].y), pg8::h16_hi(xw[j].y)} + ((const f32x4*)gate)[64 * j + lane] * a; }
#pragma unroll
  for (int j = 0; j < 4; ++j) s += (v[j].x * v[j].x + v[j].y * v[j].y) + (v[j].z * v[j].z + v[j].w * v[j].w);
  const float rs = rsqrtf(wave_sum(s) * (1.f / DM) + EPS);
  unsigned long long* o8 = (unsigned long long*)orow + lane;
#pragma unroll
  for (int j = 0; j < 4; ++j) { const f32x4 gg = ((const f32x4*)g)[64 * j + lane], sh = ((const f32x4*)shv)[64 * j + lane], sc = ((const f32x4*)scv)[64 * j + lane];
    const f32x4 y = v[j] * rs * gg * (sc + 1.f) + sh;
    o8[64 * j] = (unsigned long long)cvtpk(y.x, y.y) | ((unsigned long long)cvtpk(y.z, y.w) << 32); }
}

__device__ __forceinline__ void norm_row2(const float* x0, const float* x1, const float* g, const float* shv, const float* scv, bf16* o0, bf16* o1, int lane) {
  const f32x4* xr0 = (const f32x4*)x0 + lane; const f32x4* xr1 = (const f32x4*)x1 + lane; f32x4 v0[4], v1[4]; float s0 = 0.f, s1 = 0.f;
#pragma unroll
  for (int j = 0; j < 4; ++j) { v0[j] = xr0[64 * j]; v1[j] = xr1[64 * j]; }
#pragma unroll
  for (int j = 0; j < 4; ++j) { s0 += (v0[j].x * v0[j].x + v0[j].y * v0[j].y) + (v0[j].z * v0[j].z + v0[j].w * v0[j].w); s1 += (v1[j].x * v1[j].x + v1[j].y * v1[j].y) + (v1[j].z * v1[j].z + v1[j].w * v1[j].w); }
  const float rs0 = rsqrtf(wave_sum(s0) * (1.f / DM) + EPS), rs1 = rsqrtf(wave_sum(s1) * (1.f / DM) + EPS);
  unsigned long long* p0 = (unsigned long long*)o0 + lane; unsigned long long* p1 = (unsigned long long*)o1 + lane;
#pragma unroll
  for (int j = 0; j < 4; ++j) { const f32x4 gg = ((const f32x4*)g)[64 * j + lane], sh = ((const f32x4*)shv)[64 * j + lane], sc = ((const f32x4*)scv)[64 * j + lane]; const f32x4 gm = gg * (sc + 1.f);
    const f32x4 y0 = v0[j] * rs0 * gm + sh, y1 = v1[j] * rs1 * gm + sh;
    p0[64 * j] = (unsigned long long)cvtpk(y0.x, y0.y) | ((unsigned long long)cvtpk(y0.z, y0.w) << 32); p1[64 * j] = (unsigned long long)cvtpk(y1.x, y1.y) | ((unsigned long long)cvtpk(y1.z, y1.w) << 32); }
}

__device__ __forceinline__ void attn_item(int idx, const bf16* P, bf16* Y, const float* sink, char* shm) {
  using attn_body::attn_unit; typedef attn_body::bf16 abf;
  bool isA; int b, hq, qrow, NT, band_row0 = 0, qpos0 = 0, band_s0 = 0;
  if (idx < 1024) { isA = idx >= 512; const int id = idx & 511; b = id >> 6; hq = (id >> 4) & 3; const int q0 = (id & 15) * 256; qrow = NC + q0; NT = 68;
    if (isA) { const int s_lo = q0 - 128 > 0 ? q0 - 128 : 0, s_hi = q0 + 384 < T ? q0 + 384 : T; NT = 4 + (s_hi - s_lo) / 64; band_row0 = NC + s_lo; qpos0 = q0; band_s0 = s_lo; } }
  else { const int id = idx - 1024; isA = id >= 32; b = (id & 31) >> 2; hq = id & 3; qrow = 0; NT = 4; }
  const int g = hq >> 1; const size_t rowb = (size_t)b * RB; const int cq = isA ? 0 : 512, ck = isA ? 256 : 768, cv = isA ? 384 : 896, cy = isA ? 0 : 256;
  const abf* Q0 = (const abf*)(P + (rowb + qrow) * NP + cq + hq * 64); const abf* Kh = (const abf*)(P + rowb * NP + ck + g * 64); const abf* Vh = (const abf*)(P + rowb * NP + cv + g * 64);
  abf* O0 = (abf*)(Y + (rowb + qrow) * DM + cy + hq * 64);
#ifndef MK_NO_B
  if (!isA) attn_unit<8, 0>(Q0, Kh, Vh, O0, NT, 0, 0, 0, 0.f, shm);
#endif
#ifndef MK_NO_A
  if (isA) attn_unit<8, 1>(Q0, Kh, Vh, O0, NT, band_row0, qpos0, band_s0, sink[hq] * L2E, shm);
#endif
}

__global__ void __launch_bounds__(NWAVES * 64, 2) mk_fwd(Args args) {
  extern __shared__ __attribute__((aligned(16))) unsigned char lds_raw[];
  LAS unsigned char* lds = (LAS unsigned char*)lds_raw;
  volatile LAS unsigned* MISC = (volatile LAS unsigned*)(lds + MISC_OFF);
  const int tid0 = threadIdx.x, wave = __builtin_amdgcn_readfirstlane(tid0 >> 6);
  for (int u = tid0; u < (LDS_BYTES - LDSCTL_OFF) / 4; u += NWAVES * 64) ((LAS unsigned*)(lds + LDSCTL_OFF))[u] = 0u;
  __syncthreads();
  if (tid0 < 25) ((volatile LAS unsigned long long*)(lds + MISC_OFF + 256))[tid0] = (unsigned long long)(uintptr_t)args.in[tid0];
  __syncthreads();
  XcdBarrier bar = xcd_barrier_post(((unsigned*)(args.ws + WS_CTL)) + CW_BAR, MISC + 8);
#ifndef MK_PHSEL
#define MK_PHSEL 0xFFFF
#endif
#ifndef MK_FIRST_SEAM_CG
#define MK_FIRST_SEAM_CG 1
#endif
#ifndef MK_PROBE_NOCHAIN
#define MK_PROBE_NOCHAIN 0
#endif
#ifndef MK_STAG6
#define MK_STAG6 0
#endif
#ifndef MK_STAG9
#define MK_STAG9 0
#endif
#define MK_STAGGER(n) do { if ((n) > 0 && ((bx >> 3) & 1)) { const unsigned long long t0_ = __builtin_amdgcn_s_memrealtime(); while (__builtin_amdgcn_s_memrealtime() - t0_ < (unsigned long long)(n)) __builtin_amdgcn_s_sleep(32); } } while (0)
#ifndef MK_PROBE_PM
#define MK_PROBE_PM 15
#endif
#ifndef MK_PROBE_NOATTN
#define MK_PROBE_NOATTN 0
#endif
#ifndef MK_PROBE_NOMAMBA
#define MK_PROBE_NOMAMBA 0
#endif
#ifndef MK_PROBE_NOMLSTM
#define MK_PROBE_NOMLSTM 0
#endif
#define AIN(k) ((const float*)(GAS const float*)(uintptr_t)(((unsigned long long)(unsigned)__builtin_amdgcn_readfirstlane((int)MISC[64 + 2 * (k) + 1]) << 32) | (unsigned long long)(unsigned)__builtin_amdgcn_readfirstlane((int)MISC[64 + 2 * (k)])))
#define PH_PROLOG int tid = threadIdx.x; asm volatile("" : "+v"(tid)); const int lane = tid & 63; (void)lane; int bx_ = blockIdx.x, G_ = gridDim.x; if (kind != 0) asm volatile("" : "+s"(bx_), "+s"(G_)); const int bx = bx_, G = G_, vcu = (G % 8 == 0) ? (bx % 8) * (G / 8) + bx / 8 : bx, gw = vcu * NWAVES + wave, NGW = G * NWAVES; (void)gw; (void)NGW; (void)vcu; GAS unsigned char* wsg_ = (GAS unsigned char*)args.ws; asm volatile("" : "+s"(wsg_)); unsigned char* wsp = (unsigned char*)wsg_;

  const int nph = N_PHASES;
#pragma unroll 1
  for (int ph = args.ph_lo; ph < args.ph_hi; ++ph) {
  int kind, l = 0;
  if (ph == 0) kind = 0; else if (ph == nph - 1) kind = 10; else { l = (ph - 1) / 7; const int q = (ph - 1) % 7; kind = q < 4 ? q + 1 : (q == 4 ? 6 : q + 3); }
  const int nrep = args.rep[kind];
  if (kind == 0) { PH_PROLOG if ((MK_PHSEL >> 0) & 1) for (int rp = 0; rp < nrep; ++rp) {
    {
      for (int cbk = vcu; cbk < 192; cbk += G) {
        LAS float* sc = (LAS float*)(lds + RING_OFF);
        LAS float* red = (LAS float*)(lds + RING_OFF + 36864);
        for (int i = tid; i < 9 * DM; i += NWAVES * 64) { const int j = i / DM, k = i % DM; const float v = j < 8 ? AIN(I_C)[j * DM + k] : AIN(I_CCTX)[k]; sc[i] = v / (1.f + __expf(-v)); }
        __syncthreads();
        const int col = cbk * 64 + lane, l = col / 6144, n = col % 6144; const float* w = AIN(I_WADA) + (size_t)l * DM * 6144 + n + (size_t)(wave * 128) * 6144;
        float acc[9];
#pragma unroll
        for (int j = 0; j < 9; ++j) acc[j] = 0.f;
#pragma unroll 1
        for (int k0 = 0; k0 < 128; k0 += 16) { float wv[16];
#pragma unroll
          for (int u = 0; u < 16; ++u) wv[u] = w[(size_t)(k0 + u) * 6144];
#pragma unroll
          for (int u = 0; u < 16; ++u)
#pragma unroll
            for (int j = 0; j < 9; ++j) acc[j] += sc[j * DM + wave * 128 + k0 + u] * wv[u]; }
#pragma unroll
        for (int j = 0; j < 9; ++j) red[(wave * 9 + j) * 64 + lane] = acc[j];
        __syncthreads();
        if (wave == 0) { const float bb = AIN(I_BADA)[l * 6144 + n];
#pragma unroll
          for (int j = 0; j < 9; ++j) { float sum = bb;
#pragma unroll
            for (int wv_ = 0; wv_ < 8; ++wv_) sum += red[(wv_ * 9 + j) * 64 + lane];
            ((float*)(wsp + WS_MOD))[(size_t)(l * 9 + j) * 6144 + n] = sum; } }
        __syncthreads();
      }
      for (int i = gw * 64 + lane; i < T * 32; i += NGW * 64) { const int t = i >> 5, e = i & 31, fi = e & 15; const float invf = __builtin_amdgcn_exp2f(-(float)fi * (13.287712379549449f / 16.f));
        const float ang = (float)(e < 16 ? (t >> 6) : (t & 63)) * invf; ((float*)(wsp + WS_CS))[i] = __cosf(ang); ((float*)(wsp + WS_CS))[T * 32 + i] = __sinf(ang); }
      LAS float* scr = (LAS float*)(lds + RING_OFF + 57344 + wave * 8704);
      constexpr int I_IN = 16 * 104, I_OUT = 16 * 32, I_1 = 16 * 128, I_2 = 64 * 32, I_L = I_IN + I_OUT + I_1 + I_2;
      for (int it = gw; it < 2 * I_L; it += NGW) {
        const int l = it / I_L; int r = it % I_L; unsigned char* wl = (wsp) + WS_W + (size_t)l * W_LAYER;
        if (r < I_IN) { transpose_item(AIN(I_WIN) + (size_t)l * DM * NINO, DM, NINO, (bf16*)(wl + WO_IN), scr, r, 104, lane, [](int n) { return win_srccol(pg8::lcol(n)); }); continue; } r -= I_IN;
        if (r < I_OUT) { transpose_item(AIN(I_WOUT) + (size_t)l * DM * DM, DM, DM, (bf16*)(wl + WO_OUT), scr, r, 32, lane, [](int n) { return n; }); continue; } r -= I_OUT;
        if (r < I_1) { transpose_item(AIN(I_W1) + (size_t)l * DM * DFF, DM, DFF, (bf16*)(wl + WO_1), scr, r, 128, lane, [](int n) { return pg8::lcol(n); }); continue; } r -= I_1;
        transpose_item(AIN(I_W2) + (size_t)l * DFF * DM, DFF, DM, (bf16*)(wl + WO_2), scr, r, 32, lane, [](int n) { return n; });
      }
    }
  } }

  {
    if (kind == 1) { PH_PROLOG if ((MK_PHSEL >> 1) & 1) for (int rp = 0; rp < nrep; ++rp) {
      if (l == 0) {
        for (int m = 2 * gw; m < M; m += 2 * NGW) { const int b = m / RB, r = m % RB; const bool isc = r < NC;
          const float* xr = isc ? AIN(I_CTX) + ctx_off(b, r) : AIN(I_X) + lat_off(b, r - NC); const float* mr = ((float*)(wsp + WS_MOD)) + (isc ? 8 : b) * 6144;
          bf16* hp = ((bf16*)(wsp + WS_H)) + (size_t)m * DM; norm_row2(xr, xr + DM, AIN(I_GN1), mr, mr + 1024, hp, hp + DM, lane); }
        { LAS float* shl = (LAS float*)(lds + RING_OFF); const float* mo = (const float*)(wsp + WS_MOD);
          for (int i = tid; i < 3 * 9 * DM; i += NWAVES * 64) { const int set = i / (9 * DM), j = (i / DM) % 9, k = i % DM; shl[i] = mo[(size_t)((set == 1 ? 0 : 1) * 9 + j) * 6144 + (set == 0 ? 0 : 3072) + k]; }
          __syncthreads();
          for (int c = gw; c < 3328 + 4096 + 4096; c += NGW) { const int set = c < 3328 ? 0 : (c < 7424 ? 1 : 2), n = c - (set == 0 ? 0 : (set == 1 ? 3328 : 7424));
            const bf16* wrow = (const bf16*)(wsp + WS_W + (size_t)(set == 1 ? 0 : 1) * W_LAYER + (set == 0 ? WO_IN : WO_1)) + (size_t)n * DM;
            float wf[16];
#pragma unroll
            for (int q = 0; q < 4; ++q) { const u32x2 w2 = *(const u32x2*)(wrow + 256 * q + 4 * lane); wf[4 * q] = bf_lo(w2.x); wf[4 * q + 1] = bf_hi(w2.x); wf[4 * q + 2] = bf_lo(w2.y); wf[4 * q + 3] = bf_hi(w2.y); }
            float outv = 0.f;
#pragma unroll
            for (int j = 0; j < 9; ++j) { const LAS float* sp = shl + (set * 9 + j) * DM + 4 * lane; float a = 0.f;
#pragma unroll
              for (int q = 0; q < 4; ++q) { const f32x4 sv = *(const LAS f32x4*)(sp + 256 * q); a += (sv[0] * wf[4 * q] + sv[1] * wf[4 * q + 1]) + (sv[2] * wf[4 * q + 2] + sv[3] * wf[4 * q + 3]); }
              a = wave_sum(a); if (lane == j) outv = a; }
            if (lane < 9) ((float*)(wsp + WS_BIAS))[(size_t)(set * 9 + lane) * 4096 + n] = outv; }
          __syncthreads(); }
      } else {
        for (int i = gw; i < NB * NC; i += NGW) { const int b = i / NC, r = i % NC; const size_t m = (size_t)b * RB + r;
          const bf16* xr = (const bf16*)(wsp + WS_XS) + m * DM; const float* mr = ((float*)(wsp + WS_MOD)) + (size_t)(9 + 8) * 6144; bf16* hp = ((bf16*)(wsp + WS_H)) + m * DM;
          const float* sl = ((const float*)(args.out)) + (size_t)(b * 32) * 65536 + (size_t)r * 256; const float* gt = ((const float*)(wsp + WS_MOD)) + 8 * 6144 + 5120;
          norm_row_b(xr, AIN(I_GN1) + DM, mr, mr + 1024, hp, lane, sl, gt); }
      }
    } }
    if (kind == 2) { PH_PROLOG if ((MK_PHSEL >> 2) & 1) for (int rp = 0; rp < nrep; ++rp) {
      { pg8::Gemm g{((bf16*)(wsp + WS_H)), (const bf16*)((wsp + WS_W + (size_t)l * W_LAYER) + WO_IN), M, NP, DM, DM}; pg8::StaticOrder S; S.init(M, NP, G, bx);
        pg8::EpiInProj E{((bf16*)(wsp + WS_P)), ((float*)(wsp + WS_G)), pg8::FusedNorm{(const float*)(wsp + WS_SS), (const float*)(wsp + WS_BIAS), l == 1, 0, (const LAS float*)(lds + RS_OFF), 0}};
        if (l == 1) E.F.fill(S, (LAS float*)(lds + RS_OFF), tid);
        pg8::gemm_phase<pg8::EpiInProj, pg8::StaticOrder, true, true>(lds + RING_OFF, g, S, E); }
    } }
    if (kind == 3) { PH_PROLOG if ((MK_PHSEL >> 3) & 1) for (int rp = 0; rp < nrep; ++rp) {
      { const float* gq = AIN(I_GQ) + l * 64; const float* gk = AIN(I_GK) + l * 64; const float* cw = AIN(I_CW) + l * 3 * 768; const float* cb = AIN(I_CB) + l * 768;
        bf16* Pq = ((bf16*)(wsp + WS_P)); bf16* UCb = ((bf16*)(args.out)); float* Gp = ((float*)(wsp + WS_G)); const float* cst = ((const float*)(wsp + WS_CS));
        const int hw = 2 * gw + (lane >> 5), l32 = lane & 31, which = hw % 3, j = l32 & 7, slot = 4 * which + (l32 >> 3);
        const int blk = slot < 6 ? slot : slot + 2;
        const bool isq = slot < 4 || (slot >= 6 && slot < 10), isB = slot >= 6;
        const float* gv = isq ? gq : gk; float gn[8];
#pragma unroll
        for (int e = 0; e < 8; ++e) gn[e] = gv[8 * j + e];
        const int cch = 256 * which + 8 * l32, pcol = (which == 0 ? 2048 : (which == 1 ? 2560 : 2816)) + 8 * l32;
#define PREPA_LOAD(m_, S) do { const int r_ = (m_) % RB; w##S = *(const u32x4*)(Pq + (size_t)(m_) * NP + blk * 64 + 8 * j); \
          { const float* cp_ = cst + (r_ >= NC ? r_ - NC : 0) * 32 + (j >> 2) * 16 + (j & 1) * 8; c0##S = *(const f32x4*)cp_; c1##S = *(const f32x4*)(cp_ + 4); s0##S = *(const f32x4*)(cp_ + T * 32); s1##S = *(const f32x4*)(cp_ + T * 32 + 4); } } while (0)
#define PREPA_DO(m_, S) do { const int r_ = (m_) % RB; bf16* p_ = Pq + (size_t)(m_) * NP + blk * 64 + 8 * j; float x[8] = {bf_lo(w##S.x), bf_hi(w##S.x), bf_lo(w##S.y), bf_hi(w##S.y), bf_lo(w##S.z), bf_hi(w##S.z), bf_lo(w##S.w), bf_hi(w##S.w)}; \
            if (isB) { float ss = 0.f; _Pragma("unroll") for (int e = 0; e < 8; ++e) ss += x[e] * x[e]; \
              ss += __shfl_xor(ss, 1); ss += __shfl_xor(ss, 2); ss += __shfl_xor(ss, 4); const float rs = rsqrtf(ss * (1.f / 64.f) + EPS); _Pragma("unroll") for (int e = 0; e < 8; ++e) x[e] = x[e] * rs * gn[e]; } \
            if (r_ >= NC) { const float cc[8] = {c0##S[0], c0##S[1], c0##S[2], c0##S[3], c1##S[0], c1##S[1], c1##S[2], c1##S[3]}, sn[8] = {s0##S[0], s0##S[1], s0##S[2], s0##S[3], s1##S[0], s1##S[1], s1##S[2], s1##S[3]}; \
              _Pragma("unroll") for (int e = 0; e < 8; ++e) { const float other = __shfl_xor(x[e], 2); x[e] = (j & 2) ? x[e] * cc[e] + other * sn[e] : x[e] * cc[e] - other * sn[e]; } } \
            if (isq) { _Pragma("unroll") for (int e = 0; e < 8; ++e) x[e] *= QC2; } \
            if (rp == 0) *(u32x4*)p_ = (u32x4){cvtpk(x[0], x[1]), cvtpk(x[2], x[3]), cvtpk(x[4], x[5]), cvtpk(x[6], x[7])}; } while (0)
#define PREPB_LOAD(m_, S) do { const int r_ = (m_) % RB; const int seg0_ = r_ < NC ? 0 : NC, seglen_ = r_ < NC ? NC : T, sl_ = r_ - seg0_; const bf16* px_ = Pq + (size_t)(m_) * NP + pcol; const u32x4 z4_ = {0u, 0u, 0u, 0u}; \
          xm##S = sl_ > 0 ? *(const u32x4*)(px_ - NP) : z4_; x0##S = *(const u32x4*)px_; xp##S = sl_ + 1 < seglen_ ? *(const u32x4*)(px_ + NP) : z4_; } while (0)
#define PREPB_DO(m_, S) do { float u[8]; _Pragma("unroll") for (int e = 0; e < 4; ++e) { const int q = e >> 1, o = (e & 1) * 2; \
              const float y0 = bb[q][o] + w0[q][o] * bf_lo(xm##S[e]) + w1[q][o] * bf_lo(x0##S[e]) + w2[q][o] * bf_lo(xp##S[e]); \
              const float y1 = bb[q][o + 1] + w0[q][o + 1] * bf_hi(xm##S[e]) + w1[q][o + 1] * bf_hi(x0##S[e]) + w2[q][o + 1] * bf_hi(xp##S[e]); \
              u[2 * e] = y0 / (1.f + __expf(-y0)); u[2 * e + 1] = y1 / (1.f + __expf(-y1)); } \
            *(u32x4*)(UCb + (size_t)(m_) * 768 + cch) = (u32x4){cvtpk(u[0], u[1]), cvtpk(u[2], u[3]), cvtpk(u[4], u[5]), cvtpk(u[6], u[7])}; } while (0)
        if (hw < 4095) {
          { u32x4 wA, wB, wC, wD; f32x4 c0A, c1A, s0A, s1A, c0B, c1B, s0B, s1B, c0C, c1C, s0C, s1C, c0D, c1D, s0D, s1D;
            const int S1 = 1365, mlast = hw / 3 + ((M - 1 - hw / 3) / S1) * S1;
#define CL(x_) ((x_) <= mlast ? (x_) : mlast)
            int m = hw / 3; PREPA_LOAD(m, A); PREPA_LOAD(CL(m + S1), B); PREPA_LOAD(CL(m + 2 * S1), C);
            for (; m <= mlast; m += 4 * S1) {
              PREPA_LOAD(CL(m + 3 * S1), D); PREPA_DO(m, A);
              PREPA_LOAD(CL(m + 4 * S1), A); if (m + S1 <= mlast) PREPA_DO(m + S1, B);
              PREPA_LOAD(CL(m + 5 * S1), B); if (m + 2 * S1 <= mlast) PREPA_DO(m + 2 * S1, C);
              PREPA_LOAD(CL(m + 6 * S1), C); if (m + 3 * S1 <= mlast) PREPA_DO(m + 3 * S1, D); } }
          int cch_ = cch; asm volatile("" : "+v"(cch_));
        f32x4 w0[2], w1[2], w2[2], bb[2];
#pragma unroll
        for (int q = 0; q < 2; ++q) { w0[q] = *(const f32x4*)(cw + cch_ + 4 * q); w1[q] = *(const f32x4*)(cw + 768 + cch_ + 4 * q); w2[q] = *(const f32x4*)(cw + 1536 + cch_ + 4 * q); bb[q] = *(const f32x4*)(cb + cch_ + 4 * q); }
          { u32x4 xmA, x0A, xpA, xmB, x0B, xpB, xmC, x0C, xpC, xmD, x0D, xpD; const int S1 = 1365, mlast = hw / 3 + ((M - 1 - hw / 3) / S1) * S1;
            int m = hw / 3; PREPB_LOAD(m, A); PREPB_LOAD(CL(m + S1), B); PREPB_LOAD(CL(m + 2 * S1), C);
            for (; m <= mlast; m += 4 * S1) {
              PREPB_LOAD(CL(m + 3 * S1), D); PREPB_DO(m, A);
              PREPB_LOAD(CL(m + 4 * S1), A); if (m + S1 <= mlast) PREPB_DO(m + S1, B);
              PREPB_LOAD(CL(m + 5 * S1), B); if (m + 2 * S1 <= mlast) PREPB_DO(m + 2 * S1, C);
              PREPB_LOAD(CL(m + 6 * S1), C); if (m + 3 * S1 <= mlast) PREPB_DO(m + 3 * S1, D); } }
#undef CL
        }
#undef PREPA_LOAD
#undef PREPA_DO
#undef PREPB_LOAD
#undef PREPB_DO
        for (int t = NGW - 1 - gw; t < NB * 34 * 8; t += NGW) scan::chunk_scalars((const float*)(wsp + WS_G), (float*)(wsp + WS_G2), AIN(I_ALOG) + l * 8, AIN(I_DTB) + l * 8, AIN(I_BI) + l * 8, AIN(I_BF) + l * 8, t / 272, (t >> 3) % 34, t & 7, lane); }
    } }
    if (kind == 4) { PH_PROLOG if ((MK_PHSEL >> 4) & 1) for (int rp = 0; rp < nrep; ++rp) {
      {
#ifndef MK_NO_MAMBA
        for (int cid = bx; cid < 128; cid += G) {
        if (cid < 64 && (rp == 0 || !(MK_PROBE_NOCHAIN || MK_PROBE_NOMAMBA))) scan::mamba_chain((LAS char*)lds, ((bf16*)(args.out)), ((float*)(wsp + WS_G2)), ((bf16*)(wsp + WS_YD)), cid >> 3, (cid >> 1) & 3, cid & 1, rp == 0 ? 15 : MK_PROBE_PM);
#endif
#ifndef MK_NO_MLSTM
        if (cid >= 64 && (rp == 0 || !(MK_PROBE_NOCHAIN || MK_PROBE_NOMLSTM))) { const int c = cid - 64; scan::mlstm_chain((LAS char*)lds, ((bf16*)(wsp + WS_P)), ((float*)(wsp + WS_G2)), ((bf16*)(wsp + WS_HC)), c >> 3, (c >> 1) & 3, c & 1); }
#endif#endif
        if (tid == 0) { __builtin_amdgcn_fence(__ATOMIC_RELEASE, "agent"); (void)__hip_atomic_fetch_add(((unsigned*)(wsp + WS_CTL)) + CW_SUBBAR + 12288 + 64 * ((l * 4 + rp) * 8 + ((cid & 63) >> 3)), 1u, RLX_AGENT); }
        }
        const int nper = (l == 1) ? 128 : 136;
        if (rp == 0 || !MK_PROBE_NOATTN) { const int x0 = (int)(xb_xcc_id() & 7u);
          for (int dq = 0; dq < 8; ++dq) { const int qb_ = (x0 + dq) & 7;
            for (;;) {
              if (tid == 0) MISC[16] = __hip_atomic_fetch_add(((unsigned*)(wsp + WS_CTL)) + CW_QUEUE + 64 * ((l * 4 + rp) * 8 + qb_), 1u, RLX_AGENT);
              __syncthreads(); const int ix = __builtin_amdgcn_readfirstlane((int)MISC[16]); __syncthreads();
              if (ix >= nper) break;
              const int idx = ix < 64 ? qb_ * 64 + ix : (ix < 128 ? 512 + qb_ * 64 + (ix - 64) : (ix < 132 ? 1024 + qb_ * 4 + (ix - 128) : 1056 + qb_ * 4 + (ix - 132)));
              attn_item(idx, ((bf16*)(wsp + WS_P)), ((bf16*)(wsp + WS_Y)), AIN(I_SINK) + l * 4, (char*)lds_raw + RING_OFF);
            } } }
        if (rp == 0) { const float* gml = AIN(I_GML) + l * 256; const float* gss = AIN(I_GSSM) + l * 256; const float* dsk = AIN(I_DSK) + l * 4;
          const bf16* HCb = (const bf16*)(wsp + WS_HC); const bf16* YDb = (const bf16*)(wsp + WS_YD); const bf16* Pf = (const bf16*)(wsp + WS_P); const bf16* UCf = (const bf16*)(args.out); bf16* Yf = (bf16*)(wsp + WS_Y);
          const int l32 = lane & 31, c0 = 8 * l32; const f32x4 gmA = *(const f32x4*)(gml + c0), gmB = *(const f32x4*)(gml + c0 + 4), gsA = *(const f32x4*)(gss + c0), gsB = *(const f32x4*)(gss + c0 + 4); const float dk = dsk[l32 >> 3];
          const float gmv[8] = {gmA[0], gmA[1], gmA[2], gmA[3], gmB[0], gmB[1], gmB[2], gmB[3]}, gsv[8] = {gsA[0], gsA[1], gsA[2], gsA[3], gsB[0], gsB[1], gsB[2], gsB[3]};
#define FIN_LOAD(m_, S) do { hA##S = *(const u32x4*)(HCb + (size_t)(m_) * 256 + c0); hB##S = *(const u32x4*)(HCb + ((size_t)M + (m_)) * 256 + c0); ow##S = *(const u32x4*)(Pf + (size_t)(m_) * NP + 1792 + c0); \
          yA##S = *(const u32x4*)(YDb + (size_t)(m_) * 256 + c0); yB##S = *(const u32x4*)(YDb + ((size_t)M + (m_)) * 256 + c0); xw##S = *(const u32x4*)(UCf + (size_t)(m_) * 768 + c0); zw##S = *(const u32x4*)(Pf + (size_t)(m_) * NP + 2304 + c0); } while (0)
#define FIN_DO(m_, S) do { \
          { float hs[8]; float ss = 0.f; \
            _Pragma("unroll") for (int e = 0; e < 4; ++e) { hs[2 * e] = bf_lo(hA##S[e]) + bf_lo(hB##S[e]); hs[2 * e + 1] = bf_hi(hA##S[e]) + bf_hi(hB##S[e]); ss += hs[2 * e] * hs[2 * e] + hs[2 * e + 1] * hs[2 * e + 1]; } \
            ss += __shfl_xor(ss, 1); ss += __shfl_xor(ss, 2); ss += __shfl_xor(ss, 4); const float rs = rsqrtf(ss * (1.f / 64.f) + EPS); float y[8]; \
            _Pragma("unroll") for (int e = 0; e < 4; ++e) { const float o0 = bf_lo(ow##S[e]), o1 = bf_hi(ow##S[e]); y[2 * e] = hs[2 * e] * rs * gmv[2 * e] / (1.f + __expf(-o0)); y[2 * e + 1] = hs[2 * e + 1] * rs * gmv[2 * e + 1] / (1.f + __expf(-o1)); } \
            *(u32x4*)(Yf + (size_t)(m_) * DM + 512 + c0) = (u32x4){cvtpk(y[0], y[1]), cvtpk(y[2], y[3]), cvtpk(y[4], y[5]), cvtpk(y[6], y[7])}; } \
          { float v[8]; float ss = 0.f; \
            _Pragma("unroll") for (int e = 0; e < 4; ++e) { const float z0 = bf_lo(zw##S[e]), z1 = bf_hi(zw##S[e]); \
              v[2 * e] = (bf_lo(yA##S[e]) + bf_lo(yB##S[e]) + dk * bf_lo(xw##S[e])) * (z0 / (1.f + __expf(-z0))); v[2 * e + 1] = (bf_hi(yA##S[e]) + bf_hi(yB##S[e]) + dk * bf_hi(xw##S[e])) * (z1 / (1.f + __expf(-z1))); ss += v[2 * e] * v[2 * e] + v[2 * e + 1] * v[2 * e + 1]; } \
            ss += __shfl_xor(ss, 1); ss += __shfl_xor(ss, 2); ss += __shfl_xor(ss, 4); ss += __shfl_xor(ss, 8); ss += __shfl_xor(ss, 16); const float rs = rsqrtf(ss * (1.f / 256.f) + EPS); \
            *(u32x4*)(Yf + (size_t)(m_) * DM + 768 + c0) = (u32x4){cvtpk(v[0] * rs * gsv[0], v[1] * rs * gsv[1]), cvtpk(v[2] * rs * gsv[2], v[3] * rs * gsv[3]), cvtpk(v[4] * rs * gsv[4], v[5] * rs * gsv[5]), cvtpk(v[6] * rs * gsv[6], v[7] * rs * gsv[7])}; } } while (0)
          unsigned* fq = ((unsigned*)(wsp + WS_CTL)) + CW_SUBBAR + 16384 + 64 * (l * 4 + rp); unsigned* cdone = ((unsigned*)(wsp + WS_CTL)) + CW_SUBBAR + 12288 + 64 * ((l * 4 + rp) * 8);
          for (;;) {
            if (tid == 0) { const unsigned ix = __hip_atomic_fetch_add(fq, 1u, RLX_AGENT);
              if (ix < 8u * 68u) { unsigned sp = 0; while (__hip_atomic_load(cdone + 64 * (ix / 68u), RLX_AGENT) < 16u && ++sp < (1u << 22)) __builtin_amdgcn_s_sleep(2); __builtin_amdgcn_fence(__ATOMIC_ACQUIRE, "agent"); }
              MISC[16] = ix; }
            __syncthreads(); const int ix = __builtin_amdgcn_readfirstlane((int)MISC[16]); __syncthreads();
            if (ix >= 8 * 68) break;
            const int m0 = (ix / 68) * RB + (ix % 68) * 64 + 2 * wave + (lane >> 5);
            u32x4 hAA, hBA, owA, yAA, yBA, xwA, zwA, hAB, hBB, owB, yAB, yBB, xwB, zwB, hAC, hBC, owC, yAC, yBC, xwC, zwC, hAD, hBD, owD, yAD, yBD, xwD, zwD;
            FIN_LOAD(m0, A); FIN_LOAD(m0 + 16, B); FIN_LOAD(m0 + 32, C); FIN_LOAD(m0 + 48, D);
            FIN_DO(m0, A); FIN_DO(m0 + 16, B); FIN_DO(m0 + 32, C); FIN_DO(m0 + 48, D); }
#undef FIN_LOAD
#undef FIN_DO
        } }
    } }
    if (kind == 6) { PH_PROLOG if ((MK_PHSEL >> 6) & 1) for (int rp = 0; rp < nrep; ++rp) {
      { MK_STAGGER(MK_STAG6);
        pg8::Gemm g{((bf16*)(wsp + WS_Y)), (const bf16*)((wsp + WS_W + (size_t)l * W_LAYER) + WO_OUT), M, DM, DM, DM};
        const int eflags = 2 | ((rp & 1) << 2);
        if (l == 0) { pg8::EpiResid<true> E{wsp, AIN(I_X), AIN(I_CTX), AIN(I_GN2) + l * DM, l, eflags}; pg8::LatentOrder S; S.init(DM, G, bx); pg8::gemm_phase<pg8::EpiResid<true>, pg8::LatentOrder, true, true>(lds + RING_OFF, g, S, E); }
        else { pg8::EpiResid<false> E{wsp, AIN(I_X), AIN(I_CTX), AIN(I_GN2) + l * DM, l, eflags}; pg8::LatentOrder S; S.init(DM, G, bx); pg8::gemm_phase<pg8::EpiResid<false>, pg8::LatentOrder, true, true>(lds + RING_OFF, g, S, E); } }
    } }
    if (kind == 8) { PH_PROLOG if ((MK_PHSEL >> 8) & 1) for (int rp = 0; rp < nrep; ++rp) {
      { pg8::Gemm g{((bf16*)(wsp + WS_H)), (const bf16*)((wsp + WS_W + (size_t)l * W_LAYER) + WO_1), M, DFF, DM, DM}; pg8::EpiRelu2 E{((bf16*)(wsp + WS_U)), pg8::FusedNorm{(const float*)(wsp + WS_SS), (const float*)(wsp + WS_BIAS) + (size_t)(1 + l) * 9 * 4096, 1, 1, (const LAS float*)(lds + RS_OFF), 0}};
        if (!(l == 1)) {
          unsigned* octr = ((unsigned*)(wsp + WS_CTL)) + CW_SUBBAR + 8192 + 64 * rp;
          for (int ou = bx; ou < 32; ou += G) { pg8::Gemm go{((bf16*)(wsp + WS_Y)), (const bf16*)((wsp + WS_W) + WO_OUT), M, DM, DM, DM}; pg8::EpiResid<true> Eo{wsp, AIN(I_X), AIN(I_CTX), AIN(I_GN2), 0, 2};
            pg8::OneUnit So{{(ou >> 2) * 17, ou & 3}}; pg8::gemm_phase<pg8::EpiResid<true>, pg8::OneUnit, true, true>(lds + RING_OFF, go, So, Eo);
            asm volatile("s_waitcnt vmcnt(0)" ::: "memory"); __syncthreads();
            if (tid == 0) { __builtin_amdgcn_fence(__ATOMIC_RELEASE, "agent"); (void)__hip_atomic_fetch_add(octr, 1u, RLX_AGENT); }
            __syncthreads(); }
          { pg8::LatentOrder S; S.init(DFF, G, bx); E.F.fill(S, (LAS float*)(lds + RS_OFF), tid); pg8::gemm_phase<pg8::EpiRelu2, pg8::LatentOrder, true, true>(lds + RING_OFF, g, S, E); }
          for (int cu = (bx + G / 2) % G; cu < 128; cu += G) {
            if (tid == 0) { unsigned sp = 0; while (__hip_atomic_load(octr, RLX_AGENT) < 32u && ++sp < (1u << 22)) __builtin_amdgcn_s_sleep(2); __builtin_amdgcn_fence(__ATOMIC_ACQUIRE, "agent"); asm volatile("s_waitcnt vmcnt(0)" ::: "memory"); }
            __syncthreads();
            pg8::EpiRelu2 Ec{((bf16*)(wsp + WS_U)), pg8::FusedNorm{(const float*)(wsp + WS_SS), (const float*)(wsp + WS_BIAS) + (size_t)(1 + l) * 9 * 4096, 1, 1, (const LAS float*)(lds + RS_OFF), 0}};
            pg8::OneUnit Sc{{(cu >> 4) * 17, cu & 15}}; Ec.F.fill(Sc, (LAS float*)(lds + RS_OFF), tid); pg8::gemm_phase<pg8::EpiRelu2, pg8::OneUnit, true, true>(lds + RING_OFF, g, Sc, Ec); } }
        else { pg8::LatentOrder S; S.init(DFF, G, bx); E.F.fill(S, (LAS float*)(lds + RS_OFF), tid); pg8::gemm_phase<pg8::EpiRelu2, pg8::LatentOrder, true, true>(lds + RING_OFF, g, S, E); } }
    } }
    if (kind == 9) { PH_PROLOG if ((MK_PHSEL >> 9) & 1) for (int rp = 0; rp < nrep; ++rp) {
      { MK_STAGGER(MK_STAG9);
        pg8::Gemm g{((bf16*)(wsp + WS_U)), (const bf16*)((wsp + WS_W + (size_t)l * W_LAYER) + WO_2), M, DM, DFF, DFF};
        if (l == 1 && G == 256) {
          pg8::EpiFinal E{wsp, args.out, AIN(I_GFIN), (LAS float*)(lds + RS_OFF), l}; pg8::LatentOrder S; S.init(DM, G, bx); pg8::gemm_phase<pg8::EpiFinal, pg8::LatentOrder, true, true>(lds + RING_OFF, g, S, E); }
        else { pg8::EpiResid<false> E{wsp, AIN(I_X), AIN(I_CTX), AIN(I_GN1) + DM, l, 1 | ((l == 0) << 1) | ((rp & 1) << 2)};
          pg8::LatentOrder S; S.init(DM, G, bx); pg8::gemm_phase<pg8::EpiResid<false>, pg8::LatentOrder, true, true>(lds + RING_OFF, g, S, E); }
        if (l == 0) for (int sid = bx; sid < 256; sid += G) {
          const int un = sid >> 3, ks = sid & 7; pg8::Gemm gs{g.A + 512 * ks, g.Bt + 512 * ks, M, DM, 512, DFF}; pg8::OneUnit S1{{(un >> 2) * 17, un & 3}}; pg8::EpiSlab ES{((float*)(args.out)) + (size_t)sid * 65536};
          pg8::gemm_phase<pg8::EpiSlab, pg8::OneUnit, true, true>(lds + RING_OFF, gs, S1, ES); } }
    } }
  }
  if (kind == 10) { PH_PROLOG if ((MK_PHSEL >> 10) & 1) for (int rp = 0; rp < nrep; ++rp) {
    { const float* gf = AIN(I_GFIN); const bf16* XSb = (const bf16*)(wsp + WS_XS);
      for (int m = 2 * gw; m < NB * T; m += 2 * NGW) { const int b = m / T, t = m % T; const u32x2* xr = (const u32x2*)(XSb + ((size_t)b * RB + NC + t) * DM) + lane; f32x4* orow = (f32x4*)((args.out) + (size_t)m * DM) + lane;
        u32x2 w0[4], w1[4]; f32x4 v0[4], v1[4]; float s0 = 0.f, s1 = 0.f;
#pragma unroll
        for (int j = 0; j < 4; ++j) { w0[j] = xr[64 * j]; w1[j] = xr[256 + 64 * j]; }
#pragma unroll
        for (int j = 0; j < 4; ++j) { v0[j] = (f32x4){pg8::h16_lo(w0[j].x), pg8::h16_hi(w0[j].x), pg8::h16_lo(w0[j].y), pg8::h16_hi(w0[j].y)}; v1[j] = (f32x4){pg8::h16_lo(w1[j].x), pg8::h16_hi(w1[j].x), pg8::h16_lo(w1[j].y), pg8::h16_hi(w1[j].y)};
          s0 += (v0[j].x * v0[j].x + v0[j].y * v0[j].y) + (v0[j].z * v0[j].z + v0[j].w * v0[j].w); s1 += (v1[j].x * v1[j].x + v1[j].y * v1[j].y) + (v1[j].z * v1[j].z + v1[j].w * v1[j].w); }
        const float rs0 = rsqrtf(wave_sum(s0) * (1.f / DM) + EPS), rs1 = rsqrtf(wave_sum(s1) * (1.f / DM) + EPS);
#pragma unroll
        for (int j = 0; j < 4; ++j) { const f32x4 gg = ((const f32x4*)gf)[64 * j + lane]; orow[64 * j] = v0[j] * rs0 * gg; orow[256 + 64 * j] = v1[j] * rs1 * gg; } } }
  } }
  if (ph + 1 < args.ph_hi) { if (args.use_cg && ph == args.ph_lo) cooperative_groups::this_grid().sync(); else xcd_barrier(bar);
#ifdef MK_BAR_REP
    for (int q = 1; q < MK_BAR_REP; ++q) xcd_barrier(bar);
#endif
  }
  }
#undef PH_PROLOG
#undef AIN
}


static void launch(void* const* d_in, float* out, void* d_ws, hipStream_t stream, int n_launch_mode  , int n_layers) {
  static int grid = 0;
  if (grid == 0) {
    int dev = 0, cus = 0, per_cu = 0;
    (void)hipGetDevice(&dev); (void)hipDeviceGetAttribute(&cus, hipDeviceAttributeMultiprocessorCount, dev);
    (void)hipFuncSetAttribute((const void*)mk_fwd, hipFuncAttributeMaxDynamicSharedMemorySize, LDS_BYTES);
    (void)hipOccupancyMaxActiveBlocksPerMultiprocessor(&per_cu, (const void*)mk_fwd, NWAVES * 64, LDS_BYTES);
    (void)hipGetLastError();
    if (per_cu < 1) fprintf(stderr, "mk: occupancy query says %d blocks per CU\n", per_cu);
    grid = cus;
  }
  (void)hipMemsetAsync((char*)d_ws + WS_CTL, 0, CTL_ZERO_BYTES, stream);
  Args a{}; for (int i = 0; i < 25; ++i) a.in[i] = (const float*)d_in[i];
  a.out = out; a.ws = (unsigned char*)d_ws; a.n_layers = n_layers;
  for (int k = 0; k < 12; ++k) a.rep[k] = 1;
#ifdef MK_REP_MASK
  for (int k = 0; k < 12; ++k) if ((MK_REP_MASK >> k) & 1) a.rep[k] = MK_REP_N;
#endif
  const int nph = N_PHASES;
  if (n_launch_mode == 0) {
    a.ph_lo = 0; a.ph_hi = (grid == 256) ? nph - 1 : nph; a.use_cg = MK_FIRST_SEAM_CG;
    void* kargs[] = {&a};
    hipError_t e = hipLaunchCooperativeKernel((const void*)mk_fwd, dim3(grid), dim3(NWAVES * 64), kargs, LDS_BYTES, stream);
    if (e != hipSuccess) { fprintf(stderr, "mk: cooperative launch failed (%s), plain launch instead\n", hipGetErrorName(e)); (void)hipGetLastError(); a.use_cg = 0; hipLaunchKernelGGL(mk_fwd, dim3(grid), dim3(NWAVES * 64), LDS_BYTES, stream, a); }
  }
  else for (int p = 0; p < ((grid == 256) ? nph - 1 : nph); ++p) { a.ph_lo = p; a.ph_hi = p + 1; hipLaunchKernelGGL(mk_fwd, dim3(grid), dim3(NWAVES * 64), LDS_BYTES, stream, a); }
  const hipError_t le = hipPeekAtLastError(); if (le != hipSuccess) fprintf(stderr, "mk: launch failed: %s\n", hipGetErrorName(le));
}
}
extern "C" void kernel_launch(void* const* d_in, const int* in_sizes, int n_in, void* d_out, int out_size, void* d_ws, size_t ws_size, hipStream_t stream) {
  mk::launch(d_in, (float*)d_out, d_ws, stream, MK_LAUNCH_MODE, 2);
}
```

```cpp
#ifndef MK_LAUNCH_MODE
#define MK_LAUNCH_MODE 0
#endif
#include <hip/hip_runtime.h>
#include <hip/hip_bf16.h>
#include <hip/hip_cooperative_groups.h>
#include <cstdint>
#include <cstdio>
#include <cmath>
#define GAS __attribute__((address_space(1)))
#define LAS __attribute__((address_space(3)))
namespace mk {
constexpr int NB = 8, T = 4096, NC = 256, RB = T + NC, M = NB * RB, DM = 1024, NP = 3328, DFF = 4096, TPB = RB / 256, NINO = 3096;
constexpr float EPS = 1e-6f, L2E = 1.4426950408889634f;
constexpr float QC2 = 0.125f * 1.4426950408889634f;
typedef unsigned short bf16;
typedef unsigned u32x4 __attribute__((ext_vector_type(4)));
typedef unsigned u32x2 __attribute__((ext_vector_type(2)));
typedef float f32x4 __attribute__((ext_vector_type(4)));
typedef float f32x16 __attribute__((ext_vector_type(16)));
typedef short bf16x8 __attribute__((ext_vector_type(8)));
typedef short s16x4 __attribute__((ext_vector_type(4)));
typedef float f32x2v __attribute__((ext_vector_type(2)));
typedef __bf16 bf16x2v __attribute__((ext_vector_type(2)));

constexpr size_t MiB = 1u << 20;
constexpr size_t WS_CTL = 0, CTL_ZERO_BYTES = 1 * MiB;
constexpr size_t WS_MOD = 1 * MiB;
constexpr size_t WS_CS = 2 * MiB;
constexpr size_t WS_G = 4 * MiB;
constexpr size_t WS_XS = 423 * MiB;
constexpr size_t WS_W = 17 * MiB;
constexpr size_t W_LAYER = (size_t)(NP + DM + DFF + DFF) * 1024 * 2;
constexpr size_t WO_IN = 0, WO_OUT = (size_t)NP * DM * 2, WO_1 = WO_OUT + (size_t)DM * DM * 2, WO_2 = WO_1 + (size_t)DFF * DM * 2;
constexpr size_t WS_H = 66 * MiB;
constexpr size_t WS_P = 134 * MiB;
constexpr size_t WS_Y = 355 * MiB;
constexpr size_t WS_U = WS_P;
constexpr size_t WS_SS = 491 * MiB;
constexpr size_t WS_BIAS = 3 * MiB;
constexpr size_t WS_G2 = 8 * MiB + 512 * 1024;
constexpr size_t WS_END = 494 * MiB;
static_assert(WS_W + 2 * W_LAYER <= WS_H && WS_H + (size_t)M * DM * 2 <= WS_P && WS_P + (size_t)M * NP * 2 <= WS_Y && WS_U + (size_t)M * DFF * 2 <= WS_XS && WS_XS + (size_t)M * DM * 2 <= WS_SS && WS_SS + (size_t)M * 16 * 4 <= WS_END && WS_G + (size_t)M * 32 * 4 <= WS_G2 && WS_G2 + (size_t)M * 64 * 4 <= WS_W, "ws map");
constexpr size_t WS_HC = WS_H, WS_YD = WS_H + (size_t)2 * M * 256 * 2;
constexpr int CW_BAR = 4096;
constexpr int CW_SUBBAR = 24576;
constexpr int CW_QUEUE = 16384;

__device__ __forceinline__ unsigned cvtpk(float lo, float hi) { f32x2v v = {lo, hi}; bf16x2v b = __builtin_convertvector(v, bf16x2v); return __builtin_bit_cast(unsigned, b); }
__device__ __forceinline__ float bf_lo(unsigned w) { return __uint_as_float(w << 16); }
__device__ __forceinline__ float bf_hi(unsigned w) { return __uint_as_float(w & 0xffff0000u); }
__device__ __forceinline__ float bf2f(bf16 v) { return __uint_as_float(((unsigned)v) << 16); }
__device__ __forceinline__ bf16 f2bf(float f) { return (bf16)(cvtpk(f, 0.f) & 0xffffu); }
__device__ __forceinline__ float wave_sum(float v) {
#pragma unroll
  for (int o = 1; o < 64; o <<= 1) v += __shfl_xor(v, o);
  return v;
}
__device__ __forceinline__ int crow(int r, int hi) { return (r & 3) + 8 * (r >> 2) + 4 * hi; }
__device__ __forceinline__ size_t lat_off(int b, int t) { return ((size_t)b * T + t) * DM; }
__device__ __forceinline__ size_t ctx_off(int b, int j) { return ((size_t)b * NC + j) * DM; }
}
typedef GAS unsigned gu32;
typedef GAS unsigned long long gu64;

#define XB_TMO      128
#define XB_XCNT(j)  (256  + 64 * (j))
#define XB_XSUB(j)  (1280 + 64 * (j))
#define XB_XGEN(j)  (2304 + 64 * (j))
#define XB_TOP      3328
#define XB_TOPGEN   3392
#define XCD_BAR_WORDS 3456
#define XB_SPIN_CAP (1u << 18)

__device__ __forceinline__ unsigned xb_ld(unsigned* p)              { return __hip_atomic_load(p, __ATOMIC_RELAXED, __HIP_MEMORY_SCOPE_AGENT); }
__device__ __forceinline__ unsigned xb_add(unsigned* p, unsigned v) { return __hip_atomic_fetch_add(p, v, __ATOMIC_RELAXED, __HIP_MEMORY_SCOPE_AGENT); }
__device__ __forceinline__ unsigned xb_xcc_id() { return (unsigned)__builtin_amdgcn_s_getreg((3 << 11) | 20) & 0xFu; }
#define XB_SPIN(cond, bar) do { unsigned _sp = 0; while (cond) { __builtin_amdgcn_s_sleep(1); \
    if ((++_sp & 255u) == 0u) { if (xb_ld(&(bar)[XB_TMO])) break; if (_sp > XB_SPIN_CAP) { atomicAdd(&(bar)[XB_TMO], 1u); break; } } } } while (0)

struct XcdBarrier {
    unsigned* bar; unsigned x;
    volatile LAS unsigned* st;
};

__device__ __forceinline__ XcdBarrier xcd_barrier_post(unsigned* bar, volatile LAS unsigned* st) {
    XcdBarrier b; b.bar = bar; b.x = xb_xcc_id(); b.st = st;
    if (threadIdx.x == 0) (void)xb_add(&bar[XB_XCNT(b.x)], 1u);
    return b;
}
__device__ __forceinline__ void xcd_barrier_complete(unsigned* bar, unsigned x, unsigned& nloc, unsigned& nx) {
    const unsigned G = gridDim.x * gridDim.y * gridDim.z;
    unsigned sum, cnt, mine, sp = 0u;
    for (;;) {
        sum = 0u; cnt = 0u; mine = 0u;
#pragma unroll 1
        for (unsigned j = 0; j < 16; ++j) { const unsigned c = xb_ld(&bar[XB_XCNT(j)]); sum += c; cnt += (c > 0u) ? 1u : 0u; mine = (j == x) ? c : mine; }
        if (sum == G) break;
        __builtin_amdgcn_s_sleep(1);
        if ((++sp & 255u) == 0u) { if (xb_ld(&bar[XB_TMO])) break; if (sp > XB_SPIN_CAP) { atomicAdd(&bar[XB_TMO], 1u); break; } }
    }
    nloc = mine > 0u ? mine : 1u; nx = cnt > 0u ? cnt : 1u;
}

__device__ __forceinline__ void xcd_barrier(const XcdBarrier& b) {
    asm volatile("s_waitcnt vmcnt(0)" ::: "memory");
    __syncthreads();
    if (threadIdx.x == 0) {
        unsigned* bar = b.bar;
        __builtin_amdgcn_s_waitcnt(0);
        unsigned nloc = b.st[0], nx = b.st[1];
        if (nloc == 0u) { xcd_barrier_complete(bar, b.x, nloc, nx); b.st[0] = nloc; b.st[1] = nx; }
        const unsigned old = xb_add(&bar[XB_XSUB(b.x)], 1u);
        const unsigned gen = old / nloc;
        if (old + 1u == (gen + 1u) * nloc) {
            __builtin_amdgcn_fence(__ATOMIC_RELEASE, "agent");
            asm volatile("s_waitcnt vmcnt(0)" ::: "memory");
            const unsigned og = xb_add(&bar[XB_TOP], 1u);
            const unsigned tg = og / nx;
            if (og + 1u == (tg + 1u) * nx) xb_add(&bar[XB_TOPGEN], 1u);
            else XB_SPIN(xb_ld(&bar[XB_TOPGEN]) == tg, bar);
            __builtin_amdgcn_fence(__ATOMIC_ACQUIRE, "agent");
            xb_add(&bar[XB_XGEN(b.x)], 1u);
            asm volatile("s_waitcnt vmcnt(0)" ::: "memory");
        } else {
            XB_SPIN(xb_ld(&bar[XB_XGEN(b.x)]) == gen, bar);
            __builtin_amdgcn_fence(__ATOMIC_ACQUIRE, "agent");
            asm volatile("s_waitcnt vmcnt(0)" ::: "memory");
        }
    }
    __syncthreads();
}
namespace pg8 {
#define PG8_LAS __attribute__((address_space(3)))
typedef unsigned short bf16_t;
typedef short bf16x8 __attribute__((ext_vector_type(8)));
typedef float f32x4 __attribute__((ext_vector_type(4)));
typedef unsigned u32x4 __attribute__((ext_vector_type(4)));
#ifndef PG8_WGM
#define PG8_WGM 8
#endif
constexpr int BM = 256, BK = 64, HALF = 128, HTB = HALF * BK * 2  , STAGE_BYTES = 8 * HTB, NXCD = 8, WGM = PG8_WGM;

__host__ __device__ __forceinline__ int lds_byte(int r, int c) { const int st = (r >> 4) * 2 + (c >> 5), rr = r & 15, cc = c & 31, ob = rr * 64 + cc * 2; return st * 1024 + (ob ^ (((ob >> 9) & 1) << 5)); }
__host__ __device__ __forceinline__ void stage_rc(int b, int& R, int& C) { const int st = b / 1024, sb = b % 1024, swz = sb ^ (((sb >> 9) & 1) << 5); R = (st >> 1) * 16 + swz / 64; C = (st & 1) * 32 + (swz % 64) / 2; }
__host__ __device__ __forceinline__ int perm32(int rho) { const int n = rho >> 4, i = rho & 15; return 8 * (i >> 2) + 4 * n + (i & 3); }

struct Unit { int pm, pn; };
struct Gemm { const bf16_t* A; const bf16_t* Bt; int M, N, K, ld; };

struct StaticOrder {
    int nM, nN, nwg, G, c;
    __host__ __device__ void init(int M, int N, int G_, int c_) { nM = M / BM; nN = N / BM; nwg = nM * nN; G = G_; c = c_; }
    __host__ __device__ bool next(int i, Unit& u) const {
        const long L = (long)i * G + c; if (L >= nwg) return false;
        int wgid = (int)L; { const int q = nwg / NXCD, r = nwg % NXCD, xcd = wgid % NXCD, off = wgid / NXCD; wgid = (xcd < r ? xcd * (q + 1) : r * (q + 1) + (xcd - r) * q) + off; }
        const int nig = WGM * nN, gid = wgid / nig, fm = gid * WGM, gsz = (nM - fm) < WGM ? (nM - fm) : WGM;
        u.pm = fm + ((wgid % nig) % gsz); u.pn = (wgid % nig) / gsz; return true;
    }
    __device__ __forceinline__ void a_ready(const Unit&) const {}
    __device__ __forceinline__ void done(const Unit&) const {}
};

__device__ __forceinline__ unsigned cvt_pk_bf16(float lo, float hi) { unsigned r; asm volatile("v_cvt_pk_bf16_f32 %0, %1, %2" : "=v"(r) : "v"(lo), "v"(hi)); return r; }
typedef float f32x2 __attribute__((ext_vector_type(2)));
__device__ __forceinline__ f32x2 gelu_pk(f32x2 v) {
    const f32x2 av = __builtin_elementwise_abs(v), d = av * 0.2316418882f + 1.0f;
    f32x2 t; t.x = __builtin_amdgcn_rcpf(d.x); t.y = __builtin_amdgcn_rcpf(d.y);
    f32x2 q = t * 0.5307027145f + (-0.7265760135f); q = q * t + 0.7107068705f; q = q * t + (-0.142248368f); q = q * t + 0.127414796f; q = q * t;
    const f32x2 s = (v * v) * (-0.72134752044f);
    f32x2 e; e.x = __builtin_amdgcn_exp2f(s.x); e.y = __builtin_amdgcn_exp2f(s.y);
    const f32x2 m = v * (q * e), r = v - m;
    f32x2 o; o.x = v.x < 0.f ? m.x : r.x; o.y = v.y < 0.f ? m.y : r.y; return o;
}

template <int ACT  > struct EpiBf16 {
    static constexpr bool PERM = true, AFTER_DRAIN = false; static_assert(ACT == 0 || ACT == 1, "EpiBf16: ACT is 0 (none) or 1 (gelu_pk)");
    bf16_t* O; int ldc; const float* bias; int split_cols; size_t split_stride; float scale0;
    __device__ __forceinline__ void operator()(const f32x4 (&acc)[2][2][4][2], const Unit& u, int wr, int wc, int fr, int fq) const {
        const int row0 = u.pm * BM + wr * 64 + fr; int colt = u.pn * BM; bf16_t* base = O;
        float sc = 1.f; if (split_cols) { const int t = colt / split_cols; base += (size_t)t * split_stride; colt -= t * split_cols; if (t == 0) sc = scale0; }
        const int col0 = colt + wc * 32 + 8 * fq, bcol0 = u.pn * BM + wc * 32 + 8 * fq;
        f32x4 bv[2][2];
#pragma unroll
        for (int bj = 0; bj < 2; ++bj)
#pragma unroll
            for (int n = 0; n < 2; ++n) bv[bj][n] = bias ? *(const f32x4*)(bias + bcol0 + bj * HALF + 4 * n) : (f32x4){0.f, 0.f, 0.f, 0.f};
#pragma unroll
        for (int ai = 0; ai < 2; ++ai)
#pragma unroll
            for (int m = 0; m < 4; ++m) { bf16_t* rowp = base + (size_t)(row0 + ai * HALF + m * 16) * ldc + col0;
#pragma unroll
                for (int bj = 0; bj < 2; ++bj) { f32x4 v0 = acc[ai][bj][m][0] + bv[bj][0], v1 = acc[ai][bj][m][1] + bv[bj][1];
                    if (ACT == 1) { f32x2 a = gelu_pk((f32x2){v0[0], v0[1]}), b = gelu_pk((f32x2){v0[2], v0[3]}), c = gelu_pk((f32x2){v1[0], v1[1]}), d = gelu_pk((f32x2){v1[2], v1[3]});
                        v0 = (f32x4){a.x, a.y, b.x, b.y}; v1 = (f32x4){c.x, c.y, d.x, d.y}; }
                    v0 = v0 * sc; v1 = v1 * sc; u32x4 w; w.x = cvt_pk_bf16(v0[0], v0[1]); w.y = cvt_pk_bf16(v0[2], v0[3]); w.z = cvt_pk_bf16(v1[0], v1[1]); w.w = cvt_pk_bf16(v1[2], v1[3]);
                    *(u32x4*)(rowp + bj * HALF) = w; } }
    }
};
template <class Epi, class Sched, bool ALIGN_EPI = false, bool SP2 = false>
__device__ __forceinline__ void gemm_phase(PG8_LAS unsigned char* lds, const Gemm g, const Sched& S, const Epi& E) {
    int tid_ = threadIdx.x; asm volatile("" : "+v"(tid_));
    const int tid = tid_, wid = __builtin_amdgcn_readfirstlane(tid >> 6), lane = tid & 63, wr = wid >> 2, wc = wid & 3, fr = lane & 15, fq = lane >> 4;
    const int K = g.K, nt = K / BK, LD = g.ld;
    unsigned voffA[2], voffB[2];
#pragma unroll
    for (int i = 0; i < 2; ++i) { int R, C; stage_rc(tid * 16 + i * 8192, R, C); const int Rb = Epi::PERM ? ((R & ~31) + perm32(R & 31)) : R;
        voffA[i] = (unsigned)(R * LD + C) * 2u; voffB[i] = (unsigned)(Rb * LD + C) * 2u; }
    const size_t kstep = (size_t)(BK * 2);
    const size_t hstep = (size_t)HALF * LD * 2;
    const size_t tstep = 2 * hstep;
    const unsigned ldsw = (unsigned)wid * 1024u;
    const int aoff = lds_byte(wr * 64 + fr, fq * 8), boff = lds_byte(wc * 32 + fr, fq * 8);
#define PG8_SA(b, h) (((b) * 2 + (h)) * HTB)
#define PG8_SB(b, h) ((4 + (b) * 2 + (h)) * HTB)
#define PG8_STAGE(bufoff, gbase, voff) do { _Pragma("unroll") for (int _i = 0; _i < 2; ++_i) \
        __builtin_amdgcn_global_load_lds((const unsigned*)((const char*)(gbase) + (voff)[_i]), (PG8_LAS unsigned*)(lds + (bufoff) + ldsw + _i * 8192), 16, 0, 0); } while (0)
#define PG8_LDA(dst, b, h) do { _Pragma("unroll") for (int m = 0; m < 4; ++m) _Pragma("unroll") for (int k = 0; k < 2; ++k) dst[m][k] = *(const PG8_LAS bf16x8*)(lds + PG8_SA(b, h) + aoff + m * 2048 + k * 1024); } while (0)
#define PG8_LDB(dst, b, h) do { _Pragma("unroll") for (int n = 0; n < 2; ++n) _Pragma("unroll") for (int k = 0; k < 2; ++k) dst[n][k] = *(const PG8_LAS bf16x8*)(lds + PG8_SB(b, h) + boff + n * 2048 + k * 1024); } while (0)
#define PG8_MMA(ai, bj, At, Bt) do { __builtin_amdgcn_s_setprio(1); _Pragma("unroll") for (int m = 0; m < 4; ++m) _Pragma("unroll") for (int n = 0; n < 2; ++n) _Pragma("unroll") for (int k = 0; k < 2; ++k) \
        acc[ai][bj][m][n] = __builtin_amdgcn_mfma_f32_16x16x32_bf16(Bt[n][k], At[m][k], acc[ai][bj][m][n], 0, 0, 0); __builtin_amdgcn_s_setprio(0); } while (0)
#define PG8_WAIT_V(n) asm volatile("s_waitcnt vmcnt(" #n ")" ::: "memory")
#define PG8_WAIT_L(n) asm volatile("s_waitcnt lgkmcnt(" #n ")" ::: "memory")
#define PG8_BAR __builtin_amdgcn_s_barrier()
#define PG8_SCHED __builtin_amdgcn_sched_barrier(0)
    Unit cur, nxt; int ui = 0;
    if (!S.next(0, cur)) return;
    f32x4 acc[2][2][4][2];
#pragma unroll
    for (int a = 0; a < 2; ++a)
#pragma unroll
        for (int b = 0; b < 2; ++b)
#pragma unroll
            for (int m = 0; m < 4; ++m)
#pragma unroll
                for (int n = 0; n < 2; ++n) acc[a][b][m][n] = (f32x4){0.f, 0.f, 0.f, 0.f};
    bf16x8 At[4][2], B0[2][2], B1[2][2];
    const char* cA = (const char*)g.A + (size_t)cur.pm * tstep; const char* cB = (const char*)g.Bt + (size_t)cur.pn * tstep;
    S.a_ready(cur);
    if constexpr (SP2) {
        PG8_STAGE(PG8_SB(0, 0), cB, voffB); PG8_STAGE(PG8_SB(0, 1), cB + hstep, voffB); PG8_STAGE(PG8_SA(0, 0), cA, voffA); PG8_STAGE(PG8_SA(0, 1), cA + hstep, voffA);
        if (wr == 1) PG8_BAR;
        PG8_WAIT_V(2); PG8_BAR;
        PG8_STAGE(PG8_SB(1, 0), cB + kstep, voffB); PG8_STAGE(PG8_SA(1, 0), cA + kstep, voffA); PG8_STAGE(PG8_SB(1, 1), cB + hstep + kstep, voffB);
        PG8_WAIT_V(6); PG8_BAR;
    } else {
        PG8_STAGE(PG8_SB(0, 0), cB, voffB); PG8_STAGE(PG8_SA(0, 0), cA, voffA); PG8_STAGE(PG8_SB(0, 1), cB + hstep, voffB); PG8_STAGE(PG8_SA(0, 1), cA + hstep, voffA);
        if (wr == 1) PG8_BAR;
        PG8_WAIT_V(4); PG8_BAR;
        PG8_STAGE(PG8_SB(1, 0), cB + kstep, voffB); PG8_STAGE(PG8_SA(1, 0), cA + kstep, voffA); PG8_STAGE(PG8_SB(1, 1), cB + hstep + kstep, voffB);
        PG8_WAIT_V(6); PG8_BAR;
    }
    for (;;) {
        const bool has_next = S.next(ui + 1, nxt);
        const char* nA = has_next ? (const char*)g.A + (size_t)nxt.pm * tstep : cA; const char* nB = has_next ? (const char*)g.Bt + (size_t)nxt.pn * tstep : cB;
        for (int t = 0; t < nt; t += 2) {
            const bool last = (t == nt - 2);
            const char* a1 = cA + (size_t)(t + 1) * kstep;
            const char* a2 = last ? nA : cA + (size_t)(t + 2) * kstep; const char* b2 = last ? nB : cB + (size_t)(t + 2) * kstep;
            const char* a3 = a2 + kstep; const char* b3 = b2 + kstep;
            if (last && has_next) S.a_ready(nxt);
            if constexpr (SP2) {
            PG8_LDB(B0, 0, 0); PG8_LDB(B1, 0, 1); PG8_SCHED; PG8_LDA(At, 0, 0); PG8_STAGE(PG8_SA(1, 1), a1 + hstep, voffA);
            PG8_WAIT_V(8); PG8_WAIT_L(0); PG8_BAR; PG8_MMA(0, 0, At, B0); PG8_MMA(0, 1, At, B1); PG8_BAR; PG8_SCHED;
            PG8_LDA(At, 0, 1); PG8_STAGE(PG8_SB(0, 0), b2, voffB); PG8_STAGE(PG8_SB(0, 1), b2 + hstep, voffB); PG8_STAGE(PG8_SA(0, 0), a2, voffA);
            PG8_WAIT_V(8); PG8_WAIT_L(0); PG8_BAR; PG8_MMA(1, 0, At, B0); PG8_MMA(1, 1, At, B1); PG8_BAR; PG8_SCHED;
            PG8_LDB(B0, 1, 0); PG8_LDB(B1, 1, 1); PG8_SCHED; PG8_LDA(At, 1, 0); PG8_STAGE(PG8_SA(0, 1), a2 + hstep, voffA);
            PG8_WAIT_V(8); PG8_WAIT_L(0); PG8_BAR; PG8_MMA(0, 0, At, B0); PG8_MMA(0, 1, At, B1); PG8_BAR; PG8_SCHED;
            PG8_LDA(At, 1, 1); PG8_STAGE(PG8_SB(1, 0), b3, voffB); PG8_STAGE(PG8_SB(1, 1), b3 + hstep, voffB); PG8_STAGE(PG8_SA(1, 0), a3, voffA);
            PG8_WAIT_V(8); PG8_WAIT_L(0); PG8_BAR; PG8_MMA(1, 0, At, B0); PG8_MMA(1, 1, At, B1); PG8_BAR; PG8_SCHED;
            } else {
            PG8_LDB(B0, 0, 0); PG8_SCHED; PG8_LDA(At, 0, 0); PG8_STAGE(PG8_SA(1, 1), a1 + hstep, voffA);
            PG8_WAIT_L(8); PG8_BAR; PG8_WAIT_L(0); PG8_MMA(0, 0, At, B0); PG8_BAR; PG8_SCHED;
            PG8_LDB(B1, 0, 1); PG8_STAGE(PG8_SB(0, 0), b2, voffB);
            PG8_BAR; PG8_WAIT_L(0); PG8_MMA(0, 1, At, B1); PG8_BAR;
            PG8_LDA(At, 0, 1); PG8_STAGE(PG8_SA(0, 0), a2, voffA);
            PG8_BAR; PG8_WAIT_L(0); PG8_MMA(1, 0, At, B0); PG8_BAR; PG8_SCHED;
            PG8_STAGE(PG8_SB(0, 1), b2 + hstep, voffB);
            PG8_WAIT_V(6); PG8_BAR; PG8_MMA(1, 1, At, B1); PG8_BAR;
            PG8_LDB(B0, 1, 0); PG8_SCHED; PG8_LDA(At, 1, 0); PG8_STAGE(PG8_SA(0, 1), a2 + hstep, voffA);
            PG8_WAIT_L(8); PG8_BAR; PG8_WAIT_L(0); PG8_MMA(0, 0, At, B0); PG8_BAR; PG8_SCHED;
            PG8_LDB(B1, 1, 1); PG8_STAGE(PG8_SB(1, 0), b3, voffB);
            PG8_BAR; PG8_WAIT_L(0); PG8_MMA(0, 1, At, B1); PG8_BAR;
            PG8_LDA(At, 1, 1); PG8_STAGE(PG8_SA(1, 0), a3, voffA);
            PG8_BAR; PG8_WAIT_L(0); PG8_MMA(1, 0, At, B0); PG8_BAR; PG8_SCHED;
            PG8_STAGE(PG8_SB(1, 1), b3 + hstep, voffB);
            PG8_WAIT_V(6); PG8_BAR; PG8_MMA(1, 1, At, B1); PG8_BAR;
            }
        }
        if constexpr (ALIGN_EPI) { if (wr == 0) PG8_BAR; }
        if constexpr (!Epi::AFTER_DRAIN) { E(acc, cur, wr, wc, fr, fq); S.done(cur); }
        if (!has_next) break;
#pragma unroll
        for (int a = 0; a < 2; ++a)
#pragma unroll
            for (int b = 0; b < 2; ++b)
#pragma unroll
                for (int m = 0; m < 4; ++m)
#pragma unroll
                    for (int n = 0; n < 2; ++n) acc[a][b][m][n] = (f32x4){0.f, 0.f, 0.f, 0.f};
        cur = nxt; cA = nA; cB = nB; ++ui;
        if constexpr (ALIGN_EPI) { if (wr == 1) PG8_BAR; }
    }
    PG8_WAIT_V(0);
    if constexpr (!ALIGN_EPI) { if (wr == 0) PG8_BAR; }
    PG8_BAR;
    if constexpr (Epi::AFTER_DRAIN) { E.fused(acc, cur, wr, wc, fr, fq, lds, wid, lane); S.done(cur); }
#undef PG8_SA
#undef PG8_SB
#undef PG8_STAGE
#undef PG8_LDA
#undef PG8_LDB
#undef PG8_MMA
#undef PG8_WAIT_V
#undef PG8_WAIT_L
#undef PG8_BAR
#undef PG8_SCHED
}
}
namespace attn_body {
using bf16=__hip_bfloat16;
using bf16x8=__attribute__((ext_vector_type(8)))short;
using s16x4=__attribute__((ext_vector_type(4)))short;
using f32x16=__attribute__((ext_vector_type(16)))float;
using u32x4=__attribute__((ext_vector_type(4)))unsigned;
constexpr int D=64,PQ=3328,PO=1024;
constexpr int NW=8,QBLK=32,QB=QBLK*NW,KVBLK=64;
__device__ __forceinline__ int crow(int r,int hi){return (r&3)+8*(r>>2)+4*hi;}
#define SBAR() __builtin_amdgcn_sched_barrier(0)
__device__ __forceinline__ void wmask(f32x16&p0,f32x16&p1,int dq,int hi){
  const float NEG=-INFINITY; int kb=4*hi;
  #pragma unroll
  for(int r=0;r<16;++r){int kv=kb+(r&3)+8*(r>>2); int d0=dq-kv; if(d0>128||d0<-128)p0[r]=NEG; int d1=d0-32; if(d1>128||d1<-128)p1[r]=NEG;}
}

constexpr int NSLOT=3, SLOTB=8192;
constexpr int LDS_K=0, LDS_V=NSLOT*SLOTB, LDS_WS=2*NSLOT*SLOTB, LDS_OST=LDS_WS+NW*64*4, LDS_BYTES=LDS_OST+NW*4096;
constexpr float C2=0.125f*1.4426950408889634f;
__device__ __forceinline__ void glds16(const void*gsrc,unsigned lds_dst){unsigned keep;
  asm volatile("s_mov_b32 %0, m0\n\ts_mov_b32 m0, %2\n\ts_nop 0\n\tglobal_load_lds_dwordx4 %1, off\n\ts_mov_b32 m0, %0":"=&s"(keep):"v"(gsrc),"s"(lds_dst):"memory");}
__device__ __forceinline__ float max3f(float a,float b,float c){float r;asm("v_max3_f32 %0, %1, %2, %3":"=v"(r):"v"(a),"v"(b),"v"(c));return r;}
__device__ __forceinline__ float max2f(float a,float b){float r;asm("v_max_f32_e32 %0, %1, %2":"=v"(r):"v"(a),"v"(b));return r;}
__device__ __forceinline__ float fadd_s(float a,float b){float r;asm("v_add_f32_e32 %0, %1, %2":"=v"(r):"v"(a),"v"(b));return r;}
__device__ __forceinline__ float fsub_s(float a,float b){float r;asm("v_sub_f32_e32 %0, %1, %2":"=v"(r):"v"(a),"v"(b));return r;}
typedef float f32x2_t __attribute__((ext_vector_type(2))); typedef __bf16 bf16x2_t __attribute__((ext_vector_type(2)));
__device__ __forceinline__ unsigned cvtpk_s(float lo,float hi){f32x2_t v={lo,hi};bf16x2_t b=__builtin_convertvector(v,bf16x2_t);return __builtin_bit_cast(unsigned,b);}
#define WAIT_BAR(N) asm volatile("s_waitcnt vmcnt(" #N ") lgkmcnt(0)\n\ts_barrier":::"memory")

__device__ __forceinline__ void qkt(f32x16&p0,f32x16&p1,const char*Kslot,const bf16x8*qr,const f32x16&negm,int r32,int hi){
  const char*kb=Kslot+hi*1024+r32*16;
  #pragma unroll
  for(int d0=0;d0<4;++d0){
    const bf16x8 b0=*reinterpret_cast<const bf16x8*>(kb+d0*2048);
    const bf16x8 b1=*reinterpret_cast<const bf16x8*>(kb+d0*2048+512);
    if(d0==0){p0=__builtin_amdgcn_mfma_f32_32x32x16_bf16(b0,qr[0],negm,0,0,0);p1=__builtin_amdgcn_mfma_f32_32x32x16_bf16(b1,qr[0],negm,0,0,0);}
    else{p0=__builtin_amdgcn_mfma_f32_32x32x16_bf16(b0,qr[d0],p0,0,0,0);p1=__builtin_amdgcn_mfma_f32_32x32x16_bf16(b1,qr[d0],p1,0,0,0);}}
}
typedef __attribute__((address_space(3))) const char* lds_cptr;
typedef short v4i16_t __attribute__((ext_vector_type(4)));
__device__ __forceinline__ void kload8(bf16x8*kf,lds_cptr kp){
  kf[0]=*(const __attribute__((address_space(3))) bf16x8*)(kp);      kf[1]=*(const __attribute__((address_space(3))) bf16x8*)(kp+512);
  kf[2]=*(const __attribute__((address_space(3))) bf16x8*)(kp+2048); kf[3]=*(const __attribute__((address_space(3))) bf16x8*)(kp+2560);
  kf[4]=*(const __attribute__((address_space(3))) bf16x8*)(kp+4096); kf[5]=*(const __attribute__((address_space(3))) bf16x8*)(kp+4608);
  kf[6]=*(const __attribute__((address_space(3))) bf16x8*)(kp+6144); kf[7]=*(const __attribute__((address_space(3))) bf16x8*)(kp+6656);
}
__device__ __forceinline__ void kload2(bf16x8*kf,lds_cptr kp,int j){ kf[2*j]=*(const __attribute__((address_space(3))) bf16x8*)(kp+j*2048); kf[2*j+1]=*(const __attribute__((address_space(3))) bf16x8*)(kp+j*2048+512); }
__device__ __forceinline__ s16x4 vtr(lds_cptr p){ return __builtin_bit_cast(s16x4,__builtin_amdgcn_ds_read_tr16_b64_v4i16((__attribute__((address_space(3))) v4i16_t*)p)); }
__device__ __forceinline__ float rowmax(const f32x16&p0,const f32x16&p1){
  float a=max3f(p0[0],p0[1],p1[0]),b=max3f(p0[2],p0[3],p1[1]);a=max3f(a,p1[2],p1[3]);
  #pragma unroll
  for(int r=4;r<16;r+=4){a=max3f(a,p0[r],p0[r+1]);b=max3f(b,p0[r+2],p0[r+3]);a=max3f(a,p1[r],p1[r+1]);b=max3f(b,p1[r+2],p1[r+3]);}
  const float m=max2f(a,b);
  auto rr=__builtin_amdgcn_permlane32_swap(__float_as_uint(m),__float_as_uint(m),false,false);
  return max2f(__uint_as_float(rr[0]),__uint_as_float(rr[1]));
}
__device__ __forceinline__ void pv(f32x16*o,int vb,bf16x8 pa0,bf16x8 pa1,bf16x8 pa2,bf16x8 pa3){
  #pragma unroll
  for(int d0=0;d0<2;++d0){s16x4 lo[4],hi[4];
    #pragma unroll
    for(int ks=0;ks<4;++ks){
      asm volatile("ds_read_b64_tr_b16 %0,%1 offset:%c2":"=&v"(lo[ks]):"v"(vb),"i"(d0*4096+ks*1024):"memory");
      asm volatile("ds_read_b64_tr_b16 %0,%1 offset:%c2":"=&v"(hi[ks]):"v"(vb),"i"(d0*4096+ks*1024+512):"memory");}
    asm volatile("s_waitcnt lgkmcnt(0)":::"memory");SBAR();
    #define PK(k) (bf16x8){lo[k][0],lo[k][1],lo[k][2],lo[k][3],hi[k][0],hi[k][1],hi[k][2],hi[k][3]}
    o[d0]=__builtin_amdgcn_mfma_f32_32x32x16_bf16(pa0,PK(0),o[d0],0,0,0);
    o[d0]=__builtin_amdgcn_mfma_f32_32x32x16_bf16(pa1,PK(1),o[d0],0,0,0);
    o[d0]=__builtin_amdgcn_mfma_f32_32x32x16_bf16(pa2,PK(2),o[d0],0,0,0);
    o[d0]=__builtin_amdgcn_mfma_f32_32x32x16_bf16(pa3,PK(3),o[d0],0,0,0);
    #undef PK
  }
}

#ifndef ATTN_STORE16
#define ATTN_STORE16(p,v) (*(u32x4*)(p)=(v))
#endif
template<int THRL,int MODE> __device__ __forceinline__ void attn_unit(const bf16*Q0,const bf16*__restrict__ Kh,const bf16*__restrict__ Vh,bf16*O0,const int NT,const int band_row0,const int qpos0,const int band_s0,const float sink_l2,char*shm){
  int tid_=threadIdx.x; asm volatile("":"+v"(tid_));
  const int tid=tid_,lane=tid&63,r32=lane&31,hi=lane>>5; const int wid=__builtin_amdgcn_readfirstlane(tid>>6);
  const bf16*Qw=Q0+(long)(wid*QBLK)*PQ;
  #define TROW(t) ((MODE==1&&(t)>=4)?(band_row0+((t)-4)*KVBLK):((t)*KVBLK))
  const unsigned lds0=(unsigned)(uintptr_t)shm;
  float*wsf=(float*)(shm+LDS_WS)+wid*64;
  const bf16*ksrc=Kh+(long)lane*PQ+wid*8;
  const bf16*vsrc=Vh+(long)(16*(wid&3)+(lane>>2))*PQ+(wid>>2)*32+(lane&3)*8;
  const unsigned kdst=lds0+LDS_K+wid*1024, vdst=lds0+LDS_V+wid*1024;
  #define DMA_K(t,slot) glds16(ksrc+(long)TROW(t)*PQ,(unsigned)__builtin_amdgcn_readfirstlane(kdst+(slot)))
  #define DMA_V(t,slot) glds16(vsrc+(long)TROW(t)*PQ,(unsigned)__builtin_amdgcn_readfirstlane(vdst+(slot)))
  const int vb0=(int)(lds0+LDS_V)+((lane>>4)&1)*32+(lane&3)*8+(4*hi+((lane&15)>>2))*64;
  const char*Kbase=shm+LDS_K; bf16x8 kf[8];
  const lds_cptr shm3=(lds_cptr)shm; const lds_cptr kp0=shm3+LDS_K+hi*1024+r32*16; const lds_cptr vp0=shm3+LDS_V+((lane>>4)&1)*32+(lane&3)*8+(4*hi+((lane&15)>>2))*64;
  DMA_K(0,0);DMA_V(0,0);DMA_K(1,SLOTB);
  bf16x8 qr[4];
  #pragma unroll
  for(int d0=0;d0<4;++d0)qr[d0]=*reinterpret_cast<const bf16x8*>(&Qw[(long)r32*PQ+d0*16+hi*8]);
  float mhat=0.f,l_reg=0.f;f32x16 o[2];o[0]=f32x16{};o[1]=f32x16{};f32x16 negm=f32x16{};asm volatile("":"+v"(negm));
  const int qrel=wid*QBLK+r32;
  #define CMASK(P0,P1,t) do{ if(MODE==1&&(t)>=4){ wmask(P0,P1,qpos0+qrel-(band_s0+((t)-4)*KVBLK),hi); } }while(0)
  bool resc=false;
  #define START(P0,P1) do{ const float rm=rowmax(P0,P1); resc=false; \
    { const float dl=rm; mhat=fadd_s(mhat,dl); \
      _Pragma("unroll") for(int r=0;r<16;++r){P0[r]=fsub_s(P0[r],dl);P1[r]=fsub_s(P1[r],dl);} \
      _Pragma("unroll") for(int r=0;r<16;++r)negm[r]=-mhat; asm volatile("":"+v"(negm)); } \
    _Pragma("unroll") for(int r=0;r<16;++r)P0[r]=__builtin_amdgcn_exp2f(P0[r]); }while(0)
  #define RESC() do{ if(resc){ asm volatile("s_waitcnt lgkmcnt(0)":::"memory"); \
      _Pragma("unroll") for(int d_=0;d_<2;++d_) _Pragma("unroll") for(int r=0;r<16;++r)o[d_][r]*=wsf[crow(r,hi)]; } }while(0)
  f32x16 pA0,pA1,pB0,pB1;
  int sl_prev=0,sl_cur=0,sl_next=SLOTB;
  #define ROT() do{sl_prev=sl_cur;sl_cur=sl_next;sl_next=(sl_next==(NSLOT-1)*SLOTB)?0:sl_next+SLOTB;}while(0)
  DMA_K(2,2*SLOTB);
  WAIT_BAR(3);
  qkt(pA0,pA1,Kbase,qr,negm,r32,hi);asm volatile("s_nop 15\n\ts_nop 7":"+v"(pA0),"+v"(pA1));CMASK(pA0,pA1,0);
  START(pA0,pA1);
  _Pragma("unroll") for(int r=0;r<16;++r)pA1[r]=__builtin_amdgcn_exp2f(pA1[r]);
  WAIT_BAR(0);
  DMA_K(3,0);DMA_V(1,SLOTB);
  ROT();
  kload8(kf,kp0+sl_cur);
  WAIT_BAR(2);
  s16x4 vlo[8],vhi[8]; u32x4 pw0,pw1,pw2,pw3;
  #define PKW(P,B) cvtpk_s(P[B],P[B+1])
  #define PAF(k) __builtin_bit_cast(bf16x8,pw##k)
  #define VFR(i) (bf16x8){vlo[i][0],vlo[i][1],vlo[i][2],vlo[i][3],vhi[i][0],vhi[i][1],vhi[i][2],vhi[i][3]}
  #define PIN(x) asm volatile("":"+v"(x))
  #define MX3(a,b,c) __builtin_fmaxf(__builtin_fmaxf((a),(b)),(c))
  #define GAPA(MF,A0,A1,A2,A3,W0,W1,PW) do{ MF; sacc+=A0; sacc+=A1; sacc+=A2; sacc+=A3; PIN(sacc); W0; W1; PIN(PW); SBAR(); }while(0)
  #define EX(v) __builtin_amdgcn_exp2f(v)
  #define GAPB(MF,X,B) do{ MF; X[B]=EX(X[B]); X[B+1]=EX(X[B+1]); X[B+2]=EX(X[B+2]); X[B+3]=EX(X[B+3]); PIN(X); SBAR(); }while(0)
  #define VRD(i) do{ vlo[i]=vtr(vp_+(((i)>>2)*4096+((i)&3)*1024)); vhi[i]=vtr(vp_+(((i)>>2)*4096+((i)&3)*1024+512)); }while(0)
  #define KRD(G,j) do{ if(G){ kload2(kf,kp0+sl_next,j); SBAR(); } }while(0)
  #define STEP(C0,C1,P0,P1,t,GK,GV,GL) do{ SBAR(); \
    const lds_cptr vp_=vp0+sl_prev; \
    VRD(0); SBAR(); float sacc=(P0[0]+P0[1]); \
    GAPA(C0=__builtin_amdgcn_mfma_f32_32x32x16_bf16(kf[0],qr[0],negm,0,0,0), P0[2],P0[3],P0[4],P0[5],     pw0[0]=PKW(P0,0), pw0[1]=PKW(P0,2), pw0); \
    VRD(4); SBAR(); GAPA(C1=__builtin_amdgcn_mfma_f32_32x32x16_bf16(kf[1],qr[0],negm,0,0,0), P0[6],P0[7],P0[8],P0[9],     pw0[2]=PKW(P0,4), pw0[3]=PKW(P0,6), pw0); \
    VRD(1); SBAR(); GAPA(C0=__builtin_amdgcn_mfma_f32_32x32x16_bf16(kf[2],qr[1],C0,0,0,0),   P0[10],P0[11],P0[12],P0[13], pw1[0]=PKW(P0,8), pw1[1]=PKW(P0,10), pw1); \
    VRD(5); SBAR(); GAPA(C1=__builtin_amdgcn_mfma_f32_32x32x16_bf16(kf[3],qr[1],C1,0,0,0),   P0[14],P0[15],P1[0],P1[1],   pw1[2]=PKW(P0,12),pw1[3]=PKW(P0,14), pw1); \
    VRD(2); SBAR(); GAPA(C0=__builtin_amdgcn_mfma_f32_32x32x16_bf16(kf[4],qr[2],C0,0,0,0),   P1[2],P1[3],P1[4],P1[5],     pw2[0]=PKW(P1,0), pw2[1]=PKW(P1,2), pw2); \
    VRD(6); SBAR(); GAPA(C1=__builtin_amdgcn_mfma_f32_32x32x16_bf16(kf[5],qr[2],C1,0,0,0),   P1[6],P1[7],P1[8],P1[9],     pw2[2]=PKW(P1,4), pw2[3]=PKW(P1,6), pw2); \
    VRD(3); SBAR(); GAPA(C0=__builtin_amdgcn_mfma_f32_32x32x16_bf16(kf[6],qr[3],C0,0,0,0),   P1[10],P1[11],P1[12],P1[13], pw3[0]=PKW(P1,8), pw3[1]=PKW(P1,10), pw3); \
    VRD(7); SBAR(); GAPA(C1=__builtin_amdgcn_mfma_f32_32x32x16_bf16(kf[7],qr[3],C1,0,0,0),   P1[14],P1[15],0.f,0.f,       pw3[2]=PKW(P1,12),pw3[3]=PKW(P1,14), pw3); \
    l_reg+=sacc; \
    if(GK){DMA_K((t)+3,sl_cur);} if(GV){DMA_V((t)+1,sl_next);} \
    CMASK(C0,C1,t); \
    { float a=MX3(C0[0],C0[1],C1[0]),b=MX3(C0[2],C0[3],C1[1]); a=MX3(a,C1[2],C1[3]); \
      _Pragma("unroll") for(int r=4;r<16;r+=4){a=MX3(a,C0[r],C0[r+1]);b=MX3(b,C0[r+2],C0[r+3]);a=MX3(a,C1[r],C1[r+1]);b=MX3(b,C1[r+2],C1[r+3]);} \
      float rm=__builtin_fmaxf(a,b); { auto rr=__builtin_amdgcn_permlane32_swap(__float_as_uint(rm),__float_as_uint(rm),false,false); rm=__builtin_fmaxf(__uint_as_float(rr[0]),__uint_as_float(rr[1])); } \
      resc=false; \
      if(__builtin_expect(__any(rm>(float)THRL),0)){ const float dl=__builtin_fmaxf(rm,0.f); mhat+=dl; \
        _Pragma("unroll") for(int r=0;r<16;++r){C0[r]-=dl;C1[r]-=dl;} \
        _Pragma("unroll") for(int r=0;r<16;++r)negm[r]=-mhat; asm volatile("":"+v"(negm)); \
        const float f=__builtin_amdgcn_exp2f(-dl); l_reg*=f; if(hi==0)wsf[r32]=f; resc=true; } } \
    SBAR(); \
    GAPB(o[0]=__builtin_amdgcn_mfma_f32_32x32x16_bf16(PAF(0),VFR(0),o[0],0,0,0), C0,0); \
    GAPB(o[1]=__builtin_amdgcn_mfma_f32_32x32x16_bf16(PAF(0),VFR(4),o[1],0,0,0), C0,4); \
    KRD(GL,0); GAPB(o[0]=__builtin_amdgcn_mfma_f32_32x32x16_bf16(PAF(1),VFR(1),o[0],0,0,0), C0,8); \
    KRD(GL,1); GAPB(o[1]=__builtin_amdgcn_mfma_f32_32x32x16_bf16(PAF(1),VFR(5),o[1],0,0,0), C0,12); \
    KRD(GL,2); GAPB(o[0]=__builtin_amdgcn_mfma_f32_32x32x16_bf16(PAF(2),VFR(2),o[0],0,0,0), C1,0); \
    KRD(GL,3); GAPB(o[1]=__builtin_amdgcn_mfma_f32_32x32x16_bf16(PAF(2),VFR(6),o[1],0,0,0), C1,4); \
    GAPB(o[0]=__builtin_amdgcn_mfma_f32_32x32x16_bf16(PAF(3),VFR(3),o[0],0,0,0), C1,8); \
    GAPB(o[1]=__builtin_amdgcn_mfma_f32_32x32x16_bf16(PAF(3),VFR(7),o[1],0,0,0), C1,12); \
    }while(0)
  int t=1;
  for(;t+5<NT;t+=2){
    STEP(pB0,pB1,pA0,pA1,t,true,true,true);     WAIT_BAR(2); RESC(); ROT();
    STEP(pA0,pA1,pB0,pB1,t+1,true,true,true);   WAIT_BAR(2); RESC(); ROT();
  }
  #define ENDW(tt) do{ if((tt)+3<NT){WAIT_BAR(2);} else if((tt)+2<NT){WAIT_BAR(1);} else {WAIT_BAR(0);} }while(0)
  for(;t+1<NT;t+=2){
    STEP(pB0,pB1,pA0,pA1,t,(t+3<NT),(t+1<NT),(t+1<NT));       ENDW(t);   RESC(); ROT();
    STEP(pA0,pA1,pB0,pB1,t+1,(t+4<NT),(t+2<NT),(t+2<NT));     ENDW(t+1); RESC(); ROT();
  }
  STEP(pB0,pB1,pA0,pA1,NT-1,false,false,false); RESC();
  { float sacc=pB0[0]+pB0[1]; _Pragma("unroll") for(int r=2;r<16;++r)sacc+=pB0[r]; _Pragma("unroll") for(int r=0;r<16;++r)sacc+=pB1[r]; l_reg+=sacc;
    pw0=(u32x4){PKW(pB0,0),PKW(pB0,2),PKW(pB0,4),PKW(pB0,6)};pw1=(u32x4){PKW(pB0,8),PKW(pB0,10),PKW(pB0,12),PKW(pB0,14)};pw2=(u32x4){PKW(pB1,0),PKW(pB1,2),PKW(pB1,4),PKW(pB1,6)};pw3=(u32x4){PKW(pB1,8),PKW(pB1,10),PKW(pB1,12),PKW(pB1,14)};
    SBAR(); pv(o,vb0+sl_cur,PAF(0),PAF(1),PAF(2),PAF(3)); }
  #undef PKW
  #undef PAF
  #undef VFR
  #undef PIN
  #undef MX3
  #undef GAPA
  #undef GAPB
  #undef EX
  #undef VRD
  #undef KRD
  #undef STEP
  #undef ENDW
  {auto rr=__builtin_amdgcn_permlane32_swap(__float_as_uint(l_reg),__float_as_uint(l_reg),false,false);l_reg=__uint_as_float(rr[0])+__uint_as_float(rr[1]);}
  if(MODE==1)l_reg+=__builtin_amdgcn_exp2f(sink_l2-mhat);
  if(hi==0)wsf[32+r32]=l_reg;asm volatile("s_waitcnt lgkmcnt(0)":::"memory");
  float rli[16];
  #pragma unroll
  for(int r=0;r<16;++r)rli[r]=__builtin_amdgcn_rcpf(wsf[32+crow(r,hi)]);
  bf16*Ow=O0+(long)(wid*QBLK)*PO;
  { bf16*stg=(bf16*)(shm+LDS_OST)+wid*2048;
    #pragma unroll
    for(int r=0;r<16;++r){const int orow=crow(r,hi);
      #pragma unroll
      for(int d0=0;d0<2;++d0)stg[orow*64+d0*32+r32]=__float2bfloat16(o[d0][r]*rli[r]);}
    asm volatile("s_waitcnt lgkmcnt(0)":::"memory");
    #pragma unroll
    for(int i=0;i<4;++i){const int row=i*8+(lane>>3),ch=lane&7; const u32x4 v=*(const u32x4*)(stg+row*64+ch*8); ATTN_STORE16(Ow+(long)row*PO+ch*8,v);} }
  asm volatile("s_waitcnt lgkmcnt(0)\n\ts_barrier":::"memory");
  #undef DMA_K
  #undef DMA_V
  #undef TROW
  #undef CMASK
  #undef START
  #undef RESC
  #undef ROT
}
constexpr int ATTN_LDS_BYTES=LDS_BYTES;
#undef SBAR
#undef WAIT_BAR
}
namespace scan {
using namespace mk;
template <int NROWS> __device__ __forceinline__ int img_off(int row, int c) { return (((c >> 5) * (NROWS / 16) + (row >> 4)) << 10) + ((row & 15) << 6) + (((((c & 31) >> 3) ^ ((row >> 2) & 3))) << 4) + ((c & 7) << 1); }
__device__ __forceinline__ int tlane(int lane) { const int hh = lane >> 5, q = (lane & 15) >> 2, ch = 2 * ((lane >> 4) & 1) + ((lane & 3) >> 1), rowb = (4 * hh + q) * 64 + (lane & 1) * 8;
  const int lo = rowb + ((ch ^ hh) << 4), hi = 512 + rowb + ((ch ^ (hh + 2)) << 4); return lo | (hi << 16); }
__device__ __forceinline__ bf16x8 rfrag(LAS const char* p) { return *(LAS const bf16x8*)p; }
__device__ __forceinline__ s16x4 tr4(LAS const char* p) { return __builtin_bit_cast(s16x4, __builtin_amdgcn_ds_read_tr16_b64_v4i16((LAS s16x4*)p)); }
__device__ __forceinline__ bf16x8 tfrag(LAS const char* base, int tl) { const s16x4 lo = tr4(base + (tl & 0xffff)), hi = tr4(base + (tl >> 16)); return (bf16x8){lo[0], lo[1], lo[2], lo[3], hi[0], hi[1], hi[2], hi[3]}; }
__device__ __forceinline__ bf16x8 pack8(const f32x16& s, int b) {
  u32x4 w; w.x = cvtpk(s[b], s[b + 1]); w.y = cvtpk(s[b + 2], s[b + 3]); w.z = cvtpk(s[b + 4], s[b + 5]); w.w = cvtpk(s[b + 6], s[b + 7]); return __builtin_bit_cast(bf16x8, w);
}
#define MFMA32(a, b, c) __builtin_amdgcn_mfma_f32_32x32x16_bf16(a, b, c, 0, 0, 0)

template <int DK, int DV>
__device__ __forceinline__ void chunk_core(LAS const char* Qm, LAS const char* Km, LAS const char* Vm, LAS const char* Ss, LAS const float* rowexp, LAS const float* colexp, LAS const float* isc,
                                           f32x16& res0, f32x16& res1, int wid, int lane) {
  constexpr int KS = DK / 16, NVT = DV / 32;
  const int vp = wid >> 2, tb = vp ? 3 - (wid & 3) : (wid & 3), r32 = lane & 31, hh = lane >> 5, tl = tlane(lane);
  constexpr bool HOLDQ = (KS <= 4);
  bf16x8 qf[HOLDQ ? KS : 1];
  if (HOLDQ) {
#pragma unroll
    for (int ks = 0; ks < KS; ++ks) qf[ks] = rfrag(Qm + img_off<128>(32 * tb + r32, 16 * ks + 8 * hh)); }
#define QF(ks) (HOLDQ ? qf[HOLDQ ? (ks) : 0] : rfrag(Qm + img_off<128>(32 * tb + r32, 16 * (ks) + 8 * hh)))
  f32x16 o0 = {}, o1 = {};
  const float re = rowexp[32 * tb + r32];
  if (tb >= 2) __builtin_amdgcn_s_setprio(1);
#pragma unroll 1
  for (int st = 0; st <= tb; ++st) {
    f32x16 s = {};
#pragma unroll
    for (int ks = 0; ks < KS; ++ks) { const bf16x8 kf = rfrag(Km + img_off<128>(32 * st + r32, 16 * ks + 8 * hh)); s = MFMA32(kf, QF(ks), s); }
#pragma unroll
    for (int r = 0; r < 16; ++r) { const int sl = crow(r, hh); float w = __builtin_amdgcn_exp2f(re + colexp[32 * st + sl]); if (st == tb && sl > r32) w = 0.f; s[r] *= w; }
    const bf16x8 pa0 = pack8(s, 0), pa1 = pack8(s, 8);
    { const bf16x8 v0 = tfrag(Vm + ((vp * 8 + 2 * st) << 10), tl), v1 = tfrag(Vm + ((vp * 8 + 2 * st + 1) << 10), tl); o0 = MFMA32(pa0, v0, o0); o0 = MFMA32(pa1, v1, o0); }
    if (NVT > 2 && vp == 0) { const bf16x8 v0 = tfrag(Vm + ((2 * 8 + 2 * st) << 10), tl), v1 = tfrag(Vm + ((2 * 8 + 2 * st + 1) << 10), tl); o1 = MFMA32(pa0, v0, o1); o1 = MFMA32(pa1, v1, o1); }
  }
  f32x16 i0 = {}, i1 = {};
#pragma unroll
  for (int ks = 0; ks < KS; ++ks) { const bf16x8 sf = rfrag(Ss + img_off<DV>(32 * vp + r32, 16 * ks + 8 * hh)); i0 = MFMA32(QF(ks), sf, i0); }
  if (NVT > 2 && vp == 0) {
#pragma unroll
    for (int ks = 0; ks < KS; ++ks) { const bf16x8 sf = rfrag(Ss + img_off<DV>(64 + r32, 16 * ks + 8 * hh)); i1 = MFMA32(QF(ks), sf, i1); }
  }
#pragma unroll
  for (int r = 0; r < 16; ++r) { const float sc = isc[32 * tb + crow(r, hh)]; res0[r] = o0[r] + sc * i0[r]; res1[r] = o1[r] + sc * i1[r]; }
  __builtin_amdgcn_s_setprio(0);
#undef QF
}
template <int DK, int DV>
__device__ __forceinline__ void state_update(LAS const char* Km, LAS const char* Vw, LAS char* Ss, f32x16& st_acc, float sd, int wid, int lane) {
  constexpr int NVT = DV / 32, NDT = DK / 32;
  if (wid < NVT * NDT) {
    const int vt = wid / NDT, dt_ = wid % NDT, r32 = lane & 31, hh = lane >> 5, tl = tlane(lane);
#pragma unroll
    for (int r = 0; r < 16; ++r) st_acc[r] *= sd;
    f32x16 st2 = {};
#pragma unroll
    for (int ks = 0; ks < 8; ks += 2) { const bf16x8 af = tfrag(Vw + ((vt * 8 + ks) << 10), tl), bfr = tfrag(Km + ((dt_ * 8 + ks) << 10), tl), af2 = tfrag(Vw + ((vt * 8 + ks + 1) << 10), tl), bf2 = tfrag(Km + ((dt_ * 8 + ks + 1) << 10), tl);
      st_acc = MFMA32(af, bfr, st_acc); st2 = MFMA32(af2, bf2, st2); }
#pragma unroll
    for (int r = 0; r < 16; ++r) st_acc[r] += st2[r];
#pragma unroll
    for (int r = 0; r < 16; ++r) *(LAS bf16*)(Ss + img_off<DV>(32 * vt + crow(r, hh), 32 * dt_ + r32)) = f2bf(st_acc[r]);
  }
}
__device__ __forceinline__ float wscan_add(float x, int lane) {
#pragma unroll
  for (int o = 1; o < 64; o <<= 1) { const float y = __shfl_up(x, o); if (lane >= o) x += y; }
  return x;
}
__device__ __forceinline__ float wscan_max(float x, int lane) {
#pragma unroll
  for (int o = 1; o < 64; o <<= 1) { const float y = __shfl_up(x, o); if (lane >= o) x = fmaxf(x, y); }
  return x;
}
__device__ __forceinline__ void chunk_rows(int cc, int dir, int& row0, int& seg0, int& seglen) {
  if (cc < 2) { const int ci = dir ? 1 - cc : cc; row0 = 128 * ci; seg0 = 0; seglen = NC; }
  else { const int ci = dir ? 31 - (cc - 2) : (cc - 2); row0 = NC + 128 * ci; seg0 = NC; seglen = T; }
}
#define SCAN_BAR() do { asm volatile("s_waitcnt vmcnt(0) lgkmcnt(0)" ::: "memory"); __builtin_amdgcn_s_barrier(); asm volatile("" ::: "memory"); } while (0)

__device__ __forceinline__ size_t g2_block(int b, int c, int dh) { return ((size_t)(b * 34 + c) * 8 + dh) * 1024; }
__device__ __forceinline__ void chunk_scalars(const float* __restrict__ G, float* __restrict__ G2, const float* __restrict__ a_log, const float* __restrict__ dt_bias, const float* __restrict__ b_i, const float* __restrict__ b_f, int b, int c, int dh, int lane) {
  const size_t rowb = (size_t)b * RB; const int row0 = c < 2 ? 128 * c : NC + 128 * (c - 2);
  { const int dir = dh >> 2, h = dh & 3;
    size_t rr[2];
#pragma unroll
    for (int e = 0; e < 2; ++e) { const int i = 2 * lane + e, io = dir ? 127 - i : i; rr[e] = rowb + row0 + io; }
    {
      const float a = -__expf(a_log[dh]), dtb = dt_bias[dh]; float dt2[2], cum2[2];
#pragma unroll
      for (int e = 0; e < 2; ++e) { const float dr = G[rr[e] * 32 + 16 + dh] + dtb; dt2[e] = dr > 20.f ? dr : __logf(1.f + __expf(dr)); }
      const float p0 = dt2[0] * a, p1 = p0 + dt2[1] * a; const float inc = wscan_add(p1, lane); const float exc = inc - p1;
      cum2[0] = exc + p0; cum2[1] = exc + p1; const float cend = __shfl(inc, 63); const float sdv = __builtin_amdgcn_exp2f(cend * L2E);
      float* gb = G2 + g2_block(b, c, dh) + 2 * lane;
      *(f32x2v*)(gb) = (f32x2v){cum2[0] * L2E, cum2[1] * L2E};
      *(f32x2v*)(gb + 128) = (f32x2v){-cum2[0] * L2E + __builtin_amdgcn_logf(dt2[0]), -cum2[1] * L2E + __builtin_amdgcn_logf(dt2[1])};
      *(f32x2v*)(gb + 256) = (f32x2v){__builtin_amdgcn_exp2f(cum2[0] * L2E), __builtin_amdgcn_exp2f(cum2[1] * L2E)};
      *(f32x2v*)(gb + 384) = (f32x2v){__builtin_amdgcn_exp2f((cend - cum2[0]) * L2E) * dt2[0], __builtin_amdgcn_exp2f((cend - cum2[1]) * L2E) * dt2[1]};
      if (lane == 0) gb[896] = sdv; }
    {
      const float bi = b_i[dh], bfg = b_f[dh]; float ig[2], lf[2];
#pragma unroll
      for (int e = 0; e < 2; ++e) { const float* gr = G + rr[e] * 32; ig[e] = gr[(2 * dir) * 4 + h] + bi; const float fg = gr[(2 * dir + 1) * 4 + h] + bfg; lf[e] = fminf(fg, 0.f) - __logf(1.f + __expf(-fabsf(fg))); }
      const float p1 = lf[0] + lf[1]; const float inc = wscan_add(p1, lane); const float exc = inc - p1;
      const float bb0 = exc + lf[0], bb1 = exc + p1, aa0 = ig[0] - bb0, aa1 = ig[1] - bb1;
      const float q1m = fmaxf(aa0, aa1); const float incm = wscan_max(q1m, lane); float excm = __shfl_up(incm, 1); if (lane == 0) excm = -INFINITY;
      float* gb = G2 + g2_block(b, c, dh) + 512 + 2 * lane;
      *(f32x2v*)(gb) = (f32x2v){aa0, aa1}; *(f32x2v*)(gb + 128) = (f32x2v){fmaxf(excm, aa0), fmaxf(excm, q1m)}; *(f32x2v*)(gb + 256) = (f32x2v){bb0, bb1}; } }
}
#define SCAN_BAR_L() do { asm volatile("s_waitcnt lgkmcnt(0)" ::: "memory"); __builtin_amdgcn_s_barrier(); asm volatile("" ::: "memory"); } while (0)

__device__ __forceinline__ void mamba_chain(LAS char* lds, const bf16* __restrict__ UC, const float* __restrict__ G2, bf16* __restrict__ YD, int b, int h, int dir, int pm = 15) {
  int tid_ = threadIdx.x; asm volatile("" : "+v"(tid_));
  const int tid = tid_, lane = tid & 63, wid = __builtin_amdgcn_readfirstlane(tid >> 6), g = h >> 1;
  LAS char* Qm = lds; LAS char* Km = lds + 32768; LAS char* Vm = lds + 65536; LAS char* Vw = lds + 81920; LAS char* Ss = lds + 98304;
  LAS float* rowexp = (LAS float*)(lds + 114688); LAS float* colexp = rowexp + 128; LAS float* isc = rowexp + 256; LAS float* vw = rowexp + 384; LAS float* misc = rowexp + 512;
  for (int i = tid; i < 16384 / 4; i += 512) ((LAS unsigned*)Ss)[i] = 0u;
  f32x16 st_acc = {};
  const size_t rowb = (size_t)b * RB;
  u32x4 pb[4], pcq[4], px[2]; f32x4 scn = {0.f, 0.f, 0.f, 0.f}; float sdn = 0.f;
  const int rB = tid >> 4, cB = tid & 15, rX = tid >> 3, cX = tid & 7;
  const int iB = dir ? 127 - rB : rB, iX = dir ? 127 - rX : rX; const int oB = img_off<128>(iB, cB * 8), oX = img_off<128>(iX, cX * 8); const int stB = dir ? -2048 : 2048, stX = dir ? -4096 : 4096;
#define MAMBA_LOAD(cc_) do { int row0_, seg0_, seglen_; chunk_rows((cc_), dir, row0_, seg0_, seglen_); \
    const bf16* ub_ = UC + (rowb + row0_ + rB) * 768 + 256 + g * 128 + cB * 8; const bf16* ux_ = UC + (rowb + row0_ + rX) * 768 + h * 64 + cX * 8; \
    _Pragma("unroll") for (int k = 0; k < 4; ++k) { pb[k] = *(const u32x4*)(ub_ + (size_t)k * 32 * 768); pcq[k] = *(const u32x4*)(ub_ + (size_t)k * 32 * 768 + 256); } \
    _Pragma("unroll") for (int k = 0; k < 2; ++k) px[k] = *(const u32x4*)(ux_ + (size_t)k * 64 * 768); \
    { const float* gp_ = G2 + g2_block(b, row0_ < NC ? row0_ >> 7 : 2 + ((row0_ - NC) >> 7), dir * 4 + h); if (tid < 128) { scn = (f32x4){gp_[tid], gp_[128 + tid], gp_[256 + tid], gp_[384 + tid]}; sdn = gp_[896]; } } } while (0)
  MAMBA_LOAD(0);
  SCAN_BAR();
#pragma unroll 1
  for (int cc = 0; cc < 34; ++cc) {
    int row0, seg0, seglen; chunk_rows(cc, dir, row0, seg0, seglen);
    if (tid < 128 && (pm & 1)) { rowexp[tid] = scn[0]; colexp[tid] = scn[1]; isc[tid] = scn[2]; vw[tid] = scn[3]; if (tid == 0) misc[0] = sdn; }
    SCAN_BAR_L();
    if (pm & 2) {
#pragma unroll
      for (int k = 0; k < 4; ++k) { *(LAS u32x4*)(Km + oB + k * stB) = pb[k]; *(LAS u32x4*)(Qm + oB + k * stB) = pcq[k]; }
#pragma unroll
      for (int k = 0; k < 2; ++k) { const int i = dir ? iX - 64 * k : iX + 64 * k; const float sv = vw[i]; u32x4 pw;
#pragma unroll
        for (int e = 0; e < 4; ++e) pw[e] = cvtpk(bf_lo(px[k][e]) * sv, bf_hi(px[k][e]) * sv);
        *(LAS u32x4*)(Vm + oX + k * stX) = px[k]; *(LAS u32x4*)(Vw + oX + k * stX) = pw; }
    }
    SCAN_BAR_L();
    if (cc + 1 < 34 && (pm & 2)) MAMBA_LOAD(cc + 1);
    f32x16 res0 = {}, res1 = {}; if (pm & 4) chunk_core<128, 64>(Qm, Km, Vm, Ss, rowexp, colexp, isc, res0, res1, wid, lane);
    if (pm == 15) { const int vp = wid >> 2, tb = vp ? 3 - (wid & 3) : (wid & 3), r32 = lane & 31, hh = lane >> 5; LAS char* ot = lds + (vp ? 132096 : 117248);
#pragma unroll
      for (int r = 0; r < 16; ++r) *(LAS bf16*)(ot + (32 * tb + crow(r, hh)) * 64 + r32 * 2) = f2bf(res0[r]); }
    const float sd = misc[0];
    SCAN_BAR_L();
    if (pm == 15) {
#pragma unroll
      for (int k = 0; k < 2; ++k) { const int t = (tid >> 3) + 64 * k, pc = tid & 7, io = dir ? 127 - t : t;
        const u32x4 v = *(LAS const u32x4*)(lds + ((pc >> 2) ? 132096 : 117248) + t * 64 + (pc & 3) * 16);
        *(u32x4*)(YD + ((size_t)dir * M + rowb + row0 + io) * 256 + h * 64 + pc * 8) = v; } }
    if (pm & 8) state_update<128, 64>(Km, Vw, Ss, st_acc, sd, wid, lane);
  }
#undef MAMBA_LOAD
  SCAN_BAR();
}

__device__ __forceinline__ void mlstm_chain(LAS char* lds, const bf16* __restrict__ P, const float* __restrict__ G2, bf16* __restrict__ HC, int b, int h, int dir) {
  int tid_ = threadIdx.x; asm volatile("" : "+v"(tid_));
  const int tid = tid_, lane = tid & 63, wid = __builtin_amdgcn_readfirstlane(tid >> 6);
  LAS char* Qm = lds; LAS char* Km = lds + 16384; LAS char* Vm = lds + 32768; LAS char* Vw = lds + 57344; LAS char* Ss = lds + 81920;
  LAS float* rowexp = (LAS float*)(lds + 94208); LAS float* colexp = rowexp + 128; LAS float* isc = rowexp + 256; LAS float* vw = rowexp + 384; LAS float* emn = rowexp + 512; LAS float* den = rowexp + 640; LAS float* misc = rowexp + 768;
  for (int i = tid; i < 12288 / 4; i += 512) ((LAS unsigned*)Ss)[i] = 0u;
  f32x16 st_acc = {};
  float m_prev = 0.f;
  const size_t rowb = (size_t)b * RB;
  const int io = tid >> 2, part = tid & 3, i = dir ? 127 - io : io;
  u32x4 q0, q1, k0, k1, v0, v1; float an = 0.f, pmn = 0.f, bn = 0.f, pm_end = 0.f, b_end = 0.f;
#define MLSTM_LOAD(cc_) do { int row0_, seg0_, seglen_; chunk_rows((cc_), dir, row0_, seg0_, seglen_); \
    const bf16* pr = P + (rowb + row0_ + io) * NP + h * 64 + part * 16; \
    q0 = *(const u32x4*)(pr + 1024); q1 = *(const u32x4*)(pr + 1024 + 8); k0 = *(const u32x4*)(pr + 1280); k1 = *(const u32x4*)(pr + 1280 + 8); v0 = *(const u32x4*)(pr + 1536); v1 = *(const u32x4*)(pr + 1536 + 8); \
    { const float* gp_ = G2 + g2_block(b, row0_ < NC ? row0_ >> 7 : 2 + ((row0_ - NC) >> 7), dir * 4 + h) + 512; pm_end = gp_[128 + 127]; b_end = gp_[256 + 127]; \
      if (tid < 128) { an = gp_[tid]; pmn = gp_[128 + tid]; bn = gp_[256 + tid]; } } } while (0)
#define MLSTM_FLUSH(r0_) do { _Pragma("unroll") for (int k = 0; k < 2; ++k) { const int t = (tid >> 3) + 64 * k, pc = tid & 7, ioo = dir ? 127 - t : t; \
      const u32x4 v = *(LAS const u32x4*)(lds + 98304 + t * 128 + pc * 16); *(u32x4*)(HC + ((size_t)dir * M + rowb + (r0_) + ioo) * 256 + h * 64 + pc * 8) = v; } } while (0)
  int prow0 = 0;
  MLSTM_LOAD(0);
  SCAN_BAR();
#pragma unroll 1
  for (int cc = 0; cc < 34; ++cc) {
    int row0, seg0, seglen; chunk_rows(cc, dir, row0, seg0, seglen);
    { const float mm_end = fmaxf(m_prev, pm_end);
      if (tid < 128) { const float mm = fmaxf(m_prev, pmn); rowexp[tid] = -mm * L2E; colexp[tid] = an * L2E; isc[tid] = __builtin_amdgcn_exp2f((m_prev - mm) * L2E); emn[tid] = __builtin_amdgcn_exp2f(-(bn + mm) * L2E); vw[tid] = __builtin_amdgcn_exp2f((an - mm_end) * L2E);
        if (tid == 0) misc[0] = __builtin_amdgcn_exp2f((m_prev - mm_end) * L2E); }
      m_prev = b_end + mm_end; }
    SCAN_BAR_L();
    if (cc > 0) MLSTM_FLUSH(prow0);
    prow0 = row0;
    {
      const float s = vw[i];
      u32x4 qa, qb, va, vb;
#pragma unroll
      for (int e = 0; e < 4; ++e) { qa[e] = cvtpk(bf_lo(q0[e]) * 0.125f, bf_hi(q0[e]) * 0.125f); qb[e] = cvtpk(bf_lo(q1[e]) * 0.125f, bf_hi(q1[e]) * 0.125f);
        va[e] = cvtpk(bf_lo(v0[e]) * s, bf_hi(v0[e]) * s); vb[e] = cvtpk(bf_lo(v1[e]) * s, bf_hi(v1[e]) * s); }
      const int o0 = img_off<128>(i, part * 16), o1 = img_off<128>(i, part * 16 + 8);
      *(LAS u32x4*)(Qm + o0) = qa; *(LAS u32x4*)(Qm + o1) = qb; *(LAS u32x4*)(Km + o0) = k0; *(LAS u32x4*)(Km + o1) = k1;
      *(LAS u32x4*)(Vm + o0) = v0; *(LAS u32x4*)(Vm + o1) = v1; *(LAS u32x4*)(Vw + o0) = va; *(LAS u32x4*)(Vw + o1) = vb;
      const int o2 = img_off<128>(i, 64 + part * 8);
      const unsigned one = part == 0 ? 0x3f80u : 0u, wkb = part == 0 ? (cvtpk(s, 0.f) & 0xffffu) : 0u;
      *(LAS u32x4*)(Vm + o2) = (u32x4){one, 0u, 0u, 0u}; *(LAS u32x4*)(Vw + o2) = (u32x4){wkb, 0u, 0u, 0u};
    }
    SCAN_BAR_L();
    if (cc + 1 < 34) MLSTM_LOAD(cc + 1);
    f32x16 res0, res1; chunk_core<64, 96>(Qm, Km, Vm, Ss, rowexp, colexp, isc, res0, res1, wid, lane);
    const int vp = wid >> 2, tb = vp ? 3 - (wid & 3) : (wid & 3), r32 = lane & 31, hh = lane >> 5;
    if (vp == 0 && r32 == 0) {
#pragma unroll
      for (int r = 0; r < 16; ++r) den[32 * tb + crow(r, hh)] = res1[r];
    }
    const float sd = misc[0];
    float em[16];
#pragma unroll
    for (int r = 0; r < 16; ++r) em[r] = emn[32 * tb + crow(r, hh)];
    SCAN_BAR_L();
#pragma unroll
    for (int r = 0; r < 16; ++r) { const int t = 32 * tb + crow(r, hh); const float dn = fmaxf(fabsf(den[t]), em[r]);
      *(LAS bf16*)(lds + 98304 + t * 128 + (32 * vp + r32) * 2) = f2bf(res0[r] / dn); }
    state_update<64, 96>(Km, Vw, Ss, st_acc, sd, wid, lane);
  }
#undef MLSTM_LOAD
  SCAN_BAR();
  MLSTM_FLUSH(prow0);
#undef MLSTM_FLUSH
  SCAN_BAR();
}
#undef MFMA32
}
namespace pg8 {
typedef float f32x4e __attribute__((ext_vector_type(4)));
typedef unsigned u32x2 __attribute__((ext_vector_type(2)));
struct FusedNorm {
    const float* SS; const float* bias; int fused, fused_ctx; const PG8_LAS float* rsT; mutable int ui;
    __device__ __forceinline__ bool on(const Unit& u) const { return fused && (fused_ctx || (u.pm % 17) != 0); }
    __device__ __forceinline__ void load(const Unit& u, int wr, int fr, int col0, float (&rs)[2][4], f32x4 (&bv)[2][2]) const {
        const int b = u.pm / 17, tp = u.pm % 17; const __attribute__((address_space(1))) float* bp = (const __attribute__((address_space(1))) float*)bias + (tp == 0 ? 8 : b) * 4096 + col0;
#pragma unroll
        for (int bj = 0; bj < 2; ++bj) { bv[bj][0] = *(const __attribute__((address_space(1))) f32x4*)(bp + bj * HALF); bv[bj][1] = *(const __attribute__((address_space(1))) f32x4*)(bp + bj * HALF + 4); }
#pragma unroll
        for (int ai = 0; ai < 2; ++ai)
#pragma unroll
            for (int m = 0; m < 4; ++m) rs[ai][m] = rsT[ui * 256 + ai * HALF + wr * 64 + m * 16 + fr];
    }
    template <class Sched> __device__ __forceinline__ void fill(const Sched& S, PG8_LAS float* tab, int tid) const {
        Unit u;
        for (int i = 0; S.next(i, u); ++i) { const int row = tid >> 1, half = tid & 1; float v = 1.f;
            if (on(u)) { const __attribute__((address_space(1))) f32x4* p = (const __attribute__((address_space(1))) f32x4*)(SS + ((size_t)u.pm * BM + row) * 16 + half * 8); const f32x4 t = p[0] + p[1]; float sum = (t[0] + t[1]) + (t[2] + t[3]); sum += __shfl_xor(sum, 1);
                v = __builtin_amdgcn_rsqf(sum * (1.f / 1024.f) + 1e-6f); }
            if (half == 0) tab[i * 256 + row] = v; }
        __syncthreads();
    }
};
__host__ __device__ __forceinline__ int lcol(int p) { return (p & ~255) + ((p >> 5) & 3) * 64 + ((p >> 7) & 1) * 32 + (p & 31); }
__device__ __forceinline__ u32x4 ror8(const u32x4 v) { u32x4 r;
#pragma unroll
    for (int e = 0; e < 4; ++e) r[e] = (unsigned)__builtin_amdgcn_update_dpp(0, (int)v[e], 0x128, 0xF, 0xF, true);
    return r; }
__device__ __forceinline__ void store_rows128(bf16_t* rp, int ld, int fr, int fq, const u32x4 w0, const u32x4 w1) {
    const u32x4 x0 = ror8(w0), x1 = ror8(w1); const bool lo = fr < 8; u32x4 dA, dB;
#pragma unroll
    for (int e = 0; e < 4; ++e) { dA[e] = lo ? w0[e] : x1[e]; dB[e] = lo ? x0[e] : w1[e]; }
    bf16_t* q = rp + (size_t)(fr & 7) * ld + (lo ? 0 : 32) + 8 * fq;
    *(u32x4*)q = dA; *(u32x4*)(q + (size_t)8 * ld) = dB;
}
struct EpiInProj {
    static constexpr bool PERM = true, AFTER_DRAIN = false;
    bf16_t* O; float* G; FusedNorm F;
    __device__ __forceinline__ void operator()(const f32x4 (&acc)[2][2][4][2], const Unit& u, int wr, int wc, int fr, int fq) const {
        const int row0 = u.pm * BM + wr * 64 + fr, col0 = u.pn * BM + wc * 32 + 8 * fq;
        float rs[2][4]; f32x4 bv[2][2]; const bool fz = F.on(u);
        if (fz) F.load(u, wr, fr, col0, rs, bv);
        else {
#pragma unroll
            for (int ai = 0; ai < 2; ++ai)
#pragma unroll
                for (int m = 0; m < 4; ++m) rs[ai][m] = 1.f;
#pragma unroll
            for (int bj = 0; bj < 2; ++bj) { bv[bj][0] = (f32x4){0.f, 0.f, 0.f, 0.f}; bv[bj][1] = (f32x4){0.f, 0.f, 0.f, 0.f}; } }
#pragma unroll
        for (int ai = 0; ai < 2; ++ai)
#pragma unroll
            for (int m = 0; m < 4; ++m) { const float r_ = rs[ai][m]; u32x4 w[2];
#pragma unroll
                for (int bj = 0; bj < 2; ++bj) { const f32x4 v0 = acc[ai][bj][m][0] * r_ + bv[bj][0], v1 = acc[ai][bj][m][1] * r_ + bv[bj][1];
                    w[bj].x = cvt_pk_bf16(v0[0], v0[1]); w[bj].y = cvt_pk_bf16(v0[2], v0[3]); w[bj].z = cvt_pk_bf16(v1[0], v1[1]); w[bj].w = cvt_pk_bf16(v1[2], v1[3]); }
                store_rows128(O + (size_t)(u.pm * BM + wr * 64 + ai * HALF + m * 16) * 3328 + u.pn * BM + wc * 64, 3328, fr, fq, w[0], w[1]); }
        if (u.pn == 12 && wc == 0) {
#pragma unroll
            for (int ai = 0; ai < 2; ++ai)
#pragma unroll
                for (int m = 0; m < 4; ++m) { float* gp = G + (size_t)(row0 + ai * HALF + m * 16) * 32 + 8 * fq; const float r_ = rs[ai][m]; *(f32x4*)gp = acc[ai][0][m][0] * r_ + bv[0][0]; *(f32x4*)(gp + 4) = acc[ai][0][m][1] * r_ + bv[0][1]; }
        }
        ++F.ui;
    }
};
struct EpiRelu2 {
    static constexpr bool PERM = true, AFTER_DRAIN = false;
    bf16_t* O; FusedNorm F;
    __device__ __forceinline__ void operator()(const f32x4 (&acc)[2][2][4][2], const Unit& u, int wr, int wc, int fr, int fq) const {
        const int row0 = u.pm * BM + wr * 64 + fr, col0 = u.pn * BM + wc * 32 + 8 * fq;
        float rs[2][4]; f32x4 bv[2][2]; const bool fz = F.on(u);
        if (fz) F.load(u, wr, fr, col0, rs, bv);
        else {
#pragma unroll
            for (int ai = 0; ai < 2; ++ai)
#pragma unroll
                for (int m = 0; m < 4; ++m) rs[ai][m] = 1.f;
#pragma unroll
            for (int bj = 0; bj < 2; ++bj) { bv[bj][0] = (f32x4){0.f, 0.f, 0.f, 0.f}; bv[bj][1] = (f32x4){0.f, 0.f, 0.f, 0.f}; } }
#pragma unroll
        for (int ai = 0; ai < 2; ++ai)
#pragma unroll
            for (int m = 0; m < 4; ++m) { const float r_ = rs[ai][m]; u32x4 w[2];
#pragma unroll
                for (int bj = 0; bj < 2; ++bj) { f32x4 v0 = acc[ai][bj][m][0] * r_ + bv[bj][0], v1 = acc[ai][bj][m][1] * r_ + bv[bj][1];
#pragma unroll
                    for (int e = 0; e < 4; ++e) { const float a = v0[e] > 0.f ? v0[e] : 0.f, b = v1[e] > 0.f ? v1[e] : 0.f; v0[e] = a * a; v1[e] = b * b; }
                    w[bj].x = cvt_pk_bf16(v0[0], v0[1]); w[bj].y = cvt_pk_bf16(v0[2], v0[3]); w[bj].z = cvt_pk_bf16(v1[0], v1[1]); w[bj].w = cvt_pk_bf16(v1[2], v1[3]); }
                store_rows128(O + (size_t)(u.pm * BM + wr * 64 + ai * HALF + m * 16) * 4096 + u.pn * BM + wc * 64, 4096, fr, fq, w[0], w[1]); }
        ++F.ui;
    }
};
template <class T> __device__ __forceinline__ T* uni_ptr(T* p) { const unsigned long long v = (unsigned long long)(uintptr_t)p; const unsigned lo = (unsigned)__builtin_amdgcn_readfirstlane((int)(unsigned)v), hi = (unsigned)__builtin_amdgcn_readfirstlane((int)(unsigned)(v >> 32)); return (T*)(uintptr_t)(((unsigned long long)hi << 32) | lo); }
typedef _Float16 h16x2 __attribute__((ext_vector_type(2)));
typedef float f32x2e __attribute__((ext_vector_type(2)));
__device__ __forceinline__ unsigned pk_h16(float lo, float hi) { const f32x2e v = {lo, hi}; return __builtin_bit_cast(unsigned, __builtin_convertvector(v, h16x2)); }
__device__ __forceinline__ float h16_lo(unsigned w) { return (float)__builtin_bit_cast(h16x2, w)[0]; }
__device__ __forceinline__ float h16_hi(unsigned w) { return (float)__builtin_bit_cast(h16x2, w)[1]; }
template <bool XF32>
struct EpiResid {
    static constexpr bool PERM = false, AFTER_DRAIN = false;
    unsigned char* ws; const float* x_in; const float* ctx_in; const float* g_next; int l, flags;
    __device__ __forceinline__ void operator()(const f32x4 (&acc)[2][2][4][2], const Unit& u, int wr, int wc, int fr, int fq) const {
        const int b = u.pm / 17, tp = u.pm % 17, mb = tp == 0 ? 8 : b; const bool is_ff2 = flags & 1, fuse = flags & 2; const float gsign = (flags & 4) ? -1.f : 1.f;
        const float* modl = (const float*)(ws + mk::WS_MOD) + (size_t)l * 9 * 6144;
        const size_t grow0 = (size_t)u.pm * BM;
        bf16_t* xs = (bf16_t*)(ws + mk::WS_XS) + grow0 * 1024;
        const void* xin = xs;
        if (XF32) xin = uni_ptr(tp == 0 ? ctx_in + (size_t)b * 256 * 1024 : x_in + ((size_t)b * 4096 + (size_t)(tp - 1) * 256) * 1024);
        const auto rin = __builtin_amdgcn_make_buffer_rsrc((void*)xin, 0, 256 * 1024 * (XF32 ? 4 : 2), 0x00020000), rxs = __builtin_amdgcn_make_buffer_rsrc((void*)xs, 0, 256 * 1024 * 2, 0x00020000);
        const auto rh = __builtin_amdgcn_make_buffer_rsrc((void*)((bf16_t*)(ws + mk::WS_H) + grow0 * 1024), 0, 256 * 1024 * 2, 0x00020000);
        const auto rgate = __builtin_amdgcn_make_buffer_rsrc((void*)(modl + mb * 6144 + (is_ff2 ? 5120 : 2048)), 0, 4096, 0x00020000);
        const auto rsc = __builtin_amdgcn_make_buffer_rsrc((void*)((is_ff2 ? (const float*)(ws + mk::WS_MOD) + (size_t)9 * 6144 + 1024 : modl + 4096) + mb * 6144), 0, 4096, 0x00020000);
        const auto rgn = __builtin_amdgcn_make_buffer_rsrc((void*)g_next, 0, 4096, 0x00020000);
        typedef __attribute__((address_space(1))) u32x4 gu4; typedef __attribute__((address_space(1))) bf16_t gb16;
        gb16* xsb = (gb16*)uni_ptr(xs); gb16* hb = (gb16*)uni_ptr((bf16_t*)(ws + mk::WS_H) + grow0 * 1024);
        const int colw = u.pn * BM + wc * 32 + (fq & 1) * 16 + (fq >> 1) * 8;
        const unsigned vb = (unsigned)(((wr * 64 + fr) * 1024 + colw) * 2), vc = (unsigned)(colw * 4);
        float ssq[2][4];
#pragma unroll
        for (int ai = 0; ai < 2; ++ai)
#pragma unroll
            for (int m = 0; m < 4; ++m) ssq[ai][m] = 0.f;
#pragma unroll
        for (int bj = 0; bj < 2; ++bj) { const int cb = bj * HALF;
            u32x4 gvr[2], gnr[2], scr_[2], xr[2][4][XF32 ? 2 : 1];
#pragma unroll
            for (int h = 0; h < 2; ++h) { gvr[h] = __builtin_amdgcn_raw_buffer_load_b128(rgate, vc + cb * 4 + h * 16, 0, 0); gnr[h] = __builtin_amdgcn_raw_buffer_load_b128(rgn, vc + cb * 4 + h * 16, 0, 0); scr_[h] = __builtin_amdgcn_raw_buffer_load_b128(rsc, vc + cb * 4 + h * 16, 0, 0); }
#pragma unroll
            for (int h = 0; h < (XF32 ? 2 : 1); ++h)
#pragma unroll
            for (int ai = 0; ai < 2; ++ai)
#pragma unroll
                for (int m = 0; m < 4; ++m) {
                    if (XF32) xr[ai][m][XF32 ? h : 0] = __builtin_amdgcn_raw_buffer_load_b128(rin, vb * 2 + cb * 4 + h * 16, (ai * HALF + m * 16) * 4096, 0);
                    else xr[ai][m][0] = __builtin_amdgcn_raw_buffer_load_b128(rin, vb + cb * 2, (ai * HALF + m * 16) * 2048, 0); }
            float gv[8], gm[8];
#pragma unroll
            for (int e = 0; e < 8; ++e) { gv[e] = __uint_as_float(gvr[e >> 2][e & 3]) * gsign; gm[e] = __uint_as_float(gnr[e >> 2][e & 3]) * (__uint_as_float(scr_[e >> 2][e & 3]) + 1.f); }
#pragma unroll
            for (int ai = 0; ai < 2; ++ai)
#pragma unroll
                for (int m = 0; m < 4; ++m) { float xn[8];
#pragma unroll
                    for (int e = 0; e < 4; ++e) { const auto r = __builtin_amdgcn_permlane16_swap(__float_as_uint(acc[ai][bj][m][0][e]), __float_as_uint(acc[ai][bj][m][1][e]), false, false); xn[e] = __uint_as_float(r[0]); xn[4 + e] = __uint_as_float(r[1]); }
#pragma unroll
                    for (int e = 0; e < 8; ++e) { float xv; if (XF32) xv = __uint_as_float(xr[ai][m][XF32 ? (e >> 2) : 0][e & 3]); else { const unsigned w = xr[ai][m][0][e >> 1]; xv = (e & 1) ? h16_hi(w) : h16_lo(w); }
                        xn[e] = xv + gv[e] * xn[e]; }
                    const unsigned eo = (unsigned)((wr * 64 + fr + ai * HALF + m * 16) * 1024 + colw + cb);
                    *(gu4*)(xsb + eo) = (u32x4){pk_h16(xn[0], xn[1]), pk_h16(xn[2], xn[3]), pk_h16(xn[4], xn[5]), pk_h16(xn[6], xn[7])};
                    if (fuse) { ssq[ai][m] += ((xn[0] * xn[0] + xn[1] * xn[1]) + (xn[2] * xn[2] + xn[3] * xn[3])) + ((xn[4] * xn[4] + xn[5] * xn[5]) + (xn[6] * xn[6] + xn[7] * xn[7]));
                        *(gu4*)(hb + eo) = (u32x4){cvt_pk_bf16(xn[0] * gm[0], xn[1] * gm[1]), cvt_pk_bf16(xn[2] * gm[2], xn[3] * gm[3]), cvt_pk_bf16(xn[4] * gm[4], xn[5] * gm[5]), cvt_pk_bf16(xn[6] * gm[6], xn[7] * gm[7])}; } }
            asm volatile("" ::: "memory"); }
        if (fuse) { typedef __attribute__((address_space(1))) float gf; gf* SSp = (gf*)((float*)(ws + mk::WS_SS) + grow0 * 16);
#pragma unroll
            for (int ai = 0; ai < 2; ++ai)
#pragma unroll
                for (int m = 0; m < 4; ++m) { float sv = ssq[ai][m]; sv += __shfl_xor(sv, 16); sv += __shfl_xor(sv, 32); if (fq == 0) SSp[(unsigned)((ai * HALF + wr * 64 + m * 16 + fr) * 16 + u.pn * 4 + wc)] = sv; } }
    }
};
struct EpiFinal {
    static constexpr bool PERM = false, AFTER_DRAIN = false;
    unsigned char* ws; float* out; const float* gfin; PG8_LAS float* tab; int l;
    __device__ __forceinline__ void operator()(const f32x4 (&acc_)[2][2][4][2], const Unit& u, int wr, int wc, int fr, int fq) const {
        f32x4 (&acc)[2][2][4][2] = const_cast<f32x4 (&)[2][2][4][2]>(acc_);
        const int b = u.pm / 17, tp = u.pm % 17;
        const float* modl = (const float*)(ws + mk::WS_MOD) + (size_t)l * 9 * 6144;
        const size_t grow0 = (size_t)u.pm * BM;
        const auto rin = __builtin_amdgcn_make_buffer_rsrc((void*)((bf16_t*)(ws + mk::WS_XS) + grow0 * 1024), 0, 256 * 1024 * 2, 0x00020000);
        const auto rgate = __builtin_amdgcn_make_buffer_rsrc((void*)(modl + b * 6144 + 5120), 0, 4096, 0x00020000);
        const auto rgf = __builtin_amdgcn_make_buffer_rsrc((void*)gfin, 0, 4096, 0x00020000);
        typedef __attribute__((address_space(1))) f32x4 gf4; typedef __attribute__((address_space(1))) float gfl; gfl* ob = (gfl*)uni_ptr(out + ((size_t)b * 4096 + (size_t)(tp - 1) * 256) * 1024);
        const auto rss = __builtin_amdgcn_make_buffer_rsrc((void*)((float*)(ws + mk::WS_SS) + grow0 * 16), 0, 256 * 64, 0x00020000);
        const int colw = u.pn * BM + wc * 32 + 4 * fq;
        const unsigned vb = (unsigned)(((wr * 64 + fr) * 1024 + colw) * 2), vc = (unsigned)(colw * 4);
        float ssq[2][4];
#pragma unroll
        for (int ai = 0; ai < 2; ++ai)
#pragma unroll
            for (int m = 0; m < 4; ++m) ssq[ai][m] = 0.f;
        const unsigned vb8 = (unsigned)(((wr * 64 + fr) * 1024 + u.pn * BM + wc * 32 + (fq & 1) * 16 + (fq >> 1) * 8) * 2);
#pragma unroll
        for (int bj = 0; bj < 2; ++bj) { u32x4 xq[2][4];
#pragma unroll
            for (int ai = 0; ai < 2; ++ai)
#pragma unroll
                for (int m = 0; m < 4; ++m) xq[ai][m] = __builtin_amdgcn_raw_buffer_load_b128(rin, vb8 + bj * HALF * 2, (ai * HALF + m * 16) * 2048, 0);
            f32x4 gv[2];
#pragma unroll
            for (int n = 0; n < 2; ++n) gv[n] = __builtin_bit_cast(f32x4, __builtin_amdgcn_raw_buffer_load_b128(rgate, vc + (bj * HALF + n * 16) * 4, 0, 0));
#pragma unroll
            for (int ai = 0; ai < 2; ++ai)
#pragma unroll
                for (int m = 0; m < 4; ++m) { const auto r0 = __builtin_amdgcn_permlane16_swap(xq[ai][m].x, xq[ai][m].z, false, false), r1 = __builtin_amdgcn_permlane16_swap(xq[ai][m].y, xq[ai][m].w, false, false);
                    const unsigned xw[2][2] = {{r0[0], r1[0]}, {r0[1], r1[1]}};
#pragma unroll
                    for (int n = 0; n < 2; ++n) { const f32x4 xv = {h16_lo(xw[n][0]), h16_hi(xw[n][0]), h16_lo(xw[n][1]), h16_hi(xw[n][1])};
                        const f32x4 xn = xv + gv[n] * acc[ai][bj][m][n]; acc[ai][bj][m][n] = xn; ssq[ai][m] += (xn[0] * xn[0] + xn[1] * xn[1]) + (xn[2] * xn[2] + xn[3] * xn[3]); } } }
#pragma unroll
        for (int ai = 0; ai < 2; ++ai)
#pragma unroll
            for (int m = 0; m < 4; ++m) { float sv = ssq[ai][m]; sv += __shfl_xor(sv, 16); sv += __shfl_xor(sv, 32);
                if (fq == 0) __builtin_amdgcn_raw_buffer_store_b32(__float_as_uint(sv), rss, (unsigned)(((ai * HALF + wr * 64 + m * 16 + fr) * 16 + u.pn * 4 + wc) * 4), 0, 17); }
        asm volatile("s_waitcnt vmcnt(0)" ::: "memory");
        __builtin_amdgcn_s_barrier();
        int tid_ = threadIdx.x; asm volatile("" : "+v"(tid_));
        if (tid_ == 0) { unsigned* c = (unsigned*)(ws + mk::WS_CTL) + mk::CW_SUBBAR + 16 * u.pm;
            (void)__hip_atomic_fetch_add(c, 1u, __ATOMIC_RELAXED, __HIP_MEMORY_SCOPE_AGENT);
            unsigned sp = 0; while (__hip_atomic_load(c, __ATOMIC_RELAXED, __HIP_MEMORY_SCOPE_AGENT) < 4u && ++sp < (1u << 22)) __builtin_amdgcn_s_sleep(1);
            __builtin_amdgcn_fence(__ATOMIC_ACQUIRE, "agent"); asm volatile("s_waitcnt vmcnt(0)" ::: "memory"); }
        __builtin_amdgcn_s_barrier();
        asm volatile("" ::: "memory");
        if (tid_ < 256) { f32x4 t = {0.f, 0.f, 0.f, 0.f};
#pragma unroll
            for (int q = 0; q < 4; ++q) t += __builtin_bit_cast(f32x4, __builtin_amdgcn_raw_buffer_load_b128(rss, (unsigned)(tid_ * 64 + q * 16), 0, 17));
            tab[tid_] = __builtin_amdgcn_rsqf(((t[0] + t[1]) + (t[2] + t[3])) * (1.f / 1024.f) + 1e-6f); }
        asm volatile("s_waitcnt vmcnt(0) lgkmcnt(0)" ::: "memory");
        __builtin_amdgcn_s_barrier();
        asm volatile("" ::: "memory");
        float rs[2][4];
#pragma unroll
        for (int ai = 0; ai < 2; ++ai)
#pragma unroll
            for (int m = 0; m < 4; ++m) rs[ai][m] = tab[ai * HALF + wr * 64 + m * 16 + fr];
#pragma unroll
        for (int bj = 0; bj < 2; ++bj)
#pragma unroll
            for (int n = 0; n < 2; ++n) { const int ci = bj * HALF + n * 16;
                const f32x4 gf = __builtin_bit_cast(f32x4, __builtin_amdgcn_raw_buffer_load_b128(rgf, vc + ci * 4, 0, 0));
#pragma unroll
                for (int ai = 0; ai < 2; ++ai)
#pragma unroll
                    for (int m = 0; m < 4; ++m) { const f32x4 o = acc[ai][bj][m][n] * rs[ai][m] * gf; *(gf4*)(ob + (unsigned)((wr * 64 + fr + ai * HALF + m * 16) * 1024 + colw + ci)) = o; } }
    }
};
struct EpiSlab {
    static constexpr bool PERM = false, AFTER_DRAIN = false;
    float* slab;
    __device__ __forceinline__ void operator()(const f32x4 (&acc)[2][2][4][2], const Unit& u, int wr, int wc, int fr, int fq) const {
#pragma unroll
        for (int ai = 0; ai < 2; ++ai)
#pragma unroll
            for (int m = 0; m < 4; ++m) { float* rp = slab + (size_t)(ai * HALF + wr * 64 + m * 16 + fr) * 256 + wc * 32 + 4 * fq;
#pragma unroll
                for (int bj = 0; bj < 2; ++bj)
#pragma unroll
                    for (int n = 0; n < 2; ++n) *(f32x4*)(rp + bj * HALF + n * 16) = acc[ai][bj][m][n]; }
    }
};
struct OneUnit {
    Unit u;
    __device__ __forceinline__ bool next(int i, Unit& o) const { if (i != 0) return false; o = u; return true; }
    __device__ __forceinline__ void a_ready(const Unit&) const {}
    __device__ __forceinline__ void done(const Unit&) const {}
};
struct LatentOrder {
    StaticOrder base;
    __host__ __device__ void init(int N, int G_, int c_) { base.init(128 * 256, N, G_, c_); }
    __device__ __forceinline__ bool next(int i, Unit& u) const { if (!base.next(i, u)) return false; u.pm = (u.pm >> 4) * 17 + 1 + (u.pm & 15); return true; }
    __device__ __forceinline__ void a_ready(const Unit&) const {}
    __device__ __forceinline__ void done(const Unit&) const {}
};
struct InProjOrder {
    StaticOrder base; int G, c, nlat; unsigned* ctr; unsigned need;
    __device__ __forceinline__ void init(int N, int G_, int c_, unsigned* ctr_, unsigned need_) { base.init(128 * 256, N, G_, c_); G = G_; c = c_; nlat = (base.nwg - c_ + G_ - 1) / G_; if (nlat < 0) nlat = 0; ctr = ctr_; need = need_; }
    __device__ __forceinline__ bool next(int i, Unit& u) const {
        if (base.next(i, u)) { u.pm = (u.pm >> 4) * 17 + 1 + (u.pm & 15); return true; }
        const int cu = ((c + G / 2) % G) + (i - nlat) * G; if (cu >= 8 * base.nN) return false;
        u.pm = (cu / base.nN) * 17; u.pn = cu % base.nN; return true; }
    __device__ __forceinline__ void a_ready(const Unit& u) const {
        if (need && (u.pm % 17) == 0) { unsigned sp = 0; while (__hip_atomic_load(ctr, __ATOMIC_RELAXED, __HIP_MEMORY_SCOPE_AGENT) < need && ++sp < (1u << 22)) __builtin_amdgcn_s_sleep(2); __builtin_amdgcn_fence(__ATOMIC_ACQUIRE, "agent"); } }
    __device__ __forceinline__ void done(const Unit&) const {}
};
}

namespace mk {
constexpr int NWAVES = 8;
constexpr int N_PHASES = 1 + 6 + 6 + 1;
constexpr int RING_OFF = 0, RING_BYTES = 131072, LDSCTL_OFF = RING_BYTES, MISC_OFF = LDSCTL_OFF + 320, LDS_BYTES = 147456;
constexpr int RS_OFF = LDSCTL_OFF + 1024;
static_assert(RS_OFF + 15 * 1024 <= LDS_BYTES, "LDS map");
#define RLX_AGENT __ATOMIC_RELAXED, __HIP_MEMORY_SCOPE_AGENT

struct Args {
  const float* in[25]; float* out; unsigned char* ws; int ph_lo, ph_hi, n_layers, use_cg; int rep[12];
};
enum { I_X = 0, I_C, I_CTX, I_CCTX, I_WADA, I_BADA, I_GN1, I_GN2, I_WIN, I_SINK, I_GQ, I_GK, I_BI, I_BF, I_GML, I_CW, I_CB, I_ALOG, I_DTB, I_DSK, I_GSSM, I_WOUT, I_W1, I_W2, I_GFIN };

template <class F> __device__ __forceinline__ void transpose_item(const float* W, int K, int N, bf16* WT, LAS float* scr, int item, int nblk, int lane, F srccol) {
  const int kb = item / nblk, nb = item % nblk, k0 = 64 * kb, n0 = 32 * nb;
  const int sc = srccol(n0 + (lane & 31));
  float tv[32];
#pragma unroll
  for (int i = 0; i < 32; ++i) { const int kk = 2 * i + (lane >> 5); tv[i] = sc >= 0 ? W[(size_t)(k0 + kk) * N + sc] : 0.f; }
#pragma unroll
  for (int i = 0; i < 32; ++i) { const int kk = 2 * i + (lane >> 5); scr[kk * 33 + (lane & 31)] = tv[i]; }
  asm volatile("s_waitcnt lgkmcnt(0)" ::: "memory");
  const int c = lane & 7;
#pragma unroll
  for (int j = 0; j < 4; ++j) { const int n = (lane >> 3) + 8 * j; const LAS float* s = scr + (8 * c) * 33 + n;
    u32x4 o; o.x = cvtpk(s[0 * 33], s[1 * 33]); o.y = cvtpk(s[2 * 33], s[3 * 33]); o.z = cvtpk(s[4 * 33], s[5 * 33]); o.w = cvtpk(s[6 * 33], s[7 * 33]);
    *(u32x4*)(WT + (size_t)(n0 + n) * K + k0 + 8 * c) = o; }
  asm volatile("s_waitcnt lgkmcnt(0)" ::: "memory");
}
__device__ __forceinline__ int win_srccol(int n) { return n < 2048 ? n : (n < 3072 ? n + 16 : (n < 3088 ? n - 1024 : (n < 3096 ? n : -1))); }

__device__ __forceinline__ void norm_row(const float* xrow, const float* g, const float* shv, const float* scv, bf16* orow, int lane, const float* slab = nullptr, const float* gate = nullptr, float* xout = nullptr) {
  const f32x4* xr = (const f32x4*)xrow + lane; f32x4 v[4]; float s = 0.f;
#pragma unroll
  for (int j = 0; j < 4; ++j) v[j] = xr[64 * j];
  if (slab) {
#pragma unroll
    for (int j = 0; j < 4; ++j) { f32x4 a = {0.f, 0.f, 0.f, 0.f};
#pragma unroll
      for (int ks = 0; ks < 8; ++ks) a += *(const f32x4*)(slab + (size_t)(j * 8 + ks) * 65536 + 4 * lane);
      v[j] += ((const f32x4*)gate)[64 * j + lane] * a; if (xout) ((f32x4*)xout)[64 * j + lane] = v[j]; }
  }
#pragma unroll
  for (int j = 0; j < 4; ++j) s += (v[j].x * v[j].x + v[j].y * v[j].y) + (v[j].z * v[j].z + v[j].w * v[j].w);
  const float rs = rsqrtf(wave_sum(s) * (1.f / DM) + EPS);
  unsigned long long* o8 = (unsigned long long*)orow + lane;
#pragma unroll
  for (int j = 0; j < 4; ++j) { const f32x4 gg = ((const f32x4*)g)[64 * j + lane], sh = ((const f32x4*)shv)[64 * j + lane], sc = ((const f32x4*)scv)[64 * j + lane];
    const f32x4 y = v[j] * rs * gg * (sc + 1.f) + sh;
    o8[64 * j] = (unsigned long long)cvtpk(y.x, y.y) | ((unsigned long long)cvtpk(y.z, y.w) << 32); }
}

__device__ __forceinline__ void norm_row_b(const bf16* xrow, const float* g, const float* shv, const float* scv, bf16* orow, int lane, const float* slab, const float* gate) {
  const u32x2* xr = (const u32x2*)xrow + lane; f32x4 v[4]; float s = 0.f; u32x2 xw[4];
#pragma unroll
  for (int j = 0; j < 4; ++j) xw[j] = xr[64 * j];
#pragma unroll
  for (int j = 0; j < 4; ++j) { f32x4 a = {0.f, 0.f, 0.f, 0.f};
#pragma unroll
    for (int ks = 0; ks < 8; ++ks) a += *(const f32x4*)(slab + (size_t)(j * 8 + ks) * 65536 + 4 * lane);
    v[j] = (f32x4){pg8::h16_lo(xw[j].x), pg8::h16_hi(xw[j].x), pg8::h16_lo(xw[j].y), pg8::h16_hi(xw[j].y)} + ((const f32x4*)gate)[64 * j + lane] * a; }
#pragma unroll
  for (int j = 0; j < 4; ++j) s += (v[j].x * v[j].x + v[j].y * v[j].y) + (v[j].z * v[j].z + v[j].w * v[j].w);
  const float rs = rsqrtf(wave_sum(s) * (1.f / DM) + EPS);
  unsigned long long* o8 = (unsigned long long*)orow + lane;
#pragma unroll
  for (int j = 0; j < 4; ++j) { const f32x4 gg = ((const f32x4*)g)[64 * j + lane], sh = ((const f32x4*)shv)[64 * j + lane], sc = ((const f32x4*)scv)[64 * j + lane];
    const f32x4 y = v[j] * rs * gg * (sc + 1.f) + sh;
    o8[64 * j] = (unsigned long long)cvtpk(y.x, y.y) | ((unsigned long long)cvtpk(y.z, y.w) << 32); }
}

__device__ __forceinline__ void norm_row2(const float* x0, const float* x1, const float* g, const float* shv, const float* scv, bf16* o0, bf16* o1, int lane) {
  const f32x4* xr0 = (const f32x4*)x0 + lane; const f32x4* xr1 = (const f32x4*)x1 + lane; f32x4 v0[4], v1[4]; float s0 = 0.f, s1 = 0.f;
#pragma unroll
  for (int j = 0; j < 4; ++j) { v0[j] = xr0[64 * j]; v1[j] = xr1[64 * j]; }
#pragma unroll
  for (int j = 0; j < 4; ++j) { s0 += (v0[j].x * v0[j].x + v0[j].y * v0[j].y) + (v0[j].z * v0[j].z + v0[j].w * v0[j].w); s1 += (v1[j].x * v1[j].x + v1[j].y * v1[j].y) + (v1[j].z * v1[j].z + v1[j].w * v1[j].w); }
  const float rs0 = rsqrtf(wave_sum(s0) * (1.f / DM) + EPS), rs1 = rsqrtf(wave_sum(s1) * (1.f / DM) + EPS);
  unsigned long long* p0 = (unsigned long long*)o0 + lane; unsigned long long* p1 = (unsigned long long*)o1 + lane;
#pragma unroll
  for (int j = 0; j < 4; ++j) { const f32x4 gg = ((const f32x4*)g)[64 * j + lane], sh = ((const f32x4*)shv)[64 * j + lane], sc = ((const f32x4*)scv)[64 * j + lane]; const f32x4 gm = gg * (sc + 1.f);
    const f32x4 y0 = v0[j] * rs0 * gm + sh, y1 = v1[j] * rs1 * gm + sh;
    p0[64 * j] = (unsigned long long)cvtpk(y0.x, y0.y) | ((unsigned long long)cvtpk(y0.z, y0.w) << 32); p1[64 * j] = (unsigned long long)cvtpk(y1.x, y1.y) | ((unsigned long long)cvtpk(y1.z, y1.w) << 32); }
}

__device__ __forceinline__ void attn_item(int idx, const bf16* P, bf16* Y, const float* sink, char* shm) {
  using attn_body::attn_unit; typedef attn_body::bf16 abf;
  bool isA; int b, hq, qrow, NT, band_row0 = 0, qpos0 = 0, band_s0 = 0;
  if (idx < 1024) { isA = idx >= 512; const int id = idx & 511; b = id >> 6; hq = (id >> 4) & 3; const int q0 = (id & 15) * 256; qrow = NC + q0; NT = 68;
    if (isA) { const int s_lo = q0 - 128 > 0 ? q0 - 128 : 0, s_hi = q0 + 384 < T ? q0 + 384 : T; NT = 4 + (s_hi - s_lo) / 64; band_row0 = NC + s_lo; qpos0 = q0; band_s0 = s_lo; } }
  else { const int id = idx - 1024; isA = id >= 32; b = (id & 31) >> 2; hq = id & 3; qrow = 0; NT = 4; }
  const int g = hq >> 1; const size_t rowb = (size_t)b * RB; const int cq = isA ? 0 : 512, ck = isA ? 256 : 768, cv = isA ? 384 : 896, cy = isA ? 0 : 256;
  const abf* Q0 = (const abf*)(P + (rowb + qrow) * NP + cq + hq * 64); const abf* Kh = (const abf*)(P + rowb * NP + ck + g * 64); const abf* Vh = (const abf*)(P + rowb * NP + cv + g * 64);
  abf* O0 = (abf*)(Y + (rowb + qrow) * DM + cy + hq * 64);
#ifndef MK_NO_B
  if (!isA) attn_unit<8, 0>(Q0, Kh, Vh, O0, NT, 0, 0, 0, 0.f, shm);
#endif
#ifndef MK_NO_A
  if (isA) attn_unit<8, 1>(Q0, Kh, Vh, O0, NT, band_row0, qpos0, band_s0, sink[hq] * L2E, shm);
#endif
}

__global__ void __launch_bounds__(NWAVES * 64, 2) mk_fwd(Args args) {
  extern __shared__ __attribute__((aligned(16))) unsigned char lds_raw[];
  LAS unsigned char* lds = (LAS unsigned char*)lds_raw;
  volatile LAS unsigned* MISC = (volatile LAS unsigned*)(lds + MISC_OFF);
  const int tid0 = threadIdx.x, wave = __builtin_amdgcn_readfirstlane(tid0 >> 6);
  for (int u = tid0; u < (LDS_BYTES - LDSCTL_OFF) / 4; u += NWAVES * 64) ((LAS unsigned*)(lds + LDSCTL_OFF))[u] = 0u;
  __syncthreads();
  if (tid0 < 25) ((volatile LAS unsigned long long*)(lds + MISC_OFF + 256))[tid0] = (unsigned long long)(uintptr_t)args.in[tid0];
  __syncthreads();
  XcdBarrier bar = xcd_barrier_post(((unsigned*)(args.ws + WS_CTL)) + CW_BAR, MISC + 8);
#ifndef MK_PHSEL
#define MK_PHSEL 0xFFFF
#endif
#ifndef MK_FIRST_SEAM_CG
#define MK_FIRST_SEAM_CG 1
#endif
#ifndef MK_PROBE_NOCHAIN
#define MK_PROBE_NOCHAIN 0
#endif
#ifndef MK_STAG6
#define MK_STAG6 0
#endif
#ifndef MK_STAG9
#define MK_STAG9 0
#endif
#define MK_STAGGER(n) do { if ((n) > 0 && ((bx >> 3) & 1)) { const unsigned long long t0_ = __builtin_amdgcn_s_memrealtime(); while (__builtin_amdgcn_s_memrealtime() - t0_ < (unsigned long long)(n)) __builtin_amdgcn_s_sleep(32); } } while (0)
#ifndef MK_PROBE_PM
#define MK_PROBE_PM 15
#endif
#ifndef MK_PROBE_NOATTN
#define MK_PROBE_NOATTN 0
#endif
#ifndef MK_PROBE_NOMAMBA
#define MK_PROBE_NOMAMBA 0
#endif
#ifndef MK_PROBE_NOMLSTM
#define MK_PROBE_NOMLSTM 0
#endif
#define AIN(k) ((const float*)(GAS const float*)(uintptr_t)(((unsigned long long)(unsigned)__builtin_amdgcn_readfirstlane((int)MISC[64 + 2 * (k) + 1]) << 32) | (unsigned long long)(unsigned)__builtin_amdgcn_readfirstlane((int)MISC[64 + 2 * (k)])))
#define PH_PROLOG int tid = threadIdx.x; asm volatile("" : "+v"(tid)); const int lane = tid & 63; (void)lane; int bx_ = blockIdx.x, G_ = gridDim.x; if (kind != 0) asm volatile("" : "+s"(bx_), "+s"(G_)); const int bx = bx_, G = G_, vcu = (G % 8 == 0) ? (bx % 8) * (G / 8) + bx / 8 : bx, gw = vcu * NWAVES + wave, NGW = G * NWAVES; (void)gw; (void)NGW; (void)vcu; GAS unsigned char* wsg_ = (GAS unsigned char*)args.ws; asm volatile("" : "+s"(wsg_)); unsigned char* wsp = (unsigned char*)wsg_;

  const int nph = N_PHASES;
#pragma unroll 1
  for (int ph = args.ph_lo; ph < args.ph_hi; ++ph) {
  int kind, l = 0;
  if (ph == 0) kind = 0; else if (ph == nph - 1) kind = 10; else { l = ph >= 7; const int q = l ? ph - 6 : ph; kind = q < 4 ? q + 1 : (q == 4 ? 6 : q + 3); }
  const int nrep = args.rep[kind];
  if (kind == 0) { PH_PROLOG if ((MK_PHSEL >> 0) & 1) for (int rp = 0; rp < nrep; ++rp) {
    {
      for (int cbk = vcu; cbk < 192; cbk += G) {
        LAS float* sc = (LAS float*)(lds + RING_OFF);
        LAS float* red = (LAS float*)(lds + RING_OFF + 36864);
        for (int i = tid; i < 9 * DM; i += NWAVES * 64) { const int j = i / DM, k = i % DM; const float v = j < 8 ? AIN(I_C)[j * DM + k] : AIN(I_CCTX)[k]; sc[i] = v / (1.f + __expf(-v)); }
        __syncthreads();
        const int col = cbk * 64 + lane, l = col / 6144, n = col % 6144; const float* w = AIN(I_WADA) + (size_t)l * DM * 6144 + n + (size_t)(wave * 128) * 6144;
        float acc[9];
#pragma unroll
        for (int j = 0; j < 9; ++j) acc[j] = 0.f;
#pragma unroll 1
        for (int k0 = 0; k0 < 128; k0 += 16) { float wv[16];
#pragma unroll
          for (int u = 0; u < 16; ++u) wv[u] = w[(size_t)(k0 + u) * 6144];
#pragma unroll
          for (int u = 0; u < 16; ++u)
#pragma unroll
            for (int j = 0; j < 9; ++j) acc[j] += sc[j * DM + wave * 128 + k0 + u] * wv[u]; }
#pragma unroll
        for (int j = 0; j < 9; ++j) red[(wave * 9 + j) * 64 + lane] = acc[j];
        __syncthreads();
        if (wave == 0) { const float bb = AIN(I_BADA)[l * 6144 + n];
#pragma unroll
          for (int j = 0; j < 9; ++j) { float sum = bb;
#pragma unroll
            for (int wv_ = 0; wv_ < 8; ++wv_) sum += red[(wv_ * 9 + j) * 64 + lane];
            ((float*)(wsp + WS_MOD))[(size_t)(l * 9 + j) * 6144 + n] = sum; } }
        __syncthreads();
        if (tid == 0) { __builtin_amdgcn_fence(__ATOMIC_RELEASE, "agent"); (void)__hip_atomic_fetch_add(((unsigned*)(wsp + WS_CTL)) + CW_SUBBAR + 20480, 1u, RLX_AGENT); }
      }
      for (int i = gw * 64 + lane; i < T * 32; i += NGW * 64) { const int t = i >> 5, e = i & 31, fi = e & 15; const float invf = __builtin_amdgcn_exp2f(-(float)fi * (13.287712379549449f / 16.f));
        const float ang = (float)(e < 16 ? (t >> 6) : (t & 63)) * invf; ((float*)(wsp + WS_CS))[i] = __cosf(ang); ((float*)(wsp + WS_CS))[T * 32 + i] = __sinf(ang); }
      LAS float* scr = (LAS float*)(lds + RING_OFF + 57344 + wave * 8704);
      constexpr int I_IN = 16 * 104, I_OUT = 16 * 32, I_1 = 16 * 128, I_2 = 64 * 32, I_L = I_IN + I_OUT + I_1 + I_2;
      for (int it = gw; it < 2 * I_L; it += NGW) {
        const int l = it / I_L; int r = it % I_L; unsigned char* wl = (wsp) + WS_W + (size_t)l * W_LAYER;
        if (r < I_IN) { transpose_item(AIN(I_WIN) + (size_t)l * DM * NINO, DM, NINO, (bf16*)(wl + WO_IN), scr, r, 104, lane, [](int n) { return win_srccol(pg8::lcol(n)); }); continue; } r -= I_IN;
        if (r < I_OUT) { transpose_item(AIN(I_WOUT) + (size_t)l * DM * DM, DM, DM, (bf16*)(wl + WO_OUT), scr, r, 32, lane, [](int n) { return n; }); continue; } r -= I_OUT;
        if (r < I_1) { transpose_item(AIN(I_W1) + (size_t)l * DM * DFF, DM, DFF, (bf16*)(wl + WO_1), scr, r, 128, lane, [](int n) { return pg8::lcol(n); }); continue; } r -= I_1;
        transpose_item(AIN(I_W2) + (size_t)l * DFF * DM, DFF, DM, (bf16*)(wl + WO_2), scr, r, 32, lane, [](int n) { return n; });
      }
      __syncthreads();
      if (tid == 0) { __builtin_amdgcn_fence(__ATOMIC_RELEASE, "agent"); (void)__hip_atomic_fetch_add(((unsigned*)(wsp + WS_CTL)) + CW_SUBBAR + 20544, 1u, RLX_AGENT); }
    }
  } }

  {
    if (kind == 1 || kind == 0 || (kind == 2 && l == 1)) { PH_PROLOG if ((MK_PHSEL >> 1) & 1) for (int rp = 0; rp < 1; ++rp) {
      if (kind == 0) {
        if (tid == 0) { unsigned sp = 0; while (__hip_atomic_load(((unsigned*)(wsp + WS_CTL)) + CW_SUBBAR + 20480, RLX_AGENT) < 192u && ++sp < (1u << 22)) __builtin_amdgcn_s_sleep(2); __builtin_amdgcn_fence(__ATOMIC_ACQUIRE, "agent"); }
        __syncthreads(); }
      if (l == 0) {
        for (int m = 2 * gw; m < M; m += 2 * NGW) { const int b = m / RB, r = m % RB; const bool isc = r < NC;
          const float* xr = isc ? AIN(I_CTX) + ctx_off(b, r) : AIN(I_X) + lat_off(b, r - NC); const float* mr = ((float*)(wsp + WS_MOD)) + (isc ? 8 : b) * 6144;
          bf16* hp = ((bf16*)(wsp + WS_H)) + (size_t)m * DM; norm_row2(xr, xr + DM, AIN(I_GN1), mr, mr + 1024, hp, hp + DM, lane); }
        if (tid == 0) { unsigned sp = 0; while (__hip_atomic_load(((unsigned*)(wsp + WS_CTL)) + CW_SUBBAR + 20544, RLX_AGENT) < (unsigned)G && ++sp < (1u << 22)) __builtin_amdgcn_s_sleep(2); __builtin_amdgcn_fence(__ATOMIC_ACQUIRE, "agent"); }
        __syncthreads();
        { LAS float* shl = (LAS float*)(lds + RING_OFF); const float* mo = (const float*)(wsp + WS_MOD);
          for (int i = tid; i < 3 * 9 * DM; i += NWAVES * 64) { const int set = i / (9 * DM), j = (i / DM) % 9, k = i % DM; shl[i] = mo[(size_t)((set == 1 ? 0 : 1) * 9 + j) * 6144 + (set == 0 ? 0 : 3072) + k]; }
          __syncthreads();
          for (int c = gw; c < 3328 + 4096 + 4096; c += NGW) { const int set = c < 3328 ? 0 : (c < 7424 ? 1 : 2), n = c - (set == 0 ? 0 : (set == 1 ? 3328 : 7424));
            const bf16* wrow = (const bf16*)(wsp + WS_W + (size_t)(set == 1 ? 0 : 1) * W_LAYER + (set == 0 ? WO_IN : WO_1)) + (size_t)n * DM;
            float wf[16];
#pragma unroll
            for (int q = 0; q < 4; ++q) { const u32x2 w2 = *(const u32x2*)(wrow + 256 * q + 4 * lane); wf[4 * q] = bf_lo(w2.x); wf[4 * q + 1] = bf_hi(w2.x); wf[4 * q + 2] = bf_lo(w2.y); wf[4 * q + 3] = bf_hi(w2.y); }
            float outv = 0.f;
#pragma unroll
            for (int j = 0; j < 9; ++j) { const LAS float* sp = shl + (set * 9 + j) * DM + 4 * lane; float a = 0.f;
#pragma unroll
              for (int q = 0; q < 4; ++q) { const f32x4 sv = *(const LAS f32x4*)(sp + 256 * q); a += (sv[0] * wf[4 * q] + sv[1] * wf[4 * q + 1]) + (sv[2] * wf[4 * q + 2] + sv[3] * wf[4 * q + 3]); }
              a = wave_sum(a); if (lane == j) outv = a; }
            if (lane < 9) ((float*)(wsp + WS_BIAS))[(size_t)(set * 9 + lane) * 4096 + n] = outv; }
          __syncthreads(); }
      } else {
        for (int i = gw; i < NB * NC; i += NGW) { const int b = i / NC, r = i % NC; const size_t m = (size_t)b * RB + r;
          const bf16* xr = (const bf16*)(wsp + WS_XS) + m * DM; const float* mr = ((float*)(wsp + WS_MOD)) + (size_t)(9 + 8) * 6144; bf16* hp = ((bf16*)(wsp + WS_H)) + m * DM;
          const float* sl = ((const float*)(args.out)) + (size_t)(b * 32) * 65536 + (size_t)r * 256; const float* gt = ((const float*)(wsp + WS_MOD)) + 8 * 6144 + 5120;
          norm_row_b(xr, AIN(I_GN1) + DM, mr, mr + 1024, hp, lane, sl, gt); }
        if (kind == 2) {
          __syncthreads();
          if (tid == 0) { __builtin_amdgcn_fence(__ATOMIC_RELEASE, "agent"); (void)__hip_atomic_fetch_add(((unsigned*)(wsp + WS_CTL)) + CW_SUBBAR + 20608, 1u, RLX_AGENT); } }
      }
    } }
    if (kind == 2) { PH_PROLOG if ((MK_PHSEL >> 2) & 1) for (int rp = 0; rp < nrep; ++rp) {
      { pg8::Gemm g{((bf16*)(wsp + WS_H)), (const bf16*)((wsp + WS_W + (size_t)l * W_LAYER) + WO_IN), M, NP, DM, DM};
        pg8::InProjOrder S; S.init(NP, G, bx, ((unsigned*)(wsp + WS_CTL)) + CW_SUBBAR + 20608, (l == 1) ? (unsigned)G : 0u);
        pg8::EpiInProj E{((bf16*)(wsp + WS_P)), ((float*)(wsp + WS_G)), pg8::FusedNorm{(const float*)(wsp + WS_SS), (const float*)(wsp + WS_BIAS), l == 1, 0, (const LAS float*)(lds + RS_OFF), 0}};
        if (l == 1) E.F.fill(S, (LAS float*)(lds + RS_OFF), tid);
        pg8::gemm_phase<pg8::EpiInProj, pg8::InProjOrder, true, true>(lds + RING_OFF, g, S, E); }
    } }
    if (kind == 3) { PH_PROLOG if ((MK_PHSEL >> 3) & 1) for (int rp = 0; rp < nrep; ++rp) {
      { const float* gq = AIN(I_GQ) + l * 64; const float* gk = AIN(I_GK) + l * 64; const float* cw = AIN(I_CW) + l * 3 * 768; const float* cb = AIN(I_CB) + l * 768;
        bf16* Pq = ((bf16*)(wsp + WS_P)); bf16* UCb = ((bf16*)(args.out)); float* Gp = ((float*)(wsp + WS_G)); const float* cst = ((const float*)(wsp + WS_CS));
        const int hw = 2 * gw + (lane >> 5), l32 = lane & 31, which = hw % 3, j = l32 & 7, slot = 4 * which + (l32 >> 3);
        const int blk = slot < 6 ? slot : slot + 2;
        const bool isq = slot < 4 || (slot >= 6 && slot < 10), isB = slot >= 6;
        const float* gv = isq ? gq : gk; float gn[8];
#pragma unroll
        for (int e = 0; e < 8; ++e) gn[e] = gv[8 * j + e];
        const int cch = 256 * which + 8 * l32, pcol = (which == 0 ? 2048 : (which == 1 ? 2560 : 2816)) + 8 * l32;
#define PREPA_LOAD(m_, S) do { const int r_ = (m_) % RB; w##S = *(const u32x4*)(Pq + (size_t)(m_) * NP + blk * 64 + 8 * j); \
          { const float* cp_ = cst + (r_ >= NC ? r_ - NC : 0) * 32 + (j >> 2) * 16 + (j & 1) * 8; c0##S = *(const f32x4*)cp_; c1##S = *(const f32x4*)(cp_ + 4); s0##S = *(const f32x4*)(cp_ + T * 32); s1##S = *(const f32x4*)(cp_ + T * 32 + 4); } } while (0)
#define PREPA_DO(m_, S) do { const int r_ = (m_) % RB; bf16* p_ = Pq + (size_t)(m_) * NP + blk * 64 + 8 * j; float x[8] = {bf_lo(w##S.x), bf_hi(w##S.x), bf_lo(w##S.y), bf_hi(w##S.y), bf_lo(w##S.z), bf_hi(w##S.z), bf_lo(w##S.w), bf_hi(w##S.w)}; \
            if (isB) { float ss = 0.f; _Pragma("unroll") for (int e = 0; e < 8; ++e) ss += x[e] * x[e]; \
              ss += __shfl_xor(ss, 1); ss += __shfl_xor(ss, 2); ss += __shfl_xor(ss, 4); const float rs = rsqrtf(ss * (1.f / 64.f) + EPS); _Pragma("unroll") for (int e = 0; e < 8; ++e) x[e] = x[e] * rs * gn[e]; } \
            if (r_ >= NC) { const float cc[8] = {c0##S[0], c0##S[1], c0##S[2], c0##S[3], c1##S[0], c1##S[1], c1##S[2], c1##S[3]}, sn[8] = {s0##S[0], s0##S[1], s0##S[2], s0##S[3], s1##S[0], s1##S[1], s1##S[2], s1##S[3]}; \
              _Pragma("unroll") for (int e = 0; e < 8; ++e) { const float other = __shfl_xor(x[e], 2); x[e] = (j & 2) ? x[e] * cc[e] + other * sn[e] : x[e] * cc[e] - other * sn[e]; } } \
            if (isq) { _Pragma("unroll") for (int e = 0; e < 8; ++e) x[e] *= QC2; } \
            if (rp == 0) *(u32x4*)p_ = (u32x4){cvtpk(x[0], x[1]), cvtpk(x[2], x[3]), cvtpk(x[4], x[5]), cvtpk(x[6], x[7])}; } while (0)
#define PREPB_LOAD(m_, S) do { const int r_ = (m_) % RB; const int seg0_ = r_ < NC ? 0 : NC, seglen_ = r_ < NC ? NC : T, sl_ = r_ - seg0_; const bf16* px_ = Pq + (size_t)(m_) * NP + pcol; const u32x4 z4_ = {0u, 0u, 0u, 0u}; \
          xm##S = sl_ > 0 ? *(const u32x4*)(px_ - NP) : z4_; x0##S = *(const u32x4*)px_; xp##S = sl_ + 1 < seglen_ ? *(const u32x4*)(px_ + NP) : z4_; } while (0)
#define PREPB_DO(m_, S) do { float u[8]; _Pragma("unroll") for (int e = 0; e < 4; ++e) { const int q = e >> 1, o = (e & 1) * 2; \
              const float y0 = bb[q][o] + w0[q][o] * bf_lo(xm##S[e]) + w1[q][o] * bf_lo(x0##S[e]) + w2[q][o] * bf_lo(xp##S[e]); \
              const float y1 = bb[q][o + 1] + w0[q][o + 1] * bf_hi(xm##S[e]) + w1[q][o + 1] * bf_hi(x0##S[e]) + w2[q][o + 1] * bf_hi(xp##S[e]); \
              u[2 * e] = y0 / (1.f + __expf(-y0)); u[2 * e + 1] = y1 / (1.f + __expf(-y1)); } \
            *(u32x4*)(UCb + (size_t)(m_) * 768 + cch) = (u32x4){cvtpk(u[0], u[1]), cvtpk(u[2], u[3]), cvtpk(u[4], u[5]), cvtpk(u[6], u[7])}; } while (0)
        if (hw < 4095) {
          { u32x4 wA, wB, wC, wD; f32x4 c0A, c1A, s0A, s1A, c0B, c1B, s0B, s1B, c0C, c1C, s0C, s1C, c0D, c1D, s0D, s1D;
            const int S1 = 1365, mlast = hw / 3 + ((M - 1 - hw / 3) / S1) * S1;
#define CL(x_) ((x_) <= mlast ? (x_) : mlast)
            int m = hw / 3; PREPA_LOAD(m, A); PREPA_LOAD(CL(m + S1), B); PREPA_LOAD(CL(m + 2 * S1), C);
            for (; m <= mlast; m += 4 * S1) {
              PREPA_LOAD(CL(m + 3 * S1), D); PREPA_DO(m, A);
              PREPA_LOAD(CL(m + 4 * S1), A); if (m + S1 <= mlast) PREPA_DO(m + S1, B);
              PREPA_LOAD(CL(m + 5 * S1), B); if (m + 2 * S1 <= mlast) PREPA_DO(m + 2 * S1, C);
              PREPA_LOAD(CL(m + 6 * S1), C); if (m + 3 * S1 <= mlast) PREPA_DO(m + 3 * S1, D); } }
          int cch_ = cch; asm volatile("" : "+v"(cch_));
        f32x4 w0[2], w1[2], w2[2], bb[2];
#pragma unroll
        for (int q = 0; q < 2; ++q) { w0[q] = *(const f32x4*)(cw + cch_ + 4 * q); w1[q] = *(const f32x4*)(cw + 768 + cch_ + 4 * q); w2[q] = *(const f32x4*)(cw + 1536 + cch_ + 4 * q); bb[q] = *(const f32x4*)(cb + cch_ + 4 * q); }
          { u32x4 xmA, x0A, xpA, xmB, x0B, xpB, xmC, x0C, xpC, xmD, x0D, xpD; const int S1 = 1365, mlast = hw / 3 + ((M - 1 - hw / 3) / S1) * S1;
            int m = hw / 3; PREPB_LOAD(m, A); PREPB_LOAD(CL(m + S1), B); PREPB_LOAD(CL(m + 2 * S1), C);
            for (; m <= mlast; m += 4 * S1) {
              PREPB_LOAD(CL(m + 3 * S1), D); PREPB_DO(m, A);
              PREPB_LOAD(CL(m + 4 * S1), A); if (m + S1 <= mlast) PREPB_DO(m + S1, B);
              PREPB_LOAD(CL(m + 5 * S1), B); if (m + 2 * S1 <= mlast) PREPB_DO(m + 2 * S1, C);
              PREPB_LOAD(CL(m + 6 * S1), C); if (m + 3 * S1 <= mlast) PREPB_DO(m + 3 * S1, D); } }
#undef CL
        }
#undef PREPA_LOAD
#undef PREPA_DO
#undef PREPB_LOAD
#undef PREPB_DO
        for (int t = NGW - 1 - gw; t < NB * 34 * 8; t += NGW) scan::chunk_scalars((const float*)(wsp + WS_G), (float*)(wsp + WS_G2), AIN(I_ALOG) + l * 8, AIN(I_DTB) + l * 8, AIN(I_BI) + l * 8, AIN(I_BF) + l * 8, t / 272, (t >> 3) % 34, t & 7, lane); }
    } }
    if (kind == 4) { PH_PROLOG if ((MK_PHSEL >> 4) & 1) for (int rp = 0; rp < nrep; ++rp) {
      {
#ifndef MK_NO_MAMBA
        for (int cid = bx; cid < 128; cid += G) {
        if (cid < 64 && (rp == 0 || !(MK_PROBE_NOCHAIN || MK_PROBE_NOMAMBA))) scan::mamba_chain((LAS char*)lds, ((bf16*)(args.out)), ((float*)(wsp + WS_G2)), ((bf16*)(wsp + WS_YD)), cid >> 3, (cid >> 1) & 3, cid & 1, rp == 0 ? 15 : MK_PROBE_PM);
#endif
#ifndef MK_NO_MLSTM
        if (cid >= 64 && (rp == 0 || !(MK_PROBE_NOCHAIN || MK_PROBE_NOMLSTM))) { const int c = cid - 64; scan::mlstm_chain((LAS char*)lds, ((bf16*)(wsp + WS_P)), ((float*)(wsp + WS_G2)), ((bf16*)(wsp + WS_HC)), c >> 3, (c >> 1) & 3, c & 1); }
#endif#endif
        if (tid == 0) { __builtin_amdgcn_fence(__ATOMIC_RELEASE, "agent"); (void)__hip_atomic_fetch_add(((unsigned*)(wsp + WS_CTL)) + CW_SUBBAR + 12288 + 64 * ((l * 4 + rp) * 8 + ((cid & 63) >> 3)), 1u, RLX_AGENT); }
        }
        const int nper = (l == 1) ? 128 : 136;
        if (rp == 0 || !MK_PROBE_NOATTN) { const int x0 = (int)(xb_xcc_id() & 7u);
          for (int dq = 0; dq < 8; ++dq) { const int qb_ = (x0 + dq) & 7;
            for (;;) {
              if (tid == 0) MISC[16] = __hip_atomic_fetch_add(((unsigned*)(wsp + WS_CTL)) + CW_QUEUE + 64 * ((l * 4 + rp) * 8 + qb_), 1u, RLX_AGENT);
              __syncthreads(); const int ix = __builtin_amdgcn_readfirstlane((int)MISC[16]); __syncthreads();
              if (ix >= nper) break;
              const int idx = ix < 64 ? qb_ * 64 + ix : (ix < 128 ? 512 + qb_ * 64 + (ix - 64) : (ix < 132 ? 1024 + qb_ * 4 + (ix - 128) : 1056 + qb_ * 4 + (ix - 132)));
              attn_item(idx, ((bf16*)(wsp + WS_P)), ((bf16*)(wsp + WS_Y)), AIN(I_SINK) + l * 4, (char*)lds_raw + RING_OFF);
            } } }
        if (rp == 0) { const float* gml = AIN(I_GML) + l * 256; const float* gss = AIN(I_GSSM) + l * 256; const float* dsk = AIN(I_DSK) + l * 4;
          const bf16* HCb = (const bf16*)(wsp + WS_HC); const bf16* YDb = (const bf16*)(wsp + WS_YD); const bf16* Pf = (const bf16*)(wsp + WS_P); const bf16* UCf = (const bf16*)(args.out); bf16* Yf = (bf16*)(wsp + WS_Y);
          const int l32 = lane & 31, c0 = 8 * l32; const f32x4 gmA = *(const f32x4*)(gml + c0), gmB = *(const f32x4*)(gml + c0 + 4), gsA = *(const f32x4*)(gss + c0), gsB = *(const f32x4*)(gss + c0 + 4); const float dk = dsk[l32 >> 3];
          const float gmv[8] = {gmA[0], gmA[1], gmA[2], gmA[3], gmB[0], gmB[1], gmB[2], gmB[3]}, gsv[8] = {gsA[0], gsA[1], gsA[2], gsA[3], gsB[0], gsB[1], gsB[2], gsB[3]};
#define FIN_LOAD(m_, S) do { hA##S = *(const u32x4*)(HCb + (size_t)(m_) * 256 + c0); hB##S = *(const u32x4*)(HCb + ((size_t)M + (m_)) * 256 + c0); ow##S = *(const u32x4*)(Pf + (size_t)(m_) * NP + 1792 + c0); \
          yA##S = *(const u32x4*)(YDb + (size_t)(m_) * 256 + c0); yB##S = *(const u32x4*)(YDb + ((size_t)M + (m_)) * 256 + c0); xw##S = *(const u32x4*)(UCf + (size_t)(m_) * 768 + c0); zw##S = *(const u32x4*)(Pf + (size_t)(m_) * NP + 2304 + c0); } while (0)
#define FIN_DO(m_, S) do { \
          { float hs[8]; float ss = 0.f; \
            _Pragma("unroll") for (int e = 0; e < 4; ++e) { hs[2 * e] = bf_lo(hA##S[e]) + bf_lo(hB##S[e]); hs[2 * e + 1] = bf_hi(hA##S[e]) + bf_hi(hB##S[e]); ss += hs[2 * e] * hs[2 * e] + hs[2 * e + 1] * hs[2 * e + 1]; } \
            ss += __shfl_xor(ss, 1); ss += __shfl_xor(ss, 2); ss += __shfl_xor(ss, 4); const float rs = rsqrtf(ss * (1.f / 64.f) + EPS); float y[8]; \
            _Pragma("unroll") for (int e = 0; e < 4; ++e) { const float o0 = bf_lo(ow##S[e]), o1 = bf_hi(ow##S[e]); y[2 * e] = hs[2 * e] * rs * gmv[2 * e] / (1.f + __expf(-o0)); y[2 * e + 1] = hs[2 * e + 1] * rs * gmv[2 * e + 1] / (1.f + __expf(-o1)); } \
            *(u32x4*)(Yf + (size_t)(m_) * DM + 512 + c0) = (u32x4){cvtpk(y[0], y[1]), cvtpk(y[2], y[3]), cvtpk(y[4], y[5]), cvtpk(y[6], y[7])}; } \
          { float v[8]; float ss = 0.f; \
            _Pragma("unroll") for (int e = 0; e < 4; ++e) { const float z0 = bf_lo(zw##S[e]), z1 = bf_hi(zw##S[e]); \
              v[2 * e] = (bf_lo(yA##S[e]) + bf_lo(yB##S[e]) + dk * bf_lo(xw##S[e])) * (z0 / (1.f + __expf(-z0))); v[2 * e + 1] = (bf_hi(yA##S[e]) + bf_hi(yB##S[e]) + dk * bf_hi(xw##S[e])) * (z1 / (1.f + __expf(-z1))); ss += v[2 * e] * v[2 * e] + v[2 * e + 1] * v[2 * e + 1]; } \
            ss += __shfl_xor(ss, 1); ss += __shfl_xor(ss, 2); ss += __shfl_xor(ss, 4); ss += __shfl_xor(ss, 8); ss += __shfl_xor(ss, 16); const float rs = rsqrtf(ss * (1.f / 256.f) + EPS); \
            *(u32x4*)(Yf + (size_t)(m_) * DM + 768 + c0) = (u32x4){cvtpk(v[0] * rs * gsv[0], v[1] * rs * gsv[1]), cvtpk(v[2] * rs * gsv[2], v[3] * rs * gsv[3]), cvtpk(v[4] * rs * gsv[4], v[5] * rs * gsv[5]), cvtpk(v[6] * rs * gsv[6], v[7] * rs * gsv[7])}; } } while (0)
          unsigned* fq = ((unsigned*)(wsp + WS_CTL)) + CW_SUBBAR + 16384 + 64 * (l * 4 + rp); unsigned* cdone = ((unsigned*)(wsp + WS_CTL)) + CW_SUBBAR + 12288 + 64 * ((l * 4 + rp) * 8);
          for (;;) {
            if (tid == 0) { const unsigned ix = __hip_atomic_fetch_add(fq, 1u, RLX_AGENT);
              if (ix < 8u * 68u) { unsigned sp = 0; while (__hip_atomic_load(cdone + 64 * (ix / 68u), RLX_AGENT) < 16u && ++sp < (1u << 22)) __builtin_amdgcn_s_sleep(2); __builtin_amdgcn_fence(__ATOMIC_ACQUIRE, "agent"); }
              MISC[16] = ix; }
            __syncthreads(); const int ix = __builtin_amdgcn_readfirstlane((int)MISC[16]); __syncthreads();
            if (ix >= 8 * 68) break;
            const int m0 = (ix / 68) * RB + (ix % 68) * 64 + 2 * wave + (lane >> 5);
            u32x4 hAA, hBA, owA, yAA, yBA, xwA, zwA, hAB, hBB, owB, yAB, yBB, xwB, zwB, hAC, hBC, owC, yAC, yBC, xwC, zwC, hAD, hBD, owD, yAD, yBD, xwD, zwD;
            FIN_LOAD(m0, A); FIN_LOAD(m0 + 16, B); FIN_LOAD(m0 + 32, C); FIN_LOAD(m0 + 48, D);
            FIN_DO(m0, A); FIN_DO(m0 + 16, B); FIN_DO(m0 + 32, C); FIN_DO(m0 + 48, D); }
#undef FIN_LOAD
#undef FIN_DO
        } }
    } }
    if (kind == 6) { PH_PROLOG if ((MK_PHSEL >> 6) & 1) for (int rp = 0; rp < nrep; ++rp) {
      { MK_STAGGER(MK_STAG6);
        pg8::Gemm g{((bf16*)(wsp + WS_Y)), (const bf16*)((wsp + WS_W + (size_t)l * W_LAYER) + WO_OUT), M, DM, DM, DM};
        const int eflags = 2 | ((rp & 1) << 2);
        if (l == 0) { pg8::EpiResid<true> E{wsp, AIN(I_X), AIN(I_CTX), AIN(I_GN2) + l * DM, l, eflags}; pg8::LatentOrder S; S.init(DM, G, bx); pg8::gemm_phase<pg8::EpiResid<true>, pg8::LatentOrder, true, true>(lds + RING_OFF, g, S, E); }
        else { pg8::EpiResid<false> E{wsp, AIN(I_X), AIN(I_CTX), AIN(I_GN2) + l * DM, l, eflags}; pg8::LatentOrder S; S.init(DM, G, bx); pg8::gemm_phase<pg8::EpiResid<false>, pg8::LatentOrder, true, true>(lds + RING_OFF, g, S, E); } }
    } }
    if (kind == 8) { PH_PROLOG if ((MK_PHSEL >> 8) & 1) for (int rp = 0; rp < nrep; ++rp) {
      { pg8::Gemm g{((bf16*)(wsp + WS_H)), (const bf16*)((wsp + WS_W + (size_t)l * W_LAYER) + WO_1), M, DFF, DM, DM}; pg8::EpiRelu2 E{((bf16*)(wsp + WS_U)), pg8::FusedNorm{(const float*)(wsp + WS_SS), (const float*)(wsp + WS_BIAS) + (size_t)(1 + l) * 9 * 4096, 1, 1, (const LAS float*)(lds + RS_OFF), 0}};
        if (!(l == 1)) {
          unsigned* octr = ((unsigned*)(wsp + WS_CTL)) + CW_SUBBAR + 8192 + 64 * rp;
          for (int ou = bx; ou < 32; ou += G) { pg8::Gemm go{((bf16*)(wsp + WS_Y)), (const bf16*)((wsp + WS_W) + WO_OUT), M, DM, DM, DM}; pg8::EpiResid<true> Eo{wsp, AIN(I_X), AIN(I_CTX), AIN(I_GN2), 0, 2};
            pg8::OneUnit So{{(ou >> 2) * 17, ou & 3}}; pg8::gemm_phase<pg8::EpiResid<true>, pg8::OneUnit, true, true>(lds + RING_OFF, go, So, Eo);
            asm volatile("s_waitcnt vmcnt(0)" ::: "memory"); __syncthreads();
            if (tid == 0) { __builtin_amdgcn_fence(__ATOMIC_RELEASE, "agent"); (void)__hip_atomic_fetch_add(octr, 1u, RLX_AGENT); }
            __syncthreads(); }
          { pg8::LatentOrder S; S.init(DFF, G, bx); E.F.fill(S, (LAS float*)(lds + RS_OFF), tid); pg8::gemm_phase<pg8::EpiRelu2, pg8::LatentOrder, true, true>(lds + RING_OFF, g, S, E); }
          for (int cu = (bx + G / 2) % G; cu < 128; cu += G) {
            if (tid == 0) { unsigned sp = 0; while (__hip_atomic_load(octr, RLX_AGENT) < 32u && ++sp < (1u << 22)) __builtin_amdgcn_s_sleep(2); __builtin_amdgcn_fence(__ATOMIC_ACQUIRE, "agent"); asm volatile("s_waitcnt vmcnt(0)" ::: "memory"); }
            __syncthreads();
            pg8::EpiRelu2 Ec{((bf16*)(wsp + WS_U)), pg8::FusedNorm{(const float*)(wsp + WS_SS), (const float*)(wsp + WS_BIAS) + (size_t)(1 + l) * 9 * 4096, 1, 1, (const LAS float*)(lds + RS_OFF), 0}};
            pg8::OneUnit Sc{{(cu >> 4) * 17, cu & 15}}; Ec.F.fill(Sc, (LAS float*)(lds + RS_OFF), tid); pg8::gemm_phase<pg8::EpiRelu2, pg8::OneUnit, true, true>(lds + RING_OFF, g, Sc, Ec); } }
        else { pg8::LatentOrder S; S.init(DFF, G, bx); E.F.fill(S, (LAS float*)(lds + RS_OFF), tid); pg8::gemm_phase<pg8::EpiRelu2, pg8::LatentOrder, true, true>(lds + RING_OFF, g, S, E); } }
    } }
    if (kind == 9) { PH_PROLOG if ((MK_PHSEL >> 9) & 1) for (int rp = 0; rp < nrep; ++rp) {
      { MK_STAGGER(MK_STAG9);
        pg8::Gemm g{((bf16*)(wsp + WS_U)), (const bf16*)((wsp + WS_W + (size_t)l * W_LAYER) + WO_2), M, DM, DFF, DFF};
        if (l == 1 && G == 256) {
          pg8::EpiFinal E{wsp, args.out, AIN(I_GFIN), (LAS float*)(lds + RS_OFF), l}; pg8::LatentOrder S; S.init(DM, G, bx); pg8::gemm_phase<pg8::EpiFinal, pg8::LatentOrder, true, true>(lds + RING_OFF, g, S, E); }
        else { pg8::EpiResid<false> E{wsp, AIN(I_X), AIN(I_CTX), AIN(I_GN1) + DM, l, 1 | ((l == 0) << 1) | ((rp & 1) << 2)};
          pg8::LatentOrder S; S.init(DM, G, bx); pg8::gemm_phase<pg8::EpiResid<false>, pg8::LatentOrder, true, true>(lds + RING_OFF, g, S, E); }
        if (l == 0) for (int sid = bx; sid < 256; sid += G) {
          const int un = sid >> 3, ks = sid & 7; pg8::Gemm gs{g.A + 512 * ks, g.Bt + 512 * ks, M, DM, 512, DFF}; pg8::OneUnit S1{{(un >> 2) * 17, un & 3}}; pg8::EpiSlab ES{((float*)(args.out)) + (size_t)sid * 65536};
          pg8::gemm_phase<pg8::EpiSlab, pg8::OneUnit, true, true>(lds + RING_OFF, gs, S1, ES); } }
    } }
  }
  if (kind == 10) { PH_PROLOG if ((MK_PHSEL >> 10) & 1) for (int rp = 0; rp < nrep; ++rp) {
    { const float* gf = AIN(I_GFIN); const bf16* XSb = (const bf16*)(wsp + WS_XS);
      for (int m = 2 * gw; m < NB * T; m += 2 * NGW) { const int b = m / T, t = m % T; const u32x2* xr = (const u32x2*)(XSb + ((size_t)b * RB + NC + t) * DM) + lane; f32x4* orow = (f32x4*)((args.out) + (size_t)m * DM) + lane;
        u32x2 w0[4], w1[4]; f32x4 v0[4], v1[4]; float s0 = 0.f, s1 = 0.f;
#pragma unroll
        for (int j = 0; j < 4; ++j) { w0[j] = xr[64 * j]; w1[j] = xr[256 + 64 * j]; }
#pragma unroll
        for (int j = 0; j < 4; ++j) { v0[j] = (f32x4){pg8::h16_lo(w0[j].x), pg8::h16_hi(w0[j].x), pg8::h16_lo(w0[j].y), pg8::h16_hi(w0[j].y)}; v1[j] = (f32x4){pg8::h16_lo(w1[j].x), pg8::h16_hi(w1[j].x), pg8::h16_lo(w1[j].y), pg8::h16_hi(w1[j].y)};
          s0 += (v0[j].x * v0[j].x + v0[j].y * v0[j].y) + (v0[j].z * v0[j].z + v0[j].w * v0[j].w); s1 += (v1[j].x * v1[j].x + v1[j].y * v1[j].y) + (v1[j].z * v1[j].z + v1[j].w * v1[j].w); }
        const float rs0 = rsqrtf(wave_sum(s0) * (1.f / DM) + EPS), rs1 = rsqrtf(wave_sum(s1) * (1.f / DM) + EPS);
#pragma unroll
        for (int j = 0; j < 4; ++j) { const f32x4 gg = ((const f32x4*)gf)[64 * j + lane]; orow[64 * j] = v0[j] * rs0 * gg; orow[256 + 64 * j] = v1[j] * rs1 * gg; } } }
  } }
  if (ph + 1 < args.ph_hi) { if (args.use_cg && ph == args.ph_lo) cooperative_groups::this_grid().sync(); else xcd_barrier(bar);
#ifdef MK_BAR_REP
    for (int q = 1; q < MK_BAR_REP; ++q) xcd_barrier(bar);
#endif
  }
  }
#undef PH_PROLOG
#undef AIN
}


static void launch(void* const* d_in, float* out, void* d_ws, hipStream_t stream, int n_launch_mode  , int n_layers) {
  static int grid = 0;
  if (grid == 0) {
    int dev = 0, cus = 0, per_cu = 0;
    (void)hipGetDevice(&dev); (void)hipDeviceGetAttribute(&cus, hipDeviceAttributeMultiprocessorCount, dev);
    (void)hipFuncSetAttribute((const void*)mk_fwd, hipFuncAttributeMaxDynamicSharedMemorySize, LDS_BYTES);
    (void)hipOccupancyMaxActiveBlocksPerMultiprocessor(&per_cu, (const void*)mk_fwd, NWAVES * 64, LDS_BYTES);
    (void)hipGetLastError();
    if (per_cu < 1) fprintf(stderr, "mk: occupancy query says %d blocks per CU\n", per_cu);
    grid = cus;
  }
  (void)hipMemsetAsync((char*)d_ws + WS_CTL, 0, CTL_ZERO_BYTES, stream);
  Args a{}; for (int i = 0; i < 25; ++i) a.in[i] = (const float*)d_in[i];
  a.out = out; a.ws = (unsigned char*)d_ws; a.n_layers = n_layers;
  for (int k = 0; k < 12; ++k) a.rep[k] = 1;
#ifdef MK_REP_MASK
  for (int k = 0; k < 12; ++k) if ((MK_REP_MASK >> k) & 1) a.rep[k] = MK_REP_N;
#endif
  const int nph = N_PHASES;
  if (n_launch_mode == 0) {
    a.ph_lo = 0; a.ph_hi = (grid == 256) ? nph - 1 : nph; a.use_cg = MK_FIRST_SEAM_CG;
    void* kargs[] = {&a};
    hipError_t e = hipLaunchCooperativeKernel((const void*)mk_fwd, dim3(grid), dim3(NWAVES * 64), kargs, LDS_BYTES, stream);
    if (e != hipSuccess) { fprintf(stderr, "mk: cooperative launch failed (%s), plain launch instead\n", hipGetErrorName(e)); (void)hipGetLastError(); a.use_cg = 0; hipLaunchKernelGGL(mk_fwd, dim3(grid), dim3(NWAVES * 64), LDS_BYTES, stream, a); }
  }
  else for (int p = 0; p < ((grid == 256) ? nph - 1 : nph); ++p) { a.ph_lo = p; a.ph_hi = p + 1; hipLaunchKernelGGL(mk_fwd, dim3(grid), dim3(NWAVES * 64), LDS_BYTES, stream, a); }
  const hipError_t le = hipPeekAtLastError(); if (le != hipSuccess) fprintf(stderr, "mk: launch failed: %s\n", hipGetErrorName(le));
}
}
extern "C" void kernel_launch(void* const* d_in, const int* in_sizes, int n_in, void* d_out, int out_size, void* d_ws, size_t ws_size, hipStream_t stream) {
  mk::launch(d_in, (float*)d_out, d_ws, stream, MK_LAUNCH_MODE, 2);
}
```

```cpp
#ifndef MK_LAUNCH_MODE
#define MK_LAUNCH_MODE 0
#endif
#include <hip/hip_runtime.h>
#include <hip/hip_bf16.h>
#include <hip/hip_cooperative_groups.h>
#include <cstdint>
#include <cstdio>
#include <cmath>
#define GAS __attribute__((address_space(1)))
#define LAS __attribute__((address_space(3)))
namespace mk {
constexpr int NB = 8, T = 4096, NC = 256, RB = T + NC, M = NB * RB, DM = 1024, NP = 3328, DFF = 4096, TPB = RB / 256, NINO = 3096;
constexpr float EPS = 1e-6f, L2E = 1.4426950408889634f;
constexpr float QC2 = 0.125f * 1.4426950408889634f;
typedef unsigned short bf16;
typedef unsigned u32x4 __attribute__((ext_vector_type(4)));
typedef unsigned u32x2 __attribute__((ext_vector_type(2)));
typedef float f32x4 __attribute__((ext_vector_type(4)));
typedef float f32x16 __attribute__((ext_vector_type(16)));
typedef short bf16x8 __attribute__((ext_vector_type(8)));
typedef short s16x4 __attribute__((ext_vector_type(4)));
typedef float f32x2v __attribute__((ext_vector_type(2)));
typedef __bf16 bf16x2v __attribute__((ext_vector_type(2)));

constexpr size_t MiB = 1u << 20;
constexpr size_t WS_CTL = 0, CTL_ZERO_BYTES = 1 * MiB;
constexpr size_t WS_MOD = 1 * MiB;
constexpr size_t WS_CS = 2 * MiB;
constexpr size_t WS_G = 4 * MiB;
constexpr size_t WS_XS = 423 * MiB;
constexpr size_t WS_W = 17 * MiB;
constexpr size_t W_LAYER = (size_t)(NP + DM + DFF + DFF) * 1024 * 2;
constexpr size_t WO_IN = 0, WO_OUT = (size_t)NP * DM * 2, WO_1 = WO_OUT + (size_t)DM * DM * 2, WO_2 = WO_1 + (size_t)DFF * DM * 2;
constexpr size_t WS_H = 66 * MiB;
constexpr size_t WS_P = 134 * MiB;
constexpr size_t WS_Y = 355 * MiB;
constexpr size_t WS_U = WS_P;
constexpr size_t WS_SS = 491 * MiB;
constexpr size_t WS_BIAS = 3 * MiB;
constexpr size_t WS_G2 = 8 * MiB + 512 * 1024;
constexpr size_t WS_END = 494 * MiB;
static_assert(WS_W + 2 * W_LAYER <= WS_H && WS_H + (size_t)M * DM * 2 <= WS_P && WS_P + (size_t)M * NP * 2 <= WS_Y && WS_U + (size_t)M * DFF * 2 <= WS_XS && WS_XS + (size_t)M * DM * 2 <= WS_SS && WS_SS + (size_t)M * 16 * 4 <= WS_END && WS_G + (size_t)M * 32 * 4 <= WS_G2 && WS_G2 + (size_t)M * 64 * 4 <= WS_W, "ws map");
constexpr size_t WS_HC = WS_H, WS_YD = WS_H + (size_t)2 * M * 256 * 2;
constexpr int CW_BAR = 4096;
constexpr int CW_SUBBAR = 24576;
constexpr int CW_QUEUE = 16384;

__device__ __forceinline__ unsigned cvtpk(float lo, float hi) { f32x2v v = {lo, hi}; bf16x2v b = __builtin_convertvector(v, bf16x2v); return __builtin_bit_cast(unsigned, b); }
__device__ __forceinline__ float bf_lo(unsigned w) { return __uint_as_float(w << 16); }
__device__ __forceinline__ float bf_hi(unsigned w) { return __uint_as_float(w & 0xffff0000u); }
__device__ __forceinline__ float bf2f(bf16 v) { return __uint_as_float(((unsigned)v) << 16); }
__device__ __forceinline__ bf16 f2bf(float f) { return (bf16)(cvtpk(f, 0.f) & 0xffffu); }
__device__ __forceinline__ float wave_sum(float v) {
#pragma unroll
  for (int o = 1; o < 64; o <<= 1) v += __shfl_xor(v, o);
  return v;
}
__device__ __forceinline__ int crow(int r, int hi) { return (r & 3) + 8 * (r >> 2) + 4 * hi; }
__device__ __forceinline__ size_t lat_off(int b, int t) { return ((size_t)b * T + t) * DM; }
__device__ __forceinline__ size_t ctx_off(int b, int j) { return ((size_t)b * NC + j) * DM; }
}
typedef GAS unsigned gu32;
typedef GAS unsigned long long gu64;

#define XB_TMO      128
#define XB_XCNT(j)  (256  + 64 * (j))
#define XB_XSUB(j)  (1280 + 64 * (j))
#define XB_XGEN(j)  (2304 + 64 * (j))
#define XB_TOP      3328
#define XB_TOPGEN   3392
#define XCD_BAR_WORDS 3456
#define XB_SPIN_CAP (1u << 18)

__device__ __forceinline__ unsigned xb_ld(unsigned* p)              { return __hip_atomic_load(p, __ATOMIC_RELAXED, __HIP_MEMORY_SCOPE_AGENT); }
__device__ __forceinline__ unsigned xb_add(unsigned* p, unsigned v) { return __hip_atomic_fetch_add(p, v, __ATOMIC_RELAXED, __HIP_MEMORY_SCOPE_AGENT); }
__device__ __forceinline__ unsigned xb_xcc_id() { return (unsigned)__builtin_amdgcn_s_getreg((3 << 11) | 20) & 0xFu; }
#define XB_SPIN(cond, bar) do { unsigned _sp = 0; while (cond) { __builtin_amdgcn_s_sleep(1); \
    if ((++_sp & 255u) == 0u) { if (xb_ld(&(bar)[XB_TMO])) break; if (_sp > XB_SPIN_CAP) { atomicAdd(&(bar)[XB_TMO], 1u); break; } } } } while (0)

struct XcdBarrier {
    unsigned* bar; unsigned x;
    volatile LAS unsigned* st;
};

__device__ __forceinline__ XcdBarrier xcd_barrier_post(unsigned* bar, volatile LAS unsigned* st) {
    XcdBarrier b; b.bar = bar; b.x = xb_xcc_id(); b.st = st;
    if (threadIdx.x == 0) (void)xb_add(&bar[XB_XCNT(b.x)], 1u);
    return b;
}
__device__ __forceinline__ void xcd_barrier_complete(unsigned* bar, unsigned x, unsigned& nloc, unsigned& nx) {
    const unsigned G = gridDim.x * gridDim.y * gridDim.z;
    unsigned sum, cnt, mine, sp = 0u;
    for (;;) {
        sum = 0u; cnt = 0u; mine = 0u;
#pragma unroll 1
        for (unsigned j = 0; j < 16; ++j) { const unsigned c = xb_ld(&bar[XB_XCNT(j)]); sum += c; cnt += (c > 0u) ? 1u : 0u; mine = (j == x) ? c : mine; }
        if (sum == G) break;
        __builtin_amdgcn_s_sleep(1);
        if ((++sp & 255u) == 0u) { if (xb_ld(&bar[XB_TMO])) break; if (sp > XB_SPIN_CAP) { atomicAdd(&bar[XB_TMO], 1u); break; } }
    }
    nloc = mine > 0u ? mine : 1u; nx = cnt > 0u ? cnt : 1u;
}

__device__ __forceinline__ void xcd_barrier(const XcdBarrier& b) {
    asm volatile("s_waitcnt vmcnt(0)" ::: "memory");
    __syncthreads();
    if (threadIdx.x == 0) {
        unsigned* bar = b.bar;
        __builtin_amdgcn_s_waitcnt(0);
        unsigned nloc = b.st[0], nx = b.st[1];
        if (nloc == 0u) { xcd_barrier_complete(bar, b.x, nloc, nx); b.st[0] = nloc; b.st[1] = nx; }
        const unsigned old = xb_add(&bar[XB_XSUB(b.x)], 1u);
        const unsigned gen = old / nloc;
        if (old + 1u == (gen + 1u) * nloc) {
            __builtin_amdgcn_fence(__ATOMIC_RELEASE, "agent");
            asm volatile("s_waitcnt vmcnt(0)" ::: "memory");
            const unsigned og = xb_add(&bar[XB_TOP], 1u);
            const unsigned tg = og / nx;
            if (og + 1u == (tg + 1u) * nx) xb_add(&bar[XB_TOPGEN], 1u);
            else XB_SPIN(xb_ld(&bar[XB_TOPGEN]) == tg, bar);
            __builtin_amdgcn_fence(__ATOMIC_ACQUIRE, "agent");
            xb_add(&bar[XB_XGEN(b.x)], 1u);
            asm volatile("s_waitcnt vmcnt(0)" ::: "memory");
        } else {
            XB_SPIN(xb_ld(&bar[XB_XGEN(b.x)]) == gen, bar);
            __builtin_amdgcn_fence(__ATOMIC_ACQUIRE, "agent");
            asm volatile("s_waitcnt vmcnt(0)" ::: "memory");
        }
    }
    __syncthreads();
}
namespace pg8 {
#define PG8_LAS __attribute__((address_space(3)))
typedef unsigned short bf16_t;
typedef short bf16x8 __attribute__((ext_vector_type(8)));
typedef float f32x4 __attribute__((ext_vector_type(4)));
typedef unsigned u32x4 __attribute__((ext_vector_type(4)));
#ifndef PG8_WGM
#define PG8_WGM 8
#endif
constexpr int BM = 256, BK = 64, HALF = 128, HTB = HALF * BK * 2  , STAGE_BYTES = 8 * HTB, NXCD = 8, WGM = PG8_WGM;

__host__ __device__ __forceinline__ int lds_byte(int r, int c) { const int st = (r >> 4) * 2 + (c >> 5), rr = r & 15, cc = c & 31, ob = rr * 64 + cc * 2; return st * 1024 + (ob ^ (((ob >> 9) & 1) << 5)); }
__host__ __device__ __forceinline__ void stage_rc(int b, int& R, int& C) { const int st = b / 1024, sb = b % 1024, swz = sb ^ (((sb >> 9) & 1) << 5); R = (st >> 1) * 16 + swz / 64; C = (st & 1) * 32 + (swz % 64) / 2; }
__host__ __device__ __forceinline__ int perm32(int rho) { const int n = rho >> 4, i = rho & 15; return 8 * (i >> 2) + 4 * n + (i & 3); }

struct Unit { int pm, pn; };
struct Gemm { const bf16_t* A; const bf16_t* Bt; int M, N, K, ld; int ablk; };

struct StaticOrder {
    int nM, nN, nwg, G, c;
    __host__ __device__ void init(int M, int N, int G_, int c_) { nM = M / BM; nN = N / BM; nwg = nM * nN; G = G_; c = c_; }
    __host__ __device__ bool next(int i, Unit& u) const {
        const long L = (long)i * G + c; if (L >= nwg) return false;
        int wgid = (int)L; { const int q = nwg / NXCD, r = nwg % NXCD, xcd = wgid % NXCD, off = wgid / NXCD; wgid = (xcd < r ? xcd * (q + 1) : r * (q + 1) + (xcd - r) * q) + off; }
        const int nig = WGM * nN, gid = wgid / nig, fm = gid * WGM, gsz = (nM - fm) < WGM ? (nM - fm) : WGM;
        u.pm = fm + ((wgid % nig) % gsz); u.pn = (wgid % nig) / gsz; return true;
    }
    __device__ __forceinline__ void a_ready(const Unit&) const {}
    __device__ __forceinline__ void done(const Unit&) const {}
};

__device__ __forceinline__ unsigned cvt_pk_bf16(float lo, float hi) { unsigned r; asm volatile("v_cvt_pk_bf16_f32 %0, %1, %2" : "=v"(r) : "v"(lo), "v"(hi)); return r; }
typedef float f32x2 __attribute__((ext_vector_type(2)));
__device__ __forceinline__ f32x2 gelu_pk(f32x2 v) {
    const f32x2 av = __builtin_elementwise_abs(v), d = av * 0.2316418882f + 1.0f;
    f32x2 t; t.x = __builtin_amdgcn_rcpf(d.x); t.y = __builtin_amdgcn_rcpf(d.y);
    f32x2 q = t * 0.5307027145f + (-0.7265760135f); q = q * t + 0.7107068705f; q = q * t + (-0.142248368f); q = q * t + 0.127414796f; q = q * t;
    const f32x2 s = (v * v) * (-0.72134752044f);
    f32x2 e; e.x = __builtin_amdgcn_exp2f(s.x); e.y = __builtin_amdgcn_exp2f(s.y);
    const f32x2 m = v * (q * e), r = v - m;
    f32x2 o; o.x = v.x < 0.f ? m.x : r.x; o.y = v.y < 0.f ? m.y : r.y; return o;
}

template <int ACT  > struct EpiBf16 {
    static constexpr bool PERM = true, AFTER_DRAIN = false; static_assert(ACT == 0 || ACT == 1, "EpiBf16: ACT is 0 (none) or 1 (gelu_pk)");
    bf16_t* O; int ldc; const float* bias; int split_cols; size_t split_stride; float scale0;
    __device__ __forceinline__ void operator()(const f32x4 (&acc)[2][2][4][2], const Unit& u, int wr, int wc, int fr, int fq) const {
        const int row0 = u.pm * BM + wr * 64 + fr; int colt = u.pn * BM; bf16_t* base = O;
        float sc = 1.f; if (split_cols) { const int t = colt / split_cols; base += (size_t)t * split_stride; colt -= t * split_cols; if (t == 0) sc = scale0; }
        const int col0 = colt + wc * 32 + 8 * fq, bcol0 = u.pn * BM + wc * 32 + 8 * fq;
        f32x4 bv[2][2];
#pragma unroll
        for (int bj = 0; bj < 2; ++bj)
#pragma unroll
            for (int n = 0; n < 2; ++n) bv[bj][n] = bias ? *(const f32x4*)(bias + bcol0 + bj * HALF + 4 * n) : (f32x4){0.f, 0.f, 0.f, 0.f};
#pragma unroll
        for (int ai = 0; ai < 2; ++ai)
#pragma unroll
            for (int m = 0; m < 4; ++m) { bf16_t* rowp = base + (size_t)(row0 + ai * HALF + m * 16) * ldc + col0;
#pragma unroll
                for (int bj = 0; bj < 2; ++bj) { f32x4 v0 = acc[ai][bj][m][0] + bv[bj][0], v1 = acc[ai][bj][m][1] + bv[bj][1];
                    if (ACT == 1) { f32x2 a = gelu_pk((f32x2){v0[0], v0[1]}), b = gelu_pk((f32x2){v0[2], v0[3]}), c = gelu_pk((f32x2){v1[0], v1[1]}), d = gelu_pk((f32x2){v1[2], v1[3]});
                        v0 = (f32x4){a.x, a.y, b.x, b.y}; v1 = (f32x4){c.x, c.y, d.x, d.y}; }
                    v0 = v0 * sc; v1 = v1 * sc; u32x4 w; w.x = cvt_pk_bf16(v0[0], v0[1]); w.y = cvt_pk_bf16(v0[2], v0[3]); w.z = cvt_pk_bf16(v1[0], v1[1]); w.w = cvt_pk_bf16(v1[2], v1[3]);
                    *(u32x4*)(rowp + bj * HALF) = w; } }
    }
};
template <class Epi, class Sched, bool ALIGN_EPI = false, bool SP2 = false>
__device__ __forceinline__ void gemm_phase(PG8_LAS unsigned char* lds, const Gemm g, const Sched& S, const Epi& E) {
    int tid_ = threadIdx.x; asm volatile("" : "+v"(tid_));
    const int tid = tid_, wid = __builtin_amdgcn_readfirstlane(tid >> 6), lane = tid & 63, wr = wid >> 2, wc = wid & 3, fr = lane & 15, fq = lane >> 4;
    const int K = g.K, nt = K / BK, LD = g.ld;
    unsigned voffA[2], voffB[2];
#pragma unroll
    for (int i = 0; i < 2; ++i) { int R, C; stage_rc(tid * 16 + i * 8192, R, C); const int Rb = Epi::PERM ? ((R & ~31) + perm32(R & 31)) : R;
        voffA[i] = (unsigned)(R * (g.ablk ? 64 : LD) + C) * 2u; voffB[i] = (unsigned)(Rb * LD + C) * 2u; }
    const size_t kstep = (size_t)(BK * 2);
    const size_t hstep = (size_t)HALF * LD * 2;
    const size_t tstep = 2 * hstep;
    const size_t kstepA = g.ablk ? (size_t)32768 : kstep, hstepA = g.ablk ? (size_t)16384 : hstep, tstepA = g.ablk ? (size_t)LD * 512 : tstep;
    const unsigned ldsw = (unsigned)wid * 1024u;
    const int aoff = lds_byte(wr * 64 + fr, fq * 8), boff = lds_byte(wc * 32 + fr, fq * 8);
#define PG8_SA(b, h) (((b) * 2 + (h)) * HTB)
#define PG8_SB(b, h) ((4 + (b) * 2 + (h)) * HTB)
#define PG8_STAGE(bufoff, gbase, voff) do { _Pragma("unroll") for (int _i = 0; _i < 2; ++_i) \
        __builtin_amdgcn_global_load_lds((const unsigned*)((const char*)(gbase) + (voff)[_i]), (PG8_LAS unsigned*)(lds + (bufoff) + ldsw + _i * 8192), 16, 0, 0); } while (0)
#define PG8_LDA(dst, b, h) do { _Pragma("unroll") for (int m = 0; m < 4; ++m) _Pragma("unroll") for (int k = 0; k < 2; ++k) dst[m][k] = *(const PG8_LAS bf16x8*)(lds + PG8_SA(b, h) + aoff + m * 2048 + k * 1024); } while (0)
#define PG8_LDB(dst, b, h) do { _Pragma("unroll") for (int n = 0; n < 2; ++n) _Pragma("unroll") for (int k = 0; k < 2; ++k) dst[n][k] = *(const PG8_LAS bf16x8*)(lds + PG8_SB(b, h) + boff + n * 2048 + k * 1024); } while (0)
#define PG8_MMA(ai, bj, At, Bt) do { __builtin_amdgcn_s_setprio(1); _Pragma("unroll") for (int m = 0; m < 4; ++m) _Pragma("unroll") for (int n = 0; n < 2; ++n) _Pragma("unroll") for (int k = 0; k < 2; ++k) \
        acc[ai][bj][m][n] = __builtin_amdgcn_mfma_f32_16x16x32_bf16(Bt[n][k], At[m][k], acc[ai][bj][m][n], 0, 0, 0); __builtin_amdgcn_s_setprio(0); } while (0)
#define PG8_WAIT_V(n) asm volatile("s_waitcnt vmcnt(" #n ")" ::: "memory")
#define PG8_WAIT_L(n) asm volatile("s_waitcnt lgkmcnt(" #n ")" ::: "memory")
#define PG8_BAR __builtin_amdgcn_s_barrier()
#define PG8_SCHED __builtin_amdgcn_sched_barrier(0)
    Unit cur, nxt; int ui = 0;
    if (!S.next(0, cur)) return;
    f32x4 acc[2][2][4][2];
#pragma unroll
    for (int a = 0; a < 2; ++a)
#pragma unroll
        for (int b = 0; b < 2; ++b)
#pragma unroll
            for (int m = 0; m < 4; ++m)
#pragma unroll
                for (int n = 0; n < 2; ++n) acc[a][b][m][n] = (f32x4){0.f, 0.f, 0.f, 0.f};
    bf16x8 At[4][2], B0[2][2], B1[2][2];
    const char* cA = (const char*)g.A + (size_t)cur.pm * tstepA; const char* cB = (const char*)g.Bt + (size_t)cur.pn * tstep;
    S.a_ready(cur);
    if constexpr (SP2) {
        PG8_STAGE(PG8_SB(0, 0), cB, voffB); PG8_STAGE(PG8_SB(0, 1), cB + hstep, voffB); PG8_STAGE(PG8_SA(0, 0), cA, voffA); PG8_STAGE(PG8_SA(0, 1), cA + hstepA, voffA);
        if (wr == 1) PG8_BAR;
        PG8_WAIT_V(2); PG8_BAR;
        PG8_STAGE(PG8_SB(1, 0), cB + kstep, voffB); PG8_STAGE(PG8_SA(1, 0), cA + kstepA, voffA); PG8_STAGE(PG8_SB(1, 1), cB + hstep + kstep, voffB);
        PG8_WAIT_V(6); PG8_BAR;
    } else {
        PG8_STAGE(PG8_SB(0, 0), cB, voffB); PG8_STAGE(PG8_SA(0, 0), cA, voffA); PG8_STAGE(PG8_SB(0, 1), cB + hstep, voffB); PG8_STAGE(PG8_SA(0, 1), cA + hstepA, voffA);
        if (wr == 1) PG8_BAR;
        PG8_WAIT_V(4); PG8_BAR;
        PG8_STAGE(PG8_SB(1, 0), cB + kstep, voffB); PG8_STAGE(PG8_SA(1, 0), cA + kstepA, voffA); PG8_STAGE(PG8_SB(1, 1), cB + hstep + kstep, voffB);
        PG8_WAIT_V(6); PG8_BAR;
    }
    for (;;) {
        const bool has_next = S.next(ui + 1, nxt);
        const char* nA = has_next ? (const char*)g.A + (size_t)nxt.pm * tstepA : cA; const char* nB = has_next ? (const char*)g.Bt + (size_t)nxt.pn * tstep : cB;
        for (int t = 0; t < nt; t += 2) {
            const bool last = (t == nt - 2);
            const char* a1 = cA + (size_t)(t + 1) * kstepA;
            const char* a2 = last ? nA : cA + (size_t)(t + 2) * kstepA; const char* b2 = last ? nB : cB + (size_t)(t + 2) * kstep;
            const char* a3 = a2 + kstepA; const char* b3 = b2 + kstep;
            if (last && has_next) S.a_ready(nxt);
            if constexpr (SP2) {
            PG8_LDB(B0, 0, 0); PG8_LDB(B1, 0, 1); PG8_SCHED; PG8_LDA(At, 0, 0); PG8_STAGE(PG8_SA(1, 1), a1 + hstepA, voffA);
            PG8_WAIT_V(8); PG8_WAIT_L(0); PG8_BAR; PG8_MMA(0, 0, At, B0); PG8_MMA(0, 1, At, B1); PG8_BAR; PG8_SCHED;
            PG8_LDA(At, 0, 1); PG8_STAGE(PG8_SB(0, 0), b2, voffB); PG8_STAGE(PG8_SB(0, 1), b2 + hstep, voffB); PG8_STAGE(PG8_SA(0, 0), a2, voffA);
            PG8_WAIT_V(8); PG8_WAIT_L(0); PG8_BAR; PG8_MMA(1, 0, At, B0); PG8_MMA(1, 1, At, B1); PG8_BAR; PG8_SCHED;
            PG8_LDB(B0, 1, 0); PG8_LDB(B1, 1, 1); PG8_SCHED; PG8_LDA(At, 1, 0); PG8_STAGE(PG8_SA(0, 1), a2 + hstepA, voffA);
            PG8_WAIT_V(8); PG8_WAIT_L(0); PG8_BAR; PG8_MMA(0, 0, At, B0); PG8_MMA(0, 1, At, B1); PG8_BAR; PG8_SCHED;
            PG8_LDA(At, 1, 1); PG8_STAGE(PG8_SB(1, 0), b3, voffB); PG8_STAGE(PG8_SB(1, 1), b3 + hstep, voffB); PG8_STAGE(PG8_SA(1, 0), a3, voffA);
            PG8_WAIT_V(8); PG8_WAIT_L(0); PG8_BAR; PG8_MMA(1, 0, At, B0); PG8_MMA(1, 1, At, B1); PG8_BAR; PG8_SCHED;
            } else {
            PG8_LDB(B0, 0, 0); PG8_SCHED; PG8_LDA(At, 0, 0); PG8_STAGE(PG8_SA(1, 1), a1 + hstepA, voffA);
            PG8_WAIT_L(8); PG8_BAR; PG8_WAIT_L(0); PG8_MMA(0, 0, At, B0); PG8_BAR; PG8_SCHED;
            PG8_LDB(B1, 0, 1); PG8_STAGE(PG8_SB(0, 0), b2, voffB);
            PG8_BAR; PG8_WAIT_L(0); PG8_MMA(0, 1, At, B1); PG8_BAR;
            PG8_LDA(At, 0, 1); PG8_STAGE(PG8_SA(0, 0), a2, voffA);
            PG8_BAR; PG8_WAIT_L(0); PG8_MMA(1, 0, At, B0); PG8_BAR; PG8_SCHED;
            PG8_STAGE(PG8_SB(0, 1), b2 + hstep, voffB);
            PG8_WAIT_V(6); PG8_BAR; PG8_MMA(1, 1, At, B1); PG8_BAR;
            PG8_LDB(B0, 1, 0); PG8_SCHED; PG8_LDA(At, 1, 0); PG8_STAGE(PG8_SA(0, 1), a2 + hstepA, voffA);
            PG8_WAIT_L(8); PG8_BAR; PG8_WAIT_L(0); PG8_MMA(0, 0, At, B0); PG8_BAR; PG8_SCHED;
            PG8_LDB(B1, 1, 1); PG8_STAGE(PG8_SB(1, 0), b3, voffB);
            PG8_BAR; PG8_WAIT_L(0); PG8_MMA(0, 1, At, B1); PG8_BAR;
            PG8_LDA(At, 1, 1); PG8_STAGE(PG8_SA(1, 0), a3, voffA);
            PG8_BAR; PG8_WAIT_L(0); PG8_MMA(1, 0, At, B0); PG8_BAR; PG8_SCHED;
            PG8_STAGE(PG8_SB(1, 1), b3 + hstep, voffB);
            PG8_WAIT_V(6); PG8_BAR; PG8_MMA(1, 1, At, B1); PG8_BAR;
            }
        }
        if constexpr (ALIGN_EPI) { if (wr == 0) PG8_BAR; }
        if constexpr (!Epi::AFTER_DRAIN) { E(acc, cur, wr, wc, fr, fq); S.done(cur); }
        if (!has_next) break;
#pragma unroll
        for (int a = 0; a < 2; ++a)
#pragma unroll
            for (int b = 0; b < 2; ++b)
#pragma unroll
                for (int m = 0; m < 4; ++m)
#pragma unroll
                    for (int n = 0; n < 2; ++n) acc[a][b][m][n] = (f32x4){0.f, 0.f, 0.f, 0.f};
        cur = nxt; cA = nA; cB = nB; ++ui;
        if constexpr (ALIGN_EPI) { if (wr == 1) PG8_BAR; }
    }
    PG8_WAIT_V(0);
    if constexpr (!ALIGN_EPI) { if (wr == 0) PG8_BAR; }
    PG8_BAR;
    if constexpr (Epi::AFTER_DRAIN) { E.fused(acc, cur, wr, wc, fr, fq, lds, wid, lane); S.done(cur); }
#undef PG8_SA
#undef PG8_SB
#undef PG8_STAGE
#undef PG8_LDA
#undef PG8_LDB
#undef PG8_MMA
#undef PG8_WAIT_V
#undef PG8_WAIT_L
#undef PG8_BAR
#undef PG8_SCHED
}
}
namespace attn_body {
using bf16=__hip_bfloat16;
using bf16x8=__attribute__((ext_vector_type(8)))short;
using s16x4=__attribute__((ext_vector_type(4)))short;
using f32x16=__attribute__((ext_vector_type(16)))float;
using u32x4=__attribute__((ext_vector_type(4)))unsigned;
constexpr int D=64,PQ=3328,PO=1024;
constexpr int NW=8,QBLK=32,QB=QBLK*NW,KVBLK=64;
__device__ __forceinline__ int crow(int r,int hi){return (r&3)+8*(r>>2)+4*hi;}
#define SBAR() __builtin_amdgcn_sched_barrier(0)
__device__ __forceinline__ void wmask(f32x16&p0,f32x16&p1,int dq,int hi){
  const float NEG=-INFINITY; int kb=4*hi;
  #pragma unroll
  for(int r=0;r<16;++r){int kv=kb+(r&3)+8*(r>>2); int d0=dq-kv; if(d0>128||d0<-128)p0[r]=NEG; int d1=d0-32; if(d1>128||d1<-128)p1[r]=NEG;}
}

constexpr int NSLOT=3, SLOTB=8192;
constexpr int LDS_K=0, LDS_V=NSLOT*SLOTB, LDS_WS=2*NSLOT*SLOTB, LDS_OST=LDS_WS+NW*64*4, LDS_BYTES=LDS_OST+NW*4096;
constexpr float C2=0.125f*1.4426950408889634f;
__device__ __forceinline__ void glds16(const void*gsrc,unsigned lds_dst){unsigned keep;
  asm volatile("s_mov_b32 %0, m0\n\ts_mov_b32 m0, %2\n\ts_nop 0\n\tglobal_load_lds_dwordx4 %1, off\n\ts_mov_b32 m0, %0":"=&s"(keep):"v"(gsrc),"s"(lds_dst):"memory");}
__device__ __forceinline__ float max3f(float a,float b,float c){float r;asm("v_max3_f32 %0, %1, %2, %3":"=v"(r):"v"(a),"v"(b),"v"(c));return r;}
__device__ __forceinline__ float max2f(float a,float b){float r;asm("v_max_f32_e32 %0, %1, %2":"=v"(r):"v"(a),"v"(b));return r;}
__device__ __forceinline__ float fadd_s(float a,float b){float r;asm("v_add_f32_e32 %0, %1, %2":"=v"(r):"v"(a),"v"(b));return r;}
__device__ __forceinline__ float fsub_s(float a,float b){float r;asm("v_sub_f32_e32 %0, %1, %2":"=v"(r):"v"(a),"v"(b));return r;}
typedef float f32x2_t __attribute__((ext_vector_type(2))); typedef __bf16 bf16x2_t __attribute__((ext_vector_type(2)));
__device__ __forceinline__ unsigned cvtpk_s(float lo,float hi){f32x2_t v={lo,hi};bf16x2_t b=__builtin_convertvector(v,bf16x2_t);return __builtin_bit_cast(unsigned,b);}
#define WAIT_BAR(N) asm volatile("s_waitcnt vmcnt(" #N ") lgkmcnt(0)\n\ts_barrier":::"memory")

__device__ __forceinline__ void qkt(f32x16&p0,f32x16&p1,const char*Kslot,const bf16x8*qr,const f32x16&negm,int r32,int hi){
  const char*kb=Kslot+hi*1024+r32*16;
  #pragma unroll
  for(int d0=0;d0<4;++d0){
    const bf16x8 b0=*reinterpret_cast<const bf16x8*>(kb+d0*2048);
    const bf16x8 b1=*reinterpret_cast<const bf16x8*>(kb+d0*2048+512);
    if(d0==0){p0=__builtin_amdgcn_mfma_f32_32x32x16_bf16(b0,qr[0],negm,0,0,0);p1=__builtin_amdgcn_mfma_f32_32x32x16_bf16(b1,qr[0],negm,0,0,0);}
    else{p0=__builtin_amdgcn_mfma_f32_32x32x16_bf16(b0,qr[d0],p0,0,0,0);p1=__builtin_amdgcn_mfma_f32_32x32x16_bf16(b1,qr[d0],p1,0,0,0);}}
}
typedef __attribute__((address_space(3))) const char* lds_cptr;
typedef short v4i16_t __attribute__((ext_vector_type(4)));
__device__ __forceinline__ void kload8(bf16x8*kf,lds_cptr kp){
  kf[0]=*(const __attribute__((address_space(3))) bf16x8*)(kp);      kf[1]=*(const __attribute__((address_space(3))) bf16x8*)(kp+512);
  kf[2]=*(const __attribute__((address_space(3))) bf16x8*)(kp+2048); kf[3]=*(const __attribute__((address_space(3))) bf16x8*)(kp+2560);
  kf[4]=*(const __attribute__((address_space(3))) bf16x8*)(kp+4096); kf[5]=*(const __attribute__((address_space(3))) bf16x8*)(kp+4608);
  kf[6]=*(const __attribute__((address_space(3))) bf16x8*)(kp+6144); kf[7]=*(const __attribute__((address_space(3))) bf16x8*)(kp+6656);
}
__device__ __forceinline__ void kload2(bf16x8*kf,lds_cptr kp,int j){ kf[2*j]=*(const __attribute__((address_space(3))) bf16x8*)(kp+j*2048); kf[2*j+1]=*(const __attribute__((address_space(3))) bf16x8*)(kp+j*2048+512); }
__device__ __forceinline__ s16x4 vtr(lds_cptr p){ return __builtin_bit_cast(s16x4,__builtin_amdgcn_ds_read_tr16_b64_v4i16((__attribute__((address_space(3))) v4i16_t*)p)); }
__device__ __forceinline__ float rowmax(const f32x16&p0,const f32x16&p1){
  float a=max3f(p0[0],p0[1],p1[0]),b=max3f(p0[2],p0[3],p1[1]);a=max3f(a,p1[2],p1[3]);
  #pragma unroll
  for(int r=4;r<16;r+=4){a=max3f(a,p0[r],p0[r+1]);b=max3f(b,p0[r+2],p0[r+3]);a=max3f(a,p1[r],p1[r+1]);b=max3f(b,p1[r+2],p1[r+3]);}
  const float m=max2f(a,b);
  auto rr=__builtin_amdgcn_permlane32_swap(__float_as_uint(m),__float_as_uint(m),false,false);
  return max2f(__uint_as_float(rr[0]),__uint_as_float(rr[1]));
}
__device__ __forceinline__ void pv(f32x16*o,int vb,bf16x8 pa0,bf16x8 pa1,bf16x8 pa2,bf16x8 pa3){
  #pragma unroll
  for(int d0=0;d0<2;++d0){s16x4 lo[4],hi[4];
    #pragma unroll
    for(int ks=0;ks<4;++ks){
      asm volatile("ds_read_b64_tr_b16 %0,%1 offset:%c2":"=&v"(lo[ks]):"v"(vb),"i"(d0*4096+ks*1024):"memory");
      asm volatile("ds_read_b64_tr_b16 %0,%1 offset:%c2":"=&v"(hi[ks]):"v"(vb),"i"(d0*4096+ks*1024+512):"memory");}
    asm volatile("s_waitcnt lgkmcnt(0)":::"memory");SBAR();
    #define PK(k) (bf16x8){lo[k][0],lo[k][1],lo[k][2],lo[k][3],hi[k][0],hi[k][1],hi[k][2],hi[k][3]}
    o[d0]=__builtin_amdgcn_mfma_f32_32x32x16_bf16(pa0,PK(0),o[d0],0,0,0);
    o[d0]=__builtin_amdgcn_mfma_f32_32x32x16_bf16(pa1,PK(1),o[d0],0,0,0);
    o[d0]=__builtin_amdgcn_mfma_f32_32x32x16_bf16(pa2,PK(2),o[d0],0,0,0);
    o[d0]=__builtin_amdgcn_mfma_f32_32x32x16_bf16(pa3,PK(3),o[d0],0,0,0);
    #undef PK
  }
}

#ifndef ATTN_STORE16
#define ATTN_STORE16(p,v) (*(u32x4*)(p)=(v))
#endif
template<int THRL,int MODE> __device__ __forceinline__ void attn_unit(const bf16*Q0,const bf16*__restrict__ Kh,const bf16*__restrict__ Vh,bf16*O0,const int NT,const int band_row0,const int qpos0,const int band_s0,const float sink_l2,const float cref,char*shm,const bool pair=false,const float sink_l2b=0.f){
  const bool FIX=(MODE==0)&&(cref>0.f);
  int tid_=threadIdx.x; asm volatile("":"+v"(tid_));
  const int tid=tid_,lane=tid&63,r32=lane&31,hi=lane>>5; const int wid=__builtin_amdgcn_readfirstlane(tid>>6);
  const int wrow=pair?(wid&3)*QBLK:wid*QBLK, wcol=pair?(wid>>2)*D:0;
  const bf16*Qw=Q0+(long)wrow*PQ+wcol;
  #define TROW(t) ((MODE==1&&(t)>=4)?(band_row0+((t)-4)*KVBLK):((t)*KVBLK))
  const unsigned lds0=(unsigned)(uintptr_t)shm;
  float*wsf=(float*)(shm+LDS_WS)+wid*64;
  const bf16*ksrc=Kh+(long)lane*PQ+wid*8;
  const bf16*vsrc=Vh+(long)(16*(wid&3)+(lane>>2))*PQ+(wid>>2)*32+(lane&3)*8;
  const unsigned kdst=lds0+LDS_K+wid*1024, vdst=lds0+LDS_V+wid*1024;
  #define DMA_K(t,slot) glds16(ksrc+(long)TROW(t)*PQ,(unsigned)__builtin_amdgcn_readfirstlane(kdst+(slot)))
  #define DMA_V(t,slot) glds16(vsrc+(long)TROW(t)*PQ,(unsigned)__builtin_amdgcn_readfirstlane(vdst+(slot)))
  const int vb0=(int)(lds0+LDS_V)+((lane>>4)&1)*32+(lane&3)*8+(4*hi+((lane&15)>>2))*64;
  const char*Kbase=shm+LDS_K; bf16x8 kf[8];
  const lds_cptr shm3=(lds_cptr)shm; const lds_cptr kp0=shm3+LDS_K+hi*1024+r32*16; const lds_cptr vp0=shm3+LDS_V+((lane>>4)&1)*32+(lane&3)*8+(4*hi+((lane&15)>>2))*64;
  DMA_K(0,0);DMA_V(0,0);DMA_K(1,SLOTB);
  bf16x8 qr[4];
  #pragma unroll
  for(int d0=0;d0<4;++d0)qr[d0]=*reinterpret_cast<const bf16x8*>(&Qw[(long)r32*PQ+d0*16+hi*8]);
  float mhat=0.f,l_reg=0.f;f32x16 o[2];o[0]=f32x16{};o[1]=f32x16{};f32x16 negm=f32x16{};asm volatile("":"+v"(negm));
  const int qrel=wrow+r32;
  #define CMASK(P0,P1,t) do{ if(MODE==1&&(t)>=4){ const int dq0=qpos0+wrow-(band_s0+((t)-4)*KVBLK); \
      if(!(dq0+31<=128&&dq0-63>=-128)) wmask(P0,P1,dq0+r32,hi); } }while(0)
  bool resc=false;
  #define START(P0,P1) do{ float rm; if(FIX)rm=cref; else rm=rowmax(P0,P1); resc=false; \
    { const float dl=rm; mhat=fadd_s(mhat,dl); \
      _Pragma("unroll") for(int r=0;r<16;++r){P0[r]=fsub_s(P0[r],dl);P1[r]=fsub_s(P1[r],dl);} \
      _Pragma("unroll") for(int r=0;r<16;++r)negm[r]=-mhat; asm volatile("":"+v"(negm)); } \
    _Pragma("unroll") for(int r=0;r<16;++r)P0[r]=__builtin_amdgcn_exp2f(P0[r]); }while(0)
  #define RESC() do{ if(resc){ asm volatile("s_waitcnt lgkmcnt(0)":::"memory"); \
      _Pragma("unroll") for(int d_=0;d_<2;++d_) _Pragma("unroll") for(int r=0;r<16;++r)o[d_][r]*=wsf[crow(r,hi)]; } }while(0)
  f32x16 pA0,pA1,pB0,pB1;
  int sl_prev=0,sl_cur=0,sl_next=SLOTB;
  #define ROT() do{sl_prev=sl_cur;sl_cur=sl_next;sl_next=(sl_next==(NSLOT-1)*SLOTB)?0:sl_next+SLOTB;}while(0)
  DMA_K(2,2*SLOTB);
  WAIT_BAR(3);
  qkt(pA0,pA1,Kbase,qr,negm,r32,hi);asm volatile("s_nop 15\n\ts_nop 7":"+v"(pA0),"+v"(pA1));CMASK(pA0,pA1,0);
  START(pA0,pA1);
  _Pragma("unroll") for(int r=0;r<16;++r)pA1[r]=__builtin_amdgcn_exp2f(pA1[r]);
  WAIT_BAR(0);
  DMA_K(3,0);DMA_V(1,SLOTB);
  ROT();
  kload8(kf,kp0+sl_cur);
  WAIT_BAR(2);
  s16x4 vlo[8],vhi[8]; u32x4 pw0,pw1,pw2,pw3;
  #define PKW(P,B) cvtpk_s(P[B],P[B+1])
  #define PAF(k) __builtin_bit_cast(bf16x8,pw##k)
  #define VFR(i) (bf16x8){vlo[i][0],vlo[i][1],vlo[i][2],vlo[i][3],vhi[i][0],vhi[i][1],vhi[i][2],vhi[i][3]}
  #define PIN(x) asm volatile("":"+v"(x))
  #define MX3(a,b,c) __builtin_fmaxf(__builtin_fmaxf((a),(b)),(c))
  #define GAPA(MF,A0,A1,A2,A3,W0,W1,PW) do{ MF; sacc+=A0; sacc+=A1; sacc+=A2; sacc+=A3; PIN(sacc); W0; W1; PIN(PW); SBAR(); }while(0)
  #define EX(v) __builtin_amdgcn_exp2f(v)
  #define GAPB(MF,X,B) do{ MF; X[B]=EX(X[B]); X[B+1]=EX(X[B+1]); X[B+2]=EX(X[B+2]); X[B+3]=EX(X[B+3]); PIN(X); SBAR(); }while(0)
  #define VRD(i) do{ vlo[i]=vtr(vp_+(((i)>>2)*4096+((i)&3)*1024)); vhi[i]=vtr(vp_+(((i)>>2)*4096+((i)&3)*1024+512)); }while(0)
  #define KRD(G,j) do{ if(G){ kload2(kf,kp0+sl_next,j); SBAR(); } }while(0)
  #define STEP(C0,C1,P0,P1,t,GK,GV,GL) do{ SBAR(); \
    const lds_cptr vp_=vp0+sl_prev; \
    VRD(0); SBAR(); float sacc=(P0[0]+P0[1]); \
    GAPA(C0=__builtin_amdgcn_mfma_f32_32x32x16_bf16(kf[0],qr[0],negm,0,0,0), P0[2],P0[3],P0[4],P0[5],     pw0[0]=PKW(P0,0), pw0[1]=PKW(P0,2), pw0); \
    VRD(4); SBAR(); GAPA(C1=__builtin_amdgcn_mfma_f32_32x32x16_bf16(kf[1],qr[0],negm,0,0,0), P0[6],P0[7],P0[8],P0[9],     pw0[2]=PKW(P0,4), pw0[3]=PKW(P0,6), pw0); \
    VRD(1); SBAR(); GAPA(C0=__builtin_amdgcn_mfma_f32_32x32x16_bf16(kf[2],qr[1],C0,0,0,0),   P0[10],P0[11],P0[12],P0[13], pw1[0]=PKW(P0,8), pw1[1]=PKW(P0,10), pw1); \
    VRD(5); SBAR(); GAPA(C1=__builtin_amdgcn_mfma_f32_32x32x16_bf16(kf[3],qr[1],C1,0,0,0),   P0[14],P0[15],P1[0],P1[1],   pw1[2]=PKW(P0,12),pw1[3]=PKW(P0,14), pw1); \
    VRD(2); SBAR(); GAPA(C0=__builtin_amdgcn_mfma_f32_32x32x16_bf16(kf[4],qr[2],C0,0,0,0),   P1[2],P1[3],P1[4],P1[5],     pw2[0]=PKW(P1,0), pw2[1]=PKW(P1,2), pw2); \
    VRD(6); SBAR(); GAPA(C1=__builtin_amdgcn_mfma_f32_32x32x16_bf16(kf[5],qr[2],C1,0,0,0),   P1[6],P1[7],P1[8],P1[9],     pw2[2]=PKW(P1,4), pw2[3]=PKW(P1,6), pw2); \
    VRD(3); SBAR(); GAPA(C0=__builtin_amdgcn_mfma_f32_32x32x16_bf16(kf[6],qr[3],C0,0,0,0),   P1[10],P1[11],P1[12],P1[13], pw3[0]=PKW(P1,8), pw3[1]=PKW(P1,10), pw3); \
    VRD(7); SBAR(); GAPA(C1=__builtin_amdgcn_mfma_f32_32x32x16_bf16(kf[7],qr[3],C1,0,0,0),   P1[14],P1[15],0.f,0.f,       pw3[2]=PKW(P1,12),pw3[3]=PKW(P1,14), pw3); \
    l_reg+=sacc; \
    if(GK){DMA_K((t)+3,sl_cur);} if(GV){DMA_V((t)+1,sl_next);} \
    CMASK(C0,C1,t); \
    if(!FIX){ float a=MX3(C0[0],C0[1],C1[0]),b=MX3(C0[2],C0[3],C1[1]); a=MX3(a,C1[2],C1[3]); \
      _Pragma("unroll") for(int r=4;r<16;r+=4){a=MX3(a,C0[r],C0[r+1]);b=MX3(b,C0[r+2],C0[r+3]);a=MX3(a,C1[r],C1[r+1]);b=MX3(b,C1[r+2],C1[r+3]);} \
      float rm=__builtin_fmaxf(a,b); { auto rr=__builtin_amdgcn_permlane32_swap(__float_as_uint(rm),__float_as_uint(rm),false,false); rm=__builtin_fmaxf(__uint_as_float(rr[0]),__uint_as_float(rr[1])); } \
      resc=false; \
      if(__builtin_expect(__any(rm>(float)THRL),0)){ const float dl=__builtin_fmaxf(rm,0.f); mhat+=dl; \
        _Pragma("unroll") for(int r=0;r<16;++r){C0[r]-=dl;C1[r]-=dl;} \
        _Pragma("unroll") for(int r=0;r<16;++r)negm[r]=-mhat; asm volatile("":"+v"(negm)); \
        const float f=__builtin_amdgcn_exp2f(-dl); l_reg*=f; if(hi==0)wsf[r32]=f; resc=true; } } \
    SBAR(); \
    GAPB(o[0]=__builtin_amdgcn_mfma_f32_32x32x16_bf16(PAF(0),VFR(0),o[0],0,0,0), C0,0); \
    GAPB(o[1]=__builtin_amdgcn_mfma_f32_32x32x16_bf16(PAF(0),VFR(4),o[1],0,0,0), C0,4); \
    KRD(GL,0); GAPB(o[0]=__builtin_amdgcn_mfma_f32_32x32x16_bf16(PAF(1),VFR(1),o[0],0,0,0), C0,8); \
    KRD(GL,1); GAPB(o[1]=__builtin_amdgcn_mfma_f32_32x32x16_bf16(PAF(1),VFR(5),o[1],0,0,0), C0,12); \
    KRD(GL,2); GAPB(o[0]=__builtin_amdgcn_mfma_f32_32x32x16_bf16(PAF(2),VFR(2),o[0],0,0,0), C1,0); \
    KRD(GL,3); GAPB(o[1]=__builtin_amdgcn_mfma_f32_32x32x16_bf16(PAF(2),VFR(6),o[1],0,0,0), C1,4); \
    GAPB(o[0]=__builtin_amdgcn_mfma_f32_32x32x16_bf16(PAF(3),VFR(3),o[0],0,0,0), C1,8); \
    GAPB(o[1]=__builtin_amdgcn_mfma_f32_32x32x16_bf16(PAF(3),VFR(7),o[1],0,0,0), C1,12); \
    }while(0)
  int t=1;
  for(;t+5<NT;t+=2){
    STEP(pB0,pB1,pA0,pA1,t,true,true,true);     WAIT_BAR(2); RESC(); ROT();
    STEP(pA0,pA1,pB0,pB1,t+1,true,true,true);   WAIT_BAR(2); RESC(); ROT();
  }
  #define ENDW(tt) do{ if((tt)+3<NT){WAIT_BAR(2);} else if((tt)+2<NT){WAIT_BAR(1);} else {WAIT_BAR(0);} }while(0)
  for(;t+1<NT;t+=2){
    STEP(pB0,pB1,pA0,pA1,t,(t+3<NT),(t+1<NT),(t+1<NT));       ENDW(t);   RESC(); ROT();
    STEP(pA0,pA1,pB0,pB1,t+1,(t+4<NT),(t+2<NT),(t+2<NT));     ENDW(t+1); RESC(); ROT();
  }
  STEP(pB0,pB1,pA0,pA1,NT-1,false,false,false); RESC();
  { float sacc=pB0[0]+pB0[1]; _Pragma("unroll") for(int r=2;r<16;++r)sacc+=pB0[r]; _Pragma("unroll") for(int r=0;r<16;++r)sacc+=pB1[r]; l_reg+=sacc;
    pw0=(u32x4){PKW(pB0,0),PKW(pB0,2),PKW(pB0,4),PKW(pB0,6)};pw1=(u32x4){PKW(pB0,8),PKW(pB0,10),PKW(pB0,12),PKW(pB0,14)};pw2=(u32x4){PKW(pB1,0),PKW(pB1,2),PKW(pB1,4),PKW(pB1,6)};pw3=(u32x4){PKW(pB1,8),PKW(pB1,10),PKW(pB1,12),PKW(pB1,14)};
    SBAR(); pv(o,vb0+sl_cur,PAF(0),PAF(1),PAF(2),PAF(3)); }
  #undef PKW
  #undef PAF
  #undef VFR
  #undef PIN
  #undef MX3
  #undef GAPA
  #undef GAPB
  #undef EX
  #undef VRD
  #undef KRD
  #undef STEP
  #undef ENDW
  {auto rr=__builtin_amdgcn_permlane32_swap(__float_as_uint(l_reg),__float_as_uint(l_reg),false,false);l_reg=__uint_as_float(rr[0])+__uint_as_float(rr[1]);}
  if(MODE==1)l_reg+=__builtin_amdgcn_exp2f(((pair&&wid>=4)?sink_l2b:sink_l2)-mhat);
  if(hi==0)wsf[32+r32]=l_reg;asm volatile("s_waitcnt lgkmcnt(0)":::"memory");
  float rli[16];
  #pragma unroll
  for(int r=0;r<16;++r)rli[r]=__builtin_amdgcn_rcpf(wsf[32+crow(r,hi)]);
  bf16*Ow=O0+(long)wrow*PO+wcol;
  { bf16*stg=(bf16*)(shm+LDS_OST)+wid*2048;
    #pragma unroll
    for(int r=0;r<16;++r){const int orow=crow(r,hi);
      #pragma unroll
      for(int d0=0;d0<2;++d0)stg[orow*64+d0*32+r32]=__float2bfloat16(o[d0][r]*rli[r]);}
    asm volatile("s_waitcnt lgkmcnt(0)":::"memory");
    #pragma unroll
    for(int i=0;i<4;++i){const int row=i*8+(lane>>3),ch=lane&7; const u32x4 v=*(const u32x4*)(stg+row*64+ch*8); ATTN_STORE16(Ow+(long)row*PO+ch*8,v);} }
  asm volatile("s_waitcnt lgkmcnt(0)\n\ts_barrier":::"memory");
  #undef DMA_K
  #undef DMA_V
  #undef TROW
  #undef CMASK
  #undef START
  #undef RESC
  #undef ROT
}
constexpr int ATTN_LDS_BYTES=LDS_BYTES;
#undef SBAR
#undef WAIT_BAR
}
namespace scan {
using namespace mk;
template <int NROWS> __device__ __forceinline__ int img_off(int row, int c) { return (((c >> 5) * (NROWS / 16) + (row >> 4)) << 10) + ((row & 15) << 6) + (((((c & 31) >> 3) ^ ((row >> 2) & 3))) << 4) + ((c & 7) << 1); }
__device__ __forceinline__ int tlane(int lane) { const int hh = lane >> 5, q = (lane & 15) >> 2, ch = 2 * ((lane >> 4) & 1) + ((lane & 3) >> 1), rowb = (4 * hh + q) * 64 + (lane & 1) * 8;
  const int lo = rowb + ((ch ^ hh) << 4), hi = 512 + rowb + ((ch ^ (hh + 2)) << 4); return lo | (hi << 16); }
__device__ __forceinline__ bf16x8 rfrag(LAS const char* p) { return *(LAS const bf16x8*)p; }
__device__ __forceinline__ s16x4 tr4(LAS const char* p) { return __builtin_bit_cast(s16x4, __builtin_amdgcn_ds_read_tr16_b64_v4i16((LAS s16x4*)p)); }
__device__ __forceinline__ bf16x8 tfrag(LAS const char* base, int tl) { const s16x4 lo = tr4(base + (tl & 0xffff)), hi = tr4(base + (tl >> 16)); return (bf16x8){lo[0], lo[1], lo[2], lo[3], hi[0], hi[1], hi[2], hi[3]}; }
__device__ __forceinline__ bf16x8 pack8(const f32x16& s, int b) {
  u32x4 w; w.x = cvtpk(s[b], s[b + 1]); w.y = cvtpk(s[b + 2], s[b + 3]); w.z = cvtpk(s[b + 4], s[b + 5]); w.w = cvtpk(s[b + 6], s[b + 7]); return __builtin_bit_cast(bf16x8, w);
}
#define MFMA32(a, b, c) __builtin_amdgcn_mfma_f32_32x32x16_bf16(a, b, c, 0, 0, 0)

template <int DK, int DV>
__device__ __forceinline__ void chunk_core(LAS const char* Qm, LAS const char* Km, LAS const char* Vm, LAS const char* Ss, LAS const float* rowexp, LAS const float* colexp, LAS const float* isc,
                                           f32x16& res0, f32x16& res1, int wid, int lane) {
  constexpr int KS = DK / 16, NVT = DV / 32;
  const int vp = wid >> 2, tb = vp ? 3 - (wid & 3) : (wid & 3), r32 = lane & 31, hh = lane >> 5, tl = tlane(lane);
  constexpr bool HOLDQ = (KS <= 4);
  constexpr int PD = KS < 4 ? KS : 4;
  bf16x8 qf[HOLDQ ? KS : 1];
  if (HOLDQ) {
#pragma unroll
    for (int ks = 0; ks < KS; ++ks) qf[ks] = rfrag(Qm + img_off<128>(32 * tb + r32, 16 * ks + 8 * hh)); }
#define QF(ks) (HOLDQ ? qf[HOLDQ ? (ks) : 0] : rfrag(Qm + img_off<128>(32 * tb + r32, 16 * (ks) + 8 * hh)))
  f32x16 o0 = {}, o1 = {};
  const float re = rowexp[32 * tb + r32];
  if (tb >= 2) __builtin_amdgcn_s_setprio(1);
#pragma unroll 1
  for (int st = 0; st <= tb; ++st) {
    f32x16 s = {};
    float ce[16];
    {
      bf16x8 kfr[PD], qfr[HOLDQ ? 1 : PD];
#pragma unroll
      for (int ks = 0; ks < PD; ++ks) { kfr[ks] = rfrag(Km + img_off<128>(32 * st + r32, 16 * ks + 8 * hh)); if (!HOLDQ) qfr[ks] = rfrag(Qm + img_off<128>(32 * tb + r32, 16 * ks + 8 * hh)); }
      __builtin_amdgcn_sched_barrier(0);
#pragma unroll
      for (int ks = 0; ks < KS; ++ks) {
        s = MFMA32(kfr[ks % PD], HOLDQ ? qf[HOLDQ ? ks : 0] : qfr[HOLDQ ? 0 : ks % PD], s);
        if (ks + PD < KS) { kfr[ks % PD] = rfrag(Km + img_off<128>(32 * st + r32, 16 * (ks + PD) + 8 * hh)); if (!HOLDQ) qfr[ks % PD] = rfrag(Qm + img_off<128>(32 * tb + r32, 16 * (ks + PD) + 8 * hh)); }
        if (ks == KS - 2) {
#pragma unroll
          for (int r = 0; r < 16; ++r) ce[r] = colexp[32 * st + crow(r, hh)]; }
        __builtin_amdgcn_sched_barrier(0); } }
#pragma unroll
    for (int r = 0; r < 16; ++r) { const int sl = crow(r, hh); float w = __builtin_amdgcn_exp2f(re + ce[r]); if (st == tb && sl > r32) w = 0.f; s[r] *= w; }
    const bf16x8 pa0 = pack8(s, 0), pa1 = pack8(s, 8);
    { const bf16x8 v0 = tfrag(Vm + ((vp * 8 + 2 * st) << 10), tl), v1 = tfrag(Vm + ((vp * 8 + 2 * st + 1) << 10), tl); o0 = MFMA32(pa0, v0, o0); o0 = MFMA32(pa1, v1, o0); }
    if (NVT > 2 && vp == 0) { const bf16x8 v0 = tfrag(Vm + ((2 * 8 + 2 * st) << 10), tl), v1 = tfrag(Vm + ((2 * 8 + 2 * st + 1) << 10), tl); o1 = MFMA32(pa0, v0, o1); o1 = MFMA32(pa1, v1, o1); }
  }
  f32x16 i0 = {}, i1 = {};
#define INTER_RING(acc_, row_) do { bf16x8 sfr[PD], qfr[HOLDQ ? 1 : PD]; \
    _Pragma("unroll") for (int ks = 0; ks < PD; ++ks) { sfr[ks] = rfrag(Ss + img_off<DV>((row_) + r32, 16 * ks + 8 * hh)); if (!HOLDQ) qfr[ks] = rfrag(Qm + img_off<128>(32 * tb + r32, 16 * ks + 8 * hh)); } \
    __builtin_amdgcn_sched_barrier(0); \
    _Pragma("unroll") for (int ks = 0; ks < KS; ++ks) { acc_ = MFMA32(HOLDQ ? qf[HOLDQ ? ks : 0] : qfr[HOLDQ ? 0 : ks % PD], sfr[ks % PD], acc_); \
      if (ks + PD < KS) { sfr[ks % PD] = rfrag(Ss + img_off<DV>((row_) + r32, 16 * (ks + PD) + 8 * hh)); if (!HOLDQ) qfr[ks % PD] = rfrag(Qm + img_off<128>(32 * tb + r32, 16 * (ks + PD) + 8 * hh)); } \
      __builtin_amdgcn_sched_barrier(0); } } while (0)
  INTER_RING(i0, 32 * vp);
  if (NVT > 2 && vp == 0) INTER_RING(i1, 64);
#undef INTER_RING
#pragma unroll
  for (int r = 0; r < 16; ++r) { const float sc = isc[32 * tb + crow(r, hh)]; res0[r] = o0[r] + sc * i0[r]; res1[r] = o1[r] + sc * i1[r]; }
  __builtin_amdgcn_s_setprio(0);
#undef QF
}
template <int DK, int DV>
__device__ __forceinline__ void state_update(LAS const char* Km, LAS const char* Vw, LAS char* Ss, f32x16& st_acc, float sd, int wid, int lane) {
  constexpr int NVT = DV / 32, NDT = DK / 32;
  if (wid < NVT * NDT) {
    const int vt = wid / NDT, dt_ = wid % NDT, r32 = lane & 31, hh = lane >> 5, tl = tlane(lane);
#pragma unroll
    for (int r = 0; r < 16; ++r) st_acc[r] *= sd;
    f32x16 st2 = {};
    bf16x8 fa[2][2], fb[2][2];
#pragma unroll
    for (int j = 0; j < 2; ++j) { fa[0][j] = tfrag(Vw + ((vt * 8 + j) << 10), tl); fb[0][j] = tfrag(Km + ((dt_ * 8 + j) << 10), tl); }
    __builtin_amdgcn_sched_barrier(0);
#pragma unroll
    for (int ks = 0; ks < 8; ks += 2) { const int cb = (ks >> 1) & 1;
      if (ks + 2 < 8) {
#pragma unroll
        for (int j = 0; j < 2; ++j) { fa[cb ^ 1][j] = tfrag(Vw + ((vt * 8 + ks + 2 + j) << 10), tl); fb[cb ^ 1][j] = tfrag(Km + ((dt_ * 8 + ks + 2 + j) << 10), tl); } }
      st_acc = MFMA32(fa[cb][0], fb[cb][0], st_acc); st2 = MFMA32(fa[cb][1], fb[cb][1], st2);
      __builtin_amdgcn_sched_barrier(0); }
#pragma unroll
    for (int r = 0; r < 16; ++r) st_acc[r] += st2[r];
#pragma unroll
    for (int r = 0; r < 16; ++r) *(LAS bf16*)(Ss + img_off<DV>(32 * vt + crow(r, hh), 32 * dt_ + r32)) = f2bf(st_acc[r]);
  }
}
__device__ __forceinline__ float wscan_add(float x, int lane) {
#pragma unroll
  for (int o = 1; o < 64; o <<= 1) { const float y = __shfl_up(x, o); if (lane >= o) x += y; }
  return x;
}
__device__ __forceinline__ float wscan_max(float x, int lane) {
#pragma unroll
  for (int o = 1; o < 64; o <<= 1) { const float y = __shfl_up(x, o); if (lane >= o) x = fmaxf(x, y); }
  return x;
}
__device__ __forceinline__ void chunk_rows(int cc, int dir, int& row0, int& seg0, int& seglen) {
  if (cc < 2) { const int ci = dir ? 1 - cc : cc; row0 = 128 * ci; seg0 = 0; seglen = NC; }
  else { const int ci = dir ? 31 - (cc - 2) : (cc - 2); row0 = NC + 128 * ci; seg0 = NC; seglen = T; }
}
#define SCAN_BAR() do { asm volatile("s_waitcnt vmcnt(0) lgkmcnt(0)" ::: "memory"); __builtin_amdgcn_s_barrier(); asm volatile("" ::: "memory"); } while (0)

__device__ __forceinline__ size_t g2_block(int b, int c, int dh) { return ((size_t)(b * 34 + c) * 8 + dh) * 1024; }
__device__ __forceinline__ void chunk_scalars(const float* __restrict__ G, float* __restrict__ G2, const float* __restrict__ a_log, const float* __restrict__ dt_bias, const float* __restrict__ b_i, const float* __restrict__ b_f, int b, int c, int dh, int lane) {
  const size_t rowb = (size_t)b * RB; const int row0 = c < 2 ? 128 * c : NC + 128 * (c - 2);
  { const int dir = dh >> 2, h = dh & 3;
    size_t rr[2];
#pragma unroll
    for (int e = 0; e < 2; ++e) { const int i = 2 * lane + e, io = dir ? 127 - i : i; rr[e] = rowb + row0 + io; }
    {
      const float a = -__expf(a_log[dh]), dtb = dt_bias[dh]; float dt2[2], cum2[2];
#pragma unroll
      for (int e = 0; e < 2; ++e) { const float dr = G[rr[e] * 32 + 16 + dh] + dtb; dt2[e] = dr > 20.f ? dr : __logf(1.f + __expf(dr)); }
      const float p0 = dt2[0] * a, p1 = p0 + dt2[1] * a; const float inc = wscan_add(p1, lane); const float exc = inc - p1;
      cum2[0] = exc + p0; cum2[1] = exc + p1; const float cend = __shfl(inc, 63); const float sdv = __builtin_amdgcn_exp2f(cend * L2E);
      float* gb = G2 + g2_block(b, c, dh) + 2 * lane;
      *(f32x2v*)(gb) = (f32x2v){cum2[0] * L2E, cum2[1] * L2E};
      *(f32x2v*)(gb + 128) = (f32x2v){-cum2[0] * L2E + __builtin_amdgcn_logf(dt2[0]), -cum2[1] * L2E + __builtin_amdgcn_logf(dt2[1])};
      *(f32x2v*)(gb + 256) = (f32x2v){__builtin_amdgcn_exp2f(cum2[0] * L2E), __builtin_amdgcn_exp2f(cum2[1] * L2E)};
      *(f32x2v*)(gb + 384) = (f32x2v){__builtin_amdgcn_exp2f((cend - cum2[0]) * L2E) * dt2[0], __builtin_amdgcn_exp2f((cend - cum2[1]) * L2E) * dt2[1]};
      if (lane == 0) gb[896] = sdv; }
    {
      const float bi = b_i[dh], bfg = b_f[dh]; float ig[2], lf[2];
#pragma unroll
      for (int e = 0; e < 2; ++e) { const float* gr = G + rr[e] * 32; ig[e] = gr[(2 * dir) * 4 + h] + bi; const float fg = gr[(2 * dir + 1) * 4 + h] + bfg; lf[e] = fminf(fg, 0.f) - __logf(1.f + __expf(-fabsf(fg))); }
      const float p1 = lf[0] + lf[1]; const float inc = wscan_add(p1, lane); const float exc = inc - p1;
      const float bb0 = exc + lf[0], bb1 = exc + p1, aa0 = ig[0] - bb0, aa1 = ig[1] - bb1;
      const float q1m = fmaxf(aa0, aa1); const float incm = wscan_max(q1m, lane); float excm = __shfl_up(incm, 1); if (lane == 0) excm = -INFINITY;
      float* gb = G2 + g2_block(b, c, dh) + 512 + 2 * lane;
      *(f32x2v*)(gb) = (f32x2v){aa0, aa1}; *(f32x2v*)(gb + 128) = (f32x2v){fmaxf(excm, aa0), fmaxf(excm, q1m)}; *(f32x2v*)(gb + 256) = (f32x2v){bb0, bb1}; } }
}
#define SCAN_BAR_L() do { asm volatile("s_waitcnt lgkmcnt(0)" ::: "memory"); __builtin_amdgcn_s_barrier(); asm volatile("" ::: "memory"); } while (0)

__device__ __forceinline__ void mamba_chain(LAS char* lds, const bf16* __restrict__ UC, const float* __restrict__ G2, bf16* __restrict__ YD, int b, int h, int dir, int pm = 15, int skipn = 0) {
  int tid_ = threadIdx.x; asm volatile("" : "+v"(tid_));
  const int tid = tid_, lane = tid & 63, wid = __builtin_amdgcn_readfirstlane(tid >> 6), g = h >> 1;
  LAS char* Qm = lds; LAS char* Km = lds + 32768; LAS char* Vm = lds + 65536; LAS char* Vw = lds + 81920; LAS char* Ss = lds + 98304;
  LAS float* rowexp = (LAS float*)(lds + 114688); LAS float* colexp = rowexp + 128; LAS float* isc = rowexp + 256; LAS float* vw = rowexp + 384; LAS float* misc = rowexp + 512;
  for (int i = tid; i < 16384 / 4; i += 512) ((LAS unsigned*)Ss)[i] = 0u;
  f32x16 st_acc = {};
  const size_t rowb = (size_t)b * RB;
  u32x4 pb[4], pcq[4], px[2]; f32x4 scn = {0.f, 0.f, 0.f, 0.f}; float sdn = 0.f;
  const int rB = tid >> 4, cB = tid & 15, rX = tid >> 3, cX = tid & 7;
  const int iB = dir ? 127 - rB : rB, iX = dir ? 127 - rX : rX; const int oB = img_off<128>(iB, cB * 8), oX = img_off<128>(iX, cX * 8); const int stB = dir ? -2048 : 2048, stX = dir ? -4096 : 4096;
#define MAMBA_LOAD(cc_) do { int row0_, seg0_, seglen_; chunk_rows((cc_), dir, row0_, seg0_, seglen_); \
    const bf16* ub_ = UC + (rowb + row0_ + rB) * 768 + 256 + g * 128 + cB * 8; const bf16* ux_ = UC + (rowb + row0_ + rX) * 768 + h * 64 + cX * 8; \
    _Pragma("unroll") for (int k = 0; k < 4; ++k) { pb[k] = *(const u32x4*)(ub_ + (size_t)k * 32 * 768); pcq[k] = *(const u32x4*)(ub_ + (size_t)k * 32 * 768 + 256); } \
    _Pragma("unroll") for (int k = 0; k < 2; ++k) px[k] = *(const u32x4*)(ux_ + (size_t)k * 64 * 768); \
    { const float* gp_ = G2 + g2_block(b, row0_ < NC ? row0_ >> 7 : 2 + ((row0_ - NC) >> 7), dir * 4 + h); if (tid < 128) { scn = (f32x4){gp_[tid], gp_[128 + tid], gp_[256 + tid], gp_[384 + tid]}; sdn = gp_[896]; } } } while (0)
  MAMBA_LOAD(0);
  SCAN_BAR();
#pragma unroll 1
  for (int cc = 0; cc < 34; ++cc) {
    int row0, seg0, seglen; chunk_rows(cc, dir, row0, seg0, seglen);
    if (tid < 128 && (pm & 1)) { rowexp[tid] = scn[0]; colexp[tid] = scn[1]; isc[tid] = scn[2]; vw[tid] = scn[3]; if (tid == 0) misc[0] = sdn; }
    SCAN_BAR_L();
    if (pm & 2) {
#pragma unroll
      for (int k = 0; k < 4; ++k) { *(LAS u32x4*)(Km + oB + k * stB) = pb[k]; *(LAS u32x4*)(Qm + oB + k * stB) = pcq[k]; }
#pragma unroll
      for (int k = 0; k < 2; ++k) { const int i = dir ? iX - 64 * k : iX + 64 * k; const float sv = vw[i]; u32x4 pw;
#pragma unroll
        for (int e = 0; e < 4; ++e) pw[e] = cvtpk(bf_lo(px[k][e]) * sv, bf_hi(px[k][e]) * sv);
        *(LAS u32x4*)(Vm + oX + k * stX) = px[k]; *(LAS u32x4*)(Vw + oX + k * stX) = pw; }
    }
    SCAN_BAR_L();
    if (cc + 1 < 34 && (pm & 2)) MAMBA_LOAD(cc + 1);
    const bool sk = cc < skipn;
    f32x16 res0 = {}, res1 = {}; if ((pm & 4) && !sk) chunk_core<128, 64>(Qm, Km, Vm, Ss, rowexp, colexp, isc, res0, res1, wid, lane);
    if (pm == 15 && !sk) { const int vp = wid >> 2, tb = vp ? 3 - (wid & 3) : (wid & 3), r32 = lane & 31, hh = lane >> 5; LAS char* ot = lds + (vp ? 132096 : 117248);
#pragma unroll
      for (int r = 0; r < 16; ++r) *(LAS bf16*)(ot + (32 * tb + crow(r, hh)) * 64 + r32 * 2) = f2bf(res0[r]); }
    const float sd = misc[0];
    SCAN_BAR_L();
    if (pm == 15 && !sk) {
#pragma unroll
      for (int k = 0; k < 2; ++k) { const int t = (tid >> 3) + 64 * k, pc = tid & 7, io = dir ? 127 - t : t;
        const u32x4 v = *(LAS const u32x4*)(lds + ((pc >> 2) ? 132096 : 117248) + t * 64 + (pc & 3) * 16);
        *(u32x4*)(YD + ((size_t)dir * M + rowb + row0 + io) * 256 + h * 64 + pc * 8) = v; } }
    if (pm & 8) state_update<128, 64>(Km, Vw, Ss, st_acc, sd, wid, lane);
  }
#undef MAMBA_LOAD
  SCAN_BAR();
}

__device__ __forceinline__ void mlstm_chain(LAS char* lds, const bf16* __restrict__ P, const float* __restrict__ G2, bf16* __restrict__ HC, int b, int h, int dir, int skipn = 0) {
  int tid_ = threadIdx.x; asm volatile("" : "+v"(tid_));
  const int tid = tid_, lane = tid & 63, wid = __builtin_amdgcn_readfirstlane(tid >> 6);
  LAS char* Qm = lds; LAS char* Km = lds + 16384; LAS char* Vm = lds + 32768; LAS char* Vw = lds + 57344; LAS char* Ss = lds + 81920;
  LAS float* rowexp = (LAS float*)(lds + 94208); LAS float* colexp = rowexp + 128; LAS float* isc = rowexp + 256; LAS float* vw = rowexp + 384; LAS float* emn = rowexp + 512; LAS float* den = rowexp + 640; LAS float* misc = rowexp + 768;
  for (int i = tid; i < 12288 / 4; i += 512) ((LAS unsigned*)Ss)[i] = 0u;
  f32x16 st_acc = {};
  float m_prev = 0.f;
  const size_t rowb = (size_t)b * RB;
  const int io = tid >> 2, part = tid & 3, i = dir ? 127 - io : io;
  u32x4 q0, q1, k0, k1, v0, v1; float an = 0.f, pmn = 0.f, bn = 0.f, pm_end = 0.f, b_end = 0.f;
#define MLSTM_LOAD(cc_) do { int row0_, seg0_, seglen_; chunk_rows((cc_), dir, row0_, seg0_, seglen_); \
    const bf16* pr = P + (rowb + row0_ + io) * NP + h * 64 + part * 16; \
    q0 = *(const u32x4*)(pr + 1024); q1 = *(const u32x4*)(pr + 1024 + 8); k0 = *(const u32x4*)(pr + 1280); k1 = *(const u32x4*)(pr + 1280 + 8); v0 = *(const u32x4*)(pr + 1536); v1 = *(const u32x4*)(pr + 1536 + 8); \
    { const float* gp_ = G2 + g2_block(b, row0_ < NC ? row0_ >> 7 : 2 + ((row0_ - NC) >> 7), dir * 4 + h) + 512; pm_end = gp_[128 + 127]; b_end = gp_[256 + 127]; \
      if (tid < 128) { an = gp_[tid]; pmn = gp_[128 + tid]; bn = gp_[256 + tid]; } } } while (0)
#define MLSTM_FLUSH(r0_) do { _Pragma("unroll") for (int k = 0; k < 2; ++k) { const int t = (tid >> 3) + 64 * k, pc = tid & 7, ioo = dir ? 127 - t : t; \
      const u32x4 v = *(LAS const u32x4*)(lds + 98304 + t * 128 + pc * 16); *(u32x4*)(HC + ((size_t)dir * M + rowb + (r0_) + ioo) * 256 + h * 64 + pc * 8) = v; } } while (0)
  int prow0 = 0;
  MLSTM_LOAD(0);
  SCAN_BAR();
#pragma unroll 1
  for (int cc = 0; cc < 34; ++cc) {
    int row0, seg0, seglen; chunk_rows(cc, dir, row0, seg0, seglen);
    { const float mm_end = fmaxf(m_prev, pm_end);
      if (tid < 128) { const float mm = fmaxf(m_prev, pmn); rowexp[tid] = -mm * L2E; colexp[tid] = an * L2E; isc[tid] = __builtin_amdgcn_exp2f((m_prev - mm) * L2E); emn[tid] = __builtin_amdgcn_exp2f(-(bn + mm) * L2E); vw[tid] = __builtin_amdgcn_exp2f((an - mm_end) * L2E);
        if (tid == 0) misc[0] = __builtin_amdgcn_exp2f((m_prev - mm_end) * L2E); }
      m_prev = b_end + mm_end; }
    SCAN_BAR_L();
    if (cc > skipn) MLSTM_FLUSH(prow0);
    prow0 = row0;
    {
      const float s = vw[i];
      u32x4 qa, qb, va, vb;
#pragma unroll
      for (int e = 0; e < 4; ++e) { qa[e] = cvtpk(bf_lo(q0[e]) * 0.125f, bf_hi(q0[e]) * 0.125f); qb[e] = cvtpk(bf_lo(q1[e]) * 0.125f, bf_hi(q1[e]) * 0.125f);
        va[e] = cvtpk(bf_lo(v0[e]) * s, bf_hi(v0[e]) * s); vb[e] = cvtpk(bf_lo(v1[e]) * s, bf_hi(v1[e]) * s); }
      const int o0 = img_off<128>(i, part * 16), o1 = img_off<128>(i, part * 16 + 8);
      *(LAS u32x4*)(Qm + o0) = qa; *(LAS u32x4*)(Qm + o1) = qb; *(LAS u32x4*)(Km + o0) = k0; *(LAS u32x4*)(Km + o1) = k1;
      *(LAS u32x4*)(Vm + o0) = v0; *(LAS u32x4*)(Vm + o1) = v1; *(LAS u32x4*)(Vw + o0) = va; *(LAS u32x4*)(Vw + o1) = vb;
      const int o2 = img_off<128>(i, 64 + part * 8);
      const unsigned one = part == 0 ? 0x3f80u : 0u, wkb = part == 0 ? (cvtpk(s, 0.f) & 0xffffu) : 0u;
      *(LAS u32x4*)(Vm + o2) = (u32x4){one, 0u, 0u, 0u}; *(LAS u32x4*)(Vw + o2) = (u32x4){wkb, 0u, 0u, 0u};
    }
    SCAN_BAR_L();
    if (cc + 1 < 34) MLSTM_LOAD(cc + 1);
    const bool sk = cc < skipn;
    f32x16 res0 = {}, res1 = {}; if (!sk) chunk_core<64, 96>(Qm, Km, Vm, Ss, rowexp, colexp, isc, res0, res1, wid, lane);
    const int vp = wid >> 2, tb = vp ? 3 - (wid & 3) : (wid & 3), r32 = lane & 31, hh = lane >> 5;
    if (vp == 0 && r32 == 0 && !sk) {
#pragma unroll
      for (int r = 0; r < 16; ++r) den[32 * tb + crow(r, hh)] = res1[r];
    }
    const float sd = misc[0];
    float em[16];
#pragma unroll
    for (int r = 0; r < 16; ++r) em[r] = emn[32 * tb + crow(r, hh)];
    SCAN_BAR_L();
    if (!sk)
#pragma unroll
    for (int r = 0; r < 16; ++r) { const int t = 32 * tb + crow(r, hh); const float dn = fmaxf(fabsf(den[t]), em[r]);
      *(LAS bf16*)(lds + 98304 + t * 128 + (32 * vp + r32) * 2) = f2bf(res0[r] / dn); }
    state_update<64, 96>(Km, Vw, Ss, st_acc, sd, wid, lane);
  }
#undef MLSTM_LOAD
  SCAN_BAR();
  MLSTM_FLUSH(prow0);
#undef MLSTM_FLUSH
  SCAN_BAR();
}
#undef MFMA32
}
namespace pg8 {
typedef float f32x4e __attribute__((ext_vector_type(4)));
typedef unsigned u32x2 __attribute__((ext_vector_type(2)));
struct FusedNorm {
    const float* SS; const float* bias; int fused, fused_ctx; const PG8_LAS float* rsT; mutable int ui;
    __device__ __forceinline__ bool on(const Unit& u) const { return fused && (fused_ctx || (u.pm % 17) != 0); }
    __device__ __forceinline__ void load(const Unit& u, int wr, int fr, int col0, float (&rs)[2][4], f32x4 (&bv)[2][2]) const {
        const int b = u.pm / 17, tp = u.pm % 17; const __attribute__((address_space(1))) float* bp = (const __attribute__((address_space(1))) float*)bias + (tp == 0 ? 8 : b) * 4096 + col0;
#pragma unroll
        for (int bj = 0; bj < 2; ++bj) { bv[bj][0] = *(const __attribute__((address_space(1))) f32x4*)(bp + bj * HALF); bv[bj][1] = *(const __attribute__((address_space(1))) f32x4*)(bp + bj * HALF + 4); }
#pragma unroll
        for (int ai = 0; ai < 2; ++ai)
#pragma unroll
            for (int m = 0; m < 4; ++m) rs[ai][m] = rsT[ui * 256 + ai * HALF + wr * 64 + m * 16 + fr];
    }
    template <class Sched> __device__ __forceinline__ void fill(const Sched& S, PG8_LAS float* tab, int tid) const {
        Unit u;
        for (int i = 0; S.next(i, u); ++i) { const int row = tid >> 1, half = tid & 1; float v = 1.f;
            if (on(u)) { const __attribute__((address_space(1))) f32x4* p = (const __attribute__((address_space(1))) f32x4*)(SS + ((size_t)u.pm * BM + row) * 16 + half * 8); const f32x4 t = p[0] + p[1]; float sum = (t[0] + t[1]) + (t[2] + t[3]); sum += __shfl_xor(sum, 1);
                v = __builtin_amdgcn_rsqf(sum * (1.f / 1024.f) + 1e-6f); }
            if (half == 0) tab[i * 256 + row] = v; }
        __syncthreads();
    }
};
#ifndef MK_NT_U
#define MK_NT_U true
#endif
#ifndef MK_NT_P
#define MK_NT_P true
#endif
__host__ __device__ __forceinline__ int lcol(int p) { return (p & ~255) + ((p >> 5) & 3) * 64 + ((p >> 7) & 1) * 32 + (p & 31); }
__device__ __forceinline__ u32x4 ror8(const u32x4 v) { u32x4 r;
#pragma unroll
    for (int e = 0; e < 4; ++e) r[e] = (unsigned)__builtin_amdgcn_update_dpp(0, (int)v[e], 0x128, 0xF, 0xF, true);
    return r; }
template <bool NT = false> __device__ __forceinline__ void store_rows128(bf16_t* rp, int ld, int fr, int fq, const u32x4 w0, const u32x4 w1) {
    const u32x4 x0 = ror8(w0), x1 = ror8(w1); const bool lo = fr < 8; u32x4 dA, dB;
#pragma unroll
    for (int e = 0; e < 4; ++e) { dA[e] = lo ? w0[e] : x1[e]; dB[e] = lo ? x0[e] : w1[e]; }
    bf16_t* q = rp + (size_t)(fr & 7) * ld + (lo ? 0 : 32) + 8 * fq;
    if (NT) { __builtin_nontemporal_store(dA, (u32x4*)q); __builtin_nontemporal_store(dB, (u32x4*)(q + (size_t)8 * ld)); }
    else { *(u32x4*)q = dA; *(u32x4*)(q + (size_t)8 * ld) = dB; }
}
struct EpiInProj {
    static constexpr bool PERM = true, AFTER_DRAIN = false;
    bf16_t* O; float* G; FusedNorm F;
    __device__ __forceinline__ void operator()(const f32x4 (&acc)[2][2][4][2], const Unit& u, int wr, int wc, int fr, int fq) const {
        const int row0 = u.pm * BM + wr * 64 + fr, col0 = u.pn * BM + wc * 32 + 8 * fq;
        float rs[2][4]; f32x4 bv[2][2]; const bool fz = F.on(u);
        if (fz) F.load(u, wr, fr, col0, rs, bv);
        else {
#pragma unroll
            for (int ai = 0; ai < 2; ++ai)
#pragma unroll
                for (int m = 0; m < 4; ++m) rs[ai][m] = 1.f;
#pragma unroll
            for (int bj = 0; bj < 2; ++bj) { bv[bj][0] = (f32x4){0.f, 0.f, 0.f, 0.f}; bv[bj][1] = (f32x4){0.f, 0.f, 0.f, 0.f}; } }
        if (u.pn != 12)
#pragma unroll
        for (int ai = 0; ai < 2; ++ai)
#pragma unroll
            for (int m = 0; m < 4; ++m) { const float r_ = rs[ai][m]; u32x4 w[2];
#pragma unroll
                for (int bj = 0; bj < 2; ++bj) { const f32x4 v0 = acc[ai][bj][m][0] * r_ + bv[bj][0], v1 = acc[ai][bj][m][1] * r_ + bv[bj][1];
                    w[bj].x = cvt_pk_bf16(v0[0], v0[1]); w[bj].y = cvt_pk_bf16(v0[2], v0[3]); w[bj].z = cvt_pk_bf16(v1[0], v1[1]); w[bj].w = cvt_pk_bf16(v1[2], v1[3]); }
                store_rows128<MK_NT_P>(O + (size_t)(u.pm * BM + wr * 64 + ai * HALF + m * 16) * 3328 + u.pn * BM + wc * 64, 3328, fr, fq, w[0], w[1]); }
        if (u.pn == 12 && wc == 0) {
#pragma unroll
            for (int ai = 0; ai < 2; ++ai)
#pragma unroll
                for (int m = 0; m < 4; ++m) { float* gp = G + (size_t)(row0 + ai * HALF + m * 16) * 32 + 8 * fq; const float r_ = rs[ai][m]; *(f32x4*)gp = acc[ai][0][m][0] * r_ + bv[0][0]; *(f32x4*)(gp + 4) = acc[ai][0][m][1] * r_ + bv[0][1]; }
        }
        ++F.ui;
    }
};
struct EpiRelu2 {
    static constexpr bool PERM = true, AFTER_DRAIN = false;
    bf16_t* O; FusedNorm F;
    __device__ __forceinline__ void operator()(const f32x4 (&acc)[2][2][4][2], const Unit& u, int wr, int wc, int fr, int fq) const {
        const int row0 = u.pm * BM + wr * 64 + fr, col0 = u.pn * BM + wc * 32 + 8 * fq;
        float rs[2][4]; f32x4 bv[2][2]; const bool fz = F.on(u);
        if (fz) F.load(u, wr, fr, col0, rs, bv);
        else {
#pragma unroll
            for (int ai = 0; ai < 2; ++ai)
#pragma unroll
                for (int m = 0; m < 4; ++m) rs[ai][m] = 1.f;
#pragma unroll
            for (int bj = 0; bj < 2; ++bj) { bv[bj][0] = (f32x4){0.f, 0.f, 0.f, 0.f}; bv[bj][1] = (f32x4){0.f, 0.f, 0.f, 0.f}; } }
#pragma unroll
        for (int ai = 0; ai < 2; ++ai)
#pragma unroll
            for (int m = 0; m < 4; ++m) { const float r_ = rs[ai][m]; u32x4 w[2];
#pragma unroll
                for (int bj = 0; bj < 2; ++bj) { f32x4 v0 = acc[ai][bj][m][0] * r_ + bv[bj][0], v1 = acc[ai][bj][m][1] * r_ + bv[bj][1];
#pragma unroll
                    for (int e = 0; e < 4; ++e) { const float a = v0[e] > 0.f ? v0[e] : 0.f, b = v1[e] > 0.f ? v1[e] : 0.f; v0[e] = a * a; v1[e] = b * b; }
                    w[bj].x = cvt_pk_bf16(v0[0], v0[1]); w[bj].y = cvt_pk_bf16(v0[2], v0[3]); w[bj].z = cvt_pk_bf16(v1[0], v1[1]); w[bj].w = cvt_pk_bf16(v1[2], v1[3]); }
                store_rows128<MK_NT_U>(O + ((size_t)(u.pm * 64 + u.pn * 4 + wc) * 256 + (wr * 64 + ai * HALF + m * 16)) * 64, 64, fr, fq, w[0], w[1]); }
        ++F.ui;
    }
};
template <class T> __device__ __forceinline__ T* uni_ptr(T* p) { const unsigned long long v = (unsigned long long)(uintptr_t)p; const unsigned lo = (unsigned)__builtin_amdgcn_readfirstlane((int)(unsigned)v), hi = (unsigned)__builtin_amdgcn_readfirstlane((int)(unsigned)(v >> 32)); return (T*)(uintptr_t)(((unsigned long long)hi << 32) | lo); }
typedef _Float16 h16x2 __attribute__((ext_vector_type(2)));
typedef float f32x2e __attribute__((ext_vector_type(2)));
__device__ __forceinline__ unsigned pk_h16(float lo, float hi) { const f32x2e v = {lo, hi}; return __builtin_bit_cast(unsigned, __builtin_convertvector(v, h16x2)); }
__device__ __forceinline__ float h16_lo(unsigned w) { return (float)__builtin_bit_cast(h16x2, w)[0]; }
__device__ __forceinline__ float h16_hi(unsigned w) { return (float)__builtin_bit_cast(h16x2, w)[1]; }
template <bool XF32>
struct EpiResid {
    static constexpr bool PERM = false, AFTER_DRAIN = false;
    unsigned char* ws; const float* x_in; const float* ctx_in; const float* g_next; int l, flags;
    __device__ __forceinline__ void operator()(const f32x4 (&acc)[2][2][4][2], const Unit& u, int wr, int wc, int fr, int fq) const {
        const int b = u.pm / 17, tp = u.pm % 17, mb = tp == 0 ? 8 : b; const bool is_ff2 = flags & 1, fuse = flags & 2; const float gsign = (flags & 4) ? -1.f : 1.f;
        const float* modl = (const float*)(ws + mk::WS_MOD) + (size_t)l * 9 * 6144;
        const size_t grow0 = (size_t)u.pm * BM;
        bf16_t* xs = (bf16_t*)(ws + mk::WS_XS) + grow0 * 1024;
        const void* xin = xs;
        if (XF32) xin = uni_ptr(tp == 0 ? ctx_in + (size_t)b * 256 * 1024 : x_in + ((size_t)b * 4096 + (size_t)(tp - 1) * 256) * 1024);
        const auto rin = __builtin_amdgcn_make_buffer_rsrc((void*)xin, 0, 256 * 1024 * (XF32 ? 4 : 2), 0x00020000), rxs = __builtin_amdgcn_make_buffer_rsrc((void*)xs, 0, 256 * 1024 * 2, 0x00020000);
        const auto rh = __builtin_amdgcn_make_buffer_rsrc((void*)((bf16_t*)(ws + mk::WS_H) + grow0 * 1024), 0, 256 * 1024 * 2, 0x00020000);
        const auto rgate = __builtin_amdgcn_make_buffer_rsrc((void*)(modl + mb * 6144 + (is_ff2 ? 5120 : 2048)), 0, 4096, 0x00020000);
        const auto rsc = __builtin_amdgcn_make_buffer_rsrc((void*)((is_ff2 ? (const float*)(ws + mk::WS_MOD) + (size_t)9 * 6144 + 1024 : modl + 4096) + mb * 6144), 0, 4096, 0x00020000);
        const auto rgn = __builtin_amdgcn_make_buffer_rsrc((void*)g_next, 0, 4096, 0x00020000);
        typedef __attribute__((address_space(1))) u32x4 gu4; typedef __attribute__((address_space(1))) bf16_t gb16;
        gb16* xsb = (gb16*)uni_ptr(xs); gb16* hb = (gb16*)uni_ptr((bf16_t*)(ws + mk::WS_H) + grow0 * 1024);
        const int colw = u.pn * BM + wc * 32 + (fq & 1) * 16 + (fq >> 1) * 8;
        const unsigned vb = (unsigned)(((wr * 64 + fr) * 1024 + colw) * 2), vc = (unsigned)(colw * 4);
        float ssq[2][4];
#pragma unroll
        for (int ai = 0; ai < 2; ++ai)
#pragma unroll
            for (int m = 0; m < 4; ++m) ssq[ai][m] = 0.f;
#pragma unroll
        for (int bj = 0; bj < 2; ++bj) { const int cb = bj * HALF;
            u32x4 gvr[2], gnr[2], scr_[2], xr[2][4][XF32 ? 2 : 1];
#pragma unroll
            for (int h = 0; h < 2; ++h) { gvr[h] = __builtin_amdgcn_raw_buffer_load_b128(rgate, vc + cb * 4 + h * 16, 0, 0); gnr[h] = __builtin_amdgcn_raw_buffer_load_b128(rgn, vc + cb * 4 + h * 16, 0, 0); scr_[h] = __builtin_amdgcn_raw_buffer_load_b128(rsc, vc + cb * 4 + h * 16, 0, 0); }
#pragma unroll
            for (int h = 0; h < (XF32 ? 2 : 1); ++h)
#pragma unroll
            for (int ai = 0; ai < 2; ++ai)
#pragma unroll
                for (int m = 0; m < 4; ++m) {
                    if (XF32) xr[ai][m][XF32 ? h : 0] = __builtin_amdgcn_raw_buffer_load_b128(rin, vb * 2 + cb * 4 + h * 16, (ai * HALF + m * 16) * 4096, 0);
                    else xr[ai][m][0] = __builtin_amdgcn_raw_buffer_load_b128(rin, vb + cb * 2, (ai * HALF + m * 16) * 2048, 0); }
            float gv[8], gm[8];
#pragma unroll
            for (int e = 0; e < 8; ++e) { gv[e] = __uint_as_float(gvr[e >> 2][e & 3]) * gsign; gm[e] = __uint_as_float(gnr[e >> 2][e & 3]) * (__uint_as_float(scr_[e >> 2][e & 3]) + 1.f); }
#pragma unroll
            for (int ai = 0; ai < 2; ++ai)
#pragma unroll
                for (int m = 0; m < 4; ++m) { float xn[8];
#pragma unroll
                    for (int e = 0; e < 4; ++e) { const auto r = __builtin_amdgcn_permlane16_swap(__float_as_uint(acc[ai][bj][m][0][e]), __float_as_uint(acc[ai][bj][m][1][e]), false, false); xn[e] = __uint_as_float(r[0]); xn[4 + e] = __uint_as_float(r[1]); }
#pragma unroll
                    for (int e = 0; e < 8; ++e) { float xv; if (XF32) xv = __uint_as_float(xr[ai][m][XF32 ? (e >> 2) : 0][e & 3]); else { const unsigned w = xr[ai][m][0][e >> 1]; xv = (e & 1) ? h16_hi(w) : h16_lo(w); }
                        xn[e] = xv + gv[e] * xn[e]; }
                    const unsigned eo = (unsigned)((wr * 64 + fr + ai * HALF + m * 16) * 1024 + colw + cb);
                    *(gu4*)(xsb + eo) = (u32x4){pk_h16(xn[0], xn[1]), pk_h16(xn[2], xn[3]), pk_h16(xn[4], xn[5]), pk_h16(xn[6], xn[7])};
                    if (fuse) { ssq[ai][m] += ((xn[0] * xn[0] + xn[1] * xn[1]) + (xn[2] * xn[2] + xn[3] * xn[3])) + ((xn[4] * xn[4] + xn[5] * xn[5]) + (xn[6] * xn[6] + xn[7] * xn[7]));
                        *(gu4*)(hb + eo) = (u32x4){cvt_pk_bf16(xn[0] * gm[0], xn[1] * gm[1]), cvt_pk_bf16(xn[2] * gm[2], xn[3] * gm[3]), cvt_pk_bf16(xn[4] * gm[4], xn[5] * gm[5]), cvt_pk_bf16(xn[6] * gm[6], xn[7] * gm[7])}; } }
            asm volatile("" ::: "memory"); }
        if (fuse) { typedef __attribute__((address_space(1))) float gf; gf* SSp = (gf*)((float*)(ws + mk::WS_SS) + grow0 * 16);
#pragma unroll
            for (int ai = 0; ai < 2; ++ai)
#pragma unroll
                for (int m = 0; m < 4; ++m) { float sv = ssq[ai][m]; sv += __shfl_xor(sv, 16); sv += __shfl_xor(sv, 32); if (fq == 0) SSp[(unsigned)((ai * HALF + wr * 64 + m * 16 + fr) * 16 + u.pn * 4 + wc)] = sv; } }
    }
};
struct EpiFinal {
    static constexpr bool PERM = false, AFTER_DRAIN = false;
    unsigned char* ws; float* out; const float* gfin; PG8_LAS float* tab; int l;
    __device__ __forceinline__ void operator()(const f32x4 (&acc_)[2][2][4][2], const Unit& u, int wr, int wc, int fr, int fq) const {
        f32x4 (&acc)[2][2][4][2] = const_cast<f32x4 (&)[2][2][4][2]>(acc_);
        const int b = u.pm / 17, tp = u.pm % 17;
        const float* modl = (const float*)(ws + mk::WS_MOD) + (size_t)l * 9 * 6144;
        const size_t grow0 = (size_t)u.pm * BM;
        const auto rin = __builtin_amdgcn_make_buffer_rsrc((void*)((bf16_t*)(ws + mk::WS_XS) + grow0 * 1024), 0, 256 * 1024 * 2, 0x00020000);
        const auto rgate = __builtin_amdgcn_make_buffer_rsrc((void*)(modl + b * 6144 + 5120), 0, 4096, 0x00020000);
        const auto rgf = __builtin_amdgcn_make_buffer_rsrc((void*)gfin, 0, 4096, 0x00020000);
        typedef __attribute__((address_space(1))) f32x4 gf4; typedef __attribute__((address_space(1))) float gfl; gfl* ob = (gfl*)uni_ptr(out + ((size_t)b * 4096 + (size_t)(tp - 1) * 256) * 1024);
        const auto rss = __builtin_amdgcn_make_buffer_rsrc((void*)((float*)(ws + mk::WS_SS) + grow0 * 16), 0, 256 * 64, 0x00020000);
        const int colw = u.pn * BM + wc * 32 + 4 * fq;
        const unsigned vb = (unsigned)(((wr * 64 + fr) * 1024 + colw) * 2), vc = (unsigned)(colw * 4);
        float ssq[2][4];
#pragma unroll
        for (int ai = 0; ai < 2; ++ai)
#pragma unroll
            for (int m = 0; m < 4; ++m) ssq[ai][m] = 0.f;
        const unsigned vb8 = (unsigned)(((wr * 64 + fr) * 1024 + u.pn * BM + wc * 32 + (fq & 1) * 16 + (fq >> 1) * 8) * 2);
#pragma unroll
        for (int bj = 0; bj < 2; ++bj) { u32x4 xq[2][4];
#pragma unroll
            for (int ai = 0; ai < 2; ++ai)
#pragma unroll
                for (int m = 0; m < 4; ++m) xq[ai][m] = __builtin_amdgcn_raw_buffer_load_b128(rin, vb8 + bj * HALF * 2, (ai * HALF + m * 16) * 2048, 0);
            f32x4 gv[2];
#pragma unroll
            for (int n = 0; n < 2; ++n) gv[n] = __builtin_bit_cast(f32x4, __builtin_amdgcn_raw_buffer_load_b128(rgate, vc + (bj * HALF + n * 16) * 4, 0, 0));
#pragma unroll
            for (int ai = 0; ai < 2; ++ai)
#pragma unroll
                for (int m = 0; m < 4; ++m) { const auto r0 = __builtin_amdgcn_permlane16_swap(xq[ai][m].x, xq[ai][m].z, false, false), r1 = __builtin_amdgcn_permlane16_swap(xq[ai][m].y, xq[ai][m].w, false, false);
                    const unsigned xw[2][2] = {{r0[0], r1[0]}, {r0[1], r1[1]}};
#pragma unroll
                    for (int n = 0; n < 2; ++n) { const f32x4 xv = {h16_lo(xw[n][0]), h16_hi(xw[n][0]), h16_lo(xw[n][1]), h16_hi(xw[n][1])};
                        const f32x4 xn = xv + gv[n] * acc[ai][bj][m][n]; acc[ai][bj][m][n] = xn; ssq[ai][m] += (xn[0] * xn[0] + xn[1] * xn[1]) + (xn[2] * xn[2] + xn[3] * xn[3]); } } }
#pragma unroll
        for (int ai = 0; ai < 2; ++ai)
#pragma unroll
            for (int m = 0; m < 4; ++m) { float sv = ssq[ai][m]; sv += __shfl_xor(sv, 16); sv += __shfl_xor(sv, 32);
                if (fq == 0) __builtin_amdgcn_raw_buffer_store_b32(__float_as_uint(sv), rss, (unsigned)(((ai * HALF + wr * 64 + m * 16 + fr) * 16 + u.pn * 4 + wc) * 4), 0, 17); }
        asm volatile("s_waitcnt vmcnt(0)" ::: "memory");
        __builtin_amdgcn_s_barrier();
        int tid_ = threadIdx.x; asm volatile("" : "+v"(tid_));
        if (tid_ == 0) { unsigned* c = (unsigned*)(ws + mk::WS_CTL) + mk::CW_SUBBAR + 16 * u.pm;
            (void)__hip_atomic_fetch_add(c, 1u, __ATOMIC_RELAXED, __HIP_MEMORY_SCOPE_AGENT);
            unsigned sp = 0; while (__hip_atomic_load(c, __ATOMIC_RELAXED, __HIP_MEMORY_SCOPE_AGENT) < 4u && ++sp < (1u << 22)) __builtin_amdgcn_s_sleep(1);
            __builtin_amdgcn_fence(__ATOMIC_ACQUIRE, "agent"); asm volatile("s_waitcnt vmcnt(0)" ::: "memory"); }
        __builtin_amdgcn_s_barrier();
        asm volatile("" ::: "memory");
        if (tid_ < 256) { f32x4 t = {0.f, 0.f, 0.f, 0.f};
#pragma unroll
            for (int q = 0; q < 4; ++q) t += __builtin_bit_cast(f32x4, __builtin_amdgcn_raw_buffer_load_b128(rss, (unsigned)(tid_ * 64 + q * 16), 0, 17));
            tab[tid_] = __builtin_amdgcn_rsqf(((t[0] + t[1]) + (t[2] + t[3])) * (1.f / 1024.f) + 1e-6f); }
        asm volatile("s_waitcnt vmcnt(0) lgkmcnt(0)" ::: "memory");
        __builtin_amdgcn_s_barrier();
        asm volatile("" ::: "memory");
        float rs[2][4];
#pragma unroll
        for (int ai = 0; ai < 2; ++ai)
#pragma unroll
            for (int m = 0; m < 4; ++m) rs[ai][m] = tab[ai * HALF + wr * 64 + m * 16 + fr];
#pragma unroll
        for (int bj = 0; bj < 2; ++bj)
#pragma unroll
            for (int n = 0; n < 2; ++n) { const int ci = bj * HALF + n * 16;
                const f32x4 gf = __builtin_bit_cast(f32x4, __builtin_amdgcn_raw_buffer_load_b128(rgf, vc + ci * 4, 0, 0));
#pragma unroll
                for (int ai = 0; ai < 2; ++ai)
#pragma unroll
                    for (int m = 0; m < 4; ++m) { const f32x4 o = acc[ai][bj][m][n] * rs[ai][m] * gf; *(gf4*)(ob + (unsigned)((wr * 64 + fr + ai * HALF + m * 16) * 1024 + colw + ci)) = o; } }
    }
};
struct EpiSlab {
    static constexpr bool PERM = false, AFTER_DRAIN = false;
    unsigned short* slab;
    __device__ __forceinline__ void operator()(const f32x4 (&acc)[2][2][4][2], const Unit& u, int wr, int wc, int fr, int fq) const {
        const int c8 = wc * 32 + (fq & 1) * 16 + (fq >> 1) * 8;
#pragma unroll
        for (int ai = 0; ai < 2; ++ai)
#pragma unroll
            for (int m = 0; m < 4; ++m) { unsigned short* rp = slab + (size_t)(ai * HALF + wr * 64 + m * 16 + fr) * 256 + c8;
#pragma unroll
                for (int bj = 0; bj < 2; ++bj) { float xn[8];
#pragma unroll
                    for (int e = 0; e < 4; ++e) { const auto r = __builtin_amdgcn_permlane16_swap(__float_as_uint(acc[ai][bj][m][0][e]), __float_as_uint(acc[ai][bj][m][1][e]), false, false); xn[e] = __uint_as_float(r[0]); xn[4 + e] = __uint_as_float(r[1]); }
                    *(u32x4*)(rp + bj * HALF) = (u32x4){pk_h16(xn[0], xn[1]), pk_h16(xn[2], xn[3]), pk_h16(xn[4], xn[5]), pk_h16(xn[6], xn[7])}; } }
    }
};
struct OneUnit {
    Unit u;
    __device__ __forceinline__ bool next(int i, Unit& o) const { if (i != 0) return false; o = u; return true; }
    __device__ __forceinline__ void a_ready(const Unit&) const {}
    __device__ __forceinline__ void done(const Unit&) const {}
};
struct LatentOrder {
    StaticOrder base;
    __host__ __device__ void init(int N, int G_, int c_) { base.init(128 * 256, N, G_, c_); }
    __device__ __forceinline__ bool next(int i, Unit& u) const { if (!base.next(i, u)) return false; u.pm = (u.pm >> 4) * 17 + 1 + (u.pm & 15); return true; }
    __device__ __forceinline__ void a_ready(const Unit&) const {}
    __device__ __forceinline__ void done(const Unit&) const {}
};
struct LimitOrder {
    LatentOrder L; int lim;
    __device__ __forceinline__ bool next(int i, Unit& u) const { if (i >= lim) return false; return L.next(i, u); }
    __device__ __forceinline__ void a_ready(const Unit&) const {}
    __device__ __forceinline__ void done(const Unit&) const {}
};
struct InProjOrder {
    StaticOrder base; int G, c, nlat; unsigned* ctr; unsigned need;
    __device__ __forceinline__ void init(int N, int G_, int c_, unsigned* ctr_, unsigned need_) { base.init(128 * 256, N, G_, c_); G = G_; c = c_; nlat = (base.nwg - c_ + G_ - 1) / G_; if (nlat < 0) nlat = 0; ctr = ctr_; need = need_; }
    __device__ __forceinline__ bool next(int i, Unit& u) const {
        if (base.next(i, u)) { u.pm = (u.pm >> 4) * 17 + 1 + (u.pm & 15); return true; }
        const int cu = ((c + G / 2) % G) + (i - nlat) * G; if (cu >= 8 * base.nN) return false;
        u.pm = (cu / base.nN) * 17; u.pn = cu % base.nN; return true; }
    __device__ __forceinline__ void a_ready(const Unit& u) const {
        if (need && (u.pm % 17) == 0) { unsigned sp = 0; while (__hip_atomic_load(ctr, __ATOMIC_RELAXED, __HIP_MEMORY_SCOPE_AGENT) < need && ++sp < (1u << 22)) __builtin_amdgcn_s_sleep(2); __builtin_amdgcn_fence(__ATOMIC_ACQUIRE, "agent"); } }
    __device__ __forceinline__ void done(const Unit&) const {}
};
}

namespace mk {
constexpr int NWAVES = 8;
constexpr int N_PHASES = 1 + 6 + 6 + 1;
constexpr int RING_OFF = 0, RING_BYTES = 131072, LDSCTL_OFF = RING_BYTES, MISC_OFF = LDSCTL_OFF + 320, LDS_BYTES = 147456;
constexpr int RS_OFF = LDSCTL_OFF + 1024;
static_assert(RS_OFF + 15 * 1024 <= LDS_BYTES, "LDS map");
#define RLX_AGENT __ATOMIC_RELAXED, __HIP_MEMORY_SCOPE_AGENT

struct Args {
  const float* in[25]; float* out; unsigned char* ws; int ph_lo, ph_hi, n_layers, use_cg; int rep[12];
};
enum { I_X = 0, I_C, I_CTX, I_CCTX, I_WADA, I_BADA, I_GN1, I_GN2, I_WIN, I_SINK, I_GQ, I_GK, I_BI, I_BF, I_GML, I_CW, I_CB, I_ALOG, I_DTB, I_DSK, I_GSSM, I_WOUT, I_W1, I_W2, I_GFIN };

template <class F> __device__ __forceinline__ void transpose_item(const float* W, int K, int N, bf16* WT, LAS float* scr, int item, int nblk, int lane, F srccol) {
  const int kb = item / nblk, nb = item % nblk, k0 = 64 * kb, n0 = 32 * nb;
  const int sc = srccol(n0 + (lane & 31));
  float tv[32];
#pragma unroll
  for (int i = 0; i < 32; ++i) { const int kk = 2 * i + (lane >> 5); tv[i] = sc >= 0 ? W[(size_t)(k0 + kk) * N + sc] : 0.f; }
#pragma unroll
  for (int i = 0; i < 32; ++i) { const int kk = 2 * i + (lane >> 5); scr[kk * 33 + (lane & 31)] = tv[i]; }
  asm volatile("s_waitcnt lgkmcnt(0)" ::: "memory");
  const int c = lane & 7;
#pragma unroll
  for (int j = 0; j < 4; ++j) { const int n = (lane >> 3) + 8 * j; const LAS float* s = scr + (8 * c) * 33 + n;
    u32x4 o; o.x = cvtpk(s[0 * 33], s[1 * 33]); o.y = cvtpk(s[2 * 33], s[3 * 33]); o.z = cvtpk(s[4 * 33], s[5 * 33]); o.w = cvtpk(s[6 * 33], s[7 * 33]);
    *(u32x4*)(WT + (size_t)(n0 + n) * K + k0 + 8 * c) = o; }
  asm volatile("s_waitcnt lgkmcnt(0)" ::: "memory");
}
__device__ __forceinline__ int win_srccol(int n) { return n < 2048 ? n : (n < 3072 ? n + 16 : (n < 3088 ? n - 1024 : (n < 3096 ? n : -1))); }

__device__ __forceinline__ void norm_row(const float* xrow, const float* g, const float* shv, const float* scv, bf16* orow, int lane, const float* slab = nullptr, const float* gate = nullptr, float* xout = nullptr) {
  const f32x4* xr = (const f32x4*)xrow + lane; f32x4 v[4]; float s = 0.f;
#pragma unroll
  for (int j = 0; j < 4; ++j) v[j] = xr[64 * j];
  if (slab) {
#pragma unroll
    for (int j = 0; j < 4; ++j) { f32x4 a = {0.f, 0.f, 0.f, 0.f};
#pragma unroll
      for (int ks = 0; ks < 8; ++ks) a += *(const f32x4*)(slab + (size_t)(j * 8 + ks) * 65536 + 4 * lane);
      v[j] += ((const f32x4*)gate)[64 * j + lane] * a; if (xout) ((f32x4*)xout)[64 * j + lane] = v[j]; }
  }
#pragma unroll
  for (int j = 0; j < 4; ++j) s += (v[j].x * v[j].x + v[j].y * v[j].y) + (v[j].z * v[j].z + v[j].w * v[j].w);
  const float rs = rsqrtf(wave_sum(s) * (1.f / DM) + EPS);
  unsigned long long* o8 = (unsigned long long*)orow + lane;
#pragma unroll
  for (int j = 0; j < 4; ++j) { const f32x4 gg = ((const f32x4*)g)[64 * j + lane], sh = ((const f32x4*)shv)[64 * j + lane], sc = ((const f32x4*)scv)[64 * j + lane];
    const f32x4 y = v[j] * rs * gg * (sc + 1.f) + sh;
    o8[64 * j] = (unsigned long long)cvtpk(y.x, y.y) | ((unsigned long long)cvtpk(y.z, y.w) << 32); }
}

__device__ __forceinline__ void norm_row_b(const bf16* xrow, const float* g, const float* shv, const float* scv, bf16* orow, int lane, const unsigned short* slab, const float* gate) {
  const u32x2* xr = (const u32x2*)xrow + lane; f32x4 v[4]; float s = 0.f; u32x2 xw[4];
#pragma unroll
  for (int j = 0; j < 4; ++j) xw[j] = xr[64 * j];
#pragma unroll
  for (int j = 0; j < 4; ++j) { f32x4 a = {0.f, 0.f, 0.f, 0.f};
#pragma unroll
    for (int ks = 0; ks < 8; ++ks) { const u32x2 hw = *(const u32x2*)(slab + (size_t)(j * 8 + ks) * 65536 + 4 * lane); a += (f32x4){pg8::h16_lo(hw.x), pg8::h16_hi(hw.x), pg8::h16_lo(hw.y), pg8::h16_hi(hw.y)}; }
    v[j] = (f32x4){pg8::h16_lo(xw[j].x), pg8::h16_hi(xw[j].x), pg8::h16_lo(xw[j].y), pg8::h16_hi(xw[j].y)} + ((const f32x4*)gate)[64 * j + lane] * a; }
#pragma unroll
  for (int j = 0; j < 4; ++j) s += (v[j].x * v[j].x + v[j].y * v[j].y) + (v[j].z * v[j].z + v[j].w * v[j].w);
  const float rs = rsqrtf(wave_sum(s) * (1.f / DM) + EPS);
  unsigned long long* o8 = (unsigned long long*)orow + lane;
#pragma unroll
  for (int j = 0; j < 4; ++j) { const f32x4 gg = ((const f32x4*)g)[64 * j + lane], sh = ((const f32x4*)shv)[64 * j + lane], sc = ((const f32x4*)scv)[64 * j + lane];
    const f32x4 y = v[j] * rs * gg * (sc + 1.f) + sh;
    o8[64 * j] = (unsigned long long)cvtpk(y.x, y.y) | ((unsigned long long)cvtpk(y.z, y.w) << 32); }
}

__device__ __forceinline__ void norm_row2(const float* x0, const float* x1, const float* g, const float* shv, const float* scv, bf16* o0, bf16* o1, int lane) {
  const f32x4* xr0 = (const f32x4*)x0 + lane; const f32x4* xr1 = (const f32x4*)x1 + lane; f32x4 v0[4], v1[4]; float s0 = 0.f, s1 = 0.f;
#pragma unroll
  for (int j = 0; j < 4; ++j) { v0[j] = xr0[64 * j]; v1[j] = xr1[64 * j]; }
#pragma unroll
  for (int j = 0; j < 4; ++j) { s0 += (v0[j].x * v0[j].x + v0[j].y * v0[j].y) + (v0[j].z * v0[j].z + v0[j].w * v0[j].w); s1 += (v1[j].x * v1[j].x + v1[j].y * v1[j].y) + (v1[j].z * v1[j].z + v1[j].w * v1[j].w); }
  const float rs0 = rsqrtf(wave_sum(s0) * (1.f / DM) + EPS), rs1 = rsqrtf(wave_sum(s1) * (1.f / DM) + EPS);
  unsigned long long* p0 = (unsigned long long*)o0 + lane; unsigned long long* p1 = (unsigned long long*)o1 + lane;
#pragma unroll
  for (int j = 0; j < 4; ++j) { const f32x4 gg = ((const f32x4*)g)[64 * j + lane], sh = ((const f32x4*)shv)[64 * j + lane], sc = ((const f32x4*)scv)[64 * j + lane]; const f32x4 gm = gg * (sc + 1.f);
    const f32x4 y0 = v0[j] * rs0 * gm + sh, y1 = v1[j] * rs1 * gm + sh;
    p0[64 * j] = (unsigned long long)cvtpk(y0.x, y0.y) | ((unsigned long long)cvtpk(y0.z, y0.w) << 32); p1[64 * j] = (unsigned long long)cvtpk(y1.x, y1.y) | ((unsigned long long)cvtpk(y1.z, y1.w) << 32); }
}

__device__ __forceinline__ void attn_item(int idx, const bf16* P, bf16* Y, const float* sink, const float* gq, const float* gk, char* shm) {
  using attn_body::attn_unit; typedef attn_body::bf16 abf;
  bool isA; int b, hq, qrow, NT, band_row0 = 0, qpos0 = 0, band_s0 = 0;
  bool pair = false;
  if (idx < 1024) { isA = idx >= 512; const int id = idx & 511; b = id >> 6; hq = (id >> 4) & 3; int q0 = (id & 15) * 256; NT = 68;
    if (isA) { pair = true; hq = ((id >> 5) & 1) * 2; q0 = (id & 31) * 128;
      const int s_lo = q0 - 128 > 0 ? q0 - 128 : 0, s_hi = q0 + 256 < T ? q0 + 256 : T; NT = 4 + (s_hi - s_lo) / 64; band_row0 = NC + s_lo; qpos0 = q0; band_s0 = s_lo; }
    qrow = NC + q0; }
  else { const int id = idx - 1024; isA = id >= 32; b = (id & 31) >> 2; hq = id & 3; qrow = 0; NT = 4; }
  const int g = hq >> 1; const size_t rowb = (size_t)b * RB; const int cq = isA ? 0 : 512, ck = isA ? 256 : 768, cv = isA ? 384 : 896, cy = isA ? 0 : 256;
  const abf* Q0 = (const abf*)(P + (rowb + qrow) * NP + cq + hq * 64); const abf* Kh = (const abf*)(P + rowb * NP + ck + g * 64); const abf* Vh = (const abf*)(P + rowb * NP + cv + g * 64);
  abf* O0 = (abf*)(Y + (rowb + qrow) * DM + cy + hq * 64);
#ifndef MK_NO_B
  if (!isA) {
    float a = fabsf(gq[threadIdx.x & 63]), c = fabsf(gk[threadIdx.x & 63]);
#pragma unroll
    for (int o = 32; o > 0; o >>= 1) { a = fmaxf(a, __shfl_xor(a, o)); c = fmaxf(c, __shfl_xor(c, o)); }
    const float cref = __builtin_bit_cast(float, __builtin_amdgcn_readfirstlane(__builtin_bit_cast(int, 64.f * QC2 * 1.03f * a * c + 0.25f)));
    attn_unit<8, 0>(Q0, Kh, Vh, O0, NT, 0, 0, 0, 0.f, cref < 56.f ? cref : 0.f, shm); }
#endif
#ifndef MK_NO_A
  if (isA) attn_unit<8, 1>(Q0, Kh, Vh, O0, NT, band_row0, qpos0, band_s0, sink[hq] * L2E, 0.f, shm, pair, sink[(hq + 1) & 3] * L2E);
#endif
}

__global__ void __launch_bounds__(NWAVES * 64, 2) mk_fwd(Args args) {
  extern __shared__ __attribute__((aligned(16))) unsigned char lds_raw[];
  LAS unsigned char* lds = (LAS unsigned char*)lds_raw;
  volatile LAS unsigned* MISC = (volatile LAS unsigned*)(lds + MISC_OFF);
  const int tid0 = threadIdx.x, wave = __builtin_amdgcn_readfirstlane(tid0 >> 6);
  for (int u = tid0; u < (LDS_BYTES - LDSCTL_OFF) / 4; u += NWAVES * 64) ((LAS unsigned*)(lds + LDSCTL_OFF))[u] = 0u;
  __syncthreads();
  if (tid0 < 25) ((volatile LAS unsigned long long*)(lds + MISC_OFF + 256))[tid0] = (unsigned long long)(uintptr_t)args.in[tid0];
  __syncthreads();
  XcdBarrier bar = xcd_barrier_post(((unsigned*)(args.ws + WS_CTL)) + CW_BAR, MISC + 8);
#ifndef MK_PHSEL
#define MK_PHSEL 0xFFFF
#endif
#ifndef MK_FIRST_SEAM_CG
#define MK_FIRST_SEAM_CG 1
#endif
#ifndef MK_PROBE_NOCHAIN
#define MK_PROBE_NOCHAIN 0
#endif
#ifndef MK_STAG6
#define MK_STAG6 0
#endif
#ifndef MK_STAG9
#define MK_STAG9 0
#endif
#define MK_STAGGER(n) do { if ((n) > 0 && ((bx >> 3) & 1)) { const unsigned long long t0_ = __builtin_amdgcn_s_memrealtime(); while (__builtin_amdgcn_s_memrealtime() - t0_ < (unsigned long long)(n)) __builtin_amdgcn_s_sleep(32); } } while (0)
#ifndef MK_PROBE_PM
#define MK_PROBE_PM 15
#endif
#ifndef MK_PROBE_NOATTN
#define MK_PROBE_NOATTN 0
#endif
#ifndef MK_PROBE_NOMAMBA
#define MK_PROBE_NOMAMBA 0
#endif
#ifndef MK_PROBE_NOMLSTM
#define MK_PROBE_NOMLSTM 0
#endif
#define AIN(k) ((const float*)(GAS const float*)(uintptr_t)(((unsigned long long)(unsigned)__builtin_amdgcn_readfirstlane((int)MISC[64 + 2 * (k) + 1]) << 32) | (unsigned long long)(unsigned)__builtin_amdgcn_readfirstlane((int)MISC[64 + 2 * (k)])))
#define PH_PROLOG int tid = threadIdx.x; asm volatile("" : "+v"(tid)); const int lane = tid & 63; (void)lane; int bx_ = blockIdx.x, G_ = gridDim.x; if (kind != 0) asm volatile("" : "+s"(bx_), "+s"(G_)); const int bx = bx_, G = G_, vcu = (G % 8 == 0) ? (bx % 8) * (G / 8) + bx / 8 : bx, gw = vcu * NWAVES + wave, NGW = G * NWAVES; (void)gw; (void)NGW; (void)vcu; GAS unsigned char* wsg_ = (GAS unsigned char*)args.ws; asm volatile("" : "+s"(wsg_)); unsigned char* wsp = (unsigned char*)wsg_;

  const int nph = N_PHASES;
#pragma unroll 1
  for (int ph = args.ph_lo; ph < args.ph_hi; ++ph) {
  int kind, l = 0;
  if (ph == 0) kind = 0; else if (ph == nph - 1) kind = 10; else { l = ph >= 7; const int q = l ? ph - 6 : ph; kind = q < 4 ? q + 1 : (q == 4 ? 6 : q + 3); }
  const int nrep = args.rep[kind];
  if (kind == 0) { PH_PROLOG if ((MK_PHSEL >> 0) & 1) for (int rp = 0; rp < nrep; ++rp) {
    {
      for (int cbk = vcu; cbk < 192; cbk += G) {
        LAS float* sc = (LAS float*)(lds + RING_OFF);
        LAS float* red = (LAS float*)(lds + RING_OFF + 36864);
        for (int i = tid; i < 9 * DM; i += NWAVES * 64) { const int j = i / DM, k = i % DM; const float v = j < 8 ? AIN(I_C)[j * DM + k] : AIN(I_CCTX)[k]; sc[i] = v / (1.f + __expf(-v)); }
        __syncthreads();
        const int col = cbk * 64 + lane, l = col / 6144, n = col % 6144; const float* w = AIN(I_WADA) + (size_t)l * DM * 6144 + n + (size_t)(wave * 128) * 6144;
        float acc[9];
#pragma unroll
        for (int j = 0; j < 9; ++j) acc[j] = 0.f;
#pragma unroll 1
        for (int k0 = 0; k0 < 128; k0 += 16) { float wv[16];
#pragma unroll
          for (int u = 0; u < 16; ++u) wv[u] = w[(size_t)(k0 + u) * 6144];
#pragma unroll
          for (int u = 0; u < 16; ++u)
#pragma unroll
            for (int j = 0; j < 9; ++j) acc[j] += sc[j * DM + wave * 128 + k0 + u] * wv[u]; }
#pragma unroll
        for (int j = 0; j < 9; ++j) red[(wave * 9 + j) * 64 + lane] = acc[j];
        __syncthreads();
        if (wave == 0) { const float bb = AIN(I_BADA)[l * 6144 + n];
#pragma unroll
          for (int j = 0; j < 9; ++j) { float sum = bb;
#pragma unroll
            for (int wv_ = 0; wv_ < 8; ++wv_) sum += red[(wv_ * 9 + j) * 64 + lane];
            ((float*)(wsp + WS_MOD))[(size_t)(l * 9 + j) * 6144 + n] = sum; } }
        __syncthreads();
        if (tid == 0) { __builtin_amdgcn_fence(__ATOMIC_RELEASE, "agent"); (void)__hip_atomic_fetch_add(((unsigned*)(wsp + WS_CTL)) + CW_SUBBAR + 20480, 1u, RLX_AGENT); }
      }
      for (int i = gw * 64 + lane; i < T * 32; i += NGW * 64) { const int t = i >> 5, e = i & 31, fi = e & 15; const float invf = __builtin_amdgcn_exp2f(-(float)fi * (13.287712379549449f / 16.f));
        const float ang = (float)(e < 16 ? (t >> 6) : (t & 63)) * invf; ((float*)(wsp + WS_CS))[i] = __cosf(ang); ((float*)(wsp + WS_CS))[T * 32 + i] = __sinf(ang); }
      LAS float* scr = (LAS float*)(lds + RING_OFF + 57344 + wave * 8704);
      constexpr int I_IN = 16 * 104, I_OUT = 16 * 32, I_1 = 16 * 128, I_2 = 64 * 32, I_L = I_IN + I_OUT + I_1 + I_2;
      for (int it = gw; it < 2 * I_L; it += NGW) {
        const int l = it / I_L; int r = it % I_L; unsigned char* wl = (wsp) + WS_W + (size_t)l * W_LAYER;
        if (r < I_IN) { transpose_item(AIN(I_WIN) + (size_t)l * DM * NINO, DM, NINO, (bf16*)(wl + WO_IN), scr, r, 104, lane, [](int n) { return win_srccol(pg8::lcol(n)); }); continue; } r -= I_IN;
        if (r < I_OUT) { transpose_item(AIN(I_WOUT) + (size_t)l * DM * DM, DM, DM, (bf16*)(wl + WO_OUT), scr, r, 32, lane, [](int n) { return n; }); continue; } r -= I_OUT;
        if (r < I_1) { transpose_item(AIN(I_W1) + (size_t)l * DM * DFF, DM, DFF, (bf16*)(wl + WO_1), scr, r, 128, lane, [](int n) { return pg8::lcol(n); }); continue; } r -= I_1;
        transpose_item(AIN(I_W2) + (size_t)l * DFF * DM, DFF, DM, (bf16*)(wl + WO_2), scr, r, 32, lane, [](int n) { return n; });
      }
      __syncthreads();
      if (tid == 0) { __builtin_amdgcn_fence(__ATOMIC_RELEASE, "agent"); (void)__hip_atomic_fetch_add(((unsigned*)(wsp + WS_CTL)) + CW_SUBBAR + 20544, 1u, RLX_AGENT); }
    }
  } }

  {
    if (kind == 1 || kind == 0 || (kind == 2 && l == 1)) { PH_PROLOG if ((MK_PHSEL >> 1) & 1) for (int rp = 0; rp < 1; ++rp) {
      if (kind == 0) {
        if (tid == 0) { unsigned sp = 0; while (__hip_atomic_load(((unsigned*)(wsp + WS_CTL)) + CW_SUBBAR + 20480, RLX_AGENT) < 192u && ++sp < (1u << 22)) __builtin_amdgcn_s_sleep(2); __builtin_amdgcn_fence(__ATOMIC_ACQUIRE, "agent"); }
        __syncthreads(); }
      if (l == 0) {
        for (int m = 2 * gw; m < M; m += 2 * NGW) { const int b = m / RB, r = m % RB; const bool isc = r < NC;
          const float* xr = isc ? AIN(I_CTX) + ctx_off(b, r) : AIN(I_X) + lat_off(b, r - NC); const float* mr = ((float*)(wsp + WS_MOD)) + (isc ? 8 : b) * 6144;
          bf16* hp = ((bf16*)(wsp + WS_H)) + (size_t)m * DM; norm_row2(xr, xr + DM, AIN(I_GN1), mr, mr + 1024, hp, hp + DM, lane); }
        if (tid == 0) { unsigned sp = 0; while (__hip_atomic_load(((unsigned*)(wsp + WS_CTL)) + CW_SUBBAR + 20544, RLX_AGENT) < (unsigned)G && ++sp < (1u << 22)) __builtin_amdgcn_s_sleep(2); __builtin_amdgcn_fence(__ATOMIC_ACQUIRE, "agent"); }
        __syncthreads();
        { LAS float* shl = (LAS float*)(lds + RING_OFF); const float* mo = (const float*)(wsp + WS_MOD);
          for (int i = tid; i < 3 * 9 * DM; i += NWAVES * 64) { const int set = i / (9 * DM), j = (i / DM) % 9, k = i % DM; shl[i] = mo[(size_t)((set == 1 ? 0 : 1) * 9 + j) * 6144 + (set == 0 ? 0 : 3072) + k]; }
          __syncthreads();
          for (int c = gw; c < 3328 + 4096 + 4096; c += NGW) { const int set = c < 3328 ? 0 : (c < 7424 ? 1 : 2), n = c - (set == 0 ? 0 : (set == 1 ? 3328 : 7424));
            const bf16* wrow = (const bf16*)(wsp + WS_W + (size_t)(set == 1 ? 0 : 1) * W_LAYER + (set == 0 ? WO_IN : WO_1)) + (size_t)n * DM;
            float wf[16];
#pragma unroll
            for (int q = 0; q < 4; ++q) { const u32x2 w2 = *(const u32x2*)(wrow + 256 * q + 4 * lane); wf[4 * q] = bf_lo(w2.x); wf[4 * q + 1] = bf_hi(w2.x); wf[4 * q + 2] = bf_lo(w2.y); wf[4 * q + 3] = bf_hi(w2.y); }
            float outv = 0.f;
#pragma unroll
            for (int j = 0; j < 9; ++j) { const LAS float* sp = shl + (set * 9 + j) * DM + 4 * lane; float a = 0.f;
#pragma unroll
              for (int q = 0; q < 4; ++q) { const f32x4 sv = *(const LAS f32x4*)(sp + 256 * q); a += (sv[0] * wf[4 * q] + sv[1] * wf[4 * q + 1]) + (sv[2] * wf[4 * q + 2] + sv[3] * wf[4 * q + 3]); }
              a = wave_sum(a); if (lane == j) outv = a; }
            if (lane < 9) ((float*)(wsp + WS_BIAS))[(size_t)(set * 9 + lane) * 4096 + n] = outv; }
          __syncthreads(); }
      } else {
        for (int i = gw; i < NB * NC; i += NGW) { const int b = i / NC, r = i % NC; const size_t m = (size_t)b * RB + r;
          const bf16* xr = (const bf16*)(wsp + WS_XS) + m * DM; const float* mr = ((float*)(wsp + WS_MOD)) + (size_t)(9 + 8) * 6144; bf16* hp = ((bf16*)(wsp + WS_H)) + m * DM;
          const unsigned short* sl = ((const unsigned short*)(args.out)) + (size_t)(b * 32) * 65536 + (size_t)r * 256; const float* gt = ((const float*)(wsp + WS_MOD)) + 8 * 6144 + 5120;
          norm_row_b(xr, AIN(I_GN1) + DM, mr, mr + 1024, hp, lane, sl, gt); }
        if (kind == 2) {
          __syncthreads();
          if (tid == 0) { __builtin_amdgcn_fence(__ATOMIC_RELEASE, "agent"); (void)__hip_atomic_fetch_add(((unsigned*)(wsp + WS_CTL)) + CW_SUBBAR + 20608, 1u, RLX_AGENT); } }
      }
    } }
    if (kind == 2) { PH_PROLOG if ((MK_PHSEL >> 2) & 1) for (int rp = 0; rp < nrep; ++rp) {
      { pg8::Gemm g{((bf16*)(wsp + WS_H)), (const bf16*)((wsp + WS_W + (size_t)l * W_LAYER) + WO_IN), M, NP, DM, DM};
        pg8::InProjOrder S; S.init(NP, G, bx, ((unsigned*)(wsp + WS_CTL)) + CW_SUBBAR + 20608, (l == 1) ? (unsigned)G : 0u);
        pg8::EpiInProj E{((bf16*)(wsp + WS_P)), ((float*)(wsp + WS_G)), pg8::FusedNorm{(const float*)(wsp + WS_SS), (const float*)(wsp + WS_BIAS), l == 1, 0, (const LAS float*)(lds + RS_OFF), 0}};
        if (l == 1) E.F.fill(S, (LAS float*)(lds + RS_OFF), tid);
        pg8::gemm_phase<pg8::EpiInProj, pg8::InProjOrder, true, true>(lds + RING_OFF, g, S, E); }
    } }
    if (kind == 3) { PH_PROLOG if ((MK_PHSEL >> 3) & 1) for (int rp = 0; rp < nrep; ++rp) {
      { const float* gq = AIN(I_GQ) + l * 64; const float* gk = AIN(I_GK) + l * 64; const float* cw = AIN(I_CW) + l * 3 * 768; const float* cb = AIN(I_CB) + l * 768;
        bf16* Pq = ((bf16*)(wsp + WS_P)); bf16* UCb = ((bf16*)(args.out)); float* Gp = ((float*)(wsp + WS_G)); const float* cst = ((const float*)(wsp + WS_CS));
        const int hw = 2 * gw + (lane >> 5), l32 = lane & 31, which = hw % 3, j = l32 & 7, slot = 4 * which + (l32 >> 3);
        const int blk = slot < 6 ? slot : slot + 2;
        const bool isq = slot < 4 || (slot >= 6 && slot < 10), isB = slot >= 6;
        const float* gv = isq ? gq : gk; float gn[8];
#pragma unroll
        for (int e = 0; e < 8; ++e) gn[e] = gv[8 * j + e];
        const int cch = 256 * which + 8 * l32, pcol = (which == 0 ? 2048 : (which == 1 ? 2560 : 2816)) + 8 * l32;
#define PREPA_LOAD(m_, S) do { const int r_ = (m_) % RB; w##S = *(const u32x4*)(Pq + (size_t)(m_) * NP + blk * 64 + 8 * j); \
          { const float* cp_ = cst + (r_ >= NC ? r_ - NC : 0) * 32 + (j >> 2) * 16 + (j & 1) * 8; c0##S = *(const f32x4*)cp_; c1##S = *(const f32x4*)(cp_ + 4); s0##S = *(const f32x4*)(cp_ + T * 32); s1##S = *(const f32x4*)(cp_ + T * 32 + 4); } } while (0)
#define PREPA_DO(m_, S) do { const int r_ = (m_) % RB; bf16* p_ = Pq + (size_t)(m_) * NP + blk * 64 + 8 * j; float x[8] = {bf_lo(w##S.x), bf_hi(w##S.x), bf_lo(w##S.y), bf_hi(w##S.y), bf_lo(w##S.z), bf_hi(w##S.z), bf_lo(w##S.w), bf_hi(w##S.w)}; \
            if (isB) { float ss = 0.f; _Pragma("unroll") for (int e = 0; e < 8; ++e) ss += x[e] * x[e]; \
              ss += __shfl_xor(ss, 1); ss += __shfl_xor(ss, 2); ss += __shfl_xor(ss, 4); const float rs = rsqrtf(ss * (1.f / 64.f) + EPS); _Pragma("unroll") for (int e = 0; e < 8; ++e) x[e] = x[e] * rs * gn[e]; } \
            if (r_ >= NC) { const float cc[8] = {c0##S[0], c0##S[1], c0##S[2], c0##S[3], c1##S[0], c1##S[1], c1##S[2], c1##S[3]}, sn[8] = {s0##S[0], s0##S[1], s0##S[2], s0##S[3], s1##S[0], s1##S[1], s1##S[2], s1##S[3]}; \
              _Pragma("unroll") for (int e = 0; e < 8; ++e) { const float other = __shfl_xor(x[e], 2); x[e] = (j & 2) ? x[e] * cc[e] + other * sn[e] : x[e] * cc[e] - other * sn[e]; } } \
            if (isq) { _Pragma("unroll") for (int e = 0; e < 8; ++e) x[e] *= QC2; } \
            if (rp == 0) *(u32x4*)p_ = (u32x4){cvtpk(x[0], x[1]), cvtpk(x[2], x[3]), cvtpk(x[4], x[5]), cvtpk(x[6], x[7])}; } while (0)
#define PREPB_LOAD(m_, S) do { const int r_ = (m_) % RB; const int seg0_ = r_ < NC ? 0 : NC, seglen_ = r_ < NC ? NC : T, sl_ = r_ - seg0_; const bf16* px_ = Pq + (size_t)(m_) * NP + pcol; const u32x4 z4_ = {0u, 0u, 0u, 0u}; \
          xm##S = sl_ > 0 ? *(const u32x4*)(px_ - NP) : z4_; x0##S = *(const u32x4*)px_; xp##S = sl_ + 1 < seglen_ ? *(const u32x4*)(px_ + NP) : z4_; } while (0)
#define PREPB_DO(m_, S) do { float u[8]; _Pragma("unroll") for (int e = 0; e < 4; ++e) { const int q = e >> 1, o = (e & 1) * 2; \
              const float y0 = bb[q][o] + w0[q][o] * bf_lo(xm##S[e]) + w1[q][o] * bf_lo(x0##S[e]) + w2[q][o] * bf_lo(xp##S[e]); \
              const float y1 = bb[q][o + 1] + w0[q][o + 1] * bf_hi(xm##S[e]) + w1[q][o + 1] * bf_hi(x0##S[e]) + w2[q][o + 1] * bf_hi(xp##S[e]); \
              u[2 * e] = y0 / (1.f + __expf(-y0)); u[2 * e + 1] = y1 / (1.f + __expf(-y1)); } \
            *(u32x4*)(UCb + (size_t)(m_) * 768 + cch) = (u32x4){cvtpk(u[0], u[1]), cvtpk(u[2], u[3]), cvtpk(u[4], u[5]), cvtpk(u[6], u[7])}; } while (0)
        if (hw < 4095) {
          { u32x4 wA, wB, wC, wD; f32x4 c0A, c1A, s0A, s1A, c0B, c1B, s0B, s1B, c0C, c1C, s0C, s1C, c0D, c1D, s0D, s1D;
            const int S1 = 1365, mlast = hw / 3 + ((M - 1 - hw / 3) / S1) * S1;
#define CL(x_) ((x_) <= mlast ? (x_) : mlast)
            int m = hw / 3; PREPA_LOAD(m, A); PREPA_LOAD(CL(m + S1), B); PREPA_LOAD(CL(m + 2 * S1), C);
            for (; m <= mlast; m += 4 * S1) {
              PREPA_LOAD(CL(m + 3 * S1), D); PREPA_DO(m, A);
              PREPA_LOAD(CL(m + 4 * S1), A); if (m + S1 <= mlast) PREPA_DO(m + S1, B);
              PREPA_LOAD(CL(m + 5 * S1), B); if (m + 2 * S1 <= mlast) PREPA_DO(m + 2 * S1, C);
              PREPA_LOAD(CL(m + 6 * S1), C); if (m + 3 * S1 <= mlast) PREPA_DO(m + 3 * S1, D); } }
          int cch_ = cch; asm volatile("" : "+v"(cch_));
        f32x4 w0[2], w1[2], w2[2], bb[2];
#pragma unroll
        for (int q = 0; q < 2; ++q) { w0[q] = *(const f32x4*)(cw + cch_ + 4 * q); w1[q] = *(const f32x4*)(cw + 768 + cch_ + 4 * q); w2[q] = *(const f32x4*)(cw + 1536 + cch_ + 4 * q); bb[q] = *(const f32x4*)(cb + cch_ + 4 * q); }
          { u32x4 xmA, x0A, xpA, xmB, x0B, xpB, xmC, x0C, xpC, xmD, x0D, xpD; const int S1 = 1365, mlast = hw / 3 + ((M - 1 - hw / 3) / S1) * S1;
            int m = hw / 3; PREPB_LOAD(m, A); PREPB_LOAD(CL(m + S1), B); PREPB_LOAD(CL(m + 2 * S1), C);
            for (; m <= mlast; m += 4 * S1) {
              PREPB_LOAD(CL(m + 3 * S1), D); PREPB_DO(m, A);
              PREPB_LOAD(CL(m + 4 * S1), A); if (m + S1 <= mlast) PREPB_DO(m + S1, B);
              PREPB_LOAD(CL(m + 5 * S1), B); if (m + 2 * S1 <= mlast) PREPB_DO(m + 2 * S1, C);
              PREPB_LOAD(CL(m + 6 * S1), C); if (m + 3 * S1 <= mlast) PREPB_DO(m + 3 * S1, D); } }
#undef CL
        }
#undef PREPA_LOAD
#undef PREPA_DO
#undef PREPB_LOAD
#undef PREPB_DO
        for (int t = NGW - 1 - gw; t < NB * 34 * 8; t += NGW) scan::chunk_scalars((const float*)(wsp + WS_G), (float*)(wsp + WS_G2), AIN(I_ALOG) + l * 8, AIN(I_DTB) + l * 8, AIN(I_BI) + l * 8, AIN(I_BF) + l * 8, t / 272, (t >> 3) % 34, t & 7, lane); }
    } }
    if (kind == 4) { PH_PROLOG if ((MK_PHSEL >> 4) & 1) for (int rp = 0; rp < nrep; ++rp) {
      {
#ifndef MK_NO_MAMBA
        for (int cid = bx; cid < 128; cid += G) {
        if (cid < 64 && (rp == 0 || !(MK_PROBE_NOCHAIN || MK_PROBE_NOMAMBA))) scan::mamba_chain((LAS char*)lds, ((bf16*)(args.out)), ((float*)(wsp + WS_G2)), ((bf16*)(wsp + WS_YD)), cid >> 3, (cid >> 1) & 3, cid & 1, rp == 0 ? 15 : MK_PROBE_PM, l == 1 ? 2 : 0);
#endif
#ifndef MK_NO_MLSTM
        if (cid >= 64 && (rp == 0 || !(MK_PROBE_NOCHAIN || MK_PROBE_NOMLSTM))) { const int c = cid - 64; scan::mlstm_chain((LAS char*)lds, ((bf16*)(wsp + WS_P)), ((float*)(wsp + WS_G2)), ((bf16*)(wsp + WS_HC)), c >> 3, (c >> 1) & 3, c & 1, l == 1 ? 2 : 0); }
#endif#endif
        if (tid == 0) { __builtin_amdgcn_fence(__ATOMIC_RELEASE, "agent"); (void)__hip_atomic_fetch_add(((unsigned*)(wsp + WS_CTL)) + CW_SUBBAR + 12288 + 64 * ((l * 4 + rp) * 8 + ((cid & 63) >> 3)), 1u, RLX_AGENT); }
        }
        const int nper = (l == 1) ? 128 : 136;
        if (rp == 0 || !MK_PROBE_NOATTN) { const int x0 = (int)(xb_xcc_id() & 7u);
          for (int dq = 0; dq < 8; ++dq) { const int qb_ = (x0 + dq) & 7;
            for (;;) {
              if (tid == 0) MISC[16] = __hip_atomic_fetch_add(((unsigned*)(wsp + WS_CTL)) + CW_QUEUE + 64 * ((l * 4 + rp) * 8 + qb_), 1u, RLX_AGENT);
              __syncthreads(); const int ix = __builtin_amdgcn_readfirstlane((int)MISC[16]); __syncthreads();
              if (ix >= nper) break;
              const int idx = ix < 64 ? qb_ * 64 + ix : (ix < 128 ? 512 + qb_ * 64 + (ix - 64) : (ix < 132 ? 1024 + qb_ * 4 + (ix - 128) : 1056 + qb_ * 4 + (ix - 132)));
              attn_item(idx, ((bf16*)(wsp + WS_P)), ((bf16*)(wsp + WS_Y)), AIN(I_SINK) + l * 4, AIN(I_GQ) + l * 64, AIN(I_GK) + l * 64, (char*)lds_raw + RING_OFF);
            } } }
        if (rp == 0) { const float* gml = AIN(I_GML) + l * 256; const float* gss = AIN(I_GSSM) + l * 256; const float* dsk = AIN(I_DSK) + l * 4;
          const bf16* HCb = (const bf16*)(wsp + WS_HC); const bf16* YDb = (const bf16*)(wsp + WS_YD); const bf16* Pf = (const bf16*)(wsp + WS_P); const bf16* UCf = (const bf16*)(args.out); bf16* Yf = (bf16*)(wsp + WS_Y);
          const int l32 = lane & 31, c0 = 8 * l32; const f32x4 gmA = *(const f32x4*)(gml + c0), gmB = *(const f32x4*)(gml + c0 + 4), gsA = *(const f32x4*)(gss + c0), gsB = *(const f32x4*)(gss + c0 + 4); const float dk = dsk[l32 >> 3];
          const float gmv[8] = {gmA[0], gmA[1], gmA[2], gmA[3], gmB[0], gmB[1], gmB[2], gmB[3]}, gsv[8] = {gsA[0], gsA[1], gsA[2], gsA[3], gsB[0], gsB[1], gsB[2], gsB[3]};
#define FIN_LOAD(m_, S) do { hA##S = *(const u32x4*)(HCb + (size_t)(m_) * 256 + c0); hB##S = *(const u32x4*)(HCb + ((size_t)M + (m_)) * 256 + c0); ow##S = *(const u32x4*)(Pf + (size_t)(m_) * NP + 1792 + c0); \
          yA##S = *(const u32x4*)(YDb + (size_t)(m_) * 256 + c0); yB##S = *(const u32x4*)(YDb + ((size_t)M + (m_)) * 256 + c0); xw##S = *(const u32x4*)(UCf + (size_t)(m_) * 768 + c0); zw##S = *(const u32x4*)(Pf + (size_t)(m_) * NP + 2304 + c0); } while (0)
#define FIN_DO(m_, S) do { \
          { float hs[8]; float ss = 0.f; \
            _Pragma("unroll") for (int e = 0; e < 4; ++e) { hs[2 * e] = bf_lo(hA##S[e]) + bf_lo(hB##S[e]); hs[2 * e + 1] = bf_hi(hA##S[e]) + bf_hi(hB##S[e]); ss += hs[2 * e] * hs[2 * e] + hs[2 * e + 1] * hs[2 * e + 1]; } \
            ss += __shfl_xor(ss, 1); ss += __shfl_xor(ss, 2); ss += __shfl_xor(ss, 4); const float rs = rsqrtf(ss * (1.f / 64.f) + EPS); float y[8]; \
            _Pragma("unroll") for (int e = 0; e < 4; ++e) { const float o0 = bf_lo(ow##S[e]), o1 = bf_hi(ow##S[e]); y[2 * e] = hs[2 * e] * rs * gmv[2 * e] / (1.f + __expf(-o0)); y[2 * e + 1] = hs[2 * e + 1] * rs * gmv[2 * e + 1] / (1.f + __expf(-o1)); } \
            *(u32x4*)(Yf + (size_t)(m_) * DM + 512 + c0) = (u32x4){cvtpk(y[0], y[1]), cvtpk(y[2], y[3]), cvtpk(y[4], y[5]), cvtpk(y[6], y[7])}; } \
          { float v[8]; float ss = 0.f; \
            _Pragma("unroll") for (int e = 0; e < 4; ++e) { const float z0 = bf_lo(zw##S[e]), z1 = bf_hi(zw##S[e]); \
              v[2 * e] = (bf_lo(yA##S[e]) + bf_lo(yB##S[e]) + dk * bf_lo(xw##S[e])) * (z0 / (1.f + __expf(-z0))); v[2 * e + 1] = (bf_hi(yA##S[e]) + bf_hi(yB##S[e]) + dk * bf_hi(xw##S[e])) * (z1 / (1.f + __expf(-z1))); ss += v[2 * e] * v[2 * e] + v[2 * e + 1] * v[2 * e + 1]; } \
            ss += __shfl_xor(ss, 1); ss += __shfl_xor(ss, 2); ss += __shfl_xor(ss, 4); ss += __shfl_xor(ss, 8); ss += __shfl_xor(ss, 16); const float rs = rsqrtf(ss * (1.f / 256.f) + EPS); \
            *(u32x4*)(Yf + (size_t)(m_) * DM + 768 + c0) = (u32x4){cvtpk(v[0] * rs * gsv[0], v[1] * rs * gsv[1]), cvtpk(v[2] * rs * gsv[2], v[3] * rs * gsv[3]), cvtpk(v[4] * rs * gsv[4], v[5] * rs * gsv[5]), cvtpk(v[6] * rs * gsv[6], v[7] * rs * gsv[7])}; } } while (0)
          unsigned* fq = ((unsigned*)(wsp + WS_CTL)) + CW_SUBBAR + 16384 + 64 * (l * 4 + rp); unsigned* cdone = ((unsigned*)(wsp + WS_CTL)) + CW_SUBBAR + 12288 + 64 * ((l * 4 + rp) * 8);
          for (;;) {
            if (tid == 0) { const unsigned ix = __hip_atomic_fetch_add(fq, 1u, RLX_AGENT);
              if (ix < 8u * 68u) { unsigned sp = 0; while (__hip_atomic_load(cdone + 64 * (ix / 68u), RLX_AGENT) < 16u && ++sp < (1u << 22)) __builtin_amdgcn_s_sleep(2); __builtin_amdgcn_fence(__ATOMIC_ACQUIRE, "agent"); }
              MISC[16] = ix; }
            __syncthreads(); const int ix = __builtin_amdgcn_readfirstlane((int)MISC[16]); __syncthreads();
            if (ix >= 8 * 68) break;
            if (l == 1 && (ix % 68) < 4) continue;
            const int m0 = (ix / 68) * RB + (ix % 68) * 64 + 2 * wave + (lane >> 5);
            u32x4 hAA, hBA, owA, yAA, yBA, xwA, zwA, hAB, hBB, owB, yAB, yBB, xwB, zwB, hAC, hBC, owC, yAC, yBC, xwC, zwC, hAD, hBD, owD, yAD, yBD, xwD, zwD;
            FIN_LOAD(m0, A); FIN_LOAD(m0 + 16, B); FIN_LOAD(m0 + 32, C); FIN_LOAD(m0 + 48, D);
            FIN_DO(m0, A); FIN_DO(m0 + 16, B); FIN_DO(m0 + 32, C); FIN_DO(m0 + 48, D); }
#undef FIN_LOAD
#undef FIN_DO
        } }
    } }
    if (kind == 6) { PH_PROLOG if ((MK_PHSEL >> 6) & 1) for (int rp = 0; rp < nrep; ++rp) {
      { MK_STAGGER(MK_STAG6);
        pg8::Gemm g{((bf16*)(wsp + WS_Y)), (const bf16*)((wsp + WS_W + (size_t)l * W_LAYER) + WO_OUT), M, DM, DM, DM};
        const int eflags = 2 | ((rp & 1) << 2);
        if (l == 0) { pg8::EpiResid<true> E{wsp, AIN(I_X), AIN(I_CTX), AIN(I_GN2) + l * DM, l, eflags}; pg8::LatentOrder S; S.init(DM, G, bx); pg8::gemm_phase<pg8::EpiResid<true>, pg8::LatentOrder, true, true>(lds + RING_OFF, g, S, E); }
        else { pg8::EpiResid<false> E{wsp, AIN(I_X), AIN(I_CTX), AIN(I_GN2) + l * DM, l, eflags}; pg8::LatentOrder S; S.init(DM, G, bx); pg8::gemm_phase<pg8::EpiResid<false>, pg8::LatentOrder, true, true>(lds + RING_OFF, g, S, E); } }
    } }
    if (kind == 8) { PH_PROLOG if ((MK_PHSEL >> 8) & 1) for (int rp = 0; rp < nrep; ++rp) {
      { pg8::Gemm g{((bf16*)(wsp + WS_H)), (const bf16*)((wsp + WS_W + (size_t)l * W_LAYER) + WO_1), M, DFF, DM, DM}; pg8::EpiRelu2 E{((bf16*)(wsp + WS_U)), pg8::FusedNorm{(const float*)(wsp + WS_SS), (const float*)(wsp + WS_BIAS) + (size_t)(1 + l) * 9 * 4096, 1, 1, (const LAS float*)(lds + RS_OFF), 0}};
        if (!(l == 1)) {
          unsigned* octr = ((unsigned*)(wsp + WS_CTL)) + CW_SUBBAR + 8192 + 64 * rp;
          for (int ou = bx; ou < 32; ou += G) { pg8::Gemm go{((bf16*)(wsp + WS_Y)), (const bf16*)((wsp + WS_W) + WO_OUT), M, DM, DM, DM}; pg8::EpiResid<true> Eo{wsp, AIN(I_X), AIN(I_CTX), AIN(I_GN2), 0, 2};
            pg8::OneUnit So{{(ou >> 2) * 17, ou & 3}}; pg8::gemm_phase<pg8::EpiResid<true>, pg8::OneUnit, true, true>(lds + RING_OFF, go, So, Eo);
            asm volatile("s_waitcnt vmcnt(0)" ::: "memory"); __syncthreads();
            if (tid == 0) { __builtin_amdgcn_fence(__ATOMIC_RELEASE, "agent"); (void)__hip_atomic_fetch_add(octr, 1u, RLX_AGENT); }
            __syncthreads(); }
          { pg8::LimitOrder S; S.L.init(DFF, G, bx); S.lim = (G == 256 && bx < 32) ? 7 : (1 << 30); E.F.fill(S, (LAS float*)(lds + RS_OFF), tid); pg8::gemm_phase<pg8::EpiRelu2, pg8::LimitOrder, true, true>(lds + RING_OFF, g, S, E); }
          const bool ext = G == 256 && bx >= 32 && bx < 64;
          for (int cu = ext ? bx - 32 : (bx + G / 2) % G; cu < (ext ? 32 : 128); cu += G) {
            if (tid == 0) { unsigned sp = 0; while (__hip_atomic_load(octr, RLX_AGENT) < 32u && ++sp < (1u << 22)) __builtin_amdgcn_s_sleep(2); __builtin_amdgcn_fence(__ATOMIC_ACQUIRE, "agent"); asm volatile("s_waitcnt vmcnt(0)" ::: "memory"); }
            __syncthreads();
            pg8::EpiRelu2 Ec{((bf16*)(wsp + WS_U)), pg8::FusedNorm{(const float*)(wsp + WS_SS), (const float*)(wsp + WS_BIAS) + (size_t)(1 + l) * 9 * 4096, 1, 1, (const LAS float*)(lds + RS_OFF), 0}};
            pg8::OneUnit Sc{{(cu >> 4) * 17, cu & 15}}; if (ext) { pg8::LatentOrder t; t.init(DFF, G, cu); t.next(7, Sc.u); } Ec.F.fill(Sc, (LAS float*)(lds + RS_OFF), tid); pg8::gemm_phase<pg8::EpiRelu2, pg8::OneUnit, true, true>(lds + RING_OFF, g, Sc, Ec); } }
        else { pg8::LatentOrder S; S.init(DFF, G, bx); E.F.fill(S, (LAS float*)(lds + RS_OFF), tid); pg8::gemm_phase<pg8::EpiRelu2, pg8::LatentOrder, true, true>(lds + RING_OFF, g, S, E); } }
    } }
    if (kind == 9) { PH_PROLOG if ((MK_PHSEL >> 9) & 1) for (int rp = 0; rp < nrep; ++rp) {
      { MK_STAGGER(MK_STAG9);
        pg8::Gemm g{((bf16*)(wsp + WS_U)), (const bf16*)((wsp + WS_W + (size_t)l * W_LAYER) + WO_2), M, DM, DFF, DFF, 1};
        if (l == 1 && G == 256) {
          pg8::EpiFinal E{wsp, args.out, AIN(I_GFIN), (LAS float*)(lds + RS_OFF), l}; pg8::LatentOrder S; S.init(DM, G, bx); pg8::gemm_phase<pg8::EpiFinal, pg8::LatentOrder, true, true>(lds + RING_OFF, g, S, E); }
        else { pg8::EpiResid<false> E{wsp, AIN(I_X), AIN(I_CTX), AIN(I_GN1) + DM, l, 1 | ((l == 0) << 1) | ((rp & 1) << 2)};
          pg8::LatentOrder S; S.init(DM, G, bx); pg8::gemm_phase<pg8::EpiResid<false>, pg8::LatentOrder, true, true>(lds + RING_OFF, g, S, E); }
        if (l == 0) for (int sid = bx; sid < 256; sid += G) {
          const int un = sid >> 3, ks = sid & 7; pg8::Gemm gs{g.A + (size_t)ks * 8 * 16384, g.Bt + 512 * ks, M, DM, 512, DFF, 1}; pg8::OneUnit S1{{(un >> 2) * 17, un & 3}}; pg8::EpiSlab ES{((unsigned short*)(args.out)) + (size_t)sid * 65536};
          pg8::gemm_phase<pg8::EpiSlab, pg8::OneUnit, true, true>(lds + RING_OFF, gs, S1, ES); } }
    } }
  }
  if (kind == 10) { PH_PROLOG if ((MK_PHSEL >> 10) & 1) for (int rp = 0; rp < nrep; ++rp) {
    { const float* gf = AIN(I_GFIN); const bf16* XSb = (const bf16*)(wsp + WS_XS);
      for (int m = 2 * gw; m < NB * T; m += 2 * NGW) { const int b = m / T, t = m % T; const u32x2* xr = (const u32x2*)(XSb + ((size_t)b * RB + NC + t) * DM) + lane; f32x4* orow = (f32x4*)((args.out) + (size_t)m * DM) + lane;
        u32x2 w0[4], w1[4]; f32x4 v0[4], v1[4]; float s0 = 0.f, s1 = 0.f;
#pragma unroll
        for (int j = 0; j < 4; ++j) { w0[j] = xr[64 * j]; w1[j] = xr[256 + 64 * j]; }
#pragma unroll
        for (int j = 0; j < 4; ++j) { v0[j] = (f32x4){pg8::h16_lo(w0[j].x), pg8::h16_hi(w0[j].x), pg8::h16_lo(w0[j].y), pg8::h16_hi(w0[j].y)}; v1[j] = (f32x4){pg8::h16_lo(w1[j].x), pg8::h16_hi(w1[j].x), pg8::h16_lo(w1[j].y), pg8::h16_hi(w1[j].y)};
          s0 += (v0[j].x * v0[j].x + v0[j].y * v0[j].y) + (v0[j].z * v0[j].z + v0[j].w * v0[j].w); s1 += (v1[j].x * v1[j].x + v1[j].y * v1[j].y) + (v1[j].z * v1[j].z + v1[j].w * v1[j].w); }
        const float rs0 = rsqrtf(wave_sum(s0) * (1.f / DM) + EPS), rs1 = rsqrtf(wave_sum(s1) * (1.f / DM) + EPS);
#pragma unroll
        for (int j = 0; j < 4; ++j) { const f32x4 gg = ((const f32x4*)gf)[64 * j + lane]; orow[64 * j] = v0[j] * rs0 * gg; orow[256 + 64 * j] = v1[j] * rs1 * gg; } } }
  } }
  if (ph + 1 < args.ph_hi) { if (args.use_cg && ph == args.ph_lo) cooperative_groups::this_grid().sync(); else xcd_barrier(bar);
#ifdef MK_BAR_REP
    for (int q = 1; q < MK_BAR_REP; ++q) xcd_barrier(bar);
#endif
  }
  }
#undef PH_PROLOG
#undef AIN
}


static void launch(void* const* d_in, float* out, void* d_ws, hipStream_t stream, int n_launch_mode  , int n_layers) {
  static int grid = 0;
  if (grid == 0) {
    int dev = 0, cus = 0, per_cu = 0;
    (void)hipGetDevice(&dev); (void)hipDeviceGetAttribute(&cus, hipDeviceAttributeMultiprocessorCount, dev);
    (void)hipFuncSetAttribute((const void*)mk_fwd, hipFuncAttributeMaxDynamicSharedMemorySize, LDS_BYTES);
    (void)hipOccupancyMaxActiveBlocksPerMultiprocessor(&per_cu, (const void*)mk_fwd, NWAVES * 64, LDS_BYTES);
    (void)hipGetLastError();
    if (per_cu < 1) fprintf(stderr, "mk: occupancy query says %d blocks per CU\n", per_cu);
    grid = cus;
  }
  (void)hipMemsetAsync((char*)d_ws + WS_CTL, 0, CTL_ZERO_BYTES, stream);
  Args a{}; for (int i = 0; i < 25; ++i) a.in[i] = (const float*)d_in[i];
  a.out = out; a.ws = (unsigned char*)d_ws; a.n_layers = n_layers;
  for (int k = 0; k < 12; ++k) a.rep[k] = 1;
#ifdef MK_REP_MASK
  for (int k = 0; k < 12; ++k) if ((MK_REP_MASK >> k) & 1) a.rep[k] = MK_REP_N;
#endif
  const int nph = N_PHASES;
  if (n_launch_mode == 0) {
    a.ph_lo = 0; a.ph_hi = (grid == 256) ? nph - 1 : nph; a.use_cg = MK_FIRST_SEAM_CG;
    void* kargs[] = {&a};
    hipError_t e = hipLaunchCooperativeKernel((const void*)mk_fwd, dim3(grid), dim3(NWAVES * 64), kargs, LDS_BYTES, stream);
    if (e != hipSuccess) { fprintf(stderr, "mk: cooperative launch failed (%s), plain launch instead\n", hipGetErrorName(e)); (void)hipGetLastError(); a.use_cg = 0; hipLaunchKernelGGL(mk_fwd, dim3(grid), dim3(NWAVES * 64), LDS_BYTES, stream, a); }
  }
  else for (int p = 0; p < ((grid == 256) ? nph - 1 : nph); ++p) { a.ph_lo = p; a.ph_hi = p + 1; hipLaunchKernelGGL(mk_fwd, dim3(grid), dim3(NWAVES * 64), LDS_BYTES, stream, a); }
  const hipError_t le = hipPeekAtLastError(); if (le != hipSuccess) fprintf(stderr, "mk: launch failed: %s\n", hipGetErrorName(le));
}
}
extern "C" void kernel_launch(void* const* d_in, const int* in_sizes, int n_in, void* d_out, int out_size, void* d_ws, size_t ws_size, hipStream_t stream) {
  mk::launch(d_in, (float*)d_out, d_ws, stream, MK_LAUNCH_MODE, 2);
}
```
